# Optimizing an MI355X kernel written in HIP

```python
import math
import jax
import jax.numpy as jnp
from jax import lax
import numpy as np

D_MODEL = 2048
BATCH = 8
SEQ = 2048
DEPTH = 1

D_MIX = D_MODEL
D_SSM = D_MIX // 2
SSM_GROUP = 16
N_SSM_GROUPS = D_SSM // SSM_GROUP
SSM_STATE = 64
D_RWKV = D_MIX - D_SSM
RWKV_HEAD = 64
N_RWKV_HEADS = D_RWKV // RWKV_HEAD
LORA_W = 64
LORA_A = 64
LORA_G = 128
D_RWKV_IN = 3 * D_RWKV + LORA_W + LORA_A + LORA_G
D_IN = D_SSM + D_RWKV_IN
RWKV_SPLITS = (D_RWKV, 2 * D_RWKV, 3 * D_RWKV, 3 * D_RWKV + LORA_W, 3 * D_RWKV + LORA_W + LORA_A)
N_GROUPS = 8
EXPERTS_PER_GROUP = 8
N_EXPERTS = N_GROUPS * EXPERTS_PER_GROUP
TOP_K = 2
D_EXPERT = D_MODEL // 4
EXPERT_BLOCK = 256
RMS_EPS = 1e-6
GN_EPS = 64e-5
DECAY_SCALE = math.exp(-0.5)
DT_MIN = 1e-3
DT_MAX = 1e-1

kernel_name = "hymba_s5_rwkv7_hmoe_block"


def rms_norm(x, g):
    xf = x.astype(jnp.float32)
    y = xf * lax.rsqrt(jnp.mean(xf * xf, axis=-1, keepdims=True) + RMS_EPS)
    return (y * g.astype(jnp.float32)).astype(x.dtype)


def token_shift(z):
    return jnp.pad(z, ((0, 0), (1, 0), (0, 0)))[:, :-1]


def _complex_linear_recurrence(left, right):
    ar1, ai1, br1, bi1 = left
    ar2, ai2, br2, bi2 = right
    return (ar1 * ar2 - ai1 * ai2,
            ar1 * ai2 + ai1 * ar2,
            ar2 * br1 - ai2 * bi1 + br2,
            ar2 * bi1 + ai2 * br1 + bi2)


def s5_mixer(u, lam_re, lam_im, log_dt, b_re, b_im, c_re, c_im, d_skip, glu_w, glu_b):
    f32 = jnp.float32
    bsz, seqlen, _ = u.shape
    uf = u.astype(f32).reshape(bsz, seqlen, N_SSM_GROUPS, SSM_GROUP)
    lr = jnp.minimum(lam_re.astype(f32), -1e-4)
    li = lam_im.astype(f32)
    dt = jnp.exp(log_dt.astype(f32))[:, None]
    mag = jnp.exp(lr * dt)
    ar, ai = mag * jnp.cos(li * dt), mag * jnp.sin(li * dt)
    den = lr * lr + li * li
    qr = ((ar - 1.0) * lr + ai * li) / den
    qi = (ai * lr - (ar - 1.0) * li) / den
    br, bi = b_re.astype(f32), b_im.astype(f32)
    bbr = qr[..., None] * br - qi[..., None] * bi
    bbi = qr[..., None] * bi + qi[..., None] * br
    ur = jnp.einsum("blgc,gpc->lbgp", uf, bbr)
    ui = jnp.einsum("blgc,gpc->lbgp", uf, bbi)
    a_r = jnp.broadcast_to(ar[None, None], (seqlen, 1, N_SSM_GROUPS, SSM_STATE))
    a_i = jnp.broadcast_to(ai[None, None], (seqlen, 1, N_SSM_GROUPS, SSM_STATE))
    _, _, sr, si = lax.associative_scan(_complex_linear_recurrence, (a_r, a_i, ur, ui), axis=0)
    y = (jnp.einsum("lbgp,gcp->blgc", sr, c_re.astype(f32))
         - jnp.einsum("lbgp,gcp->blgc", si, c_im.astype(f32))
         + d_skip.astype(f32).reshape(N_SSM_GROUPS, SSM_GROUP) * uf)
    y = jax.nn.gelu(y.reshape(bsz, seqlen, D_SSM))
    return y * jax.nn.sigmoid(y @ glu_w.astype(f32) + glu_b.astype(f32))


def _rwkv7_step(state, inp):
    r_t, w_t, k_t, v_t, a_t, b_t = inp
    sa = jnp.einsum("bhvk,bhk->bhv", state, a_t)
    state = (state * w_t[:, :, None, :] + sa[..., None] * b_t[:, :, None, :]
             + v_t[..., None] * k_t[:, :, None, :])
    y_t = jnp.einsum("bhvk,bhk->bhv", state, r_t)
    return state, y_t


def rwkv7_mixer(z, mu, w0, w_up, a0, a_up, g_up, k_k, k_a, r_k, ln_w, ln_b):
    f32 = jnp.float32
    bsz, seqlen, _ = z.shape
    z = z.astype(f32)
    z = z + mu.astype(f32) * (token_shift(z) - z)
    r, k, v, xw, xa, xg = jnp.split(z, RWKV_SPLITS, axis=-1)
    decay = jnp.exp(-DECAY_SCALE * jax.nn.sigmoid(w0.astype(f32) + jnp.tanh(xw) @ w_up.astype(f32)))
    a = jax.nn.sigmoid(a0.astype(f32) + xa @ a_up.astype(f32))
    g = jax.nn.sigmoid(xg) @ g_up.astype(f32)

    def heads(t):
        return t.reshape(bsz, seqlen, N_RWKV_HEADS, RWKV_HEAD)

    kk = heads(k * k_k.astype(f32))
    kk = kk / jnp.maximum(jnp.sqrt(jnp.sum(kk * kk, axis=-1, keepdims=True)), 1e-12)
    k = k * (1.0 + (a - 1.0) * k_a.astype(f32))
    r_h, k_h, v_h, w_h, a_h = heads(r), heads(k), heads(v), heads(decay), heads(a)

    def tmaj(t):
        return jnp.moveaxis(t, 1, 0)

    s0 = jnp.zeros((bsz, N_RWKV_HEADS, RWKV_HEAD, RWKV_HEAD), f32)
    _, y = lax.scan(_rwkv7_step, s0,
                    (tmaj(r_h), tmaj(w_h), tmaj(k_h), tmaj(v_h), tmaj(-kk), tmaj(kk * a_h)))
    y = jnp.moveaxis(y, 0, 1)
    mean = jnp.mean(y, axis=-1, keepdims=True)
    var = jnp.mean(jnp.square(y - mean), axis=-1, keepdims=True)
    y = (y - mean) * lax.rsqrt(var + GN_EPS)
    y = y * ln_w.astype(f32).reshape(N_RWKV_HEADS, RWKV_HEAD) + ln_b.astype(f32).reshape(N_RWKV_HEADS, RWKV_HEAD)
    y = y + jnp.sum(r_h * k_h * r_k.astype(f32), axis=-1, keepdims=True) * v_h
    return y.reshape(bsz, seqlen, D_RWKV) * g


def hier_moe(h, w_grp, b_grp, w_exp, b_exp, w1, w3, w2):
    f32 = jnp.float32
    bsz, seqlen, d = h.shape
    n_tok = bsz * seqlen
    xt = h.reshape(n_tok, d)
    grp_prob = jax.nn.softmax((xt @ w_grp + b_grp).astype(f32), axis=-1)
    p_grp, grp_idx = lax.top_k(grp_prob, 1)
    exp_logits = (xt @ w_exp + b_exp).astype(f32).reshape(n_tok, N_GROUPS, EXPERTS_PER_GROUP)
    within = jnp.take_along_axis(exp_logits, grp_idx[:, :, None], axis=1)[:, 0]
    p_exp, exp_local = lax.top_k(jax.nn.softmax(within, axis=-1), TOP_K)
    p_exp = p_exp / jnp.sum(p_exp, axis=-1, keepdims=True)
    gate_w = p_grp * p_exp
    expert_id = grp_idx * EXPERTS_PER_GROUP + exp_local

    n_slots = n_tok * TOP_K
    flat_e = expert_id.reshape(n_slots).astype(jnp.int32)
    flat_tok = jnp.repeat(jnp.arange(n_tok, dtype=jnp.int32), TOP_K)
    order = jnp.argsort(flat_e, stable=True)
    sorted_e = flat_e[order]
    counts = jnp.zeros((N_EXPERTS,), jnp.int32).at[flat_e].add(1)
    padded = (counts + EXPERT_BLOCK - 1) // EXPERT_BLOCK * EXPERT_BLOCK
    start = jnp.cumsum(counts) - counts
    pend = jnp.cumsum(padded)
    pstart = pend - padded
    dest_sorted = pstart[sorted_e] + (jnp.arange(n_slots, dtype=jnp.int32) - start[sorted_e])
    n_blocks = -(-n_slots // EXPERT_BLOCK) + N_EXPERTS
    cap = n_blocks * EXPERT_BLOCK
    slot_tok = jnp.full((cap,), n_tok, jnp.int32).at[dest_sorted].set(flat_tok[order])
    x_pad = jnp.concatenate([xt, jnp.zeros((1, d), xt.dtype)], axis=0)
    x_buf = x_pad[slot_tok].reshape(n_blocks, EXPERT_BLOCK, d)
    block_e = jnp.minimum(
        jnp.searchsorted(pend, jnp.arange(n_blocks, dtype=jnp.int32) * EXPERT_BLOCK, side="right"),
        N_EXPERTS - 1)

    def expert_block(args):
        xb, e = args
        hid = jax.nn.silu(xb @ w1[e]) * (xb @ w3[e])
        return hid @ w2[e]

    y_buf = lax.map(expert_block, (x_buf, block_e)).reshape(cap, d)
    dest_slot = jnp.zeros((n_slots,), jnp.int32).at[order].set(dest_sorted)
    y_slots = y_buf[dest_slot].reshape(n_tok, TOP_K, d)
    y = jnp.einsum("nk,nkd->nd", gate_w.astype(y_slots.dtype), y_slots)
    return y.reshape(bsz, seqlen, d)


def setup_inputs(seed: int = 0) -> dict:
    key = jax.random.key(seed)
    keys = iter(jax.random.split(key, 48))
    f32 = jnp.float32

    def nrm(shape, scale):
        return jax.random.normal(next(keys), shape, f32) * scale

    def unif(shape, lo, hi):
        return jax.random.uniform(next(keys), shape, f32, lo, hi)

    nl = DEPTH
    g, p, cg = N_SSM_GROUPS, SSM_STATE, SSM_GROUP
    n_idx = jnp.arange(p, dtype=f32)
    return {
        "x": nrm((BATCH, SEQ, D_MODEL), 1.0),
        "c": nrm((BATCH, D_MODEL), 1.0),
        "ada_w": nrm((nl, D_MODEL, 6 * D_MODEL), 0.5 * D_MODEL ** -0.5),
        "ada_b": nrm((nl, 6 * D_MODEL), 0.02),
        "norm_mix_pre": 1.0 + nrm((nl, D_MODEL), 0.02),
        "norm_mix_post": 1.0 + nrm((nl, D_MODEL), 0.02),
        "norm_ffn_pre": 1.0 + nrm((nl, D_MODEL), 0.02),
        "norm_ffn_post": 1.0 + nrm((nl, D_MODEL), 0.02),
        "w_in": nrm((nl, D_MODEL, D_IN), D_MODEL ** -0.5),
        "w_out": nrm((nl, D_MIX, D_MODEL), D_MIX ** -0.5),
        "ssm_lam_re": -0.5 + nrm((nl, g, p), 0.01),
        "ssm_lam_im": math.pi * n_idx + nrm((nl, g, p), 0.01),
        "ssm_log_dt": unif((nl, g), math.log(DT_MIN), math.log(DT_MAX)),
        "ssm_b_re": nrm((nl, g, p, cg), (2 * cg) ** -0.5),
        "ssm_b_im": nrm((nl, g, p, cg), (2 * cg) ** -0.5),
        "ssm_c_re": nrm((nl, g, cg, p), (2 * p) ** -0.5),
        "ssm_c_im": nrm((nl, g, cg, p), (2 * p) ** -0.5),
        "ssm_d": nrm((nl, D_SSM), 1.0),
        "glu_w": nrm((nl, D_SSM, D_SSM), D_SSM ** -0.5),
        "glu_b": nrm((nl, D_SSM), 0.02),
        "rwkv_mu": unif((nl, D_RWKV_IN), 0.0, 1.0),
        "rwkv_w0": unif((nl, D_RWKV), -6.0, 1.0),
        "rwkv_w_up": nrm((nl, LORA_W, D_RWKV), 0.5 * LORA_W ** -0.5),
        "rwkv_a0": nrm((nl, D_RWKV), 0.1),
        "rwkv_a_up": nrm((nl, LORA_A, D_RWKV), 0.5 * LORA_A ** -0.5),
        "rwkv_g_up": nrm((nl, LORA_G, D_RWKV), LORA_G ** -0.5),
        "rwkv_k_k": 0.85 + nrm((nl, D_RWKV), 0.05),
        "rwkv_k_a": 1.0 + nrm((nl, D_RWKV), 0.05),
        "rwkv_r_k": nrm((nl, N_RWKV_HEADS, RWKV_HEAD), 0.1),
        "rwkv_ln_w": 1.0 + nrm((nl, D_RWKV), 0.02),
        "rwkv_ln_b": nrm((nl, D_RWKV), 0.02),
        "moe_w_grp": nrm((nl, D_MODEL, N_GROUPS), D_MODEL ** -0.5),
        "moe_b_grp": nrm((nl, N_GROUPS), 0.01),
        "moe_w_exp": nrm((nl, D_MODEL, N_EXPERTS), D_MODEL ** -0.5),
        "moe_b_exp": nrm((nl, N_EXPERTS), 0.01),
        "moe_w1": nrm((nl, N_EXPERTS, D_MODEL, D_EXPERT), D_MODEL ** -0.5),
        "moe_w3": nrm((nl, N_EXPERTS, D_MODEL, D_EXPERT), D_MODEL ** -0.5),
        "moe_w2": nrm((nl, N_EXPERTS, D_EXPERT, D_MODEL), D_EXPERT ** -0.5),
    }


def reference(x, c, ada_w, ada_b, norm_mix_pre, norm_mix_post, norm_ffn_pre, norm_ffn_post,
              w_in, w_out, ssm_lam_re, ssm_lam_im, ssm_log_dt, ssm_b_re, ssm_b_im, ssm_c_re, ssm_c_im,
              ssm_d, glu_w, glu_b, rwkv_mu, rwkv_w0, rwkv_w_up, rwkv_a0, rwkv_a_up, rwkv_g_up,
              rwkv_k_k, rwkv_k_a, rwkv_r_k, rwkv_ln_w, rwkv_ln_b, moe_w_grp, moe_b_grp, moe_w_exp,
              moe_b_exp, moe_w1, moe_w3, moe_w2):
    cond = jax.nn.silu(c)
    for l in range(DEPTH):
        mod = cond @ ada_w[l] + ada_b[l]
        sh1, sc1, gt1, sh2, sc2, gt2 = [m[:, None, :] for m in jnp.split(mod, 6, axis=-1)]

        h = rms_norm(x, norm_mix_pre[l]) * (1.0 + sc1) + sh1
        proj = h @ w_in[l]
        y_ssm = s5_mixer(proj[..., :D_SSM], ssm_lam_re[l], ssm_lam_im[l], ssm_log_dt[l],
                         ssm_b_re[l], ssm_b_im[l], ssm_c_re[l], ssm_c_im[l], ssm_d[l],
                         glu_w[l], glu_b[l])
        y_rwkv = rwkv7_mixer(proj[..., D_SSM:], rwkv_mu[l], rwkv_w0[l], rwkv_w_up[l], rwkv_a0[l],
                             rwkv_a_up[l], rwkv_g_up[l], rwkv_k_k[l], rwkv_k_a[l], rwkv_r_k[l],
                             rwkv_ln_w[l], rwkv_ln_b[l])
        mixed = jnp.concatenate([y_ssm.astype(x.dtype), y_rwkv.astype(x.dtype)], axis=-1) @ w_out[l]
        x = x + gt1 * rms_norm(mixed, norm_mix_post[l])

        h = rms_norm(x, norm_ffn_pre[l]) * (1.0 + sc2) + sh2
        ffn = hier_moe(h, moe_w_grp[l], moe_b_grp[l], moe_w_exp[l], moe_b_exp[l],
                       moe_w1[l], moe_w3[l], moe_w2[l])
        x = x + gt2 * rms_norm(ffn.astype(x.dtype), norm_ffn_post[l])
    return x
```

```cpp
#include <hip/hip_runtime.h>
#include <cstdio>
#include <cstdint>

#ifndef MK_N_LAUNCHES
#define MK_N_LAUNCHES 0
#endif

namespace pg8 {
#define PG8_LAS __attribute__((address_space(3)))
typedef unsigned short bf16_t;
typedef short bf16x8 __attribute__((ext_vector_type(8)));
typedef float f32x4 __attribute__((ext_vector_type(4)));
typedef float f32x2 __attribute__((ext_vector_type(2)));
typedef unsigned u32x4 __attribute__((ext_vector_type(4)));
typedef unsigned u32x2 __attribute__((ext_vector_type(2)));
constexpr int BM = 256, BK = 64, HALF = 128, HTB = HALF * BK * 2, STAGE_BYTES = 8 * HTB, NXCD = 8, WGM = 8;

__host__ __device__ __forceinline__ int lds_byte(int r, int c) { const int st = (r >> 4) * 2 + (c >> 5), rr = r & 15, cc = c & 31, ob = rr * 64 + cc * 2; return st * 1024 + (ob ^ (((ob >> 9) & 1) << 5)); }
__host__ __device__ __forceinline__ void stage_rc(int b, int& R, int& C) { const int st = b / 1024, sb = b % 1024, swz = sb ^ (((sb >> 9) & 1) << 5); R = (st >> 1) * 16 + swz / 64; C = (st & 1) * 32 + (swz % 64) / 2; }
__host__ __device__ __forceinline__ int perm32(int rho) { const int n = rho >> 4, i = rho & 15; return 8 * (i >> 2) + 4 * n + (i & 3); }

struct Unit { int pm, pn, e, cnt; const char* Ab; const char* Bb; };
struct Gemm { const bf16_t* A; const bf16_t* Bt; int M, N, K; };

struct StaticOrder {
    static constexpr bool GATHER = false;
    int nM, nN, nwg, G, c, K; const char* A; const char* Bt;
    __device__ void init(const Gemm& g, int G_, int c_) { nM = g.M / BM; nN = g.N / BM; nwg = nM * nN; G = G_; c = c_; K = g.K; A = (const char*)g.A; Bt = (const char*)g.Bt; }
    __device__ bool next(int i, Unit& u) const {
        const long L = (long)i * G + c; if (L >= nwg) return false;
        int wgid = (int)L; { const int q = nwg / NXCD, r = nwg % NXCD, xcd = wgid % NXCD, off = wgid / NXCD; wgid = (xcd < r ? xcd * (q + 1) : r * (q + 1) + (xcd - r) * q) + off; }
        const int nig = WGM * nN, gid = wgid / nig, fm = gid * WGM, gsz = (nM - fm) < WGM ? (nM - fm) : WGM;
        u.pm = fm + ((wgid % nig) % gsz); u.pn = (wgid % nig) / gsz; u.e = 0; u.cnt = BM;
        u.Ab = A + (size_t)u.pm * BM * K * 2; u.Bb = Bt + (size_t)u.pn * BM * K * 2; return true;
    }
    template <int NV> __device__ __forceinline__ void a_voff(const Unit&, unsigned (&v)[NV][2], const int (&R)[2], const int (&C)[2]) const {
#pragma unroll
        for (int i = 0; i < 2; ++i) v[0][i] = (unsigned)(R[i] * K + C[i]) * 2u;
    }
};

__device__ __forceinline__ unsigned cvt_pk_bf16(float lo, float hi) { unsigned r; asm volatile("v_cvt_pk_bf16_f32 %0, %1, %2" : "=v"(r) : "v"(lo), "v"(hi)); return r; }
__device__ __forceinline__ float bf_lo(unsigned w) { return __uint_as_float(w << 16); }
__device__ __forceinline__ float bf_hi(unsigned w) { return __uint_as_float(w & 0xffff0000u); }
__device__ __forceinline__ float sigmoidf_(float x) { return 1.0f / (1.0f + __expf(-x)); }

struct EpiF32 {
    static constexpr bool PERM = false;
    float* C; int ldc;
    __device__ __forceinline__ void operator()(const f32x4 (&acc)[2][2][4][2], const Unit& u, int wr, int wc, int fr, int fq) const {
        const int row0 = u.pm * BM + wr * 64 + fr, col0 = u.pn * BM + wc * 32 + 4 * fq;
#pragma unroll
        for (int ai = 0; ai < 2; ++ai)
#pragma unroll
            for (int m = 0; m < 4; ++m) { float* rowp = C + (size_t)(row0 + ai * HALF + m * 16) * ldc + col0;
#pragma unroll
                for (int bj = 0; bj < 2; ++bj)
#pragma unroll
                    for (int n = 0; n < 2; ++n) *(f32x4*)(rowp + bj * HALF + n * 16) = acc[ai][bj][m][n]; }
    }
};
struct EpiBf16 {
    static constexpr bool PERM = true;
    bf16_t* O; int ldc;
    __device__ __forceinline__ void operator()(const f32x4 (&acc)[2][2][4][2], const Unit& u, int wr, int wc, int fr, int fq) const {
        const int row0 = u.pm * BM + wr * 64 + fr, col0 = u.pn * BM + wc * 32 + 8 * fq;
#pragma unroll
        for (int ai = 0; ai < 2; ++ai)
#pragma unroll
            for (int m = 0; m < 4; ++m) { bf16_t* rowp = O + (size_t)(row0 + ai * HALF + m * 16) * ldc + col0;
#pragma unroll
                for (int bj = 0; bj < 2; ++bj) { const f32x4 v0 = acc[ai][bj][m][0], v1 = acc[ai][bj][m][1];
                    u32x4 w; w.x = cvt_pk_bf16(v0[0], v0[1]); w.y = cvt_pk_bf16(v0[2], v0[3]); w.z = cvt_pk_bf16(v1[0], v1[1]); w.w = cvt_pk_bf16(v1[2], v1[3]);
                    *(u32x4*)(rowp + bj * HALF) = w; } }
    }
};
struct EpiLora {
    static constexpr bool PERM = false;
    float* base; size_t stride; const float* w0; const float* a0;
    __device__ __forceinline__ void operator()(const f32x4 (&acc)[2][2][4][2], const Unit& u, int wr, int wc, int fr, int fq) const {
        const int row0 = u.pm * BM + wr * 64 + fr; const int kind = u.pn >> 2; const int col0 = (u.pn & 3) * BM + wc * 32 + 4 * fq;
        float* dst = base + (size_t)kind * stride;
        const float* bp = (kind == 0) ? w0 : a0; const float bs = (kind == 2) ? 0.f : 1.f;
        f32x4 bv[2][2];
#pragma unroll
        for (int bj = 0; bj < 2; ++bj)
#pragma unroll
            for (int n = 0; n < 2; ++n) bv[bj][n] = *(const f32x4*)(bp + col0 + bj * HALF + n * 16) * bs;
#pragma unroll
        for (int ai = 0; ai < 2; ++ai)
#pragma unroll
            for (int m = 0; m < 4; ++m) { float* rowp = dst + (size_t)(row0 + ai * HALF + m * 16) * 1024 + col0;
#pragma unroll
                for (int bj = 0; bj < 2; ++bj)
#pragma unroll
                    for (int n = 0; n < 2; ++n) { f32x4 v = acc[ai][bj][m][n] + bv[bj][n];
                        if (kind == 0) {
#pragma unroll
                            for (int j = 0; j < 4; ++j) v[j] = __expf(-0.6065306597126334f * sigmoidf_(v[j])); }
                        else if (kind == 1) {
#pragma unroll
                            for (int j = 0; j < 4; ++j) v[j] = sigmoidf_(v[j]); }
                        *(f32x4*)(rowp + bj * HALF + n * 16) = v; } }
    }
};
struct EpiGlu {
    static constexpr bool PERM = true;
    const bf16_t* Y; bf16_t* O; int ldo; const float* bias;
    __device__ __forceinline__ void operator()(const f32x4 (&acc)[2][2][4][2], const Unit& u, int wr, int wc, int fr, int fq) const {
        const int row0 = u.pm * BM + wr * 64 + fr, col0 = u.pn * BM + wc * 32 + 8 * fq;
        f32x4 bv[2][2];
#pragma unroll
        for (int bj = 0; bj < 2; ++bj)
#pragma unroll
            for (int n = 0; n < 2; ++n) bv[bj][n] = *(const f32x4*)(bias + col0 + bj * HALF + 4 * n);
#pragma unroll
        for (int ai = 0; ai < 2; ++ai)
#pragma unroll
            for (int m = 0; m < 4; ++m) { const size_t r = (size_t)(row0 + ai * HALF + m * 16);
#pragma unroll
                for (int bj = 0; bj < 2; ++bj) { const u32x4 yv = *(const u32x4*)(Y + r * 1024 + col0 + bj * HALF);
                    const f32x4 v0 = acc[ai][bj][m][0] + bv[bj][0], v1 = acc[ai][bj][m][1] + bv[bj][1];
                    u32x4 w;
                    w.x = cvt_pk_bf16(bf_lo(yv.x) * sigmoidf_(v0[0]), bf_hi(yv.x) * sigmoidf_(v0[1]));
                    w.y = cvt_pk_bf16(bf_lo(yv.y) * sigmoidf_(v0[2]), bf_hi(yv.y) * sigmoidf_(v0[3]));
                    w.z = cvt_pk_bf16(bf_lo(yv.z) * sigmoidf_(v1[0]), bf_hi(yv.z) * sigmoidf_(v1[1]));
                    w.w = cvt_pk_bf16(bf_lo(yv.w) * sigmoidf_(v1[2]), bf_hi(yv.w) * sigmoidf_(v1[3]));
                    *(u32x4*)(O + r * ldo + col0 + bj * HALF) = w; } }
    }
};
struct EpiSwiglu {
    static constexpr bool PERM = true;
    bf16_t* Hd;
    __device__ __forceinline__ void operator()(const f32x4 (&acc)[2][2][4][2], const Unit& u, int wr, int wc, int fr, int fq) const {
        const int row0 = u.pm * BM + wr * 64 + fr, col0 = u.pn * HALF + wc * 32 + 8 * fq;
#pragma unroll
        for (int ai = 0; ai < 2; ++ai)
#pragma unroll
            for (int m = 0; m < 4; ++m) { bf16_t* rowp = Hd + (size_t)(row0 + ai * HALF + m * 16) * 512 + col0;
                float o[8];
#pragma unroll
                for (int n = 0; n < 2; ++n)
#pragma unroll
                    for (int j = 0; j < 4; ++j) { const float a = acc[ai][0][m][n][j], b = acc[ai][1][m][n][j]; o[n * 4 + j] = a * sigmoidf_(a) * b; }
                u32x4 w; w.x = cvt_pk_bf16(o[0], o[1]); w.y = cvt_pk_bf16(o[2], o[3]); w.z = cvt_pk_bf16(o[4], o[5]); w.w = cvt_pk_bf16(o[6], o[7]);
                *(u32x4*)rowp = w; }
    }
};

template <class Epi, class Sched>
__device__ __forceinline__ void gemm_phase(PG8_LAS unsigned char* lds, const int K, const Sched& S, const Epi& E) {
    const int tid = threadIdx.x, wid = __builtin_amdgcn_readfirstlane(tid >> 6), lane = tid & 63, wr = wid >> 2, wc = wid & 3, fr = lane & 15, fq = lane >> 4;
    const int nt = K / BK;
    int RR[2], CC[2]; unsigned voffB[2];
#pragma unroll
    for (int i = 0; i < 2; ++i) { stage_rc(tid * 16 + i * 8192, RR[i], CC[i]); const int Rb = Epi::PERM ? ((RR[i] & ~31) + perm32(RR[i] & 31)) : RR[i];
        voffB[i] = (unsigned)(Rb * K + CC[i]) * 2u; }
    const size_t kstep = (size_t)(BK * 2);
    const size_t hstep = (size_t)HALF * K * 2;
    const unsigned ldsw = (unsigned)wid * 1024u;
    const int aoff = lds_byte(wr * 64 + fr, fq * 8), boff = lds_byte(wc * 32 + fr, fq * 8);
#define PG8_SA(b, h) (((b) * 2 + (h)) * HTB)
#define PG8_SB(b, h) ((4 + (b) * 2 + (h)) * HTB)
#define PG8_STAGE(bufoff, gbase, voff) do { _Pragma("unroll") for (int _i = 0; _i < 2; ++_i) \
        __builtin_amdgcn_global_load_lds((const unsigned*)((const char*)(gbase) + (voff)[_i]), (PG8_LAS unsigned*)(lds + (bufoff) + ldsw + _i * 8192), 16, 0, 0); } while (0)
#define PG8_LDA(dst, b, h) do { _Pragma("unroll") for (int m = 0; m < 4; ++m) _Pragma("unroll") for (int k = 0; k < 2; ++k) dst[m][k] = *(const PG8_LAS bf16x8*)(lds + PG8_SA(b, h) + aoff + m * 2048 + k * 1024); } while (0)
#define PG8_LDB(dst, b, h) do { _Pragma("unroll") for (int n = 0; n < 2; ++n) _Pragma("unroll") for (int k = 0; k < 2; ++k) dst[n][k] = *(const PG8_LAS bf16x8*)(lds + PG8_SB(b, h) + boff + n * 2048 + k * 1024); } while (0)
#define PG8_MMA(ai, bj, At, Bt) do { __builtin_amdgcn_s_setprio(1); _Pragma("unroll") for (int m = 0; m < 4; ++m) _Pragma("unroll") for (int n = 0; n < 2; ++n) _Pragma("unroll") for (int k = 0; k < 2; ++k) \
        acc[ai][bj][m][n] = __builtin_amdgcn_mfma_f32_16x16x32_bf16(Bt[n][k], At[m][k], acc[ai][bj][m][n], 0, 0, 0); __builtin_amdgcn_s_setprio(0); } while (0)
#define PG8_WAIT_V(n) asm volatile("s_waitcnt vmcnt(" #n ")" ::: "memory")
#define PG8_WAIT_L(n) asm volatile("s_waitcnt lgkmcnt(" #n ")" ::: "memory")
#define PG8_BAR __builtin_amdgcn_s_barrier()
#define PG8_SCHED __builtin_amdgcn_sched_barrier(0)
    Unit cur, nxt; int ui = 0;
    if (!S.next(0, cur)) return;
    f32x4 acc[2][2][4][2];
#pragma unroll
    for (int a = 0; a < 2; ++a)
#pragma unroll
        for (int b = 0; b < 2; ++b)
#pragma unroll
            for (int m = 0; m < 4; ++m)
#pragma unroll
                for (int n = 0; n < 2; ++n) acc[a][b][m][n] = (f32x4){0.f, 0.f, 0.f, 0.f};
    bf16x8 At[4][2], B0[2][2], B1[2][2];
    constexpr bool GA = Sched::GATHER;
    constexpr int NV = GA ? 2 : 1;
    unsigned vA[NV][2], vN[NV][2];
    const size_t hstepA = GA ? 0 : hstep;
    S.template a_voff<NV>(cur, vA, RR, CC);
    const char* cA = cur.Ab; const char* cB = cur.Bb;
    PG8_STAGE(PG8_SB(0, 0), cB, voffB); PG8_STAGE(PG8_SB(0, 1), cB + hstep, voffB); PG8_STAGE(PG8_SA(0, 0), cA, vA[0]); PG8_STAGE(PG8_SA(0, 1), cA + hstepA, vA[NV - 1]);
    if (wr == 1) PG8_BAR;
    PG8_WAIT_V(2); PG8_BAR;
    PG8_STAGE(PG8_SB(1, 0), cB + kstep, voffB); PG8_STAGE(PG8_SA(1, 0), cA + kstep, vA[0]); PG8_STAGE(PG8_SB(1, 1), cB + hstep + kstep, voffB);
    PG8_WAIT_V(6); PG8_BAR;
    for (;;) {
        const bool has_next = S.next(ui + 1, nxt);
        const char* nA = has_next ? nxt.Ab : cA; const char* nB = has_next ? nxt.Bb : cB;
        if constexpr (GA) {
            if (has_next) S.template a_voff<NV>(nxt, vN, RR, CC);
            else {
#pragma unroll
                for (int h = 0; h < NV; ++h)
#pragma unroll
                    for (int i = 0; i < 2; ++i) vN[h][i] = vA[h][i]; }
        }
        for (int t = 0; t < nt; t += 2) {
            const bool last = (t == nt - 2);
            const char* a1 = cA + (size_t)(t + 1) * kstep;
            const char* a2 = last ? nA : cA + (size_t)(t + 2) * kstep; const char* b2 = last ? nB : cB + (size_t)(t + 2) * kstep;
            const char* a3 = a2 + kstep; const char* b3 = b2 + kstep;
            unsigned v2[NV][2];
#pragma unroll
            for (int h = 0; h < NV; ++h)
#pragma unroll
                for (int i = 0; i < 2; ++i) v2[h][i] = (GA && last) ? vN[h][i] : vA[h][i];
            PG8_LDB(B0, 0, 0); PG8_LDB(B1, 0, 1); PG8_SCHED; PG8_LDA(At, 0, 0); PG8_STAGE(PG8_SA(1, 1), a1 + hstepA, vA[NV - 1]);
            PG8_WAIT_V(8); PG8_WAIT_L(0); PG8_BAR; PG8_MMA(0, 0, At, B0); PG8_MMA(0, 1, At, B1); PG8_BAR; PG8_SCHED;
            PG8_LDA(At, 0, 1); PG8_STAGE(PG8_SB(0, 0), b2, voffB); PG8_STAGE(PG8_SB(0, 1), b2 + hstep, voffB); PG8_STAGE(PG8_SA(0, 0), a2, v2[0]);
            PG8_WAIT_V(8); PG8_WAIT_L(0); PG8_BAR; PG8_MMA(1, 0, At, B0); PG8_MMA(1, 1, At, B1); PG8_BAR; PG8_SCHED;
            PG8_LDB(B0, 1, 0); PG8_LDB(B1, 1, 1); PG8_SCHED; PG8_LDA(At, 1, 0); PG8_STAGE(PG8_SA(0, 1), a2 + hstepA, v2[NV - 1]);
            PG8_WAIT_V(8); PG8_WAIT_L(0); PG8_BAR; PG8_MMA(0, 0, At, B0); PG8_MMA(0, 1, At, B1); PG8_BAR; PG8_SCHED;
            PG8_LDA(At, 1, 1); PG8_STAGE(PG8_SB(1, 0), b3, voffB); PG8_STAGE(PG8_SB(1, 1), b3 + hstep, voffB); PG8_STAGE(PG8_SA(1, 0), a3, v2[0]);
            PG8_WAIT_V(8); PG8_WAIT_L(0); PG8_BAR; PG8_MMA(1, 0, At, B0); PG8_MMA(1, 1, At, B1); PG8_BAR; PG8_SCHED;
        }
        if (wr == 0) PG8_BAR;
        E(acc, cur, wr, wc, fr, fq);
        if (!has_next) break;
#pragma unroll
        for (int a = 0; a < 2; ++a)
#pragma unroll
            for (int b = 0; b < 2; ++b)
#pragma unroll
                for (int m = 0; m < 4; ++m)
#pragma unroll
                    for (int n = 0; n < 2; ++n) acc[a][b][m][n] = (f32x4){0.f, 0.f, 0.f, 0.f};
        cur = nxt; cA = nA; cB = nB; ++ui;
        if constexpr (GA) {
#pragma unroll
            for (int h = 0; h < NV; ++h)
#pragma unroll
                for (int i = 0; i < 2; ++i) vA[h][i] = vN[h][i]; }
        if (wr == 1) PG8_BAR;
    }
    PG8_WAIT_V(0);
    PG8_BAR;
#undef PG8_SA
#undef PG8_SB
#undef PG8_STAGE
#undef PG8_LDA
#undef PG8_LDB
#undef PG8_MMA
#undef PG8_WAIT_V
#undef PG8_WAIT_L
#undef PG8_BAR
#undef PG8_SCHED
}
}
using pg8::f32x4; using pg8::f32x2; using pg8::u32x4; using pg8::u32x2; using pg8::cvt_pk_bf16; using pg8::bf_lo; using pg8::bf_hi; using pg8::sigmoidf_;

constexpr int NWAVES = 8, NTHR = 512;
constexpr int DM = 2048, NB = 8, SEQ = 2048, NT = NB * SEQ;
constexpr int DSSM = 1024, NG = 64, GC = 16, NP = 64;
constexpr int DRW = 1024, NH = 16, HD = 64;
constexpr int DIN = 4352, ZW = 3328;
constexpr int NEXP = 64, DEXP = 512, NMOD = 6 * DM;
constexpr float RMS_EPS = 1e-6f, GN_EPS = 64e-5f;
constexpr int CAP_ROWS = 49152;

constexpr size_t MiB = 1u << 20;
constexpr size_t WS_CTL = 0, CTL_ZERO_BYTES = 1 * MiB;
constexpr size_t WS_MOD = 1 * MiB;
constexpr size_t WS_RWT = 1 * MiB + 512 * 1024;
constexpr size_t WS_LORA_T = 2 * MiB + 512 * 1024;
constexpr size_t WS_GLU_T = 4 * MiB;
constexpr size_t WS_WOUT_T = 6 * MiB;
constexpr size_t WS_WIN_T = 14 * MiB;
constexpr size_t WS_TOKINFO = 31 * MiB;
constexpr size_t WS_LIST = 32 * MiB;
constexpr size_t WS_LIN = 36 * MiB;
constexpr size_t WS_H = 44 * MiB;
constexpr size_t WS_PROJ = 108 * MiB;
constexpr size_t WS_MIX = 244 * MiB;
constexpr size_t WS_SC = 308 * MiB;
constexpr size_t SC_STRIDE = 64 * MiB;
constexpr size_t WS_YSG = 884 * MiB;
constexpr size_t WS_END = 916 * MiB;
constexpr size_t WS_MIXED = 108 * MiB;
constexpr size_t WS_X1 = 308 * MiB;
constexpr size_t WS_EW1 = 436 * MiB;
constexpr size_t WS_EW2 = 692 * MiB;
constexpr size_t WS_HID = 820 * MiB;
constexpr size_t WS_YSLOT = 108 * MiB;
static_assert(WS_YSLOT + (size_t)CAP_ROWS * 2048 * 2 <= WS_SC, "yslot overlay");
static_assert(WS_HID + (size_t)CAP_ROWS * 512 * 2 <= WS_END, "hid");
constexpr int CW_TMO = 0;
constexpr int CW_BAR = 4096;
constexpr int CW_CNT = 16384;

constexpr int RING_BYTES = 131072;
constexpr int LDSCTL_OFF = RING_BYTES;
constexpr int MISC_OFF = LDSCTL_OFF;
constexpr int TP_OFF = LDSCTL_OFF + 256;
constexpr int LDS_BYTES = 147456;

#define GAS __attribute__((address_space(1)))
#define LAS __attribute__((address_space(3)))
typedef unsigned short bf16;
typedef GAS unsigned gu32;
#define RLX_AGENT __ATOMIC_RELAXED, __HIP_MEMORY_SCOPE_AGENT

#define XB_TMO      128
#define XB_XCNT(j)  (256  + 64 * (j))
#define XB_XSUB(j)  (1280 + 64 * (j))
#define XB_XGEN(j)  (2304 + 64 * (j))
#define XB_TOP      3328
#define XB_TOPGEN   3392
#define XCD_BAR_WORDS 3456
#define XB_SPIN_CAP (1u << 18)
__device__ __forceinline__ unsigned xb_ld(unsigned* p)              { return __hip_atomic_load(p, __ATOMIC_RELAXED, __HIP_MEMORY_SCOPE_AGENT); }
__device__ __forceinline__ unsigned xb_add(unsigned* p, unsigned v) { return __hip_atomic_fetch_add(p, v, __ATOMIC_RELAXED, __HIP_MEMORY_SCOPE_AGENT); }
__device__ __forceinline__ unsigned xb_xcc_id() { return (unsigned)__builtin_amdgcn_s_getreg((3 << 11) | 20) & 0xFu; }
#define XB_SPIN(cond, bar) do { unsigned _sp = 0; while (cond) { __builtin_amdgcn_s_sleep(1); \
    if ((++_sp & 255u) == 0u) { if (xb_ld(&(bar)[XB_TMO])) break; if (_sp > XB_SPIN_CAP) { atomicAdd(&(bar)[XB_TMO], 1u); break; } } } } while (0)
struct XcdBarrier { unsigned* bar; unsigned x; volatile LAS unsigned* st; };
__device__ __forceinline__ XcdBarrier xcd_barrier_post(unsigned* bar, volatile LAS unsigned* st) {
    XcdBarrier b; b.bar = bar; b.x = xb_xcc_id(); b.st = st;
    if (threadIdx.x == 0) (void)xb_add(&bar[XB_XCNT(b.x)], 1u);
    return b;
}
__device__ __forceinline__ void xcd_barrier_complete(unsigned* bar, unsigned x, unsigned& nloc, unsigned& nx) {
    const unsigned G = gridDim.x * gridDim.y * gridDim.z;
    unsigned sum, cnt, mine, sp = 0u;
    for (;;) {
        sum = 0u; cnt = 0u; mine = 0u;
#pragma unroll
        for (unsigned j = 0; j < 16; ++j) { const unsigned c = xb_ld(&bar[XB_XCNT(j)]); sum += c; cnt += (c > 0u) ? 1u : 0u; mine = (j == x) ? c : mine; }
        if (sum == G) break;
        __builtin_amdgcn_s_sleep(1);
        if ((++sp & 255u) == 0u) { if (xb_ld(&bar[XB_TMO])) break; if (sp > XB_SPIN_CAP) { atomicAdd(&bar[XB_TMO], 1u); break; } }
    }
    nloc = mine > 0u ? mine : 1u; nx = cnt > 0u ? cnt : 1u;
}
__device__ __forceinline__ void xcd_barrier(const XcdBarrier& b) {
    asm volatile("s_waitcnt vmcnt(0)" ::: "memory");
    __syncthreads();
    if (threadIdx.x == 0) {
        unsigned* bar = b.bar;
        __builtin_amdgcn_s_waitcnt(0);
        unsigned nloc = b.st[0], nx = b.st[1];
        if (nloc == 0u) { xcd_barrier_complete(bar, b.x, nloc, nx); b.st[0] = nloc; b.st[1] = nx; }
        const unsigned old = xb_add(&bar[XB_XSUB(b.x)], 1u);
        const unsigned gen = old / nloc;
        if (old + 1u == (gen + 1u) * nloc) {
            __builtin_amdgcn_fence(__ATOMIC_RELEASE, "agent");
            asm volatile("s_waitcnt vmcnt(0)" ::: "memory");
            const unsigned og = xb_add(&bar[XB_TOP], 1u);
            const unsigned tg = og / nx;
            if (og + 1u == (tg + 1u) * nx) xb_add(&bar[XB_TOPGEN], 1u);
            else XB_SPIN(xb_ld(&bar[XB_TOPGEN]) == tg, bar);
            __builtin_amdgcn_fence(__ATOMIC_ACQUIRE, "agent");
            xb_add(&bar[XB_XGEN(b.x)], 1u);
            asm volatile("s_waitcnt vmcnt(0)" ::: "memory");
        } else {
            XB_SPIN(xb_ld(&bar[XB_XGEN(b.x)]) == gen, bar);
            __builtin_amdgcn_fence(__ATOMIC_ACQUIRE, "agent");
            asm volatile("s_waitcnt vmcnt(0)" ::: "memory");
        }
    }
    __syncthreads();
}

struct Args { const float* in[38]; float* out; unsigned char* ws; int ph_lo, ph_hi; };
typedef const float* cfp_t;
typedef __attribute__((address_space(4))) const unsigned char* kargp_t;
struct InTab { kargp_t kp;
    __device__ __forceinline__ const float* operator[](int i) const { return *(const __attribute__((address_space(4))) cfp_t*)(kp + 8 * i); } };
struct Frame {
    LAS unsigned char* lds; volatile LAS unsigned* MISC; unsigned* ctl;
    int tid, lane, wave, vcu, G;
    InTab in; float* out; unsigned char* ws;
};
#define LDS_WAIT() asm volatile("s_waitcnt lgkmcnt(0)" ::: "memory")
#define LAUNDER(p) asm volatile("" : "+s"(p))
#define PHASE_VIEW() Frame F = F0; LAUNDER(F.ws); LAUNDER(F.in.kp); LAUNDER(F.ctl)
__device__ __forceinline__ float wave_sum(float v) {
#pragma unroll
    for (int o = 1; o < 64; o <<= 1) v += __shfl_xor(v, o);
    return v;
}
__device__ __forceinline__ float wave_max(float v) {
#pragma unroll
    for (int o = 1; o < 64; o <<= 1) v = fmaxf(v, __shfl_xor(v, o));
    return v;
}
__device__ __forceinline__ float row16_sum(float x) {
    x += __builtin_bit_cast(float, __builtin_amdgcn_update_dpp(0, __builtin_bit_cast(int, x), 0xB1, 0xf, 0xf, false));
    x += __builtin_bit_cast(float, __builtin_amdgcn_update_dpp(0, __builtin_bit_cast(int, x), 0x4E, 0xf, 0xf, false));
    x += __builtin_bit_cast(float, __builtin_amdgcn_update_dpp(0, __builtin_bit_cast(int, x), 0x141, 0xf, 0xf, false));
    x += __builtin_bit_cast(float, __builtin_amdgcn_update_dpp(0, __builtin_bit_cast(int, x), 0x140, 0xf, 0xf, false));
    return x;
}
__device__ __forceinline__ unsigned pk2(float lo, float hi) { return cvt_pk_bf16(lo, hi); }
__device__ __forceinline__ float bf2f(bf16 b) { return __uint_as_float(((unsigned)b) << 16); }
__device__ __forceinline__ float gelu_tanh(float y) { const float u = 0.7978845608028654f * (y + 0.044715f * y * y * y); const float e = __expf(2.f * u); const float th = 1.f - 2.f / (e + 1.f); return 0.5f * y * (1.f + th); }

__device__ __forceinline__ void transpose_item(const float* W, int N, bf16* WT, int ldk, int dst_row0, int k0, int n0, int kdst0, LAS float* scr, int lane) {
#pragma unroll 8
    for (int i = 0; i < 32; ++i) { const int kk = 2 * i + (lane >> 5); scr[kk * 33 + (lane & 31)] = W[(size_t)(k0 + kk) * N + n0 + (lane & 31)]; }
    LDS_WAIT(); asm volatile("" ::: "memory");
    const int c = lane & 7;
#pragma unroll
    for (int j = 0; j < 4; ++j) { const int n = (lane >> 3) + 8 * j; const LAS float* s = scr + (8 * c) * 33 + n;
        u32x4 o; o.x = pk2(s[0 * 33], s[1 * 33]); o.y = pk2(s[2 * 33], s[3 * 33]); o.z = pk2(s[4 * 33], s[5 * 33]); o.w = pk2(s[6 * 33], s[7 * 33]);
        *(u32x4*)(WT + (size_t)(dst_row0 + n) * ldk + kdst0 + 8 * c) = o; }
    LDS_WAIT(); asm volatile("" ::: "memory");
}

__device__ __forceinline__ void p0_prologue(const Frame& F0) {
    PHASE_VIEW();
    const float* c = F.in[1]; const float* ada_w = F.in[2]; const float* ada_b = F.in[3];
    float* mod = (float*)(F.ws + WS_MOD);
    LAS float* sc = (LAS float*)F.lds;
    LAS float* red = (LAS float*)(F.lds + 65536);
    for (int i = F.tid; i < NB * DM; i += NTHR) { const float v = c[i]; sc[i] = v / (1.f + __expf(-v)); }
    __syncthreads();
    for (int item = F.vcu; item < NMOD / 64; item += F.G) {
        const int col = item * 64 + F.lane, ks = F.wave;
        float acc[8] = {0.f, 0.f, 0.f, 0.f, 0.f, 0.f, 0.f, 0.f};
        for (int k = ks * 256; k < ks * 256 + 256; ++k) { const float w = ada_w[(size_t)k * NMOD + col];
#pragma unroll
            for (int b = 0; b < 8; ++b) acc[b] += sc[b * DM + k] * w; }
#pragma unroll
        for (int b = 0; b < 8; ++b) red[(ks * 8 + b) * 64 + F.lane] = acc[b];
        __syncthreads();
        { const int b = F.wave; float s = 0.f;
#pragma unroll
          for (int k2 = 0; k2 < 8; ++k2) s += red[(k2 * 8 + b) * 64 + F.lane];
          mod[b * NMOD + col] = s + ada_b[col]; }
        __syncthreads();
    }
    __syncthreads();
    LAS float* scr = (LAS float*)(F.lds + F.wave * 16384);
    const int gw = F.vcu * NWAVES + F.wave, NGW = F.G * NWAVES;
    bf16* WinT = (bf16*)(F.ws + WS_WIN_T); bf16* WoutT = (bf16*)(F.ws + WS_WOUT_T); bf16* GluT = (bf16*)(F.ws + WS_GLU_T); bf16* LoraT = (bf16*)(F.ws + WS_LORA_T);
    constexpr int I_IN = (DM / 64) * (DIN / 32), I_OUT = (DM / 64) * (DM / 32), I_GLU = (DSSM / 64) * (DSSM / 32), I_W = 32, I_A = 32, I_G = 64;
    constexpr int NITEMS = I_IN + I_OUT + I_GLU + I_W + I_A + I_G;
    for (int it = gw; it < NITEMS; it += NGW) {
        int r = it;
        if (r < I_IN) { const int nb = DIN / 32, kb = r / nb, n0 = (r % nb) * 32; transpose_item(F.in[8], DIN, WinT, DM, n0, kb * 64, n0, kb * 64, scr, F.lane); continue; } r -= I_IN;
        if (r < I_OUT) { const int nb = DM / 32, kb = r / nb, n0 = (r % nb) * 32; transpose_item(F.in[9], DM, WoutT, DM, n0, kb * 64, n0, kb * 64, scr, F.lane); continue; } r -= I_OUT;
        if (r < I_GLU) { const int nb = DSSM / 32, kb = r / nb, n0 = (r % nb) * 32; transpose_item(F.in[18], DSSM, GluT, DSSM, n0, kb * 64, n0, kb * 64, scr, F.lane); continue; } r -= I_GLU;
        if (r < I_W) { transpose_item(F.in[22], DRW, LoraT, 256, r * 32, 0, r * 32, 0, scr, F.lane); continue; } r -= I_W;
        if (r < I_A) { transpose_item(F.in[24], DRW, LoraT, 256, 1024 + r * 32, 0, r * 32, 64, scr, F.lane); continue; } r -= I_A;
        { const int kb = r / 32, n0 = (r % 32) * 32; transpose_item(F.in[25], DRW, LoraT, 256, 2048 + n0, kb * 64, n0, 128 + kb * 64, scr, F.lane); }
    }
    for (int p = blockIdx.x * NTHR + F.tid; p < 3072 * 32; p += F.G * NTHR) { const int row = p >> 5, c8 = (p & 31) * 8; const int kind = row >> 10;
        const bool data = kind == 0 ? (c8 < 64) : (kind == 1 ? (c8 >= 64 && c8 < 128) : (c8 >= 128));
        if (!data) *(u32x4*)(LoraT + (size_t)row * 256 + c8) = (u32x4){0u, 0u, 0u, 0u}; }
    float* rwt = (float*)(F.ws + WS_RWT);
    for (int p = blockIdx.x * NTHR + F.tid; p < 72 * DM; p += F.G * NTHR) { const int j = p / DM, k = p % DM; rwt[p] = j < 8 ? F.in[31][k * 8 + j] : F.in[33][k * 64 + (j - 8)]; }
}

__device__ __forceinline__ void p1_h1(const Frame& F0) {
    PHASE_VIEW();
    const float* x = F.in[0]; const float* g = F.in[4]; const float* mod = (const float*)(F.ws + WS_MOD); bf16* H = (bf16*)(F.ws + WS_H);
    const int gw = F.vcu * NWAVES + F.wave, NGW = F.G * NWAVES;
    for (int row = gw; row < NT; row += NGW) {
        const int b = row >> 11; const f32x4* xr = (const f32x4*)(x + (size_t)row * DM) + F.lane;
        f32x4 v[8]; float ss = 0.f;
#pragma unroll
        for (int j = 0; j < 8; ++j) { v[j] = xr[64 * j]; ss += (v[j].x * v[j].x + v[j].y * v[j].y) + (v[j].z * v[j].z + v[j].w * v[j].w); }
        const float rs = rsqrtf(wave_sum(ss) * (1.f / DM) + RMS_EPS);
        u32x2* o = (u32x2*)(H + (size_t)row * DM) + F.lane;
#pragma unroll
        for (int j = 0; j < 8; ++j) { const int col = 4 * (F.lane + 64 * j);
            const f32x4 gv = *(const f32x4*)(g + col), sh = *(const f32x4*)(mod + b * NMOD + col), scv = *(const f32x4*)(mod + b * NMOD + DM + col);
            const f32x4 h = v[j] * rs * gv * (scv + 1.0f) + sh;
            u32x2 w; w.x = pk2(h.x, h.y); w.y = pk2(h.z, h.w); o[64 * j] = w; }
    }
}

__device__ __forceinline__ void p3_rwkv_prep(const Frame& F0) {
    PHASE_VIEW();
    const bf16* PROJ = (const bf16*)(F.ws + WS_PROJ); const float* mu = F.in[20];
    float* Rr = (float*)(F.ws + WS_SC + 0 * SC_STRIDE); float* Kk = (float*)(F.ws + WS_SC + 1 * SC_STRIDE); float* Vv = (float*)(F.ws + WS_SC + 2 * SC_STRIDE);
    bf16* LIN = (bf16*)(F.ws + WS_LIN);
    const int gw = F.vcu * NWAVES + F.wave, NGW = F.G * NWAVES;
    for (int row = gw; row < NT; row += NGW) {
        const bool first = (row & (SEQ - 1)) == 0;
        const unsigned* z = (const unsigned*)(PROJ + (size_t)row * DIN + DSSM); const unsigned* zp = (const unsigned*)(PROJ + (size_t)(first ? row : row - 1) * DIN + DSSM);
#pragma unroll 2
        for (int j = 0; j < 26; ++j) { const int q = F.lane + 64 * j, col = 2 * q; const unsigned zw = z[q], pw = first ? 0u : zp[q];
            const f32x2 m = *(const f32x2*)(mu + col);
            const float z0 = bf_lo(zw), z1 = bf_hi(zw); const float a0 = z0 + m.x * (bf_lo(pw) - z0), a1 = z1 + m.y * (bf_hi(pw) - z1);
            if (col < 1024) *(f32x2*)(Rr + (size_t)row * 1024 + col) = (f32x2){a0, a1};
            else if (col < 2048) *(f32x2*)(Kk + (size_t)row * 1024 + col - 1024) = (f32x2){a0, a1};
            else if (col < 3072) *(f32x2*)(Vv + (size_t)row * 1024 + col - 2048) = (f32x2){a0, a1};
            else { float o0, o1; const int lc = col - 3072;
                if (lc < 64) { o0 = tanhf(a0); o1 = tanhf(a1); } else if (lc < 128) { o0 = a0; o1 = a1; } else { o0 = sigmoidf_(a0); o1 = sigmoidf_(a1); }
                *(unsigned*)(LIN + (size_t)row * 256 + lc) = pk2(o0, o1); }
        }
    }
}

__device__ __forceinline__ void p5_scan_inputs(const Frame& F0) {
    PHASE_VIEW();
    float* Kk = (float*)(F.ws + WS_SC + 1 * SC_STRIDE); const float* Aa = (const float*)(F.ws + WS_SC + 4 * SC_STRIDE);
    float* AS = (float*)(F.ws + WS_SC + 6 * SC_STRIDE); float* BS = (float*)(F.ws + WS_SC + 7 * SC_STRIDE);
    const float* k_k = F.in[26]; const float* k_a = F.in[27];
    const int gw = F.vcu * NWAVES + F.wave, NGW = F.G * NWAVES;
    for (int it = gw; it < NT * NH; it += NGW) {
        const int row = it >> 4, h = it & 15, c = h * 64 + F.lane; const size_t idx = (size_t)row * 1024 + c;
        const float k = Kk[idx], a = Aa[idx];
        float kk = k * k_k[c]; const float n2 = wave_sum(kk * kk); kk = kk / fmaxf(sqrtf(n2), 1e-12f);
        Kk[idx] = k * (1.f + (a - 1.f) * k_a[c]); AS[idx] = -kk; BS[idx] = kk * a;
    }
}

__device__ __forceinline__ void p6_rwkv_scan(const Frame& F0) {
    PHASE_VIEW();
    const float* Rr = (const float*)(F.ws + WS_SC + 0 * SC_STRIDE); const float* Kk = (const float*)(F.ws + WS_SC + 1 * SC_STRIDE); const float* Vv = (const float*)(F.ws + WS_SC + 2 * SC_STRIDE);
    const float* Wd = (const float*)(F.ws + WS_SC + 3 * SC_STRIDE); const float* AS = (const float*)(F.ws + WS_SC + 6 * SC_STRIDE); const float* BS = (const float*)(F.ws + WS_SC + 7 * SC_STRIDE);
    float* Yy = (float*)(F.ws + WS_SC + 8 * SC_STRIDE);
    constexpr int TS = 32;
    LAS float* sr = (LAS float*)F.lds; LAS float* sw = sr + TS * 64; LAS float* sk = sw + TS * 64; LAS float* sa = sk + TS * 64; LAS float* sb = sa + TS * 64;
    LAS float* sv = sb + TS * 64; LAS float* sy = sv + TS * 32;
    const int vl = F.lane >> 4, kg = F.lane & 15;
    for (int item = F.vcu; item < NB * NH * 2; item += F.G) {
        const int b = item >> 5, h = (item >> 1) & 15, vh = item & 1;
        float S0 = 0.f, S1 = 0.f, S2 = 0.f, S3 = 0.f;
        for (int t0 = 0; t0 < SEQ; t0 += TS) {
            __syncthreads();
            { const int tt = F.tid >> 4, c4 = (F.tid & 15) * 4; const size_t gi = (size_t)(b * SEQ + t0 + tt) * 1024 + h * 64 + c4;
              *(f32x4*)(sr + tt * 64 + c4) = *(const f32x4*)(Rr + gi); *(f32x4*)(sw + tt * 64 + c4) = *(const f32x4*)(Wd + gi); *(f32x4*)(sk + tt * 64 + c4) = *(const f32x4*)(Kk + gi);
              *(f32x4*)(sa + tt * 64 + c4) = *(const f32x4*)(AS + gi); *(f32x4*)(sb + tt * 64 + c4) = *(const f32x4*)(BS + gi);
              if (F.tid < 256) { const int t2 = F.tid >> 3, v4 = (F.tid & 7) * 4; *(f32x4*)(sv + t2 * 32 + v4) = *(const f32x4*)(Vv + (size_t)(b * SEQ + t0 + t2) * 1024 + h * 64 + vh * 32 + v4); } }
            __syncthreads();
#pragma unroll 4
            for (int tt = 0; tt < TS; ++tt) {
                const f32x4 r4 = *(const LAS f32x4*)(sr + tt * 64 + kg * 4), w4 = *(const LAS f32x4*)(sw + tt * 64 + kg * 4), k4 = *(const LAS f32x4*)(sk + tt * 64 + kg * 4);
                const f32x4 a4 = *(const LAS f32x4*)(sa + tt * 64 + kg * 4), b4 = *(const LAS f32x4*)(sb + tt * 64 + kg * 4);
                const float vv = sv[tt * 32 + F.wave * 4 + vl];
                float s = (S0 * a4.x + S1 * a4.y) + (S2 * a4.z + S3 * a4.w);
                s = row16_sum(s);
                S0 = S0 * w4.x + (s * b4.x + vv * k4.x); S1 = S1 * w4.y + (s * b4.y + vv * k4.y); S2 = S2 * w4.z + (s * b4.z + vv * k4.z); S3 = S3 * w4.w + (s * b4.w + vv * k4.w);
                float y = (S0 * r4.x + S1 * r4.y) + (S2 * r4.z + S3 * r4.w);
                y = row16_sum(y);
                if (kg == 0) sy[tt * 32 + F.wave * 4 + vl] = y;
            }
            __syncthreads();
            if (F.tid < 256) { const int t2 = F.tid >> 3, v4 = (F.tid & 7) * 4; *(f32x4*)(Yy + (size_t)(b * SEQ + t0 + t2) * 1024 + h * 64 + vh * 32 + v4) = *(const LAS f32x4*)(sy + t2 * 32 + v4); }
        }
    }
    __syncthreads();
}

__device__ __forceinline__ void p7_s5_scan(const Frame& F0) {
    PHASE_VIEW();
    const bf16* PROJ = (const bf16*)(F.ws + WS_PROJ); bf16* YSG = (bf16*)(F.ws + WS_YSG);
    const float* lam_re = F.in[10]; const float* lam_im = F.in[11]; const float* log_dt = F.in[12];
    const float* b_re = F.in[13]; const float* b_im = F.in[14]; const float* c_re = F.in[15]; const float* c_im = F.in[16]; const float* dsk = F.in[17];
    constexpr int TC = 16, RS = 68;
    LAS float* cre = (LAS float*)F.lds; LAS float* cim = cre + 16 * RS;
    LAS float* base = (LAS float*)(F.lds + 16384 + F.wave * 16384);
    LAS float* ssr = base; LAS float* ssi = ssr + TC * RS; LAS float* us = ssi + TC * RS;
    const int p = F.lane;
    for (int item = F.vcu; item < NG * 4; item += F.G) {
        const int g = item & 63, bq = item >> 6;
        __syncthreads();
        for (int i = F.tid; i < 16 * 64; i += NTHR) { const int c = i >> 6, pp = i & 63; cre[c * RS + pp] = c_re[(g * GC + c) * NP + pp]; cim[c * RS + pp] = c_im[(g * GC + c) * NP + pp]; }
        __syncthreads();
        if (F.wave < 2) {
            const int b = bq * 2 + F.wave;
            const float lr = fminf(lam_re[g * NP + p], -1e-4f), li = lam_im[g * NP + p], dt = __expf(log_dt[g]);
            const float mag = __expf(lr * dt); const float ang = li * dt; const float sn = sinf(ang), cs = cosf(ang);
            const float ar = mag * cs, ai = mag * sn, den = lr * lr + li * li;
            const float qr = ((ar - 1.f) * lr + ai * li) / den, qi = (ai * lr - (ar - 1.f) * li) / den;
            float bbr[16], bbi[16];
#pragma unroll
            for (int c = 0; c < 16; ++c) { const float br = b_re[(g * NP + p) * GC + c], bi = b_im[(g * NP + p) * GC + c]; bbr[c] = qr * br - qi * bi; bbi[c] = qr * bi + qi * br; }
            const int tb = F.lane >> 2, cq = F.lane & 3;
            const f32x4 dv = *(const f32x4*)(dsk + g * GC + cq * 4);
            float sr_ = 0.f, si_ = 0.f;
            for (int t0 = 0; t0 < SEQ; t0 += TC) {
                { const u32x2 w = *(const u32x2*)(PROJ + (size_t)(b * SEQ + t0 + tb) * DIN + g * GC + cq * 4);
                  *(LAS f32x4*)(us + tb * 16 + cq * 4) = (f32x4){bf_lo(w.x), bf_hi(w.x), bf_lo(w.y), bf_hi(w.y)}; }
                LDS_WAIT(); asm volatile("" ::: "memory");
#pragma unroll 4
                for (int tt = 0; tt < TC; ++tt) {
                    float ur = 0.f, ui = 0.f;
#pragma unroll
                    for (int c4 = 0; c4 < 4; ++c4) { const f32x4 u = *(const LAS f32x4*)(us + tt * 16 + c4 * 4);
#pragma unroll
                        for (int j = 0; j < 4; ++j) { ur += bbr[c4 * 4 + j] * u[j]; ui += bbi[c4 * 4 + j] * u[j]; } }
                    const float nr = ar * sr_ - ai * si_ + ur, ni = ar * si_ + ai * sr_ + ui; sr_ = nr; si_ = ni;
                    ssr[tt * RS + p] = nr; ssi[tt * RS + p] = ni;
                }
                LDS_WAIT(); asm volatile("" ::: "memory");
                f32x4 y = (f32x4){0.f, 0.f, 0.f, 0.f};
#pragma unroll 4
                for (int p4 = 0; p4 < 16; ++p4) { const f32x4 a = *(const LAS f32x4*)(ssr + tb * RS + p4 * 4), bq4 = *(const LAS f32x4*)(ssi + tb * RS + p4 * 4);
#pragma unroll
                    for (int j = 0; j < 4; ++j) { const f32x4 cr = *(const LAS f32x4*)(cre + (cq * 4 + j) * RS + p4 * 4), ci = *(const LAS f32x4*)(cim + (cq * 4 + j) * RS + p4 * 4);
                        y[j] += (a.x * cr.x - bq4.x * ci.x) + (a.y * cr.y - bq4.y * ci.y) + (a.z * cr.z - bq4.z * ci.z) + (a.w * cr.w - bq4.w * ci.w); } }
                const f32x4 u = *(const LAS f32x4*)(us + tb * 16 + cq * 4);
                y = y + dv * u;
                u32x2 o; o.x = pk2(gelu_tanh(y.x), gelu_tanh(y.y)); o.y = pk2(gelu_tanh(y.z), gelu_tanh(y.w));
                *(u32x2*)(YSG + (size_t)(b * SEQ + t0 + tb) * DSSM + g * GC + cq * 4) = o;
                LDS_WAIT(); asm volatile("" ::: "memory");
            }
        }
    }
    __syncthreads();
}

__device__ __forceinline__ void p9_rwkv_post(const Frame& F0) {
    PHASE_VIEW();
    const float* Rr = (const float*)(F.ws + WS_SC + 0 * SC_STRIDE); const float* Kk = (const float*)(F.ws + WS_SC + 1 * SC_STRIDE); const float* Vv = (const float*)(F.ws + WS_SC + 2 * SC_STRIDE);
    const float* Gg = (const float*)(F.ws + WS_SC + 5 * SC_STRIDE); const float* Yy = (const float*)(F.ws + WS_SC + 8 * SC_STRIDE);
    const float* r_k = F.in[28]; const float* ln_w = F.in[29]; const float* ln_b = F.in[30]; bf16* MIX = (bf16*)(F.ws + WS_MIX);
    const int gw = F.vcu * NWAVES + F.wave, NGW = F.G * NWAVES;
    for (int it = gw; it < NT * NH; it += NGW) {
        const int row = it >> 4, h = it & 15, c = h * 64 + F.lane; const size_t idx = (size_t)row * 1024 + c;
        const float y = Yy[idx]; const float mean = wave_sum(y) * (1.f / 64.f); const float d = y - mean; const float var = wave_sum(d * d) * (1.f / 64.f);
        float yn = d * rsqrtf(var + GN_EPS) * ln_w[c] + ln_b[c];
        const float bonus = wave_sum(Rr[idx] * Kk[idx] * r_k[c]);
        yn = (yn + bonus * Vv[idx]) * Gg[idx];
        const float other = __shfl_xor(yn, 1);
        if ((F.lane & 1) == 0) *(unsigned*)(MIX + (size_t)row * DM + DSSM + c) = pk2(yn, other);
    }
}

__device__ __forceinline__ void p11_x1_router(const Frame& F0) {
    PHASE_VIEW();
    const float* x = F.in[0]; const float* gpost = F.in[5]; const float* gpre2 = F.in[6]; const float* mod = (const float*)(F.ws + WS_MOD);
    const float* MIXED = (const float*)(F.ws + WS_MIXED); float* X1 = (float*)(F.ws + WS_X1); bf16* H = (bf16*)(F.ws + WS_H);
    const float* rwt = (const float*)(F.ws + WS_RWT); const float* b_grp = F.in[32]; const float* b_exp = F.in[34];
    unsigned* tokinfo = (unsigned*)(F.ws + WS_TOKINFO); int* list = (int*)(F.ws + WS_LIST);
    const int gw = F.vcu * NWAVES + F.wave, NGW = F.G * NWAVES;
    for (int row = gw; row < NT; row += NGW) {
        const int b = row >> 11;
        const f32x4* mr = (const f32x4*)(MIXED + (size_t)row * DM) + F.lane; const f32x4* xr = (const f32x4*)(x + (size_t)row * DM) + F.lane;
        f32x4 v[8]; float ss = 0.f;
#pragma unroll
        for (int j = 0; j < 8; ++j) { v[j] = mr[64 * j]; ss += (v[j].x * v[j].x + v[j].y * v[j].y) + (v[j].z * v[j].z + v[j].w * v[j].w); }
        const float rs = rsqrtf(wave_sum(ss) * (1.f / DM) + RMS_EPS);
        float ss2 = 0.f;
#pragma unroll
        for (int j = 0; j < 8; ++j) { const int col = 4 * (F.lane + 64 * j);
            const f32x4 gv = *(const f32x4*)(gpost + col), gt = *(const f32x4*)(mod + b * NMOD + 2 * DM + col);
            v[j] = xr[64 * j] + gt * (v[j] * rs * gv);
            ((f32x4*)(X1 + (size_t)row * DM))[F.lane + 64 * j] = v[j];
            ss2 += (v[j].x * v[j].x + v[j].y * v[j].y) + (v[j].z * v[j].z + v[j].w * v[j].w); }
        const float rs2 = rsqrtf(wave_sum(ss2) * (1.f / DM) + RMS_EPS);
        u32x2* o = (u32x2*)(H + (size_t)row * DM) + F.lane;
#pragma unroll
        for (int j = 0; j < 8; ++j) { const int col = 4 * (F.lane + 64 * j);
            const f32x4 gv = *(const f32x4*)(gpre2 + col), sh = *(const f32x4*)(mod + b * NMOD + 3 * DM + col), scv = *(const f32x4*)(mod + b * NMOD + 4 * DM + col);
            v[j] = v[j] * rs2 * gv * (scv + 1.0f) + sh;
            u32x2 w; w.x = pk2(v[j].x, v[j].y); w.y = pk2(v[j].z, v[j].w); o[64 * j] = w; }
        float lg = -INFINITY, le = 0.f;
        for (int jj = 0; jj < 72; ++jj) { const f32x4* wr_ = (const f32x4*)(rwt + (size_t)jj * DM) + F.lane; float p = 0.f;
#pragma unroll
            for (int j = 0; j < 8; ++j) { const f32x4 w = wr_[64 * j]; p += (v[j].x * w.x + v[j].y * w.y) + (v[j].z * w.z + v[j].w * w.w); }
            p = wave_sum(p);
            if (jj < 8) { if (F.lane == jj) lg = p + b_grp[jj]; } else { if (F.lane == jj - 8) le = p + b_exp[jj - 8]; } }
        const float gmax = wave_max(lg);
        const int gi = __builtin_ctzll(__ballot(lg == gmax));
        const float gsum = wave_sum(F.lane < 8 ? __expf(lg - gmax) : 0.f); const float pg = 1.f / gsum;
        const float el = ((F.lane >> 3) == gi) ? le : -INFINITY;
        const float m1 = wave_max(el); const int i1 = __builtin_ctzll(__ballot(el == m1));
        const float el2 = (F.lane == i1) ? -INFINITY : el;
        const float m2 = wave_max(el2); const int i2 = __builtin_ctzll(__ballot(el2 == m2));
        const float e2 = __expf(m2 - m1); const float g1 = pg / (1.f + e2), g2 = pg * e2 / (1.f + e2);
        if (F.lane == 0) {
            const unsigned p1 = atomicAdd(F.ctl + CW_CNT + 64 * i1, 1u), p2 = atomicAdd(F.ctl + CW_CNT + 64 * i2, 1u);
            list[i1 * NT + p1] = row; list[i2 * NT + p2] = row;
            u32x4 a; a.x = (unsigned)i1; a.y = p1; a.z = (unsigned)i2; a.w = p2; *(u32x4*)(tokinfo + (size_t)row * 8) = a;
            u32x2 g; g.x = __float_as_uint(g1); g.y = __float_as_uint(g2); *(u32x2*)(tokinfo + (size_t)row * 8 + 4) = g;
        }
    }
}

__device__ __forceinline__ void p12_expert_convert(const Frame& F0) {
    PHASE_VIEW();
    LAS float* scr = (LAS float*)(F.lds + F.wave * 16384);
    const int gw = F.vcu * NWAVES + F.wave, NGW = F.G * NWAVES;
    bf16* EW1 = (bf16*)(F.ws + WS_EW1); bf16* EW2 = (bf16*)(F.ws + WS_EW2);
    constexpr int PER_E = 1536;
    for (int it = gw; it < NEXP * PER_E; it += NGW) {
        const int e = it / PER_E; int r = it % PER_E;
        if (r < 1024) { const int which = r >> 9; r &= 511; const int kb = r >> 4, n0 = (r & 15) * 32;
            const float* W = F.in[which ? 36 : 35] + (size_t)e * DM * DEXP;
            const int drow = (n0 >> 7) * 256 + which * 128 + (n0 & 127);
            transpose_item(W, DEXP, EW1 + (size_t)e * 1024 * DM, DM, drow, kb * 64, n0, kb * 64, scr, F.lane); }
        else { r -= 1024; const int kb = r >> 6, n0 = (r & 63) * 32;
            const float* W = F.in[37] + (size_t)e * DEXP * DM;
            transpose_item(W, DM, EW2 + (size_t)e * DM * DEXP, DEXP, n0, kb * 64, n0, kb * 64, scr, F.lane); }
    }
}

__device__ __forceinline__ void moe_build_tp(const Frame& F0) {
    PHASE_VIEW();
    volatile LAS int* tp = (volatile LAS int*)(F.lds + TP_OFF);
    __syncthreads();
    if (F.tid == 0) { int s = 0; for (int e = 0; e < NEXP; ++e) { tp[e] = s; const unsigned c = __hip_atomic_load(F.ctl + CW_CNT + 64 * e, RLX_AGENT); s += (int)((c + 255u) >> 8); } tp[NEXP] = s; }
    __syncthreads();
}
template <bool G1> struct MoeOrder {
    static constexpr bool GATHER = G1;
    static constexpr int NNT = G1 ? 4 : 8, KK = G1 ? DM : DEXP;
    const LAS int* tp; const unsigned* cntw; const int* list; const char* A; const char* EW; int G, c;
    __device__ bool next(int i, pg8::Unit& u) const {
        const int L = i * G + c; const int total = tp[NEXP];
        if (L >= total * NNT) return false;
        const int tile = L / NNT; u.pn = L % NNT;
        int lo = 0, hi = NEXP - 1;
        while (lo < hi) { const int mid = (lo + hi + 1) >> 1; if (tp[mid] <= tile) lo = mid; else hi = mid - 1; }
        const int e = __builtin_amdgcn_readfirstlane(lo); const int mt = tile - tp[e];
        u.e = e; u.pm = tile; u.cnt = (int)cntw[64 * e] - mt * 256;
        u.Bb = EW + ((size_t)e * (G1 ? 1024 : DM) + (size_t)u.pn * 256) * KK * 2;
        u.Ab = G1 ? A : A + (size_t)tile * 256 * KK * 2;
        return true;
    }
    template <int NV> __device__ __forceinline__ void a_voff(const pg8::Unit& u, unsigned (&v)[NV][2], const int (&R)[2], const int (&C)[2]) const {
        if constexpr (G1) {
            const int mt = u.pm - tp[u.e];
#pragma unroll
            for (int h = 0; h < 2; ++h)
#pragma unroll
                for (int i = 0; i < 2; ++i) { const int rr = h * 128 + R[i]; const int tok = list[u.e * NT + mt * 256 + (rr < u.cnt ? rr : 0)]; v[h][i] = (unsigned)(tok * KK + C[i]) * 2u; }
        } else {
#pragma unroll
            for (int i = 0; i < 2; ++i) v[0][i] = (unsigned)(R[i] * KK + C[i]) * 2u;
        }
    }
};

__device__ __forceinline__ void p15_final(const Frame& F0) {
    PHASE_VIEW();
    const float* X1 = (const float*)(F.ws + WS_X1); const bf16* YS = (const bf16*)(F.ws + WS_YSLOT); const unsigned* tokinfo = (const unsigned*)(F.ws + WS_TOKINFO);
    const float* gpost2 = F.in[7]; const float* mod = (const float*)(F.ws + WS_MOD);
    const LAS int* tp = (const LAS int*)(F.lds + TP_OFF);
    const int gw = F.vcu * NWAVES + F.wave, NGW = F.G * NWAVES;
    for (int row = gw; row < NT; row += NGW) {
        const int b = row >> 11;
        const u32x4 ti = *(const u32x4*)(tokinfo + (size_t)row * 8); const u32x2 tg = *(const u32x2*)(tokinfo + (size_t)row * 8 + 4);
        const size_t r1 = (size_t)tp[ti.x] * 256 + ti.y, r2 = (size_t)tp[ti.z] * 256 + ti.w; const float g1 = __uint_as_float(tg.x), g2 = __uint_as_float(tg.y);
        const u32x2* y1 = (const u32x2*)(YS + r1 * DM) + F.lane; const u32x2* y2 = (const u32x2*)(YS + r2 * DM) + F.lane;
        f32x4 v[8]; float ss = 0.f;
#pragma unroll
        for (int j = 0; j < 8; ++j) { const u32x2 a = y1[64 * j], c = y2[64 * j];
            v[j] = (f32x4){bf_lo(a.x), bf_hi(a.x), bf_lo(a.y), bf_hi(a.y)} * g1 + (f32x4){bf_lo(c.x), bf_hi(c.x), bf_lo(c.y), bf_hi(c.y)} * g2;
            ss += (v[j].x * v[j].x + v[j].y * v[j].y) + (v[j].z * v[j].z + v[j].w * v[j].w); }
        const float rs = rsqrtf(wave_sum(ss) * (1.f / DM) + RMS_EPS);
#pragma unroll
        for (int j = 0; j < 8; ++j) { const int col = 4 * (F.lane + 64 * j);
            const f32x4 gv = *(const f32x4*)(gpost2 + col), gt = *(const f32x4*)(mod + b * NMOD + 5 * DM + col);
            const f32x4 xv = ((const f32x4*)(X1 + (size_t)row * DM))[F.lane + 64 * j];
            ((f32x4*)(F.out + (size_t)row * DM))[F.lane + 64 * j] = xv + gt * (v[j] * rs * gv); }
    }
}

constexpr int NPH = 16;
__global__ void __launch_bounds__(NTHR, 2) mk_fwd(Args args) {
    extern __shared__ __attribute__((aligned(16))) unsigned char lds[];
    Frame F0;
    F0.lds = (LAS unsigned char*)lds; F0.MISC = (volatile LAS unsigned*)(F0.lds + MISC_OFF);
    F0.tid = threadIdx.x; F0.lane = F0.tid & 63; F0.wave = __builtin_amdgcn_readfirstlane(F0.tid >> 6);
    F0.G = gridDim.x; { const int bx = blockIdx.x; F0.vcu = (F0.G % 8 == 0) ? (bx % 8) * (F0.G / 8) + bx / 8 : bx; }
    F0.in.kp = (kargp_t)__builtin_amdgcn_kernarg_segment_ptr(); F0.out = args.out; F0.ws = args.ws; F0.ctl = (unsigned*)(args.ws + WS_CTL);
    if (F0.tid < 64) F0.MISC[F0.tid] = 0u;
    __syncthreads();
    const int lo = args.ph_lo, hi = args.ph_hi;
    XcdBarrier bar; bar.bar = F0.ctl + CW_BAR; bar.x = 0; bar.st = nullptr;
    if (hi - lo > 1) bar = xcd_barrier_post(F0.ctl + CW_BAR, F0.MISC + 8);
#define IN(k) (lo <= (k) && (k) < hi)
#define SEAM(k) do { if (IN(k) && IN((k) + 1)) xcd_barrier(bar); } while (0)
    LAS unsigned char* ring = F0.lds;

    if (IN(0)) { p0_prologue(F0); } SEAM(0);
    if (IN(1)) { p1_h1(F0); } SEAM(1);
    if (IN(2)) {
        PHASE_VIEW();
        pg8::Gemm g{(const bf16*)(F.ws + WS_H), (const bf16*)(F.ws + WS_WIN_T), NT, DIN, DM}; pg8::StaticOrder S; S.init(g, F.G, (int)blockIdx.x);
        pg8::EpiBf16 E{(bf16*)(F.ws + WS_PROJ), DIN};
        pg8::gemm_phase(ring, DM, S, E);
    } SEAM(2);
    if (IN(3)) { p3_rwkv_prep(F0); } SEAM(3);
    if (IN(4)) {
        PHASE_VIEW();
        pg8::Gemm g{(const bf16*)(F.ws + WS_LIN), (const bf16*)(F.ws + WS_LORA_T), NT, 3072, 256}; pg8::StaticOrder S; S.init(g, F.G, (int)blockIdx.x);
        pg8::EpiLora E{(float*)(F.ws + WS_SC + 3 * SC_STRIDE), SC_STRIDE / 4, F.in[21], F.in[23]};
        pg8::gemm_phase(ring, 256, S, E);
    } SEAM(4);
    if (IN(5)) { p5_scan_inputs(F0); } SEAM(5);
    if (IN(6)) { p6_rwkv_scan(F0); } SEAM(6);
    if (IN(7)) { p7_s5_scan(F0); } SEAM(7);
    if (IN(8)) {
        PHASE_VIEW();
        pg8::Gemm g{(const bf16*)(F.ws + WS_YSG), (const bf16*)(F.ws + WS_GLU_T), NT, DSSM, DSSM}; pg8::StaticOrder S; S.init(g, F.G, (int)blockIdx.x);
        pg8::EpiGlu E{(const bf16*)(F.ws + WS_YSG), (bf16*)(F.ws + WS_MIX), DM, F.in[19]};
        pg8::gemm_phase(ring, DSSM, S, E);
    } SEAM(8);
    if (IN(9)) { p9_rwkv_post(F0); } SEAM(9);
    if (IN(10)) {
        PHASE_VIEW();
        pg8::Gemm g{(const bf16*)(F.ws + WS_MIX), (const bf16*)(F.ws + WS_WOUT_T), NT, DM, DM}; pg8::StaticOrder S; S.init(g, F.G, (int)blockIdx.x);
        pg8::EpiF32 E{(float*)(F.ws + WS_MIXED), DM};
        pg8::gemm_phase(ring, DM, S, E);
    } SEAM(10);
    if (IN(11)) { p11_x1_router(F0); } SEAM(11);
    if (IN(12)) { p12_expert_convert(F0); } SEAM(12);
    if (IN(13)) {
        PHASE_VIEW();
        moe_build_tp(F);
        MoeOrder<true> S{(const LAS int*)(F.lds + TP_OFF), F.ctl + CW_CNT, (const int*)(F.ws + WS_LIST), (const char*)(F.ws + WS_H), (const char*)(F.ws + WS_EW1), F.G, (int)blockIdx.x};
        pg8::EpiSwiglu E{(bf16*)(F.ws + WS_HID)};
        pg8::gemm_phase(ring, DM, S, E);
    } SEAM(13);
    if (IN(14)) {
        PHASE_VIEW();
        moe_build_tp(F);
        MoeOrder<false> S{(const LAS int*)(F.lds + TP_OFF), F.ctl + CW_CNT, (const int*)(F.ws + WS_LIST), (const char*)(F.ws + WS_HID), (const char*)(F.ws + WS_EW2), F.G, (int)blockIdx.x};
        pg8::EpiBf16 E{(bf16*)(F.ws + WS_YSLOT), DM};
        pg8::gemm_phase(ring, DEXP, S, E);
    } SEAM(14);
    if (IN(15)) { moe_build_tp(F0); p15_final(F0); }
#undef IN
#undef SEAM
}

extern "C" void kernel_launch(void* const* d_in, const int* in_sizes, int n_in, void* d_out, int out_size, void* d_ws, size_t ws_size, hipStream_t stream) {
    static int grid = 0;
    if (grid == 0) {
        if (n_in != 38 || out_size != NT * DM || ws_size < WS_END) { fprintf(stderr, "kernel_launch: unexpected problem (n_in %d, out %d, ws %zu < %zu)\n", n_in, out_size, ws_size, (size_t)WS_END); grid = -1; return; }
        int dev = 0, cus = 0, per_cu = 0;
        if (hipGetDevice(&dev) != hipSuccess || hipDeviceGetAttribute(&cus, hipDeviceAttributeMultiprocessorCount, dev) != hipSuccess) { grid = -1; return; }
        if (hipFuncSetAttribute((const void*)mk_fwd, hipFuncAttributeMaxDynamicSharedMemorySize, LDS_BYTES) != hipSuccess) { fprintf(stderr, "kernel_launch: hipFuncSetAttribute failed\n"); grid = -1; return; }
        if (hipOccupancyMaxActiveBlocksPerMultiprocessor(&per_cu, (const void*)mk_fwd, NTHR, LDS_BYTES) != hipSuccess || per_cu < 1) fprintf(stderr, "kernel_launch: occupancy query says %d\n", per_cu);
        (void)hipGetLastError();
        grid = cus;
    }
    if (grid < 0) return;
    if (hipMemsetAsync((char*)d_ws + WS_CTL, 0, CTL_ZERO_BYTES, stream) != hipSuccess) return;
    Args a{};
    for (int i = 0; i < 38; ++i) a.in[i] = (const float*)d_in[i];
    a.out = (float*)d_out; a.ws = (unsigned char*)d_ws;
#if MK_N_LAUNCHES == 1
    a.ph_lo = 0; a.ph_hi = NPH;
    hipLaunchKernelGGL(mk_fwd, dim3(grid), dim3(NTHR), LDS_BYTES, stream, a);
#else
    for (int p = 0; p < NPH; ++p) { a.ph_lo = p; a.ph_hi = p + 1; hipLaunchKernelGGL(mk_fwd, dim3(grid), dim3(NTHR), LDS_BYTES, stream, a); }
#endif
}
```

```cpp
#include <hip/hip_runtime.h>
#include <cstdio>
#include <cstdint>

#ifndef MK_N_LAUNCHES
#define MK_N_LAUNCHES 1
#endif

#ifndef CONV_GEMM_BLOCKS
#define CONV_GEMM_BLOCKS 184
#endif

#define GAS __attribute__((address_space(1)))
namespace pg8 {
#define PG8_LAS __attribute__((address_space(3)))
typedef unsigned short bf16_t;
typedef short bf16x8 __attribute__((ext_vector_type(8)));
typedef float f32x4 __attribute__((ext_vector_type(4)));
typedef float f32x2 __attribute__((ext_vector_type(2)));
typedef unsigned u32x4 __attribute__((ext_vector_type(4)));
typedef unsigned u32x2 __attribute__((ext_vector_type(2)));
constexpr int BM = 256, BK = 64, HALF = 128, HTB = HALF * BK * 2, STAGE_BYTES = 8 * HTB, NXCD = 8, WGM = 8;

__host__ __device__ __forceinline__ int lds_byte(int r, int c) { const int st = (r >> 4) * 2 + (c >> 5), rr = r & 15, cc = c & 31, ob = rr * 64 + cc * 2; return st * 1024 + (ob ^ (((ob >> 9) & 1) << 5)); }
__host__ __device__ __forceinline__ void stage_rc(int b, int& R, int& C) { const int st = b / 1024, sb = b % 1024, swz = sb ^ (((sb >> 9) & 1) << 5); R = (st >> 1) * 16 + swz / 64; C = (st & 1) * 32 + (swz % 64) / 2; }
__host__ __device__ __forceinline__ int perm32(int rho) { const int n = rho >> 4, i = rho & 15; return 8 * (i >> 2) + 4 * n + (i & 3); }

struct Unit { int pm, pn, e, cnt; const char* Ab; const char* Bb; };
struct Gemm { const bf16_t* A; const bf16_t* Bt; int M, N, K; };

struct StaticOrder {
    static constexpr bool GATHER = false; static constexpr int A2 = 0;
    __device__ __forceinline__ size_t kstepA() const { return (size_t)BK * 2; }
    __device__ __forceinline__ size_t hstepA() const { return (size_t)HALF * K * 2; }
    __device__ __forceinline__ size_t a2off() const { return 0; }
    int nM, nN, nwg, G, c, K; const char* A; const char* Bt;
    __device__ void init(const Gemm& g, int G_, int c_) { nM = g.M / BM; nN = g.N / BM; nwg = nM * nN; G = G_; c = c_; K = g.K; A = (const char*)g.A; Bt = (const char*)g.Bt; }
    __device__ bool next(int i, Unit& u) const {
        const long L = (long)i * G + c; if (L >= nwg) return false;
        int wgid = (int)L; { const int q = nwg / NXCD, r = nwg % NXCD, xcd = wgid % NXCD, off = wgid / NXCD; wgid = (xcd < r ? xcd * (q + 1) : r * (q + 1) + (xcd - r) * q) + off; }
        const int nig = WGM * nN, gid = wgid / nig, fm = gid * WGM, gsz = (nM - fm) < WGM ? (nM - fm) : WGM;
        u.pm = fm + ((wgid % nig) % gsz); u.pn = (wgid % nig) / gsz; u.e = 0; u.cnt = BM;
        u.Ab = A + (size_t)u.pm * BM * K * 2; u.Bb = Bt + (size_t)u.pn * BM * K * 2; return true;
    }
    template <int NV> __device__ __forceinline__ void a_voff(const Unit&, unsigned (&v)[NV][2], const int (&R)[2], const int (&C)[2]) const {
#pragma unroll
        for (int i = 0; i < 2; ++i) v[0][i] = (unsigned)(R[i] * K + C[i]) * 2u;
    }
};

typedef __bf16 bf16x2_v __attribute__((ext_vector_type(2)));
__device__ __forceinline__ unsigned cvt_pk_bf16(float lo, float hi) { const f32x2 v = {lo, hi}; const bf16x2_v b = __builtin_convertvector(v, bf16x2_v); return __builtin_bit_cast(unsigned, b); }
__device__ __forceinline__ float bf_lo(unsigned w) { return __uint_as_float(w << 16); }
__device__ __forceinline__ float bf_hi(unsigned w) { return __uint_as_float(w & 0xffff0000u); }
__device__ __forceinline__ float sigmoidf_(float x) { return __builtin_amdgcn_rcpf(1.0f + __builtin_amdgcn_exp2f(-1.4426950408889634f * x)); }

struct EpiF32 {
    static constexpr bool AFTER_DRAIN = false; static constexpr bool PERM = false;
    float* C; int ldc;
    __device__ __forceinline__ void operator()(const f32x4 (&acc)[2][2][4][2], const Unit& u, int wr, int wc, int fr, int fq) const {
        const int row0 = u.pm * BM + wr * 64 + fr, col0 = u.pn * BM + wc * 32 + 4 * fq;
#pragma unroll
        for (int ai = 0; ai < 2; ++ai)
#pragma unroll
            for (int m = 0; m < 4; ++m) { float* rowp = C + (size_t)(row0 + ai * HALF + m * 16) * ldc + col0;
#pragma unroll
                for (int bj = 0; bj < 2; ++bj)
#pragma unroll
                    for (int n = 0; n < 2; ++n) *(f32x4*)(rowp + bj * HALF + n * 16) = acc[ai][bj][m][n]; }
    }
};
struct EpiBf16 {
    static constexpr bool AFTER_DRAIN = false; static constexpr bool PERM = true;
    bf16_t* O; int ldc;
    __device__ __forceinline__ void operator()(const f32x4 (&acc)[2][2][4][2], const Unit& u, int wr, int wc, int fr, int fq) const {
        const int row0 = u.pm * BM + wr * 64 + fr, col0 = u.pn * BM + wc * 32 + 8 * fq;
#pragma unroll
        for (int ai = 0; ai < 2; ++ai)
#pragma unroll
            for (int m = 0; m < 4; ++m) { GAS bf16_t* rowp = (GAS bf16_t*)O + (size_t)(row0 + ai * HALF + m * 16) * ldc + col0;
#pragma unroll
                for (int bj = 0; bj < 2; ++bj) { const f32x4 v0 = acc[ai][bj][m][0], v1 = acc[ai][bj][m][1];
                    u32x4 w; w.x = cvt_pk_bf16(v0[0], v0[1]); w.y = cvt_pk_bf16(v0[2], v0[3]); w.z = cvt_pk_bf16(v1[0], v1[1]); w.w = cvt_pk_bf16(v1[2], v1[3]);
                    *(GAS u32x4*)(rowp + bj * HALF) = w; } }
    }
};
struct EpiLora {
    static constexpr bool AFTER_DRAIN = false; static constexpr bool PERM = false;
    float* base; size_t stride; const float* w0; const float* a0;
    __device__ __forceinline__ void operator()(const f32x4 (&acc)[2][2][4][2], const Unit& u, int wr, int wc, int fr, int fq) const {
        const int row0 = u.pm * BM + wr * 64 + fr; const int kind = u.pn >> 2; const int col0 = (u.pn & 3) * BM + wc * 32 + 4 * fq;
        float* dst = base + (size_t)kind * stride;
        const float* bp = (kind == 0) ? w0 : a0; const float bs = (kind == 2) ? 0.f : 1.f;
        f32x4 bv[2][2];
#pragma unroll
        for (int bj = 0; bj < 2; ++bj)
#pragma unroll
            for (int n = 0; n < 2; ++n) bv[bj][n] = *(const f32x4*)(bp + col0 + bj * HALF + n * 16) * bs;
#pragma unroll
        for (int ai = 0; ai < 2; ++ai)
#pragma unroll
            for (int m = 0; m < 4; ++m) { float* rowp = dst + (size_t)(row0 + ai * HALF + m * 16) * 1024 + col0;
#pragma unroll
                for (int bj = 0; bj < 2; ++bj)
#pragma unroll
                    for (int n = 0; n < 2; ++n) { f32x4 v = acc[ai][bj][m][n] + bv[bj][n];
                        if (kind == 0) {
#pragma unroll
                            for (int j = 0; j < 4; ++j) v[j] = __expf(-0.6065306597126334f * sigmoidf_(v[j])); }
                        else if (kind == 1) {
#pragma unroll
                            for (int j = 0; j < 4; ++j) v[j] = sigmoidf_(v[j]); }
                        *(f32x4*)(rowp + bj * HALF + n * 16) = v; } }
    }
};
struct EpiGlu {
    static constexpr bool AFTER_DRAIN = false; static constexpr bool PERM = true;
    const bf16_t* Y; bf16_t* O; int ldo; const float* bias;
    __device__ __forceinline__ void operator()(const f32x4 (&acc)[2][2][4][2], const Unit& u, int wr, int wc, int fr, int fq) const {
        const int row0 = u.pm * BM + wr * 64 + fr, col0 = u.pn * BM + wc * 32 + 8 * fq;
        f32x4 bv[2][2];
#pragma unroll
        for (int bj = 0; bj < 2; ++bj)
#pragma unroll
            for (int n = 0; n < 2; ++n) bv[bj][n] = *(const GAS f32x4*)((const GAS float*)bias + col0 + bj * HALF + 4 * n);
#pragma unroll
        for (int ai = 0; ai < 2; ++ai)
#pragma unroll
            for (int m = 0; m < 4; ++m) { const size_t r = (size_t)(row0 + ai * HALF + m * 16);
#pragma unroll
                for (int bj = 0; bj < 2; ++bj) { const u32x4 yv = *(const GAS u32x4*)((const GAS bf16_t*)Y + r * 1024 + col0 + bj * HALF);
                    const f32x4 v0 = acc[ai][bj][m][0] + bv[bj][0], v1 = acc[ai][bj][m][1] + bv[bj][1];
                    u32x4 w;
                    w.x = cvt_pk_bf16(bf_lo(yv.x) * sigmoidf_(v0[0]), bf_hi(yv.x) * sigmoidf_(v0[1]));
                    w.y = cvt_pk_bf16(bf_lo(yv.y) * sigmoidf_(v0[2]), bf_hi(yv.y) * sigmoidf_(v0[3]));
                    w.z = cvt_pk_bf16(bf_lo(yv.z) * sigmoidf_(v1[0]), bf_hi(yv.z) * sigmoidf_(v1[1]));
                    w.w = cvt_pk_bf16(bf_lo(yv.w) * sigmoidf_(v1[2]), bf_hi(yv.w) * sigmoidf_(v1[3]));
                    *(GAS u32x4*)((GAS bf16_t*)O + r * ldo + col0 + bj * HALF) = w; } }
    }
};
struct EpiSwiglu {
    static constexpr bool AFTER_DRAIN = false; static constexpr bool PERM = true;
    bf16_t* Hd;
    __device__ __forceinline__ void operator()(const f32x4 (&acc)[2][2][4][2], const Unit& u, int wr, int wc, int fr, int fq) const {
        const int row0 = u.pm * BM + wr * 64 + fr, col0 = u.pn * HALF + wc * 32 + 8 * fq;
#pragma unroll
        for (int ai = 0; ai < 2; ++ai)
#pragma unroll
            for (int m = 0; m < 4; ++m) { GAS bf16_t* rowp = (GAS bf16_t*)Hd + (size_t)(row0 + ai * HALF + m * 16) * 512 + col0;
                float o[8];
#pragma unroll
                for (int n = 0; n < 2; ++n)
#pragma unroll
                    for (int j = 0; j < 4; ++j) { const float a = acc[ai][0][m][n][j], b = acc[ai][1][m][n][j]; o[n * 4 + j] = a * sigmoidf_(a) * b; }
                u32x4 w; w.x = cvt_pk_bf16(o[0], o[1]); w.y = cvt_pk_bf16(o[2], o[3]); w.z = cvt_pk_bf16(o[4], o[5]); w.w = cvt_pk_bf16(o[6], o[7]);
                *(GAS u32x4*)rowp = w; }
    }
};

struct EpiS5Scan {
    static constexpr bool AFTER_DRAIN = true; static constexpr bool PERM = false;
    bf16_t* SIN; const float* lam_re; const float* lam_im; const float* log_dt;
    __device__ __forceinline__ void operator()(const f32x4 (&)[2][2][4][2], const Unit&, int, int, int, int) const {}
    __device__ __forceinline__ void fused(const f32x4 (&acc)[2][2][4][2], const Unit& u, int wr, int wc, int fr, int fq, PG8_LAS unsigned char* lds) const {
        PG8_LAS float* T = (PG8_LAS float*)lds;
#pragma unroll
        for (int ai = 0; ai < 2; ++ai)
#pragma unroll
            for (int m = 0; m < 4; ++m)
#pragma unroll
                for (int n = 0; n < 2; ++n) *(PG8_LAS f32x4*)(T + (ai * HALF + wr * 64 + m * 16 + fr) * 128 + wc * 32 + n * 16 + 4 * fq) = acc[ai][0][m][n];
        __syncthreads();
        const int tid = threadIdx.x;
        if (tid < 128) {
            const int b2 = tid >> 6, p = tid & 63, g = u.e;
            const float lr = fminf(lam_re[g * 64 + p], -1e-4f), li = lam_im[g * 64 + p], dt = __expf(log_dt[g]);
            const float mag = __expf(lr * dt * 16.f), ang = li * dt * 16.f; const float ar = mag * cosf(ang), ai_ = mag * sinf(ang);
            float sr = 0.f, si = 0.f;
            GAS bf16_t* dst = (GAS bf16_t*)SIN + ((size_t)(u.pm * 256 + b2 * 128) * 16 + (p >> 4)) * 4352 + g * 16 + (p & 15);
            const PG8_LAS float* src = T + (b2 * 128) * 128 + p;
#pragma unroll 8
            for (int ch = 0; ch < 128; ++ch) {
                const unsigned w = cvt_pk_bf16(sr, si);
                dst[(size_t)ch * 16 * 4352] = (bf16_t)(w & 0xffffu); dst[(size_t)ch * 16 * 4352 + 4 * 4352] = (bf16_t)(w >> 16);
                const float lr_ = src[ch * 128], li_ = src[ch * 128 + 64];
                const float nr = ar * sr - ai_ * si + lr_, ni = ar * si + ai_ * sr + li_; sr = nr; si = ni;
            }
        }
    }
};
__device__ __forceinline__ float gelu_tanh_(float y) { const float u = 0.7978845608028654f * (y + 0.044715f * y * y * y); const float e = __builtin_amdgcn_exp2f(2.8853900817779268f * u); return y * (1.f - __builtin_amdgcn_rcpf(e + 1.f)); }
struct EpiS5Y {
    static constexpr bool AFTER_DRAIN = false; static constexpr bool PERM = true;
    bf16_t* Y;
    __device__ __forceinline__ void operator()(const f32x4 (&acc)[2][2][4][2], const Unit& u, int wr, int wc, int fr, int fq) const {
        const int row0 = u.pm * BM + wr * 64 + fr;
#pragma unroll
        for (int ai = 0; ai < 2; ++ai)
#pragma unroll
            for (int m = 0; m < 4; ++m) { const size_t r = (size_t)(row0 + ai * HALF + m * 16);
#pragma unroll
                for (int bj = 0; bj < 2; ++bj) { const int col = bj * HALF + wc * 32 + 8 * fq; const int t = col >> 4, c = col & 15;
                    const f32x4 v0 = acc[ai][bj][m][0], v1 = acc[ai][bj][m][1];
                    u32x4 w; w.x = cvt_pk_bf16(gelu_tanh_(v0[0]), gelu_tanh_(v0[1])); w.y = cvt_pk_bf16(gelu_tanh_(v0[2]), gelu_tanh_(v0[3]));
                    w.z = cvt_pk_bf16(gelu_tanh_(v1[0]), gelu_tanh_(v1[1])); w.w = cvt_pk_bf16(gelu_tanh_(v1[2]), gelu_tanh_(v1[3]));
                    *(GAS u32x4*)((GAS bf16_t*)Y + (r * 16 + t) * 1024 + u.e * 16 + c) = w; } }
    }
};

template <class Epi, class Sched>
__device__ __forceinline__ void gemm_phase(PG8_LAS unsigned char* lds, const int K, const Sched& S, const Epi& E) {
    const int tid = threadIdx.x, wid = __builtin_amdgcn_readfirstlane(tid >> 6), lane = tid & 63, wr = wid >> 2, wc = wid & 3, fr = lane & 15, fq = lane >> 4;
    const int nt = K / BK;
    int RR[2], CC[2]; unsigned voffB[2];
#pragma unroll
    for (int i = 0; i < 2; ++i) { stage_rc(tid * 16 + i * 8192, RR[i], CC[i]); const int Rb = Epi::PERM ? ((RR[i] & ~31) + perm32(RR[i] & 31)) : RR[i];
        voffB[i] = (unsigned)(Rb * K + CC[i]) * 2u; }
    const size_t kstep = (size_t)(BK * 2);
    const size_t hstep = (size_t)HALF * K * 2;
    const unsigned ldsw = (unsigned)wid * 1024u;
    const int aoff = lds_byte(wr * 64 + fr, fq * 8), boff = lds_byte(wc * 32 + fr, fq * 8);
#define PG8_SA(b, h) (((b) * 2 + (h)) * HTB)
#define PG8_SB(b, h) ((4 + (b) * 2 + (h)) * HTB)
#define PG8_STAGE(bufoff, gbase, voff) do { _Pragma("unroll") for (int _i = 0; _i < 2; ++_i) \
        __builtin_amdgcn_global_load_lds((const unsigned*)((const char*)(gbase) + (voff)[_i]), (PG8_LAS unsigned*)(lds + (bufoff) + ldsw + _i * 8192), 16, 0, 0); } while (0)
#define PG8_LDA(dst, b, h) do { _Pragma("unroll") for (int m = 0; m < 4; ++m) _Pragma("unroll") for (int k = 0; k < 2; ++k) dst[m][k] = *(const PG8_LAS bf16x8*)(lds + PG8_SA(b, h) + aoff + m * 2048 + k * 1024); } while (0)
#define PG8_LDB(dst, b, h) do { _Pragma("unroll") for (int n = 0; n < 2; ++n) _Pragma("unroll") for (int k = 0; k < 2; ++k) dst[n][k] = *(const PG8_LAS bf16x8*)(lds + PG8_SB(b, h) + boff + n * 2048 + k * 1024); } while (0)
#define PG8_MMA(ai, bj, At, Bt) do { __builtin_amdgcn_s_setprio(1); _Pragma("unroll") for (int m = 0; m < 4; ++m) _Pragma("unroll") for (int n = 0; n < 2; ++n) _Pragma("unroll") for (int k = 0; k < 2; ++k) \
        acc[ai][bj][m][n] = __builtin_amdgcn_mfma_f32_16x16x32_bf16(Bt[n][k], At[m][k], acc[ai][bj][m][n], 0, 0, 0); __builtin_amdgcn_s_setprio(0); } while (0)
#define PG8_WAIT_V(n) asm volatile("s_waitcnt vmcnt(" #n ")" ::: "memory")
#define PG8_WAIT_L(n) asm volatile("s_waitcnt lgkmcnt(" #n ")" ::: "memory")
#define PG8_BAR __builtin_amdgcn_s_barrier()
#define PG8_SCHED __builtin_amdgcn_sched_barrier(0)
    Unit cur, nxt; int ui = 0;
    if (!S.next(0, cur)) return;
    f32x4 acc[2][2][4][2];
#pragma unroll
    for (int a = 0; a < 2; ++a)
#pragma unroll
        for (int b = 0; b < 2; ++b)
#pragma unroll
            for (int m = 0; m < 4; ++m)
#pragma unroll
                for (int n = 0; n < 2; ++n) acc[a][b][m][n] = (f32x4){0.f, 0.f, 0.f, 0.f};
    bf16x8 At[4][2], B0[2][2], B1[2][2];
    constexpr bool GA = Sched::GATHER;
    constexpr int A2 = Sched::A2;
    constexpr int NV = GA ? 2 : 1;
    unsigned vA[NV][2], vN[NV][2];
    const size_t kstepA = S.kstepA(), hstepA = GA ? 0 : S.hstepA();
    const size_t a2off = (A2 > 0) ? S.a2off() : 0;
    S.template a_voff<NV>(cur, vA, RR, CC);
    const char* cA = cur.Ab; const char* cB = cur.Bb;
    PG8_STAGE(PG8_SB(0, 0), cB, voffB); PG8_STAGE(PG8_SB(0, 1), cB + hstep, voffB); PG8_STAGE(PG8_SA(0, 0), cA, vA[0]); PG8_STAGE(PG8_SA(0, 1), cA + hstepA, vA[NV - 1]);
    if (wr == 1) PG8_BAR;
    PG8_WAIT_V(2); PG8_BAR;
    PG8_STAGE(PG8_SB(1, 0), cB + kstep, voffB); PG8_STAGE(PG8_SA(1, 0), cA + kstepA, vA[0]); PG8_STAGE(PG8_SB(1, 1), cB + hstep + kstep, voffB);
    PG8_WAIT_V(6); PG8_BAR;
    for (;;) {
        const bool has_next = S.next(ui + 1, nxt);
        const char* nA = has_next ? nxt.Ab : cA; const char* nB = has_next ? nxt.Bb : cB;
        if constexpr (GA) {
            if (has_next) S.template a_voff<NV>(nxt, vN, RR, CC);
            else {
#pragma unroll
                for (int h = 0; h < NV; ++h)
#pragma unroll
                    for (int i = 0; i < 2; ++i) vN[h][i] = vA[h][i]; }
        }
#pragma clang loop unroll(disable)
        for (int t = 0; t < nt; t += 2) {
            const bool last = (t == nt - 2);
            const bool s1 = (A2 > 0) && (t + 1 >= A2), s2 = (A2 > 0) && !last && (t + 2 >= A2);
            const char* a1 = cA + (size_t)(t + 1) * kstepA + (s1 ? a2off : 0);
            const char* a2 = last ? nA : cA + (size_t)(t + 2) * kstepA + (s2 ? a2off : 0);
            const char* a3 = a2 + kstepA;
            const char* b2 = last ? nB : cB + (size_t)(t + 2) * kstep; const char* b3 = b2 + kstep;
            unsigned v2[NV][2];
#pragma unroll
            for (int h = 0; h < NV; ++h)
#pragma unroll
                for (int i = 0; i < 2; ++i) v2[h][i] = (GA && last) ? vN[h][i] : vA[h][i];
            PG8_LDB(B0, 0, 0); PG8_LDB(B1, 0, 1); PG8_SCHED; PG8_LDA(At, 0, 0); PG8_STAGE(PG8_SA(1, 1), a1 + hstepA, vA[NV - 1]);
            PG8_WAIT_V(8); PG8_WAIT_L(0); PG8_BAR; PG8_MMA(0, 0, At, B0); PG8_MMA(0, 1, At, B1); PG8_BAR; PG8_SCHED;
            PG8_LDA(At, 0, 1); PG8_STAGE(PG8_SB(0, 0), b2, voffB); PG8_STAGE(PG8_SB(0, 1), b2 + hstep, voffB); PG8_STAGE(PG8_SA(0, 0), a2, v2[0]);
            PG8_WAIT_V(8); PG8_WAIT_L(0); PG8_BAR; PG8_MMA(1, 0, At, B0); PG8_MMA(1, 1, At, B1); PG8_BAR; PG8_SCHED;
            PG8_LDB(B0, 1, 0); PG8_LDB(B1, 1, 1); PG8_SCHED; PG8_LDA(At, 1, 0); PG8_STAGE(PG8_SA(0, 1), a2 + hstepA, v2[NV - 1]);
            PG8_WAIT_V(8); PG8_WAIT_L(0); PG8_BAR; PG8_MMA(0, 0, At, B0); PG8_MMA(0, 1, At, B1); PG8_BAR; PG8_SCHED;
            PG8_LDA(At, 1, 1); PG8_STAGE(PG8_SB(1, 0), b3, voffB); PG8_STAGE(PG8_SB(1, 1), b3 + hstep, voffB); PG8_STAGE(PG8_SA(1, 0), a3, v2[0]);
            PG8_WAIT_V(8); PG8_WAIT_L(0); PG8_BAR; PG8_MMA(1, 0, At, B0); PG8_MMA(1, 1, At, B1); PG8_BAR; PG8_SCHED;
        }
        if (wr == 0) PG8_BAR;
        if constexpr (!Epi::AFTER_DRAIN) E(acc, cur, wr, wc, fr, fq);
        if (!has_next) break;
#pragma unroll
        for (int a = 0; a < 2; ++a)
#pragma unroll
            for (int b = 0; b < 2; ++b)
#pragma unroll
                for (int m = 0; m < 4; ++m)
#pragma unroll
                    for (int n = 0; n < 2; ++n) acc[a][b][m][n] = (f32x4){0.f, 0.f, 0.f, 0.f};
        cur = nxt; cA = nA; cB = nB; ++ui;
        if constexpr (GA) {
#pragma unroll
            for (int h = 0; h < NV; ++h)
#pragma unroll
                for (int i = 0; i < 2; ++i) vA[h][i] = vN[h][i]; }
        if (wr == 1) PG8_BAR;
    }
    PG8_WAIT_V(0);
    PG8_BAR;
    if constexpr (Epi::AFTER_DRAIN) E.fused(acc, cur, wr, wc, fr, fq, lds);
#undef PG8_SA
#undef PG8_SB
#undef PG8_STAGE
#undef PG8_LDA
#undef PG8_LDB
#undef PG8_MMA
#undef PG8_WAIT_V
#undef PG8_WAIT_L
#undef PG8_BAR
#undef PG8_SCHED
}
}
using pg8::f32x4; using pg8::f32x2; using pg8::u32x4; using pg8::u32x2; using pg8::cvt_pk_bf16; using pg8::bf_lo; using pg8::bf_hi; using pg8::sigmoidf_;

constexpr int NWAVES = 8, NTHR = 512;
constexpr int DM = 2048, NB = 8, SEQ = 2048, NT = NB * SEQ;
constexpr int DSSM = 1024, NG = 64, GC = 16, NP = 64;
constexpr int DRW = 1024, NH = 16, HD = 64;
constexpr int DIN = 4352, ZW = 3328;
constexpr int NEXP = 64, DEXP = 512, NMOD = 6 * DM;
constexpr float RMS_EPS = 1e-6f, GN_EPS = 64e-5f;
constexpr int CAP_ROWS = 49152;

constexpr size_t MiB = 1u << 20;
constexpr size_t WS_CTL = 0, CTL_ZERO_BYTES = 1 * MiB;
constexpr size_t WS_MOD = 1 * MiB;
constexpr size_t WS_RWT = 1 * MiB + 512 * 1024;
constexpr size_t WS_LORA_T = 2 * MiB + 512 * 1024;
constexpr size_t WS_GLU_T = 4 * MiB;
constexpr size_t WS_WOUT_T = 6 * MiB;
constexpr size_t WS_WIN_T = 14 * MiB;
constexpr size_t WS_TOKINFO = 31 * MiB;
constexpr size_t WS_LIST = 32 * MiB;
constexpr size_t WS_LIN = 36 * MiB;
constexpr size_t WS_H = 44 * MiB;
constexpr size_t WS_PROJ = 108 * MiB;
constexpr size_t WS_MIX = 244 * MiB;
constexpr size_t WS_EW1 = 308 * MiB;
constexpr size_t WS_EW2 = 564 * MiB;
constexpr size_t WS_SIN = 692 * MiB;
constexpr size_t WS_YSG = 828 * MiB;
constexpr size_t WS_S5MT = 860 * MiB;
constexpr size_t WS_S5WT = 872 * MiB;
constexpr size_t WS_VB = 692 * MiB;
constexpr size_t WS_GB = 724 * MiB;
constexpr size_t WS_GHQ = 756 * MiB;
constexpr size_t WS_GT = 948 * MiB;
constexpr size_t WS_BON = 950 * MiB;
constexpr size_t WS_Y = 952 * MiB;
constexpr size_t WS_X1 = 692 * MiB;
constexpr size_t WS_HID = 756 * MiB;
constexpr size_t WS_END = 984 * MiB;
constexpr size_t WS_MIXED = 108 * MiB;
constexpr size_t WS_YSLOT = 108 * MiB;
static_assert(WS_YSLOT + (size_t)CAP_ROWS * 2048 * 2 <= WS_EW1, "yslot overlay");
static_assert(WS_HID + (size_t)CAP_ROWS * 512 * 2 <= WS_END && WS_GHQ + (size_t)8192 * 12288 * 2 <= WS_GT && WS_SIN + (size_t)NT * DIN * 2 <= WS_YSG, "pool");
constexpr int CW_TMO = 0;
constexpr int CW_BAR = 4096;
constexpr int CW_CNT = 16384;
constexpr int CW_GDONE = 8192, CW_STOP = 8192 + 64, CW_PROG = 8192 + 128;
constexpr int CONV_ITEMS = NEXP * 1536;


constexpr int RING_BYTES = 131072;
constexpr int LDSCTL_OFF = 147456 - 2048;
constexpr int MISC_OFF = LDSCTL_OFF;
constexpr int TP_OFF = LDSCTL_OFF + 256;
constexpr int LDS_BYTES = 147456;

#define LAS __attribute__((address_space(3)))
typedef unsigned short bf16;
typedef GAS unsigned gu32;
#define RLX_AGENT __ATOMIC_RELAXED, __HIP_MEMORY_SCOPE_AGENT

#define XB_TMO      128
#define XB_XCNT(j)  (256  + 64 * (j))
#define XB_XSUB(j)  (1280 + 64 * (j))
#define XB_XGEN(j)  (2304 + 64 * (j))
#define XB_TOP      3328
#define XB_TOPGEN   3392
#define XCD_BAR_WORDS 3456
#define XB_SPIN_CAP (1u << 18)
__device__ __forceinline__ unsigned xb_ld(unsigned* p)              { return __hip_atomic_load(p, __ATOMIC_RELAXED, __HIP_MEMORY_SCOPE_AGENT); }
__device__ __forceinline__ unsigned xb_add(unsigned* p, unsigned v) { return __hip_atomic_fetch_add(p, v, __ATOMIC_RELAXED, __HIP_MEMORY_SCOPE_AGENT); }
__device__ __forceinline__ unsigned xb_xcc_id() { return (unsigned)__builtin_amdgcn_s_getreg((3 << 11) | 20) & 0xFu; }
#define XB_SPIN(cond, bar) do { unsigned _sp = 0; while (cond) { __builtin_amdgcn_s_sleep(1); \
    if ((++_sp & 255u) == 0u) { if (xb_ld(&(bar)[XB_TMO])) break; if (_sp > XB_SPIN_CAP) { atomicAdd(&(bar)[XB_TMO], 1u); break; } } } } while (0)
struct XcdBarrier { unsigned* bar; unsigned x; volatile LAS unsigned* st; };
__device__ __forceinline__ XcdBarrier xcd_barrier_post(unsigned* bar, volatile LAS unsigned* st) {
    XcdBarrier b; b.bar = bar; b.x = xb_xcc_id(); b.st = st;
    if (threadIdx.x == 0) (void)xb_add(&bar[XB_XCNT(b.x)], 1u);
    return b;
}
__device__ __forceinline__ void xcd_barrier_complete(unsigned* bar, unsigned x, unsigned& nloc, unsigned& nx) {
    const unsigned G = gridDim.x * gridDim.y * gridDim.z;
    unsigned sum, cnt, mine, sp = 0u;
    for (;;) {
        sum = 0u; cnt = 0u; mine = 0u;
#pragma unroll
        for (unsigned j = 0; j < 16; ++j) { const unsigned c = xb_ld(&bar[XB_XCNT(j)]); sum += c; cnt += (c > 0u) ? 1u : 0u; mine = (j == x) ? c : mine; }
        if (sum == G) break;
        __builtin_amdgcn_s_sleep(1);
        if ((++sp & 255u) == 0u) { if (xb_ld(&bar[XB_TMO])) break; if (sp > XB_SPIN_CAP) { atomicAdd(&bar[XB_TMO], 1u); break; } }
    }
    nloc = mine > 0u ? mine : 1u; nx = cnt > 0u ? cnt : 1u;
}
__device__ __forceinline__ void xcd_barrier(const XcdBarrier& b) {
    asm volatile("s_waitcnt vmcnt(0)" ::: "memory");
    __syncthreads();
    if (threadIdx.x == 0) {
        unsigned* bar = b.bar;
        __builtin_amdgcn_s_waitcnt(0);
        unsigned nloc = b.st[0], nx = b.st[1];
        if (nloc == 0u) { xcd_barrier_complete(bar, b.x, nloc, nx); b.st[0] = nloc; b.st[1] = nx; }
        const unsigned old = xb_add(&bar[XB_XSUB(b.x)], 1u);
        const unsigned gen = old / nloc;
        if (old + 1u == (gen + 1u) * nloc) {
            __builtin_amdgcn_fence(__ATOMIC_RELEASE, "agent");
            asm volatile("s_waitcnt vmcnt(0)" ::: "memory");
            const unsigned og = xb_add(&bar[XB_TOP], 1u);
            const unsigned tg = og / nx;
            if (og + 1u == (tg + 1u) * nx) xb_add(&bar[XB_TOPGEN], 1u);
            else XB_SPIN(xb_ld(&bar[XB_TOPGEN]) == tg, bar);
            __builtin_amdgcn_fence(__ATOMIC_ACQUIRE, "agent");
            xb_add(&bar[XB_XGEN(b.x)], 1u);
            asm volatile("s_waitcnt vmcnt(0)" ::: "memory");
        } else {
            XB_SPIN(xb_ld(&bar[XB_XGEN(b.x)]) == gen, bar);
            __builtin_amdgcn_fence(__ATOMIC_ACQUIRE, "agent");
            asm volatile("s_waitcnt vmcnt(0)" ::: "memory");
        }
    }
    __syncthreads();
}

struct Args { const float* in[38]; float* out; unsigned char* ws; int ph_lo, ph_hi; };
typedef const float* cfp_t;
typedef __attribute__((address_space(4))) const unsigned char* kargp_t;
struct InTab { kargp_t kp;
    __device__ __forceinline__ const float* operator[](int i) const { return *(const __attribute__((address_space(4))) cfp_t*)(kp + 8 * i); } };
struct Frame {
    LAS unsigned char* lds; volatile LAS unsigned* MISC; unsigned* ctl;
    int tid, lane, wave, vcu, G;
    InTab in; float* out; unsigned char* ws;
};
#define LDS_WAIT() asm volatile("s_waitcnt lgkmcnt(0)" ::: "memory")
#define LAUNDER(p) asm volatile("" : "+s"(p))
#define LDS_BARRIER() do { asm volatile("s_waitcnt lgkmcnt(0)" ::: "memory"); __builtin_amdgcn_s_barrier(); asm volatile("" ::: "memory"); } while (0)
#define PHASE_VIEW() Frame F = F0; LAUNDER(F.ws); LAUNDER(F.in.kp); LAUNDER(F.ctl)
__device__ __forceinline__ float wave_sum(float v) {
#pragma unroll
    for (int o = 1; o < 64; o <<= 1) v += __shfl_xor(v, o);
    return v;
}
__device__ __forceinline__ float wave_max(float v) {
#pragma unroll
    for (int o = 1; o < 64; o <<= 1) v = fmaxf(v, __shfl_xor(v, o));
    return v;
}
__device__ __forceinline__ float row16_sum(float x) {
    x += __builtin_bit_cast(float, __builtin_amdgcn_update_dpp(0, __builtin_bit_cast(int, x), 0xB1, 0xf, 0xf, false));
    x += __builtin_bit_cast(float, __builtin_amdgcn_update_dpp(0, __builtin_bit_cast(int, x), 0x4E, 0xf, 0xf, false));
    x += __builtin_bit_cast(float, __builtin_amdgcn_update_dpp(0, __builtin_bit_cast(int, x), 0x141, 0xf, 0xf, false));
    x += __builtin_bit_cast(float, __builtin_amdgcn_update_dpp(0, __builtin_bit_cast(int, x), 0x140, 0xf, 0xf, false));
    return x;
}
__device__ __forceinline__ unsigned pk2(float lo, float hi) { return cvt_pk_bf16(lo, hi); }
__device__ __forceinline__ float bf2f(bf16 b) { return __uint_as_float(((unsigned)b) << 16); }
__device__ __forceinline__ float gelu_tanh(float y) { const float u = 0.7978845608028654f * (y + 0.044715f * y * y * y); const float e = __expf(2.f * u); const float th = 1.f - 2.f / (e + 1.f); return 0.5f * y * (1.f + th); }

__device__ __forceinline__ void transpose_item(const float* W, int N, bf16* WT, int ldk, int dst_row0, int k0, int n0, int kdst0, LAS float* scr, int lane) {
    float tv[32];
#pragma unroll
    for (int i = 0; i < 32; ++i) tv[i] = W[(size_t)(k0 + 2 * i + (lane >> 5)) * N + n0 + (lane & 31)];
#pragma unroll
    for (int i = 0; i < 32; ++i) scr[(2 * i + (lane >> 5)) * 33 + (lane & 31)] = tv[i];
    LDS_WAIT(); asm volatile("" ::: "memory");
    const int c = lane & 7;
#pragma unroll
    for (int j = 0; j < 4; ++j) { const int n = (lane >> 3) + 8 * j; const LAS float* s = scr + (8 * c) * 33 + n;
        u32x4 o; o.x = pk2(s[0 * 33], s[1 * 33]); o.y = pk2(s[2 * 33], s[3 * 33]); o.z = pk2(s[4 * 33], s[5 * 33]); o.w = pk2(s[6 * 33], s[7 * 33]);
        *(u32x4*)(WT + (size_t)(dst_row0 + n) * ldk + kdst0 + 8 * c) = o; }
    LDS_WAIT(); asm volatile("" ::: "memory");
}

constexpr int PROJ_PITCH = DIN * 2;
template <int PASS> struct S5Order {
    static constexpr bool GATHER = false; static constexpr int A2 = PASS == 2 ? 4 : 0;
    static constexpr int KB = PASS == 2 ? 384 : 256;
    const char* U; const char* SIN; const char* BT; int G, c;
    __device__ __forceinline__ size_t kstepA() const { return (size_t)4 * PROJ_PITCH; }
    __device__ __forceinline__ size_t hstepA() const { return (size_t)128 * 16 * PROJ_PITCH; }
    __device__ __forceinline__ size_t a2off() const { return (size_t)(SIN - U) - (size_t)A2 * kstepA(); }
    __device__ bool next(int i, pg8::Unit& u) const {
        const int L = i * G + c; if (L >= NG * 4) return false;
        const int g = L >> 2, pm = L & 3; u.e = g; u.pm = pm; u.pn = 0; u.cnt = 256;
        u.Ab = U + (size_t)g * 32 + (size_t)pm * 256 * 16 * PROJ_PITCH; u.Bb = BT + (size_t)g * 256 * KB * 2;
        return true;
    }
    template <int NV> __device__ __forceinline__ void a_voff(const pg8::Unit&, unsigned (&v)[NV][2], const int (&R)[2], const int (&C)[2]) const {
#pragma unroll
        for (int i = 0; i < 2; ++i) v[0][i] = (unsigned)(R[i] * 16 * PROJ_PITCH + (C[i] >> 4) * PROJ_PITCH + (C[i] & 15) * 2);
    }
};
__device__ __forceinline__ void s5_build(const Frame& F, int g) {
    const float* lam_re = F.in[10]; const float* lam_im = F.in[11]; const float* log_dt = F.in[12];
    const float* b_re = F.in[13]; const float* b_im = F.in[14]; const float* c_re = F.in[15]; const float* c_im = F.in[16]; const float* dsk = F.in[17];
    LAS float* pwr = (LAS float*)F.lds; LAS float* pwi = pwr + 17 * 64; LAS float* bbr = pwi + 17 * 64; LAS float* bbi = bbr + 1024; LAS float* cre = bbi + 1024; LAS float* cim = cre + 1024; LAS float* Kt = cim + 1024;
    bf16* MT = (bf16*)(F.ws + WS_S5MT) + (size_t)g * 256 * 384; bf16* WT = (bf16*)(F.ws + WS_S5WT) + (size_t)g * 256 * 256;
    const float dt = __expf(log_dt[g]);
    __syncthreads();
    for (int i = F.tid; i < 17 * 64; i += NTHR) { const int tau = i >> 6, p = i & 63; const float lr = fminf(lam_re[g * NP + p], -1e-4f), li = lam_im[g * NP + p];
        const float mag = __expf(lr * dt * (float)tau), ang = li * dt * (float)tau; pwr[i] = mag * cosf(ang); pwi[i] = mag * sinf(ang); }
    for (int i = F.tid; i < 1024; i += NTHR) { const int p = i >> 4; const float lr = fminf(lam_re[g * NP + p], -1e-4f), li = lam_im[g * NP + p];
        const float mag = __expf(lr * dt), ang = li * dt; const float ar = mag * cosf(ang), ai = mag * sinf(ang), den = lr * lr + li * li;
        const float qr = ((ar - 1.f) * lr + ai * li) / den, qi = (ai * lr - (ar - 1.f) * li) / den;
        const float br = b_re[(size_t)g * 1024 + i], bi = b_im[(size_t)g * 1024 + i]; bbr[i] = qr * br - qi * bi; bbi[i] = qr * bi + qi * br;
        cre[i] = c_re[(size_t)g * 1024 + i]; cim[i] = c_im[(size_t)g * 1024 + i]; }
    __syncthreads();
    for (int i = F.tid; i < 4096; i += NTHR) { const int tau = i >> 8, c = (i >> 4) & 15, c2 = i & 15; float acc = 0.f;
        for (int p = 0; p < 64; ++p) { const float cr = cre[c * 64 + p], ci = cim[c * 64 + p], pr = pwr[tau * 64 + p], pi = pwi[tau * 64 + p];
            const float car = cr * pr - ci * pi, cai = cr * pi + ci * pr; acc += car * bbr[p * 16 + c2] - cai * bbi[p * 16 + c2]; }
        Kt[i] = acc; }
    __syncthreads();
    for (int i = F.tid; i < 256 * 192; i += NTHR) { const int row = i / 192, col = (i % 192) * 2; const int t = row >> 4, c = row & 15; float v[2];
#pragma unroll
        for (int q = 0; q < 2; ++q) { const int cc = col + q;
            if (cc < 256) { const int j = cc >> 4, c2 = cc & 15; float x = (j <= t) ? Kt[(t - j) * 256 + c * 16 + c2] : 0.f; if (j == t && c2 == c) x += dsk[g * GC + c]; v[q] = x; }
            else { const int pp = cc - 256, p = pp & 63; const float pr = pwr[(t + 1) * 64 + p], pi = pwi[(t + 1) * 64 + p], cr = cre[c * 64 + p], ci = cim[c * 64 + p];
                v[q] = (pp < 64) ? (cr * pr - ci * pi) : -(cr * pi + ci * pr); } }
        *(unsigned*)(MT + (size_t)row * 384 + col) = pk2(v[0], v[1]); }
    for (int i = F.tid; i < 128 * 128; i += NTHR) { const int row = i >> 7, col = (i & 127) * 2; const int part = row >> 6, p = row & 63; float v[2];
#pragma unroll
        for (int q = 0; q < 2; ++q) { const int cc = col + q, j = cc >> 4, c2 = cc & 15; const float pr = pwr[(15 - j) * 64 + p], pi = pwi[(15 - j) * 64 + p], br = bbr[p * 16 + c2], bi = bbi[p * 16 + c2];
            v[q] = part == 0 ? (pr * br - pi * bi) : (pr * bi + pi * br); }
        *(unsigned*)(WT + (size_t)row * 256 + col) = pk2(v[0], v[1]); }
    __syncthreads();
}

__device__ __forceinline__ void p0_prologue(const Frame& F0) {
    PHASE_VIEW();
    const float* c = F.in[1]; const float* ada_w = F.in[2]; const float* ada_b = F.in[3];
    float* mod = (float*)(F.ws + WS_MOD);
    LAS float* sc = (LAS float*)F.lds;
    LAS float* red = (LAS float*)(F.lds + 65536);
    for (int i = F.tid; i < NB * DM; i += NTHR) { const float v = c[i]; sc[i] = v / (1.f + __expf(-v)); }
    __syncthreads();
    for (int item = F.vcu; item < NMOD / 64; item += F.G) {
        const int col = item * 64 + F.lane, ks = F.wave;
        float acc[8] = {0.f, 0.f, 0.f, 0.f, 0.f, 0.f, 0.f, 0.f};
        for (int k = ks * 256; k < ks * 256 + 256; k += 16) { float w[16];
#pragma unroll
            for (int u = 0; u < 16; ++u) w[u] = ada_w[(size_t)(k + u) * NMOD + col];
#pragma unroll
            for (int u = 0; u < 16; ++u)
#pragma unroll
                for (int b = 0; b < 8; ++b) acc[b] += sc[b * DM + k + u] * w[u]; }
#pragma unroll
        for (int b = 0; b < 8; ++b) red[(ks * 8 + b) * 64 + F.lane] = acc[b];
        __syncthreads();
        { const int b = F.wave; float s = 0.f;
#pragma unroll
          for (int k2 = 0; k2 < 8; ++k2) s += red[(k2 * 8 + b) * 64 + F.lane];
          mod[b * NMOD + col] = s + ada_b[col]; }
        __syncthreads();
    }
    __syncthreads();
    for (int g = F.G - 1 - F.vcu; g < NG; g += F.G) s5_build(F, g);
    LAS float* scr = (LAS float*)(F.lds + F.wave * 16384);
    const int gw = F.vcu * NWAVES + F.wave, NGW = F.G * NWAVES;
    bf16* WinT = (bf16*)(F.ws + WS_WIN_T); bf16* WoutT = (bf16*)(F.ws + WS_WOUT_T); bf16* GluT = (bf16*)(F.ws + WS_GLU_T); bf16* LoraT = (bf16*)(F.ws + WS_LORA_T);
    constexpr int I_IN = (DM / 64) * (DIN / 32), I_OUT = (DM / 64) * (DM / 32), I_GLU = (DSSM / 64) * (DSSM / 32), I_W = 32, I_A = 32, I_G = 64;
    constexpr int NITEMS = I_IN + I_OUT + I_GLU + I_W + I_A + I_G;
    for (int it = gw; it < NITEMS; it += NGW) {
        int r = it;
        if (r < I_IN) { const int nb = DIN / 32, kb = r / nb, n0 = (r % nb) * 32; transpose_item(F.in[8], DIN, WinT, DM, n0, kb * 64, n0, kb * 64, scr, F.lane); continue; } r -= I_IN;
        if (r < I_OUT) { const int nb = DM / 32, kb = r / nb, n0 = (r % nb) * 32; transpose_item(F.in[9], DM, WoutT, DM, n0, kb * 64, n0, kb * 64, scr, F.lane); continue; } r -= I_OUT;
        if (r < I_GLU) { const int nb = DSSM / 32, kb = r / nb, n0 = (r % nb) * 32; transpose_item(F.in[18], DSSM, GluT, DSSM, n0, kb * 64, n0, kb * 64, scr, F.lane); continue; } r -= I_GLU;
        if (r < I_W) { transpose_item(F.in[22], DRW, LoraT, 256, r * 32, 0, r * 32, 0, scr, F.lane); continue; } r -= I_W;
        if (r < I_A) { transpose_item(F.in[24], DRW, LoraT, 256, 1024 + r * 32, 0, r * 32, 64, scr, F.lane); continue; } r -= I_A;
        { const int kb = r / 32, n0 = (r % 32) * 32; transpose_item(F.in[25], DRW, LoraT, 256, 2048 + n0, kb * 64, n0, 128 + kb * 64, scr, F.lane); }
    }
    for (int p = blockIdx.x * NTHR + F.tid; p < 3072 * 32; p += F.G * NTHR) { const int row = p >> 5, c8 = (p & 31) * 8; const int kind = row >> 10;
        const bool data = kind == 0 ? (c8 < 64) : (kind == 1 ? (c8 >= 64 && c8 < 128) : (c8 >= 128));
        if (!data) *(u32x4*)(LoraT + (size_t)row * 256 + c8) = (u32x4){0u, 0u, 0u, 0u}; }
    bf16* rwt = (bf16*)(F.ws + WS_RWT);
    for (int p = blockIdx.x * NTHR + F.tid; p < 64 * 5 * 64 * 8; p += F.G * NTHR) { const int e = p & 7, ln = (p >> 3) & 63, jt = (p >> 9) % 5, ks = (p >> 9) / 5;
        const int j = 16 * jt + (ln & 15), k = 32 * ks + 8 * (ln >> 4) + e;
        const float w = j < 8 ? F.in[31][k * 8 + j] : (j < 72 ? F.in[33][k * 64 + (j - 8)] : 0.f);
        const unsigned hi = pk2(w, 0.f) & 0xffffu; const float wl = w - __uint_as_float(hi << 16);
        const size_t o = ((size_t)((ks * 5 + jt) * 2) * 64 + ln) * 8 + e;
        rwt[o] = (bf16)hi; rwt[o + 512] = (bf16)(pk2(wl, 0.f) & 0xffffu); }
}

__device__ __forceinline__ void p1_h1(const Frame& F0) {
    PHASE_VIEW();
    const float* x = F.in[0]; const float* g = F.in[4]; const float* mod = (const float*)(F.ws + WS_MOD); bf16* H = (bf16*)(F.ws + WS_H);
    const int gw = F.vcu * NWAVES + F.wave, NGW = F.G * NWAVES;
    for (int row = gw; row < NT; row += NGW) {
        const int b = row >> 11; const f32x4* xr = (const f32x4*)(x + (size_t)row * DM) + F.lane;
        f32x4 v[8]; float ss = 0.f;
#pragma unroll
        for (int j = 0; j < 8; ++j) { v[j] = xr[64 * j]; ss += (v[j].x * v[j].x + v[j].y * v[j].y) + (v[j].z * v[j].z + v[j].w * v[j].w); }
        const float rs = rsqrtf(wave_sum(ss) * (1.f / DM) + RMS_EPS);
        u32x2* o = (u32x2*)(H + (size_t)row * DM) + F.lane;
#pragma unroll
        for (int j = 0; j < 8; ++j) { const int col = 4 * (F.lane + 64 * j);
            const f32x4 gv = *(const f32x4*)(g + col), sh = *(const f32x4*)(mod + b * NMOD + col), scv = *(const f32x4*)(mod + b * NMOD + DM + col);
            const f32x4 h = v[j] * rs * gv * (scv + 1.0f) + sh;
            u32x2 w; w.x = pk2(h.x, h.y); w.y = pk2(h.z, h.w); o[64 * j] = w; }
    }
}

typedef short bf16x8_t __attribute__((ext_vector_type(8)));
#define MFMA16(a, b, c) __builtin_amdgcn_mfma_f32_16x16x32_bf16((a), (b), (c), 0, 0, 0)
__device__ __forceinline__ bf16x8_t lfrag(const LAS bf16* m, int pitch, int row, int k0) { return *(const LAS bf16x8_t*)(m + row * pitch + k0); }
__device__ __forceinline__ void st4(LAS bf16* p, const f32x4& v) { u32x2 w; w.x = pk2(v[0], v[1]); w.y = pk2(v[2], v[3]); *(LAS u32x2*)p = w; }
constexpr int CH_T = 32, CHP_K = 72, CHP_T = 40;
constexpr int CH_GRP_BYTES = 66560;
constexpr size_t GHQ_CHUNK = 12288;
__device__ __forceinline__ float wave_sum_dpp(float x) {
    x = row16_sum(x);
    x += __builtin_bit_cast(float, __builtin_amdgcn_update_dpp(0, __builtin_bit_cast(int, x), 0x142, 0xa, 0xf, false));
    x += __builtin_bit_cast(float, __builtin_amdgcn_update_dpp(0, __builtin_bit_cast(int, x), 0x143, 0xc, 0xf, false));
    return __builtin_bit_cast(float, __builtin_amdgcn_readlane(__builtin_bit_cast(int, x), 63));
}
__device__ __forceinline__ void wave_sum8_dpp(float (&x)[8]) {
#define WS8_STAGE(ctrl, rmask) _Pragma("unroll") for (int i_ = 0; i_ < 8; ++i_) x[i_] += __builtin_bit_cast(float, __builtin_amdgcn_update_dpp(0, __builtin_bit_cast(int, x[i_]), ctrl, rmask, 0xf, false));
    WS8_STAGE(0xB1, 0xf) WS8_STAGE(0x4E, 0xf) WS8_STAGE(0x141, 0xf) WS8_STAGE(0x140, 0xf) WS8_STAGE(0x142, 0xa) WS8_STAGE(0x143, 0xc)
#undef WS8_STAGE
#pragma unroll
    for (int i = 0; i < 8; ++i) x[i] = __builtin_bit_cast(float, __builtin_amdgcn_readlane(__builtin_bit_cast(int, x[i]), 63));
}
__device__ __forceinline__ float tanh_fast(float x) { const float e = __builtin_amdgcn_exp2f(2.8853900817779268f * x); return 1.f - 2.f * __builtin_amdgcn_rcpf(e + 1.f); }
__device__ __forceinline__ void p9a_rwkv_chunks(const Frame& F0) {
    PHASE_VIEW();
    const GAS bf16* PROJ = (const GAS bf16*)(F.ws + WS_PROJ); const GAS bf16* LoraT = (const GAS bf16*)(F.ws + WS_LORA_T);
    GAS bf16* VB = (GAS bf16*)(F.ws + WS_VB); GAS bf16* GB = (GAS bf16*)(F.ws + WS_GB); GAS float* BON = (GAS float*)(F.ws + WS_BON);
    const float* mu = F.in[20]; const float* w0 = F.in[21]; const float* a0 = F.in[23]; const float* k_k = F.in[26]; const float* k_a = F.in[27]; const float* r_k = F.in[28];
    GAS bf16* GHQ = (GAS bf16*)(F.ws + WS_GHQ); GAS float* GT = (GAS float*)(F.ws + WS_GT);
    const int grp = F.tid >> 8, gt = F.tid & 255, gw = (F.tid >> 6) & 3, lo = F.lane & 15, hi = F.lane >> 4;
    LAS unsigned char* gb = F.lds + grp * CH_GRP_BYTES;
    LAS bf16* At = (LAS bf16*)gb; LAS bf16* Bt = At + 32 * CHP_K; LAS bf16* Kt = Bt + 32 * CHP_K; LAS bf16* Rt = Kt + 32 * CHP_K;
    LAS bf16* X1T = At; LAS bf16* P1T = X1T + 64 * CHP_T; LAS bf16* Minv = P1T + 64 * CHP_T; LAS bf16* XG = At;
    LAS bf16* AtT = Rt + 32 * CHP_K; LAS bf16* BhT = AtT + 64 * CHP_T; LAS bf16* KhT = BhT + 64 * CHP_T; LAS bf16* VmT = KhT + 64 * CHP_T;
    LAS float* AabF = (LAS float*)(VmT + 64 * CHP_T);
    LAS bf16* Aak = (LAS bf16*)(AabF + 32 * 36); LAS bf16* Arb = Aak + 32 * CHP_T; LAS bf16* Ark = Arb + 32 * CHP_T; LAS bf16* P2T = Ark + 32 * CHP_T;
    LAS float* LWs = AabF; LAS float* AAs = LWs + 32 * 68;
    LAS float* part = (LAS float*)(P2T + 64 * CHP_T);
    LAS bf16* XW = (LAS bf16*)(part + 256); LAS bf16* XA = XW + 32 * CHP_K;
    const f32x4 z4 = (f32x4){0.f, 0.f, 0.f, 0.f};
    for (int it0 = F.vcu * 2; it0 < NB * (SEQ / CH_T); it0 += F.G * 2) {
        const int item = it0 + grp; const int c = item & 63, b = item >> 6;
        const size_t tok0 = (size_t)b * SEQ + c * CH_T;
        LDS_BARRIER();
#pragma unroll 4
        for (int i = 0; i < 16; ++i) { const int pidx = gt + 256 * i, t = pidx >> 7, cp = (pidx & 127) * 2;
            const unsigned zw = *(const GAS unsigned*)(PROJ + (tok0 + t) * DIN + 4096 + cp);
            const unsigned pw = (c == 0 && t == 0) ? 0u : *(const GAS unsigned*)(PROJ + (tok0 + t - 1) * DIN + 4096 + cp);
            const f32x2 m = *(const f32x2*)(mu + 3072 + cp);
            const float z0 = bf_lo(zw), z1 = bf_hi(zw); const float v0 = z0 + m.x * (bf_lo(pw) - z0), v1 = z1 + m.y * (bf_hi(pw) - z1);
            if (cp < 64) *(LAS unsigned*)(XW + t * CHP_K + cp) = pk2(tanh_fast(v0), tanh_fast(v1));
            else if (cp < 128) *(LAS unsigned*)(XA + t * CHP_K + cp - 64) = pk2(v0, v1);
            else *(LAS unsigned*)(XG + t * 136 + cp - 128) = pk2(sigmoidf_(v0), sigmoidf_(v1)); }
        LDS_BARRIER();
        { bf16x8_t xg[2][4];
#pragma unroll
          for (int mt = 0; mt < 2; ++mt)
#pragma unroll
              for (int ks = 0; ks < 4; ++ks) xg[mt][ks] = lfrag(XG, 136, 16 * mt + lo, 32 * ks + 8 * hi);
#pragma unroll 1
          for (int hh = 0; hh < NH; ++hh) { const int n0 = hh * 64 + 16 * gw; f32x4 dg[2] = {z4, z4};
#pragma unroll
              for (int ks = 0; ks < 4; ++ks) { const bf16x8_t yg = *(const GAS bf16x8_t*)(LoraT + (size_t)(2048 + n0 + lo) * 256 + 128 + 32 * ks + 8 * hi);
                  dg[0] = MFMA16(yg, xg[0][ks], dg[0]); dg[1] = MFMA16(yg, xg[1][ks], dg[1]); }
#pragma unroll
              for (int mt = 0; mt < 2; ++mt) { u32x2 w; w.x = pk2(dg[mt][0], dg[mt][1]); w.y = pk2(dg[mt][2], dg[mt][3]); *(GAS u32x2*)(GB + (tok0 + 16 * mt + lo) * 1024 + n0 + 4 * hi) = w; } }
        }
        const int k = gt & 63, tq = gw; const bool first = (c == 0 && tq == 0);
        const GAS bf16* pp = PROJ + (tok0 + tq * 8) * DIN + 1024 + k;
        bf16 nr[9], nk[9], nv[9];
#pragma unroll
        for (int i = 0; i < 9; ++i) { const GAS bf16* q = pp + (ptrdiff_t)(i - 1) * DIN; const bool z = first && i == 0;
            nr[i] = z ? (bf16)0 : q[0]; nk[i] = z ? (bf16)0 : q[1024]; nv[i] = z ? (bf16)0 : q[2048]; }
#pragma unroll 1
        for (int h = 0; h < NH; ++h) {
            const int ci = (b * NH + h) * 64 + c; const int ch = h * 64 + k;
            LDS_BARRIER();
            { const int n0 = h * 64 + 16 * gw; f32x4 dw[2] = {z4, z4}, da[2] = {z4, z4};
#pragma unroll
              for (int ks = 0; ks < 2; ++ks) { const bf16x8_t yw = *(const GAS bf16x8_t*)(LoraT + (size_t)(n0 + lo) * 256 + 32 * ks + 8 * hi), ya = *(const GAS bf16x8_t*)(LoraT + (size_t)(1024 + n0 + lo) * 256 + 64 + 32 * ks + 8 * hi);
#pragma unroll
                  for (int mt = 0; mt < 2; ++mt) { dw[mt] = MFMA16(yw, lfrag(XW, CHP_K, 16 * mt + lo, 32 * ks + 8 * hi), dw[mt]); da[mt] = MFMA16(ya, lfrag(XA, CHP_K, 16 * mt + lo, 32 * ks + 8 * hi), da[mt]); } }
              const f32x4 w0v = *(const f32x4*)(w0 + n0 + 4 * hi), a0v = *(const f32x4*)(a0 + n0 + 4 * hi);
#pragma unroll
              for (int mt = 0; mt < 2; ++mt) { const int t = 16 * mt + lo; f32x4 lwv, aav;
#pragma unroll
                  for (int r = 0; r < 4; ++r) { lwv[r] = (-0.6065306597126334f * 1.4426950408889634f) * sigmoidf_(dw[mt][r] + w0v[r]);     aav[r] = sigmoidf_(da[mt][r] + a0v[r]); }
                  *(LAS f32x4*)(LWs + t * 68 + 16 * gw + 4 * hi) = lwv; *(LAS f32x4*)(AAs + t * 68 + 16 * gw + 4 * hi) = aav; }
            }
            LDS_BARRIER();
            { const float mur = mu[ch], muk = mu[1024 + ch], muv = mu[2048 + ch], kkc = k_k[ch], kac = k_a[ch], rkc = r_k[ch];
              float lw[8], ls[8], rv[8], kv[8], vv[8], av[8], bv[8]; float run = 0.f;
              float kraw[8], x8[8];
#pragma unroll
              for (int i = 0; i < 8; ++i) { const int t = tq * 8 + i;
                  const float zr = bf2f(nr[i + 1]), zk = bf2f(nk[i + 1]), zv = bf2f(nv[i + 1]), pr = bf2f(nr[i]), pk_ = bf2f(nk[i]), pv = bf2f(nv[i]);
                  rv[i] = zr + mur * (pr - zr); kraw[i] = zk + muk * (pk_ - zk); vv[i] = zv + muv * (pv - zv);
                  av[i] = AAs[t * 68 + k]; lw[i] = LWs[t * 68 + k];
                  const float kk = kraw[i] * kkc; x8[i] = kk * kk; }
              wave_sum8_dpp(x8);
#pragma unroll
              for (int i = 0; i < 8; ++i) { const float a = av[i]; const float kk = kraw[i] * kkc * __builtin_amdgcn_rsqf(fmaxf(x8[i], 1e-24f));
                  const float km = kraw[i] * (1.f + (a - 1.f) * kac);
                  x8[i] = rv[i] * km * rkc; kv[i] = km; av[i] = -kk; bv[i] = kk * a; run += lw[i]; ls[i] = run; }
              wave_sum8_dpp(x8);
              { float bsel = x8[0];
#pragma unroll
                for (int i = 1; i < 8; ++i) bsel = (F.lane == i) ? x8[i] : bsel;
                if (F.lane < 8) BON[(tok0 + tq * 8 + F.lane) * 16 + h] = bsel; }
              if (h + 1 < NH) {
#pragma unroll
                  for (int i = 0; i < 9; ++i) { const GAS bf16* q = pp + (ptrdiff_t)(i - 1) * DIN + (h + 1) * 64; const bool z = first && i == 0;
                      nr[i] = z ? (bf16)0 : q[0]; nk[i] = z ? (bf16)0 : q[1024]; nv[i] = z ? (bf16)0 : q[2048]; } }
              { u32x4 w; w.x = pk2(vv[0], vv[1]); w.y = pk2(vv[2], vv[3]); w.z = pk2(vv[4], vv[5]); w.w = pk2(vv[6], vv[7]);
                GAS bf16* vb = VB + (tok0 + tq * 8) * 1024 + ch;
                vb[0] = (bf16)(w.x & 0xffffu); vb[1024] = (bf16)(w.x >> 16); vb[2048] = (bf16)(w.y & 0xffffu); vb[3072] = (bf16)(w.y >> 16);
                vb[4096] = (bf16)(w.z & 0xffffu); vb[5120] = (bf16)(w.z >> 16); vb[6144] = (bf16)(w.w & 0xffffu); vb[7168] = (bf16)(w.w >> 16); }
              part[tq * 64 + k] = run;
              LDS_BARRIER();
              float off = 0.f, tot = 0.f;
#pragma unroll
              for (int q = 0; q < 4; ++q) { const float pq = part[q * 64 + k]; tot += pq; if (q < tq) off += pq; }
              if (tq == 0) GT[(size_t)ci * 64 + k] = __builtin_amdgcn_exp2f(tot);
              float aT[8], bT[8], kT[8];
#pragma unroll
              for (int i = 0; i < 8; ++i) { const int t = tq * 8 + i; const float lg = off + ls[i], lgm = lg - lw[i];
                  const float eneg = __builtin_amdgcn_exp2f(-lg), eh = __builtin_amdgcn_exp2f(tot - lg);
                  const float at = av[i] * __builtin_amdgcn_exp2f(lgm);
                  const unsigned wa = pk2(at, bv[i] * eneg), wk = pk2(kv[i] * eneg, rv[i] * __builtin_amdgcn_exp2f(lg));
                  At[t * CHP_K + k] = (bf16)(wa & 0xffffu); Bt[t * CHP_K + k] = (bf16)(wa >> 16); Kt[t * CHP_K + k] = (bf16)(wk & 0xffffu); Rt[t * CHP_K + k] = (bf16)(wk >> 16);
                  aT[i] = at; bT[i] = bv[i] * eh; kT[i] = kv[i] * eh; }
              u32x4 w;
              w.x = pk2(aT[0], aT[1]); w.y = pk2(aT[2], aT[3]); w.z = pk2(aT[4], aT[5]); w.w = pk2(aT[6], aT[7]); *(LAS u32x4*)(AtT + k * CHP_T + tq * 8) = w;
              w.x = pk2(bT[0], bT[1]); w.y = pk2(bT[2], bT[3]); w.z = pk2(bT[4], bT[5]); w.w = pk2(bT[6], bT[7]); *(LAS u32x4*)(BhT + k * CHP_T + tq * 8) = w;
              w.x = pk2(kT[0], kT[1]); w.y = pk2(kT[2], kT[3]); w.z = pk2(kT[4], kT[5]); w.w = pk2(kT[6], kT[7]); *(LAS u32x4*)(KhT + k * CHP_T + tq * 8) = w;
              w.x = pk2(vv[0], vv[1]); w.y = pk2(vv[2], vv[3]); w.z = pk2(vv[4], vv[5]); w.w = pk2(vv[6], vv[7]); *(LAS u32x4*)(VmT + k * CHP_T + tq * 8) = w;
            }
            LDS_BARRIER();
            f32x4 aab[2][2];
            const int mi = gw ^ grp;
            { const LAS bf16* X = (mi < 2) ? At : Rt; const LAS bf16* Y = (mi & 1) ? Kt : Bt;
              f32x4 acc[2][2] = {{z4, z4}, {z4, z4}};
#pragma unroll
              for (int ks = 0; ks < 2; ++ks) { bf16x8_t xf[2], yf[2];
#pragma unroll
                  for (int m = 0; m < 2; ++m) { xf[m] = lfrag(X, CHP_K, 16 * m + lo, 32 * ks + 8 * hi); yf[m] = lfrag(Y, CHP_K, 16 * m + lo, 32 * ks + 8 * hi); }
#pragma unroll
                  for (int m = 0; m < 2; ++m)
#pragma unroll
                      for (int n = 0; n < 2; ++n) acc[m][n] = MFMA16(yf[n], xf[m], acc[m][n]); }
              LAS bf16* dstb = (mi == 1) ? Aak : ((mi == 2) ? Arb : Ark);
#pragma unroll
              for (int m = 0; m < 2; ++m)
#pragma unroll
                  for (int n = 0; n < 2; ++n) { const int t = 16 * m + lo, j0 = 16 * n + 4 * hi; f32x4 v = acc[m][n];
#pragma unroll
                      for (int r = 0; r < 4; ++r) { const int j = j0 + r; const bool keep = (mi < 2) ? (j < t) : (j <= t); v[r] = keep ? v[r] : 0.f; }
                      aab[m][n] = v; if (mi != 0) st4(dstb + t * CHP_T + j0, v); }
            }
            LDS_BARRIER();
            const int inv_w = grp;
            if (mi == 0) {
                int cc = F.lane & 31; asm volatile("" : "+v"(cc));
                float mcol[32];
#pragma unroll
                for (int t = 0; t < 32; ++t) { float acc = (t == cc) ? 1.f : 0.f;
#pragma unroll
                    for (int j = 0; j < t; ++j) { float tmp;
                        asm volatile("v_readlane_b32 %1, %2, %3\n\tv_fmac_f32 %0, %1, %4" : "+v"(acc), "=&s"(tmp) : "v"(aab[t >> 4][j >> 4][j & 3]), "i"((t & 15) + 16 * ((j & 15) >> 2)), "v"(mcol[j])); }
                    mcol[t] = acc; }
                if (F.lane < 32) {
#pragma unroll
                    for (int t = 0; t < 32; ++t) Minv[t * CHP_T + cc] = (bf16)(pk2(mcol[t], 0.f) & 0xffffu); }
            } else {
                const int wk = gw - (gw > inv_w ? 1 : 0);
                for (int tile = wk * 3; tile < ((wk == 2) ? 8 : wk * 3 + 3); ++tile) { const int mt = tile >> 2, nt = tile & 3;
                    const bf16x8_t xf = lfrag(Aak, CHP_T, 16 * mt + lo, 8 * hi), yf = lfrag(VmT, CHP_T, 16 * nt + lo, 8 * hi);
                    const f32x4 d = MFMA16(xf, yf, z4);
                    st4(X1T + (16 * nt + lo) * CHP_T + 16 * mt + 4 * hi, d); }
            }
            LDS_BARRIER();
            { const bf16x8_t ya = lfrag(AtT, CHP_T, 16 * gw + lo, 8 * hi), yx = lfrag(X1T, CHP_T, 16 * gw + lo, 8 * hi);
              f32x4 d1[2], d2[2];
#pragma unroll
              for (int mt = 0; mt < 2; ++mt) { const bf16x8_t xf = lfrag(Minv, CHP_T, 16 * mt + lo, 8 * hi);
                  d1[mt] = MFMA16(xf, ya, z4); d2[mt] = MFMA16(xf, yx, z4); }
#pragma unroll
              for (int mt = 0; mt < 2; ++mt) { st4(P1T + (16 * gw + lo) * CHP_T + 16 * mt + 4 * hi, d1[mt]); st4(P2T + (16 * gw + lo) * CHP_T + 16 * mt + 4 * hi, d2[mt]); }
            }
            LDS_BARRIER();
            { GAS bf16* outp = GHQ + (size_t)ci * GHQ_CHUNK;
              const bf16x8_t p1 = lfrag(P1T, CHP_T, 16 * gw + lo, 8 * hi), p2 = lfrag(P2T, CHP_T, 16 * gw + lo, 8 * hi), vm = lfrag(VmT, CHP_T, 16 * gw + lo, 8 * hi);
#pragma unroll
              for (int mt = 0; mt < 2; ++mt) { const bf16x8_t arb = lfrag(Arb, CHP_T, 16 * mt + lo, 8 * hi), ark = lfrag(Ark, CHP_T, 16 * mt + lo, 8 * hi);
                  f32x4 q1 = MFMA16(p1, arb, z4);
                  { const int t = 16 * mt + lo, k0 = 16 * gw + 4 * hi; const u32x2 rw = *(const LAS u32x2*)(Rt + t * CHP_K + k0);
                    q1[0] += bf_lo(rw.x); q1[1] += bf_hi(rw.x); q1[2] += bf_lo(rw.y); q1[3] += bf_hi(rw.y);
                    u32x2 w; w.x = pk2(q1[0], q1[1]); w.y = pk2(q1[2], q1[3]); *(GAS u32x2*)(outp + 8192 + t * 64 + k0) = w; }
                  f32x4 q2 = MFMA16(arb, p2, z4); q2 = MFMA16(ark, vm, q2);
                  { u32x2 w; w.x = pk2(q2[0], q2[1]); w.y = pk2(q2[2], q2[3]); *(GAS u32x2*)(outp + 10240 + (16 * gw + lo) * 32 + 16 * mt + 4 * hi) = w; } }
#pragma unroll
              for (int mt = 0; mt < 4; ++mt) { const bf16x8_t bh = lfrag(BhT, CHP_T, 16 * mt + lo, 8 * hi), kh = lfrag(KhT, CHP_T, 16 * mt + lo, 8 * hi);
                  const f32x4 g = MFMA16(p1, bh, z4);
                  { u32x2 w; w.x = pk2(g[0], g[1]); w.y = pk2(g[2], g[3]); *(GAS u32x2*)(outp + (16 * mt + lo) * 64 + 16 * gw + 4 * hi) = w; }
                  f32x4 hh = MFMA16(bh, p2, z4); hh = MFMA16(kh, vm, hh);
                  { u32x2 w; w.x = pk2(hh[0], hh[1]); w.y = pk2(hh[2], hh[3]); *(GAS u32x2*)(outp + 4096 + (16 * gw + lo) * 64 + 16 * mt + 4 * hi) = w; } }
            }
        }
    }
    __syncthreads();
}
__device__ __forceinline__ void p9b_rwkv_seq(const Frame& F0) {
    PHASE_VIEW();
    const GAS bf16* GHQ = (const GAS bf16*)(F.ws + WS_GHQ); const GAS float* GT = (const GAS float*)(F.ws + WS_GT); GAS bf16* Yy = (GAS bf16*)(F.ws + WS_Y);
    LAS bf16* Sb = (LAS bf16*)F.lds;
    const int lo = F.lane & 15, hi = F.lane >> 4, kt = F.wave >> 1, vt = F.wave & 1, mt = F.wave >> 1;
    const f32x4 z4 = (f32x4){0.f, 0.f, 0.f, 0.f};
    for (int item = F.vcu; item < NB * NH * 2; item += F.G) {
        const int b = item >> 5, h = (item >> 1) & 15, vh = item & 1;
        __syncthreads();
        for (int i = F.tid; i < 2 * 32 * CHP_K / 2; i += NTHR) ((LAS unsigned*)Sb)[i] = 0u;
        __syncthreads();
        f32x4 Sf = z4;
        const size_t cbase = (size_t)(b * NH + h) * 64;
        const int vrow = vh * 32 + 16 * vt + lo;
#define SEQ_LOAD(G_, Q_, H_, Q2_, GT_, cc_) do { const int cn_ = (cc_) < 64 ? (cc_) : 63; const GAS bf16* cp_ = GHQ + (cbase + cn_) * GHQ_CHUNK; \
            G_[0] = *(const GAS bf16x8_t*)(cp_ + (16 * kt + lo) * 64 + 8 * hi); G_[1] = *(const GAS bf16x8_t*)(cp_ + (16 * kt + lo) * 64 + 32 + 8 * hi); \
            H_ = *(const GAS u32x2*)(cp_ + 4096 + vrow * 64 + 16 * kt + 4 * hi); GT_ = *(const GAS f32x4*)(GT + (cbase + cn_) * 64 + 16 * kt + 4 * hi); \
            Q_[0] = *(const GAS bf16x8_t*)(cp_ + 8192 + (16 * (mt & 1) + lo) * 64 + 8 * hi); Q_[1] = *(const GAS bf16x8_t*)(cp_ + 8192 + (16 * (mt & 1) + lo) * 64 + 32 + 8 * hi); \
            Q2_ = *(const GAS u32x2*)(cp_ + 10240 + vrow * 32 + 16 * (mt & 1) + 4 * hi); } while (0)
#define SEQ_STEP(G_, Q_, H_, Q2_, GT_, cc_) do { \
            const LAS bf16* Sc = Sb + ((cc_) & 1) * 32 * CHP_K; LAS bf16* Sn = Sb + (((cc_) + 1) & 1) * 32 * CHP_K; \
            const bf16x8_t s0 = lfrag(Sc, CHP_K, 16 * vt + lo, 8 * hi), s1 = lfrag(Sc, CHP_K, 16 * vt + lo, 32 + 8 * hi); \
            if (F.wave < 4) { f32x4 y = (f32x4){bf_lo(Q2_.x), bf_hi(Q2_.x), bf_lo(Q2_.y), bf_hi(Q2_.y)}; \
                y = MFMA16(Q_[0], s0, y); y = MFMA16(Q_[1], s1, y); \
                GAS bf16* yp = Yy + (size_t)(b * SEQ + (cc_) * CH_T + 16 * mt + 4 * hi) * 1024 + h * 64 + vrow; const unsigned w01 = pk2(y[0], y[1]), w23 = pk2(y[2], y[3]); \
                yp[0] = (bf16)(w01 & 0xffffu); yp[1024] = (bf16)(w01 >> 16); yp[2048] = (bf16)(w23 & 0xffffu); yp[3072] = (bf16)(w23 >> 16); } \
            f32x4 acc = (f32x4){bf_lo(H_.x), bf_hi(H_.x), bf_lo(H_.y), bf_hi(H_.y)} + GT_ * Sf; \
            acc = MFMA16(G_[0], s0, acc); acc = MFMA16(G_[1], s1, acc); \
            Sf = acc; st4(Sn + (16 * vt + lo) * CHP_K + 16 * kt + 4 * hi, acc); \
            SEQ_LOAD(G_, Q_, H_, Q2_, GT_, (cc_) + 4); \
            asm volatile("s_waitcnt lgkmcnt(0)" ::: "memory"); __builtin_amdgcn_s_barrier(); asm volatile("" ::: "memory"); } while (0)
        bf16x8_t gA[2], qA[2], gB[2], qB[2], gC[2], qC[2], gD[2], qD[2]; u32x2 hA, q2A, hB, q2B, hC, q2C, hD, q2D; f32x4 gtA, gtB, gtC, gtD;
        SEQ_LOAD(gA, qA, hA, q2A, gtA, 0); SEQ_LOAD(gB, qB, hB, q2B, gtB, 1); SEQ_LOAD(gC, qC, hC, q2C, gtC, 2); SEQ_LOAD(gD, qD, hD, q2D, gtD, 3);
#pragma unroll
        for (int c = 0; c < 64; c += 4) {
            SEQ_STEP(gA, qA, hA, q2A, gtA, c); SEQ_STEP(gB, qB, hB, q2B, gtB, c + 1); SEQ_STEP(gC, qC, hC, q2C, gtC, c + 2); SEQ_STEP(gD, qD, hD, q2D, gtD, c + 3);
        }
#undef SEQ_LOAD
#undef SEQ_STEP
    }
}

__device__ __forceinline__ void p9_rwkv_post(const Frame& F0) {
    PHASE_VIEW();
    const bf16* VB = (const bf16*)(F.ws + WS_VB); const bf16* GB = (const bf16*)(F.ws + WS_GB); const float* BON = (const float*)(F.ws + WS_BON);
    const bf16* Yy = (const bf16*)(F.ws + WS_Y);
    const float* ln_w = F.in[29]; const float* ln_b = F.in[30]; bf16* MIX = (bf16*)(F.ws + WS_MIX);
    const int gw = F.vcu * NWAVES + F.wave, NGW = F.G * NWAVES;
    for (int it = gw; it < NT * 4; it += NGW) {
        const int row = it >> 2, c = (it & 3) * 256 + F.lane * 4, h = c >> 6; const size_t idx = (size_t)row * 1024 + c;
        const u32x2 yw = *(const u32x2*)(Yy + idx); const f32x4 y = (f32x4){bf_lo(yw.x), bf_hi(yw.x), bf_lo(yw.y), bf_hi(yw.y)}; const u32x2 vw = *(const u32x2*)(VB + idx), gwv = *(const u32x2*)(GB + idx);
        const f32x4 lw = *(const f32x4*)(ln_w + c), lb = *(const f32x4*)(ln_b + c); const float bon = BON[row * 16 + h];
        const float mean = row16_sum((y.x + y.y) + (y.z + y.w)) * (1.f / 64.f); const f32x4 d = y - mean;
        const float var = row16_sum((d.x * d.x + d.y * d.y) + (d.z * d.z + d.w * d.w)) * (1.f / 64.f); const float rstd = rsqrtf(var + GN_EPS);
        const f32x4 vv = (f32x4){bf_lo(vw.x), bf_hi(vw.x), bf_lo(vw.y), bf_hi(vw.y)}, gg = (f32x4){bf_lo(gwv.x), bf_hi(gwv.x), bf_lo(gwv.y), bf_hi(gwv.y)};
        const f32x4 o = (d * rstd * lw + lb + vv * bon) * gg;
        u32x2 w; w.x = pk2(o.x, o.y); w.y = pk2(o.z, o.w); *(u32x2*)(MIX + (size_t)row * DM + DSSM + c) = w;
    }
}

__device__ __forceinline__ void p11_x1_router(const Frame& F0) {
    PHASE_VIEW();
    const float* x = F.in[0]; const float* gpost = F.in[5]; const float* gpre2 = F.in[6]; const float* mod = (const float*)(F.ws + WS_MOD);
    const bf16* MIXED = (const bf16*)(F.ws + WS_MIXED); bf16* X1 = (bf16*)(F.ws + WS_X1); bf16* H = (bf16*)(F.ws + WS_H);
    const bf16x8_t* rwt = (const bf16x8_t*)(F.ws + WS_RWT); const float* b_grp = F.in[32]; const float* b_exp = F.in[34];
    unsigned* tokinfo = (unsigned*)(F.ws + WS_TOKINFO); int* list = (int*)(F.ws + WS_LIST);
    LAS float* slab = (LAS float*)(F.lds + F.wave * 16384) + F.lane * 8;
    LAS float* Lp = (LAS float*)F.lds;
    LAS float* red1 = (LAS float*)(F.lds + 131072); LAS float* red2 = red1 + 128; LAS float* Lf = red2 + 128;
    const int lo = F.lane & 15, hi = F.lane >> 4, k0 = 256 * F.wave + 8 * hi;
    const f32x4 z4 = (f32x4){0.f, 0.f, 0.f, 0.f};
    for (int tile = F.vcu; tile < NT / 16; tile += F.G) {
        const int row = tile * 16 + lo, b = tile >> 7;
        const size_t ro = (size_t)row * DM + k0;
        float ss = 0.f;
#pragma unroll 2
        for (int s_ = 0; s_ < 8; ++s_) { const u32x4 mw = *(const u32x4*)(MIXED + ro + 32 * s_); const f32x4 a0 = (f32x4){bf_lo(mw.x), bf_hi(mw.x), bf_lo(mw.y), bf_hi(mw.y)}, a1 = (f32x4){bf_lo(mw.z), bf_hi(mw.z), bf_lo(mw.w), bf_hi(mw.w)};
            *(LAS f32x4*)(slab + s_ * 512) = a0; *(LAS f32x4*)(slab + s_ * 512 + 4) = a1;
            ss += (a0.x * a0.x + a0.y * a0.y) + (a0.z * a0.z + a0.w * a0.w) + (a1.x * a1.x + a1.y * a1.y) + (a1.z * a1.z + a1.w * a1.w); }
        ss += __shfl_xor(ss, 16); ss += __shfl_xor(ss, 32);
        if (hi == 0) red1[F.wave * 16 + lo] = ss;
        LDS_BARRIER();
        float tot = 0.f;
#pragma unroll
        for (int w = 0; w < 8; ++w) tot += red1[w * 16 + lo];
        const float rs = rsqrtf(tot * (1.f / DM) + RMS_EPS);
        float ss2 = 0.f;
        const float* modb = mod + b * NMOD + k0;
#pragma unroll 2
        for (int s_ = 0; s_ < 8; ++s_) { const float* xp = x + ro + 32 * s_; f32x4 xo[2];
#pragma unroll
            for (int q = 0; q < 2; ++q) { const f32x4 xv = *(const f32x4*)(xp + 4 * q), gv = *(const f32x4*)(gpost + k0 + 32 * s_ + 4 * q), gt = *(const f32x4*)(modb + 2 * DM + 32 * s_ + 4 * q);
                const f32x4 mm = *(const LAS f32x4*)(slab + s_ * 512 + 4 * q);
                const f32x4 v = xv + gt * (mm * rs * gv); *(LAS f32x4*)(slab + s_ * 512 + 4 * q) = v; xo[q] = v;
                ss2 += (v.x * v.x + v.y * v.y) + (v.z * v.z + v.w * v.w); }
            u32x4 xw; xw.x = pk2(xo[0].x, xo[0].y); xw.y = pk2(xo[0].z, xo[0].w); xw.z = pk2(xo[1].x, xo[1].y); xw.w = pk2(xo[1].z, xo[1].w); *(u32x4*)(X1 + ro + 32 * s_) = xw; }
        ss2 += __shfl_xor(ss2, 16); ss2 += __shfl_xor(ss2, 32);
        if (hi == 0) red2[F.wave * 16 + lo] = ss2;
        LDS_BARRIER();
        float tot2 = 0.f;
#pragma unroll
        for (int w = 0; w < 8; ++w) tot2 += red2[w * 16 + lo];
        const float rs2 = rsqrtf(tot2 * (1.f / DM) + RMS_EPS);
        f32x4 acc[5] = {z4, z4, z4, z4, z4};
        const bf16x8_t* wp = rwt + (size_t)(F.wave * 8) * 640 + F.lane;
#pragma unroll 1
        for (int s_ = 0; s_ < 8; ++s_) { f32x4 hv[2];
#pragma unroll
            for (int q = 0; q < 2; ++q) { const f32x4 gv = *(const f32x4*)(gpre2 + k0 + 32 * s_ + 4 * q), sh = *(const f32x4*)(modb + 3 * DM + 32 * s_ + 4 * q), scv = *(const f32x4*)(modb + 4 * DM + 32 * s_ + 4 * q);
                const f32x4 mm = *(const LAS f32x4*)(slab + s_ * 512 + 4 * q);
                hv[q] = mm * rs2 * gv * (scv + 1.0f) + sh; }
            u32x4 hh, hl;
            hh.x = pk2(hv[0].x, hv[0].y); hh.y = pk2(hv[0].z, hv[0].w); hh.z = pk2(hv[1].x, hv[1].y); hh.w = pk2(hv[1].z, hv[1].w);
            *(u32x4*)(H + ro + 32 * s_) = hh;
            hl.x = pk2(hv[0].x - bf_lo(hh.x), hv[0].y - bf_hi(hh.x)); hl.y = pk2(hv[0].z - bf_lo(hh.y), hv[0].w - bf_hi(hh.y));
            hl.z = pk2(hv[1].x - bf_lo(hh.z), hv[1].y - bf_hi(hh.z)); hl.w = pk2(hv[1].z - bf_lo(hh.w), hv[1].w - bf_hi(hh.w));
            const bf16x8_t fh = __builtin_bit_cast(bf16x8_t, hh), fl = __builtin_bit_cast(bf16x8_t, hl);
#pragma unroll
            for (int jt = 0; jt < 5; ++jt) { const bf16x8_t wh = wp[(jt * 2) * 64], wl = wp[(jt * 2 + 1) * 64];
                acc[jt] = MFMA16(wh, fh, acc[jt]); acc[jt] = MFMA16(wh, fl, acc[jt]); acc[jt] = MFMA16(wl, fh, acc[jt]); }
            wp += 640;
        }
#pragma unroll
        for (int jt = 0; jt < 5; ++jt) *(LAS f32x4*)(Lp + F.wave * 4096 + lo * 80 + 16 * jt + 4 * hi) = acc[jt];
        LDS_BARRIER();
        for (int i = F.tid; i < 16 * 80; i += NTHR) { float sacc = 0.f;
#pragma unroll
            for (int w = 0; w < 8; ++w) sacc += Lp[w * 4096 + i];
            const int j = i % 80; Lf[i] = sacc + (j < 8 ? b_grp[j] : (j < 72 ? b_exp[j - 8] : 0.f)); }
        LDS_BARRIER();
        if (F.tid < 16) { const LAS float* lg = Lf + F.tid * 80; const int tok = tile * 16 + F.tid;
            int gi = 0; float gmax = lg[0];
#pragma unroll
            for (int j = 1; j < 8; ++j) if (lg[j] > gmax) { gmax = lg[j]; gi = j; }
            float gsum = 0.f;
#pragma unroll
            for (int j = 0; j < 8; ++j) gsum += __expf(lg[j] - gmax);
            const float pg = 1.f / gsum;
            const LAS float* le = lg + 8 + gi * 8; int i1 = 0; float m1 = le[0];
#pragma unroll
            for (int j = 1; j < 8; ++j) if (le[j] > m1) { m1 = le[j]; i1 = j; }
            int i2 = -1; float m2 = -INFINITY;
#pragma unroll
            for (int j = 0; j < 8; ++j) if (j != i1 && le[j] > m2) { m2 = le[j]; i2 = j; }
            const float e2 = __expf(m2 - m1); const float g1 = pg / (1.f + e2), g2 = pg * e2 / (1.f + e2);
            const int x1i = gi * 8 + i1, x2i = gi * 8 + i2;
            const unsigned p1 = atomicAdd(F.ctl + CW_CNT + 64 * x1i, 1u), p2 = atomicAdd(F.ctl + CW_CNT + 64 * x2i, 1u);
            list[x1i * NT + p1] = tok; list[x2i * NT + p2] = tok;
            u32x4 a; a.x = (unsigned)x1i; a.y = p1; a.z = (unsigned)x2i; a.w = p2; *(u32x4*)(tokinfo + (size_t)tok * 8) = a;
            u32x2 g; g.x = __float_as_uint(g1); g.y = __float_as_uint(g2); *(u32x2*)(tokinfo + (size_t)tok * 8 + 4) = g;
        }
    }
    __syncthreads();
}

__device__ __forceinline__ void conv_item_src(const Frame& F, int it, const float*& W, int& N, bf16*& WT, int& ldk, int& drow, int& k0, int& n0) {
    if (it < NEXP * 1024) { const int e = it >> 10, r = it & 1023, which = r >> 9, rr = r & 511; k0 = (rr >> 4) * 64; n0 = (rr & 15) * 32;
        W = F.in[which ? 36 : 35] + (size_t)e * DM * DEXP; N = DEXP; WT = (bf16*)(F.ws + WS_EW1) + (size_t)e * 1024 * DM; ldk = DM; drow = (n0 >> 7) * 256 + which * 128 + (n0 & 127); }
    else { const int j = it - NEXP * 1024, e = j >> 9, r = j & 511; k0 = (r >> 6) * 64; n0 = (r & 63) * 32;
        W = F.in[37] + (size_t)e * DEXP * DM; N = DM; WT = (bf16*)(F.ws + WS_EW2) + (size_t)e * DM * DEXP; ldk = DEXP; drow = n0; }
}
struct ConvItem { const GAS float* src; GAS bf16* dst; int ldk; };
__device__ __forceinline__ void conv_decode(const Frame& F, int it, int lane, ConvItem& ci, int& N) {
    const float* W; int ldk, drow, k0, n0; bf16* WT; conv_item_src(F, it, W, N, WT, ldk, drow, k0, n0);
    ci.src = (const GAS float*)W + (size_t)(k0 + (lane >> 3)) * N + n0 + 4 * (lane & 7); ci.dst = (GAS bf16*)WT + (size_t)(drow + (lane >> 3)) * ldk + k0 + 8 * (lane & 7); ci.ldk = ldk;
}
__device__ __forceinline__ int conv_stream(const Frame& F, int first, int step, int total, const unsigned* stopw) {
    LAS float* scr = (LAS float*)(F.lds + F.wave * 16384);
    const int lane = F.lane;
    f32x4 bA[8], bB[8], bC[8]; ConvItem iA, iB, iC; int done = 0;
#define CV_LOAD(buf, ci, idx) do { int N_; conv_decode(F, (idx) < total ? (idx) : total - 1, lane, ci, N_); _Pragma("unroll") for (int i_ = 0; i_ < 8; ++i_) buf[i_] = *(const GAS f32x4*)(ci.src + (size_t)(8 * i_) * N_); } while (0)
#define CV_PROC(buf, ci) do { _Pragma("unroll") for (int i_ = 0; i_ < 8; ++i_) *(LAS f32x4*)(scr + (8 * i_ + (lane >> 3)) * 36 + 4 * (lane & 7)) = buf[i_]; \
        LDS_WAIT(); asm volatile("" ::: "memory"); \
        { const int c_ = lane & 7; _Pragma("unroll") for (int j_ = 0; j_ < 4; ++j_) { const LAS float* sp = scr + (8 * c_) * 36 + (lane >> 3) + 8 * j_; \
              u32x4 o; o.x = pk2(sp[0 * 36], sp[1 * 36]); o.y = pk2(sp[2 * 36], sp[3 * 36]); o.z = pk2(sp[4 * 36], sp[5 * 36]); o.w = pk2(sp[6 * 36], sp[7 * 36]); \
              *(GAS u32x4*)(ci.dst + (size_t)(8 * j_) * ci.ldk) = o; } } \
        LDS_WAIT(); asm volatile("" ::: "memory"); ++done; } while (0)
#define CV_STOPLD() __hip_atomic_load((const GAS unsigned*)stopw, RLX_AGENT)
#define CV_STOP(v) (__builtin_amdgcn_readfirstlane((int)(v)) != 0)
    int it = first;
    CV_LOAD(bA, iA, it); CV_LOAD(bB, iB, it + step);
    while (it < total) {
        unsigned sv = CV_STOPLD();
        CV_LOAD(bC, iC, it + 2 * step);
        CV_PROC(bA, iA); if (CV_STOP(sv)) break;
        if (it + step >= total) break;
        sv = CV_STOPLD();
        CV_LOAD(bA, iA, it + 3 * step);
        CV_PROC(bB, iB); if (CV_STOP(sv)) break;
        if (it + 2 * step >= total) break;
        sv = CV_STOPLD();
        CV_LOAD(bB, iB, it + 4 * step);
        CV_PROC(bC, iC); if (CV_STOP(sv)) break;
        it += 3 * step;
    }
#undef CV_STOPLD
#undef CV_LOAD
#undef CV_PROC
#undef CV_STOP
    return done;
}
__device__ __forceinline__ void p12_expert_convert(const Frame& F0) {
    PHASE_VIEW();
    volatile LAS int* red = (volatile LAS int*)(F.lds + 131072);
    const int ncw = (F.G >= 256) ? (F.G - CONV_GEMM_BLOCKS) * NWAVES : 0;
    __syncthreads();
    if (F.tid == 0) red[0] = 0x7fffffff;
    __syncthreads();
    for (int i = F.tid; i < ncw; i += NTHR) atomicMin((int*)red, (int)__hip_atomic_load(F.ctl + CW_PROG + i, RLX_AGENT));
    __syncthreads();
    const int start = ncw ? red[0] * ncw : 0;
    __syncthreads();
    const int gw = F.vcu * NWAVES + F.wave, NGW = F.G * NWAVES;
    (void)conv_stream(F, start + gw, NGW, CONV_ITEMS, F.ctl + CW_TMO + 2);
}

__device__ __forceinline__ void moe_build_tp(const Frame& F0) {
    PHASE_VIEW();
    volatile LAS int* tp = (volatile LAS int*)(F.lds + TP_OFF);
    __syncthreads();
    if (F.tid < NEXP) { const unsigned c = __hip_atomic_load(F.ctl + CW_CNT + 64 * F.tid, RLX_AGENT); tp[80 + F.tid] = (int)((c + 255u) >> 8); tp[160 + F.tid] = (int)c; }
    __syncthreads();
    if (F.tid == 0) { int s = 0; for (int e = 0; e < NEXP; ++e) { tp[e] = s; s += tp[80 + e]; } tp[NEXP] = s; }
    __syncthreads();
}
template <bool G1> struct MoeOrder {
    static constexpr bool GATHER = G1; static constexpr int A2 = 0;
    static constexpr int NNT = G1 ? 4 : 8, KK = G1 ? DM : DEXP;
    __device__ __forceinline__ size_t kstepA() const { return 128; }
    __device__ __forceinline__ size_t hstepA() const { return (size_t)128 * KK * 2; }
    __device__ __forceinline__ size_t a2off() const { return 0; }
    const LAS int* tp; const unsigned* cntw; const int* list; const char* A; const char* EW; int G, c;
    __device__ bool next(int i, pg8::Unit& u) const {
        const int x = c & 7, r = c >> 3, W = G >> 3;
        const int L = i * W + r, tl = L / NNT; u.pn = L % NNT;
        int cum = 0, e = -1, mt = 0;
#pragma unroll
        for (int j = 0; j < 8; ++j) { const int nj = tp[80 + x + 8 * j]; if (e < 0 && tl < cum + nj) { e = x + 8 * j; mt = tl - cum; } cum += nj; }
        if (e < 0) return false;
        e = __builtin_amdgcn_readfirstlane(e); mt = __builtin_amdgcn_readfirstlane(mt);
        const int tile = tp[e] + mt;
        u.e = e; u.pm = tile; u.cnt = tp[160 + e] - mt * 256;
        u.Bb = EW + ((size_t)e * (G1 ? 1024 : DM) + (size_t)u.pn * 256) * KK * 2;
        u.Ab = G1 ? A : A + (size_t)tile * 256 * KK * 2;
        return true;
    }
    template <int NV> __device__ __forceinline__ void a_voff(const pg8::Unit& u, unsigned (&v)[NV][2], const int (&R)[2], const int (&C)[2]) const {
        if constexpr (G1) {
            const int mt = u.pm - tp[u.e];
#pragma unroll
            for (int h = 0; h < 2; ++h)
#pragma unroll
                for (int i = 0; i < 2; ++i) { const int rr = h * 128 + R[i]; const int tok = list[u.e * NT + mt * 256 + (rr < u.cnt ? rr : 0)]; v[h][i] = (unsigned)(tok * KK + C[i]) * 2u; }
        } else {
#pragma unroll
            for (int i = 0; i < 2; ++i) v[0][i] = (unsigned)(R[i] * KK + C[i]) * 2u;
        }
    }
};

__device__ __forceinline__ void p15_final(const Frame& F0) {
    PHASE_VIEW();
    const bf16* X1 = (const bf16*)(F.ws + WS_X1); const bf16* YS = (const bf16*)(F.ws + WS_YSLOT); const unsigned* tokinfo = (const unsigned*)(F.ws + WS_TOKINFO);
    const float* gpost2 = F.in[7]; const float* mod = (const float*)(F.ws + WS_MOD);
    const LAS int* tp = (const LAS int*)(F.lds + TP_OFF);
    const int gw = F.vcu * NWAVES + F.wave, NGW = F.G * NWAVES;
    u32x4 tin = *(const u32x4*)(tokinfo + (size_t)gw * 8); u32x2 tgn = *(const u32x2*)(tokinfo + (size_t)gw * 8 + 4);
    for (int row = gw; row < NT; row += NGW) {
        const int b = row >> 11;
        const u32x4 ti = tin; const u32x2 tg = tgn;
        const size_t r1 = (size_t)tp[ti.x] * 256 + ti.y, r2 = (size_t)tp[ti.z] * 256 + ti.w; const float g1 = __uint_as_float(tg.x), g2 = __uint_as_float(tg.y);
        const u32x2* y1 = (const u32x2*)(YS + r1 * DM) + F.lane; const u32x2* y2 = (const u32x2*)(YS + r2 * DM) + F.lane; const u32x2* xp = (const u32x2*)(X1 + (size_t)row * DM) + F.lane;
        u32x2 ya[8], yb[8], xw[8];
#pragma unroll
        for (int j = 0; j < 8; ++j) { ya[j] = y1[64 * j]; yb[j] = y2[64 * j]; xw[j] = xp[64 * j]; }
        { const int rn = (row + NGW < NT) ? row + NGW : row; tin = *(const u32x4*)(tokinfo + (size_t)rn * 8); tgn = *(const u32x2*)(tokinfo + (size_t)rn * 8 + 4); }
        f32x4 v[8]; float ss = 0.f;
#pragma unroll
        for (int j = 0; j < 8; ++j) { const u32x2 a = ya[j], c = yb[j];
            v[j] = (f32x4){bf_lo(a.x), bf_hi(a.x), bf_lo(a.y), bf_hi(a.y)} * g1 + (f32x4){bf_lo(c.x), bf_hi(c.x), bf_lo(c.y), bf_hi(c.y)} * g2;
            ss += (v[j].x * v[j].x + v[j].y * v[j].y) + (v[j].z * v[j].z + v[j].w * v[j].w); }
        const float rs = rsqrtf(wave_sum_dpp(ss) * (1.f / DM) + RMS_EPS);
#pragma unroll
        for (int j = 0; j < 8; ++j) { const int col = 4 * (F.lane + 64 * j);
            const f32x4 gv = *(const f32x4*)(gpost2 + col), gt = *(const f32x4*)(mod + b * NMOD + 5 * DM + col);
            const f32x4 xv = (f32x4){bf_lo(xw[j].x), bf_hi(xw[j].x), bf_lo(xw[j].y), bf_hi(xw[j].y)};
            ((f32x4*)(F.out + (size_t)row * DM))[F.lane + 64 * j] = xv + gt * (v[j] * rs * gv); }
    }
}

constexpr int NPH = 15;
__global__ void __launch_bounds__(NTHR, 2) mk_fwd(Args args) {
    extern __shared__ __attribute__((aligned(16))) unsigned char lds[];
    Frame F0;
    F0.lds = (LAS unsigned char*)lds; F0.MISC = (volatile LAS unsigned*)(F0.lds + MISC_OFF);
    F0.tid = threadIdx.x; F0.lane = F0.tid & 63; F0.wave = __builtin_amdgcn_readfirstlane(F0.tid >> 6);
    F0.G = gridDim.x; { const int bx = blockIdx.x; F0.vcu = (F0.G % 8 == 0) ? (bx % 8) * (F0.G / 8) + bx / 8 : bx; }
    F0.in.kp = (kargp_t)__builtin_amdgcn_kernarg_segment_ptr(); F0.out = args.out; F0.ws = args.ws; F0.ctl = (unsigned*)(args.ws + WS_CTL);
    if (F0.tid < 64) F0.MISC[F0.tid] = 0u;
    __syncthreads();
    const int lo = args.ph_lo, hi = args.ph_hi;
    XcdBarrier bar; bar.bar = F0.ctl + CW_BAR; bar.x = 0; bar.st = nullptr;
    if (hi - lo > 1) bar = xcd_barrier_post(F0.ctl + CW_BAR, F0.MISC + 8);
#ifndef PROBE_MASK
#define PROBE_MASK 0
#endif
#define REPS(k) ((((PROBE_MASK) >> (k)) & 1) + 1)
#define IN(k) (lo <= (k) && (k) < hi)
#define SEAM(k) do { if (IN(k) && IN((k) + 1)) xcd_barrier(bar); } while (0)
    LAS unsigned char* ring = F0.lds;

    if (IN(0)) for (int rep_ = 0; rep_ < REPS(0); ++rep_) { p0_prologue(F0); } SEAM(0);
    if (IN(1)) for (int rep_ = 0; rep_ < REPS(1); ++rep_) { p1_h1(F0); } SEAM(1);
    if (IN(2)) for (int rep_ = 0; rep_ < REPS(2); ++rep_) {
        PHASE_VIEW();
        const int G_GEMM = (F.G >= 256) ? CONV_GEMM_BLOCKS : F.G;
        if ((int)blockIdx.x < G_GEMM) {
            pg8::Gemm g{(const bf16*)(F.ws + WS_H), (const bf16*)(F.ws + WS_WIN_T), NT, DIN, DM}; pg8::StaticOrder S; S.init(g, G_GEMM, (int)blockIdx.x);
            pg8::EpiBf16 E{(bf16*)(F.ws + WS_PROJ), DIN};
            pg8::gemm_phase(ring, DM, S, E);
            __syncthreads();
            if (F.tid == 0 && rep_ == 0) { const unsigned d = atomicAdd(F.ctl + CW_GDONE, 1u); if (d == (unsigned)G_GEMM - 1u) __hip_atomic_store(F.ctl + CW_STOP, 1u, RLX_AGENT); }
        } else if (rep_ == 0) {
            const int jw = ((int)blockIdx.x - G_GEMM) * NWAVES + F.wave, ncw = (F.G - G_GEMM) * NWAVES;
            const int done = conv_stream(F, jw, ncw, CONV_ITEMS, F.ctl + CW_STOP);
            if (F.lane == 0) __hip_atomic_store(F.ctl + CW_PROG + jw, (unsigned)done, RLX_AGENT);
        }
    } SEAM(2);
    if (IN(3)) for (int rep_ = 0; rep_ < REPS(3); ++rep_) {
        PHASE_VIEW();
        S5Order<1> S{(const char*)(F.ws + WS_PROJ), (const char*)(F.ws + WS_SIN), (const char*)(F.ws + WS_S5WT), F.G, F.vcu};
        pg8::EpiS5Scan E{(bf16*)(F.ws + WS_SIN), F.in[10], F.in[11], F.in[12]};
        if (F.G >= NG * 4) pg8::gemm_phase(ring, 256, S, E);
    }
    if (IN(3) && IN(4)) { asm volatile("s_waitcnt vmcnt(0)" ::: "memory"); __syncthreads(); __builtin_amdgcn_fence(__ATOMIC_ACQUIRE, "agent"); asm volatile("s_waitcnt vmcnt(0)" ::: "memory"); __syncthreads(); }
    if (IN(4)) for (int rep_ = 0; rep_ < REPS(4); ++rep_) {
        PHASE_VIEW();
        S5Order<2> S{(const char*)(F.ws + WS_PROJ), (const char*)(F.ws + WS_SIN), (const char*)(F.ws + WS_S5MT), F.G, F.vcu};
        pg8::EpiS5Y E{(bf16*)(F.ws + WS_YSG)};
        int kk = 384; LAUNDER(kk);
        pg8::gemm_phase(ring, kk, S, E);
    } SEAM(4);
    if (IN(5)) for (int rep_ = 0; rep_ < REPS(5); ++rep_) {
        PHASE_VIEW();
        pg8::Gemm g{(const bf16*)(F.ws + WS_YSG), (const bf16*)(F.ws + WS_GLU_T), NT, DSSM, DSSM}; pg8::StaticOrder S; S.init(g, F.G, (int)blockIdx.x);
        pg8::EpiGlu E{(const bf16*)(F.ws + WS_YSG), (bf16*)(F.ws + WS_MIX), DM, F.in[19]};
        pg8::gemm_phase(ring, DSSM, S, E);
    } SEAM(5);
    if (IN(6)) for (int rep_ = 0; rep_ < REPS(6); ++rep_) { p9a_rwkv_chunks(F0); } SEAM(6);
    if (IN(7)) for (int rep_ = 0; rep_ < REPS(7); ++rep_) { p9b_rwkv_seq(F0); } SEAM(7);
    if (IN(8)) for (int rep_ = 0; rep_ < REPS(8); ++rep_) { p9_rwkv_post(F0); } SEAM(8);
    if (IN(9)) for (int rep_ = 0; rep_ < REPS(9); ++rep_) {
        PHASE_VIEW();
        pg8::Gemm g{(const bf16*)(F.ws + WS_MIX), (const bf16*)(F.ws + WS_WOUT_T), NT, DM, DM}; pg8::StaticOrder S; S.init(g, F.G, (int)blockIdx.x);
        pg8::EpiBf16 E{(bf16*)(F.ws + WS_MIXED), DM};
        pg8::gemm_phase(ring, DM, S, E);
    } SEAM(9);
    if (IN(10)) for (int rep_ = 0; rep_ < REPS(10); ++rep_) { p11_x1_router(F0); }
    if (IN(11)) for (int rep_ = 0; rep_ < REPS(11); ++rep_) { p12_expert_convert(F0); } SEAM(11);
    if (IN(12)) for (int rep_ = 0; rep_ < REPS(12); ++rep_) {
        PHASE_VIEW();
        moe_build_tp(F);
        MoeOrder<true> S{(const LAS int*)(F.lds + TP_OFF), F.ctl + CW_CNT, (const int*)(F.ws + WS_LIST), (const char*)(F.ws + WS_H), (const char*)(F.ws + WS_EW1), F.G, (int)blockIdx.x};
        pg8::EpiSwiglu E{(bf16*)(F.ws + WS_HID)};
        pg8::gemm_phase(ring, DM, S, E);
    } SEAM(12);
    if (IN(13)) for (int rep_ = 0; rep_ < REPS(13); ++rep_) {
        PHASE_VIEW();
        moe_build_tp(F);
        MoeOrder<false> S{(const LAS int*)(F.lds + TP_OFF), F.ctl + CW_CNT, (const int*)(F.ws + WS_LIST), (const char*)(F.ws + WS_HID), (const char*)(F.ws + WS_EW2), F.G, (int)blockIdx.x};
        pg8::EpiBf16 E{(bf16*)(F.ws + WS_YSLOT), DM};
        pg8::gemm_phase(ring, DEXP, S, E);
    } SEAM(13);
    if (IN(14)) for (int rep_ = 0; rep_ < REPS(14); ++rep_) { moe_build_tp(F0); p15_final(F0); }
#undef IN
#undef SEAM
}

extern "C" void kernel_launch(void* const* d_in, const int* in_sizes, int n_in, void* d_out, int out_size, void* d_ws, size_t ws_size, hipStream_t stream) {
    static int grid = 0;
    if (grid == 0) {
        if (n_in != 38 || out_size != NT * DM || ws_size < WS_END) { fprintf(stderr, "kernel_launch: unexpected problem (n_in %d, out %d, ws %zu < %zu)\n", n_in, out_size, ws_size, (size_t)WS_END); grid = -1; return; }
        int dev = 0, cus = 0, per_cu = 0;
        if (hipGetDevice(&dev) != hipSuccess || hipDeviceGetAttribute(&cus, hipDeviceAttributeMultiprocessorCount, dev) != hipSuccess) { grid = -1; return; }
        if (hipFuncSetAttribute((const void*)mk_fwd, hipFuncAttributeMaxDynamicSharedMemorySize, LDS_BYTES) != hipSuccess) { fprintf(stderr, "kernel_launch: hipFuncSetAttribute failed\n"); grid = -1; return; }
        if (hipOccupancyMaxActiveBlocksPerMultiprocessor(&per_cu, (const void*)mk_fwd, NTHR, LDS_BYTES) != hipSuccess || per_cu < 1) fprintf(stderr, "kernel_launch: occupancy query says %d\n", per_cu);
        (void)hipGetLastError();
        grid = cus;
    }
    if (grid < 0) return;
    if (hipMemsetAsync((char*)d_ws + WS_CTL, 0, CTL_ZERO_BYTES, stream) != hipSuccess) return;
    Args a{};
    for (int i = 0; i < 38; ++i) a.in[i] = (const float*)d_in[i];
    a.out = (float*)d_out; a.ws = (unsigned char*)d_ws;
#if MK_N_LAUNCHES == 1
    a.ph_lo = 0; a.ph_hi = NPH;
    hipLaunchKernelGGL(mk_fwd, dim3(grid), dim3(NTHR), LDS_BYTES, stream, a);
#else
    for (int p = 0; p < NPH; ++p) { a.ph_lo = p; a.ph_hi = p + 1; hipLaunchKernelGGL(mk_fwd, dim3(grid), dim3(NTHR), LDS_BYTES, stream, a); }
#endif
}
```

```cpp
#include <hip/hip_runtime.h>
#include <cstdio>
#include <cstdint>

#ifndef MK_N_LAUNCHES
#define MK_N_LAUNCHES 1
#endif

#ifndef CONV_GEMM_BLOCKS
#define CONV_GEMM_BLOCKS 184
#endif

#define GAS __attribute__((address_space(1)))
namespace pg8 {
#define PG8_LAS __attribute__((address_space(3)))
typedef unsigned short bf16_t;
typedef short bf16x8 __attribute__((ext_vector_type(8)));
typedef float f32x4 __attribute__((ext_vector_type(4)));
typedef float f32x2 __attribute__((ext_vector_type(2)));
typedef unsigned u32x4 __attribute__((ext_vector_type(4)));
typedef unsigned u32x2 __attribute__((ext_vector_type(2)));
constexpr int BM = 256, BK = 64, HALF = 128, HTB = HALF * BK * 2, STAGE_BYTES = 8 * HTB, NXCD = 8, WGM = 8;

__host__ __device__ __forceinline__ int lds_byte(int r, int c) { const int st = (r >> 4) * 2 + (c >> 5), rr = r & 15, cc = c & 31, ob = rr * 64 + cc * 2; return st * 1024 + (ob ^ (((ob >> 9) & 1) << 5)); }
__host__ __device__ __forceinline__ void stage_rc(int b, int& R, int& C) { const int st = b / 1024, sb = b % 1024, swz = sb ^ (((sb >> 9) & 1) << 5); R = (st >> 1) * 16 + swz / 64; C = (st & 1) * 32 + (swz % 64) / 2; }
__host__ __device__ __forceinline__ int perm32(int rho) { const int n = rho >> 4, i = rho & 15; return 8 * (i >> 2) + 4 * n + (i & 3); }

struct Unit { int pm, pn, e, cnt; const char* Ab; const char* Bb; };
struct Gemm { const bf16_t* A; const bf16_t* Bt; int M, N, K; };

struct StaticOrder {
    static constexpr bool GATHER = false; static constexpr int A2 = 0;
    __device__ __forceinline__ size_t kstepA() const { return (size_t)BK * 2; }
    __device__ __forceinline__ size_t hstepA() const { return (size_t)HALF * K * 2; }
    __device__ __forceinline__ size_t a2off() const { return 0; }
    int nM, nN, nwg, G, c, K; const char* A; const char* Bt;
    __device__ void init(const Gemm& g, int G_, int c_) { nM = g.M / BM; nN = g.N / BM; nwg = nM * nN; G = G_; c = c_; K = g.K; A = (const char*)g.A; Bt = (const char*)g.Bt; }
    __device__ bool next(int i, Unit& u) const {
        const long L = (long)i * G + c; if (L >= nwg) return false;
        int wgid = (int)L; { const int q = nwg / NXCD, r = nwg % NXCD, xcd = wgid % NXCD, off = wgid / NXCD; wgid = (xcd < r ? xcd * (q + 1) : r * (q + 1) + (xcd - r) * q) + off; }
        const int nig = WGM * nN, gid = wgid / nig, fm = gid * WGM, gsz = (nM - fm) < WGM ? (nM - fm) : WGM;
        u.pm = fm + ((wgid % nig) % gsz); u.pn = (wgid % nig) / gsz; u.e = 0; u.cnt = BM;
        u.Ab = A + (size_t)u.pm * BM * K * 2; u.Bb = Bt + (size_t)u.pn * BM * K * 2; return true;
    }
    template <int NV> __device__ __forceinline__ void a_voff(const Unit&, unsigned (&v)[NV][2], const int (&R)[2], const int (&C)[2]) const {
#pragma unroll
        for (int i = 0; i < 2; ++i) v[0][i] = (unsigned)(R[i] * K + C[i]) * 2u;
    }
};

typedef __bf16 bf16x2_v __attribute__((ext_vector_type(2)));
__device__ __forceinline__ unsigned cvt_pk_bf16(float lo, float hi) { const f32x2 v = {lo, hi}; const bf16x2_v b = __builtin_convertvector(v, bf16x2_v); return __builtin_bit_cast(unsigned, b); }
__device__ __forceinline__ float bf_lo(unsigned w) { return __uint_as_float(w << 16); }
__device__ __forceinline__ float bf_hi(unsigned w) { return __uint_as_float(w & 0xffff0000u); }
__device__ __forceinline__ float sigmoidf_(float x) { return __builtin_amdgcn_rcpf(1.0f + __builtin_amdgcn_exp2f(-1.4426950408889634f * x)); }

struct EpiF32 {
    static constexpr bool AFTER_DRAIN = false; static constexpr bool PERM = false;
    float* C; int ldc;
    __device__ __forceinline__ void operator()(const f32x4 (&acc)[2][2][4][2], const Unit& u, int wr, int wc, int fr, int fq) const {
        const int row0 = u.pm * BM + wr * 64 + fr, col0 = u.pn * BM + wc * 32 + 4 * fq;
#pragma unroll
        for (int ai = 0; ai < 2; ++ai)
#pragma unroll
            for (int m = 0; m < 4; ++m) { float* rowp = C + (size_t)(row0 + ai * HALF + m * 16) * ldc + col0;
#pragma unroll
                for (int bj = 0; bj < 2; ++bj)
#pragma unroll
                    for (int n = 0; n < 2; ++n) *(f32x4*)(rowp + bj * HALF + n * 16) = acc[ai][bj][m][n]; }
    }
};
struct EpiBf16 {
    static constexpr bool AFTER_DRAIN = false; static constexpr bool PERM = true;
    bf16_t* O; int ldc;
    __device__ __forceinline__ void operator()(const f32x4 (&acc)[2][2][4][2], const Unit& u, int wr, int wc, int fr, int fq) const {
        const int row0 = u.pm * BM + wr * 64 + fr, col0 = u.pn * BM + wc * 32 + 8 * fq;
#pragma unroll
        for (int ai = 0; ai < 2; ++ai)
#pragma unroll
            for (int m = 0; m < 4; ++m) { GAS bf16_t* rowp = (GAS bf16_t*)O + (size_t)(row0 + ai * HALF + m * 16) * ldc + col0;
#pragma unroll
                for (int bj = 0; bj < 2; ++bj) { const f32x4 v0 = acc[ai][bj][m][0], v1 = acc[ai][bj][m][1];
                    u32x4 w; w.x = cvt_pk_bf16(v0[0], v0[1]); w.y = cvt_pk_bf16(v0[2], v0[3]); w.z = cvt_pk_bf16(v1[0], v1[1]); w.w = cvt_pk_bf16(v1[2], v1[3]);
                    *(GAS u32x4*)(rowp + bj * HALF) = w; } }
    }
};
struct EpiLora {
    static constexpr bool AFTER_DRAIN = false; static constexpr bool PERM = false;
    float* base; size_t stride; const float* w0; const float* a0;
    __device__ __forceinline__ void operator()(const f32x4 (&acc)[2][2][4][2], const Unit& u, int wr, int wc, int fr, int fq) const {
        const int row0 = u.pm * BM + wr * 64 + fr; const int kind = u.pn >> 2; const int col0 = (u.pn & 3) * BM + wc * 32 + 4 * fq;
        float* dst = base + (size_t)kind * stride;
        const float* bp = (kind == 0) ? w0 : a0; const float bs = (kind == 2) ? 0.f : 1.f;
        f32x4 bv[2][2];
#pragma unroll
        for (int bj = 0; bj < 2; ++bj)
#pragma unroll
            for (int n = 0; n < 2; ++n) bv[bj][n] = *(const f32x4*)(bp + col0 + bj * HALF + n * 16) * bs;
#pragma unroll
        for (int ai = 0; ai < 2; ++ai)
#pragma unroll
            for (int m = 0; m < 4; ++m) { float* rowp = dst + (size_t)(row0 + ai * HALF + m * 16) * 1024 + col0;
#pragma unroll
                for (int bj = 0; bj < 2; ++bj)
#pragma unroll
                    for (int n = 0; n < 2; ++n) { f32x4 v = acc[ai][bj][m][n] + bv[bj][n];
                        if (kind == 0) {
#pragma unroll
                            for (int j = 0; j < 4; ++j) v[j] = __expf(-0.6065306597126334f * sigmoidf_(v[j])); }
                        else if (kind == 1) {
#pragma unroll
                            for (int j = 0; j < 4; ++j) v[j] = sigmoidf_(v[j]); }
                        *(f32x4*)(rowp + bj * HALF + n * 16) = v; } }
    }
};
struct EpiGlu {
    static constexpr bool AFTER_DRAIN = false; static constexpr bool PERM = true;
    const bf16_t* Y; bf16_t* O; int ldo; const float* bias;
    __device__ __forceinline__ void operator()(const f32x4 (&acc)[2][2][4][2], const Unit& u, int wr, int wc, int fr, int fq) const {
        const int row0 = u.pm * BM + wr * 64 + fr, col0 = u.pn * BM + wc * 32 + 8 * fq;
        f32x4 bv[2][2];
#pragma unroll
        for (int bj = 0; bj < 2; ++bj)
#pragma unroll
            for (int n = 0; n < 2; ++n) bv[bj][n] = *(const GAS f32x4*)((const GAS float*)bias + col0 + bj * HALF + 4 * n);
#pragma unroll
        for (int ai = 0; ai < 2; ++ai)
#pragma unroll
            for (int m = 0; m < 4; ++m) { const size_t r = (size_t)(row0 + ai * HALF + m * 16);
#pragma unroll
                for (int bj = 0; bj < 2; ++bj) { const u32x4 yv = *(const GAS u32x4*)((const GAS bf16_t*)Y + r * 1024 + col0 + bj * HALF);
                    const f32x4 v0 = acc[ai][bj][m][0] + bv[bj][0], v1 = acc[ai][bj][m][1] + bv[bj][1];
                    u32x4 w;
                    w.x = cvt_pk_bf16(bf_lo(yv.x) * sigmoidf_(v0[0]), bf_hi(yv.x) * sigmoidf_(v0[1]));
                    w.y = cvt_pk_bf16(bf_lo(yv.y) * sigmoidf_(v0[2]), bf_hi(yv.y) * sigmoidf_(v0[3]));
                    w.z = cvt_pk_bf16(bf_lo(yv.z) * sigmoidf_(v1[0]), bf_hi(yv.z) * sigmoidf_(v1[1]));
                    w.w = cvt_pk_bf16(bf_lo(yv.w) * sigmoidf_(v1[2]), bf_hi(yv.w) * sigmoidf_(v1[3]));
                    *(GAS u32x4*)((GAS bf16_t*)O + r * ldo + col0 + bj * HALF) = w; } }
    }
};
struct EpiSwiglu {
    static constexpr bool AFTER_DRAIN = false; static constexpr bool PERM = true;
    bf16_t* Hd;
    __device__ __forceinline__ void operator()(const f32x4 (&acc)[2][2][4][2], const Unit& u, int wr, int wc, int fr, int fq) const {
        const int row0 = u.pm * BM + wr * 64 + fr, col0 = u.pn * HALF + wc * 32 + 8 * fq;
#pragma unroll
        for (int ai = 0; ai < 2; ++ai)
#pragma unroll
            for (int m = 0; m < 4; ++m) { GAS bf16_t* rowp = (GAS bf16_t*)Hd + (size_t)(row0 + ai * HALF + m * 16) * 512 + col0;
                float o[8];
#pragma unroll
                for (int n = 0; n < 2; ++n)
#pragma unroll
                    for (int j = 0; j < 4; ++j) { const float a = acc[ai][0][m][n][j], b = acc[ai][1][m][n][j]; o[n * 4 + j] = a * sigmoidf_(a) * b; }
                u32x4 w; w.x = cvt_pk_bf16(o[0], o[1]); w.y = cvt_pk_bf16(o[2], o[3]); w.z = cvt_pk_bf16(o[4], o[5]); w.w = cvt_pk_bf16(o[6], o[7]);
                *(GAS u32x4*)rowp = w; }
    }
};

struct EpiS5Scan {
    static constexpr bool AFTER_DRAIN = true; static constexpr bool PERM = false;
    bf16_t* SIN; const float* lam_re; const float* lam_im; const float* log_dt;
    __device__ __forceinline__ void operator()(const f32x4 (&)[2][2][4][2], const Unit&, int, int, int, int) const {}
    __device__ __forceinline__ void fused(const f32x4 (&acc)[2][2][4][2], const Unit& u, int wr, int wc, int fr, int fq, PG8_LAS unsigned char* lds) const {
        PG8_LAS float* T = (PG8_LAS float*)lds;
#pragma unroll
        for (int ai = 0; ai < 2; ++ai)
#pragma unroll
            for (int m = 0; m < 4; ++m)
#pragma unroll
                for (int n = 0; n < 2; ++n) *(PG8_LAS f32x4*)(T + (ai * HALF + wr * 64 + m * 16 + fr) * 128 + wc * 32 + n * 16 + 4 * fq) = acc[ai][0][m][n];
        __syncthreads();
        const int tid = threadIdx.x;
        if (tid < 128) {
            const int b2 = tid >> 6, p = tid & 63, g = u.e;
            const float lr = fminf(lam_re[g * 64 + p], -1e-4f), li = lam_im[g * 64 + p], dt = __expf(log_dt[g]);
            const float mag = __expf(lr * dt * 16.f), ang = li * dt * 16.f; const float ar = mag * cosf(ang), ai_ = mag * sinf(ang);
            float sr = 0.f, si = 0.f;
            GAS bf16_t* dst = (GAS bf16_t*)SIN + ((size_t)(u.pm * 256 + b2 * 128) * 16 + (p >> 4)) * 4352 + g * 16 + (p & 15);
            const PG8_LAS float* src = T + (b2 * 128) * 128 + p;
#pragma unroll 8
            for (int ch = 0; ch < 128; ++ch) {
                const unsigned w = cvt_pk_bf16(sr, si);
                dst[(size_t)ch * 16 * 4352] = (bf16_t)(w & 0xffffu); dst[(size_t)ch * 16 * 4352 + 4 * 4352] = (bf16_t)(w >> 16);
                const float lr_ = src[ch * 128], li_ = src[ch * 128 + 64];
                const float nr = ar * sr - ai_ * si + lr_, ni = ar * si + ai_ * sr + li_; sr = nr; si = ni;
            }
        }
    }
};
__device__ __forceinline__ float gelu_tanh_(float y) { const float u = 0.7978845608028654f * (y + 0.044715f * y * y * y); const float e = __builtin_amdgcn_exp2f(2.8853900817779268f * u); return y * (1.f - __builtin_amdgcn_rcpf(e + 1.f)); }
struct EpiS5Y {
    static constexpr bool AFTER_DRAIN = false; static constexpr bool PERM = true;
    bf16_t* Y;
    __device__ __forceinline__ void operator()(const f32x4 (&acc)[2][2][4][2], const Unit& u, int wr, int wc, int fr, int fq) const {
        const int row0 = u.pm * BM + wr * 64 + fr;
#pragma unroll
        for (int ai = 0; ai < 2; ++ai)
#pragma unroll
            for (int m = 0; m < 4; ++m) { const size_t r = (size_t)(row0 + ai * HALF + m * 16);
#pragma unroll
                for (int bj = 0; bj < 2; ++bj) { const int col = bj * HALF + wc * 32 + 8 * fq; const int t = col >> 4, c = col & 15;
                    const f32x4 v0 = acc[ai][bj][m][0], v1 = acc[ai][bj][m][1];
                    u32x4 w; w.x = cvt_pk_bf16(gelu_tanh_(v0[0]), gelu_tanh_(v0[1])); w.y = cvt_pk_bf16(gelu_tanh_(v0[2]), gelu_tanh_(v0[3]));
                    w.z = cvt_pk_bf16(gelu_tanh_(v1[0]), gelu_tanh_(v1[1])); w.w = cvt_pk_bf16(gelu_tanh_(v1[2]), gelu_tanh_(v1[3]));
                    *(GAS u32x4*)((GAS bf16_t*)Y + (r * 16 + t) * 1024 + u.e * 16 + c) = w; } }
    }
};

template <class Epi, class Sched>
__device__ __forceinline__ void gemm_phase(PG8_LAS unsigned char* lds, const int K, const Sched& S, const Epi& E) {
    const int tid = threadIdx.x, wid = __builtin_amdgcn_readfirstlane(tid >> 6), lane = tid & 63, wr = wid >> 2, wc = wid & 3, fr = lane & 15, fq = lane >> 4;
    const int nt = K / BK;
    int RR[2], CC[2]; unsigned voffB[2];
#pragma unroll
    for (int i = 0; i < 2; ++i) { stage_rc(tid * 16 + i * 8192, RR[i], CC[i]); const int Rb = Epi::PERM ? ((RR[i] & ~31) + perm32(RR[i] & 31)) : RR[i];
        voffB[i] = (unsigned)(Rb * K + CC[i]) * 2u; }
    const size_t kstep = (size_t)(BK * 2);
    const size_t hstep = (size_t)HALF * K * 2;
    const unsigned ldsw = (unsigned)wid * 1024u;
    const int aoff = lds_byte(wr * 64 + fr, fq * 8), boff = lds_byte(wc * 32 + fr, fq * 8);
#define PG8_SA(b, h) (((b) * 2 + (h)) * HTB)
#define PG8_SB(b, h) ((4 + (b) * 2 + (h)) * HTB)
#define PG8_STAGE(bufoff, gbase, voff) do { _Pragma("unroll") for (int _i = 0; _i < 2; ++_i) \
        __builtin_amdgcn_global_load_lds((const unsigned*)((const char*)(gbase) + (voff)[_i]), (PG8_LAS unsigned*)(lds + (bufoff) + ldsw + _i * 8192), 16, 0, 0); } while (0)
#define PG8_LDA(dst, b, h) do { _Pragma("unroll") for (int m = 0; m < 4; ++m) _Pragma("unroll") for (int k = 0; k < 2; ++k) dst[m][k] = *(const PG8_LAS bf16x8*)(lds + PG8_SA(b, h) + aoff + m * 2048 + k * 1024); } while (0)
#define PG8_LDB(dst, b, h) do { _Pragma("unroll") for (int n = 0; n < 2; ++n) _Pragma("unroll") for (int k = 0; k < 2; ++k) dst[n][k] = *(const PG8_LAS bf16x8*)(lds + PG8_SB(b, h) + boff + n * 2048 + k * 1024); } while (0)
#define PG8_MMA(ai, bj, At, Bt) do { __builtin_amdgcn_s_setprio(1); _Pragma("unroll") for (int m = 0; m < 4; ++m) _Pragma("unroll") for (int n = 0; n < 2; ++n) _Pragma("unroll") for (int k = 0; k < 2; ++k) \
        acc[ai][bj][m][n] = __builtin_amdgcn_mfma_f32_16x16x32_bf16(Bt[n][k], At[m][k], acc[ai][bj][m][n], 0, 0, 0); __builtin_amdgcn_s_setprio(0); } while (0)
#define PG8_WAIT_V(n) asm volatile("s_waitcnt vmcnt(" #n ")" ::: "memory")
#define PG8_WAIT_L(n) asm volatile("s_waitcnt lgkmcnt(" #n ")" ::: "memory")
#define PG8_BAR __builtin_amdgcn_s_barrier()
#define PG8_SCHED __builtin_amdgcn_sched_barrier(0)
    Unit cur, nxt; int ui = 0;
    if (!S.next(0, cur)) return;
    f32x4 acc[2][2][4][2];
#pragma unroll
    for (int a = 0; a < 2; ++a)
#pragma unroll
        for (int b = 0; b < 2; ++b)
#pragma unroll
            for (int m = 0; m < 4; ++m)
#pragma unroll
                for (int n = 0; n < 2; ++n) acc[a][b][m][n] = (f32x4){0.f, 0.f, 0.f, 0.f};
    bf16x8 At[4][2], B0[2][2], B1[2][2];
    constexpr bool GA = Sched::GATHER;
    constexpr int A2 = Sched::A2;
    constexpr int NV = GA ? 2 : 1;
    unsigned vA[NV][2], vN[NV][2];
    const size_t kstepA = S.kstepA(), hstepA = GA ? 0 : S.hstepA();
    const size_t a2off = (A2 > 0) ? S.a2off() : 0;
    S.template a_voff<NV>(cur, vA, RR, CC);
    const char* cA = cur.Ab; const char* cB = cur.Bb;
    PG8_STAGE(PG8_SB(0, 0), cB, voffB); PG8_STAGE(PG8_SB(0, 1), cB + hstep, voffB); PG8_STAGE(PG8_SA(0, 0), cA, vA[0]); PG8_STAGE(PG8_SA(0, 1), cA + hstepA, vA[NV - 1]);
    if (wr == 1) PG8_BAR;
    PG8_WAIT_V(2); PG8_BAR;
    PG8_STAGE(PG8_SB(1, 0), cB + kstep, voffB); PG8_STAGE(PG8_SA(1, 0), cA + kstepA, vA[0]); PG8_STAGE(PG8_SB(1, 1), cB + hstep + kstep, voffB);
    PG8_WAIT_V(6); PG8_BAR;
    for (;;) {
        const bool has_next = S.next(ui + 1, nxt);
        const char* nA = has_next ? nxt.Ab : cA; const char* nB = has_next ? nxt.Bb : cB;
        if constexpr (GA) {
            if (has_next) S.template a_voff<NV>(nxt, vN, RR, CC);
            else {
#pragma unroll
                for (int h = 0; h < NV; ++h)
#pragma unroll
                    for (int i = 0; i < 2; ++i) vN[h][i] = vA[h][i]; }
        }
#pragma clang loop unroll(disable)
        for (int t = 0; t < nt; t += 2) {
            const bool last = (t == nt - 2);
            const bool s1 = (A2 > 0) && (t + 1 >= A2), s2 = (A2 > 0) && !last && (t + 2 >= A2);
            const char* a1 = cA + (size_t)(t + 1) * kstepA + (s1 ? a2off : 0);
            const char* a2 = last ? nA : cA + (size_t)(t + 2) * kstepA + (s2 ? a2off : 0);
            const char* a3 = a2 + kstepA;
            const char* b2 = last ? nB : cB + (size_t)(t + 2) * kstep; const char* b3 = b2 + kstep;
            unsigned v2[NV][2];
#pragma unroll
            for (int h = 0; h < NV; ++h)
#pragma unroll
                for (int i = 0; i < 2; ++i) v2[h][i] = (GA && last) ? vN[h][i] : vA[h][i];
            PG8_LDB(B0, 0, 0); PG8_LDB(B1, 0, 1); PG8_SCHED; PG8_LDA(At, 0, 0); PG8_STAGE(PG8_SA(1, 1), a1 + hstepA, vA[NV - 1]);
            PG8_WAIT_V(8); PG8_WAIT_L(0); PG8_BAR; PG8_MMA(0, 0, At, B0); PG8_MMA(0, 1, At, B1); PG8_BAR; PG8_SCHED;
            PG8_LDA(At, 0, 1); PG8_STAGE(PG8_SB(0, 0), b2, voffB); PG8_STAGE(PG8_SB(0, 1), b2 + hstep, voffB); PG8_STAGE(PG8_SA(0, 0), a2, v2[0]);
            PG8_WAIT_V(8); PG8_WAIT_L(0); PG8_BAR; PG8_MMA(1, 0, At, B0); PG8_MMA(1, 1, At, B1); PG8_BAR; PG8_SCHED;
            PG8_LDB(B0, 1, 0); PG8_LDB(B1, 1, 1); PG8_SCHED; PG8_LDA(At, 1, 0); PG8_STAGE(PG8_SA(0, 1), a2 + hstepA, v2[NV - 1]);
            PG8_WAIT_V(8); PG8_WAIT_L(0); PG8_BAR; PG8_MMA(0, 0, At, B0); PG8_MMA(0, 1, At, B1); PG8_BAR; PG8_SCHED;
            PG8_LDA(At, 1, 1); PG8_STAGE(PG8_SB(1, 0), b3, voffB); PG8_STAGE(PG8_SB(1, 1), b3 + hstep, voffB); PG8_STAGE(PG8_SA(1, 0), a3, v2[0]);
            PG8_WAIT_V(8); PG8_WAIT_L(0); PG8_BAR; PG8_MMA(1, 0, At, B0); PG8_MMA(1, 1, At, B1); PG8_BAR; PG8_SCHED;
        }
        if (wr == 0) PG8_BAR;
        if constexpr (!Epi::AFTER_DRAIN) E(acc, cur, wr, wc, fr, fq);
        if (!has_next) break;
#pragma unroll
        for (int a = 0; a < 2; ++a)
#pragma unroll
            for (int b = 0; b < 2; ++b)
#pragma unroll
                for (int m = 0; m < 4; ++m)
#pragma unroll
                    for (int n = 0; n < 2; ++n) acc[a][b][m][n] = (f32x4){0.f, 0.f, 0.f, 0.f};
        cur = nxt; cA = nA; cB = nB; ++ui;
        if constexpr (GA) {
#pragma unroll
            for (int h = 0; h < NV; ++h)
#pragma unroll
                for (int i = 0; i < 2; ++i) vA[h][i] = vN[h][i]; }
        if (wr == 1) PG8_BAR;
    }
    PG8_WAIT_V(0);
    PG8_BAR;
    if constexpr (Epi::AFTER_DRAIN) E.fused(acc, cur, wr, wc, fr, fq, lds);
#undef PG8_SA
#undef PG8_SB
#undef PG8_STAGE
#undef PG8_LDA
#undef PG8_LDB
#undef PG8_MMA
#undef PG8_WAIT_V
#undef PG8_WAIT_L
#undef PG8_BAR
#undef PG8_SCHED
}
}
using pg8::f32x4; using pg8::f32x2; using pg8::u32x4; using pg8::u32x2; using pg8::cvt_pk_bf16; using pg8::bf_lo; using pg8::bf_hi; using pg8::sigmoidf_;

constexpr int NWAVES = 8, NTHR = 512;
constexpr int DM = 2048, NB = 8, SEQ = 2048, NT = NB * SEQ;
constexpr int DSSM = 1024, NG = 64, GC = 16, NP = 64;
constexpr int DRW = 1024, NH = 16, HD = 64;
constexpr int DIN = 4352, ZW = 3328;
constexpr int NEXP = 64, DEXP = 512, NMOD = 6 * DM;
constexpr float RMS_EPS = 1e-6f, GN_EPS = 64e-5f;
constexpr int CAP_ROWS = 49152;

constexpr size_t MiB = 1u << 20;
constexpr size_t WS_CTL = 0, CTL_ZERO_BYTES = 1 * MiB;
constexpr size_t WS_MOD = 1 * MiB;
constexpr size_t WS_RWT = 1 * MiB + 512 * 1024;
constexpr size_t WS_LORA_T = 2 * MiB + 512 * 1024;
constexpr size_t WS_GLU_T = 4 * MiB;
constexpr size_t WS_WOUT_T = 6 * MiB;
constexpr size_t WS_WIN_T = 14 * MiB;
constexpr size_t WS_TOKINFO = 31 * MiB;
constexpr size_t WS_LIST = 32 * MiB;
constexpr size_t WS_LIN = 36 * MiB;
constexpr size_t WS_H = 44 * MiB;
constexpr size_t WS_PROJ = 108 * MiB;
constexpr size_t WS_MIX = 244 * MiB;
constexpr size_t WS_EW1 = 308 * MiB;
constexpr size_t WS_EW2 = 564 * MiB;
constexpr size_t WS_SIN = 692 * MiB;
constexpr size_t WS_YSG = 828 * MiB;
constexpr size_t WS_S5MT = 860 * MiB;
constexpr size_t WS_S5WT = 872 * MiB;
constexpr size_t WS_VB = 692 * MiB;
constexpr size_t WS_GB = 724 * MiB;
constexpr size_t WS_GHQ = 756 * MiB;
constexpr size_t WS_GT = 948 * MiB;
constexpr size_t WS_BON = 950 * MiB;
constexpr size_t WS_Y = 952 * MiB;
constexpr size_t WS_X1 = 692 * MiB;
constexpr size_t WS_HID = 756 * MiB;
constexpr size_t WS_END = 984 * MiB;
constexpr size_t WS_MIXED = 108 * MiB;
constexpr size_t WS_YSLOT = 108 * MiB;
static_assert(WS_YSLOT + (size_t)CAP_ROWS * 2048 * 2 <= WS_EW1, "yslot overlay");
static_assert(WS_HID + (size_t)CAP_ROWS * 512 * 2 <= WS_END && WS_GHQ + (size_t)8192 * 12288 * 2 <= WS_GT && WS_SIN + (size_t)NT * DIN * 2 <= WS_YSG, "pool");
constexpr int CW_TMO = 0;
constexpr int CW_BAR = 4096;
constexpr int CW_CNT = 16384;
constexpr int CW_GDONE = 8192, CW_STOP = 8192 + 64, CW_PROG = 8192 + 128;
constexpr int CONV_ITEMS = NEXP * 1536;


constexpr int RING_BYTES = 131072;
constexpr int LDSCTL_OFF = 147456 - 2048;
constexpr int MISC_OFF = LDSCTL_OFF;
constexpr int TP_OFF = LDSCTL_OFF + 256;
constexpr int LDS_BYTES = 147456;

#define LAS __attribute__((address_space(3)))
typedef unsigned short bf16;
typedef GAS unsigned gu32;
#define RLX_AGENT __ATOMIC_RELAXED, __HIP_MEMORY_SCOPE_AGENT

#define XB_TMO      128
#define XB_XCNT(j)  (256  + 64 * (j))
#define XB_XSUB(j)  (1280 + 64 * (j))
#define XB_XGEN(j)  (2304 + 64 * (j))
#define XB_TOP      3328
#define XB_TOPGEN   3392
#define XCD_BAR_WORDS 3456
#define XB_SPIN_CAP (1u << 18)
__device__ __forceinline__ unsigned xb_ld(unsigned* p)              { return __hip_atomic_load(p, __ATOMIC_RELAXED, __HIP_MEMORY_SCOPE_AGENT); }
__device__ __forceinline__ unsigned xb_add(unsigned* p, unsigned v) { return __hip_atomic_fetch_add(p, v, __ATOMIC_RELAXED, __HIP_MEMORY_SCOPE_AGENT); }
__device__ __forceinline__ unsigned xb_xcc_id() { return (unsigned)__builtin_amdgcn_s_getreg((3 << 11) | 20) & 0xFu; }
#define XB_SPIN(cond, bar) do { unsigned _sp = 0; while (cond) { __builtin_amdgcn_s_sleep(1); \
    if ((++_sp & 255u) == 0u) { if (xb_ld(&(bar)[XB_TMO])) break; if (_sp > XB_SPIN_CAP) { atomicAdd(&(bar)[XB_TMO], 1u); break; } } } } while (0)
struct XcdBarrier { unsigned* bar; unsigned x; volatile LAS unsigned* st; };
__device__ __forceinline__ XcdBarrier xcd_barrier_post(unsigned* bar, volatile LAS unsigned* st) {
    XcdBarrier b; b.bar = bar; b.x = xb_xcc_id(); b.st = st;
    if (threadIdx.x == 0) (void)xb_add(&bar[XB_XCNT(b.x)], 1u);
    return b;
}
__device__ __forceinline__ void xcd_barrier_complete(unsigned* bar, unsigned x, unsigned& nloc, unsigned& nx) {
    const unsigned G = gridDim.x * gridDim.y * gridDim.z;
    unsigned sum, cnt, mine, sp = 0u;
    for (;;) {
        sum = 0u; cnt = 0u; mine = 0u;
#pragma unroll
        for (unsigned j = 0; j < 16; ++j) { const unsigned c = xb_ld(&bar[XB_XCNT(j)]); sum += c; cnt += (c > 0u) ? 1u : 0u; mine = (j == x) ? c : mine; }
        if (sum == G) break;
        __builtin_amdgcn_s_sleep(1);
        if ((++sp & 255u) == 0u) { if (xb_ld(&bar[XB_TMO])) break; if (sp > XB_SPIN_CAP) { atomicAdd(&bar[XB_TMO], 1u); break; } }
    }
    nloc = mine > 0u ? mine : 1u; nx = cnt > 0u ? cnt : 1u;
}
__device__ __forceinline__ void xcd_barrier(const XcdBarrier& b) {
    asm volatile("s_waitcnt vmcnt(0)" ::: "memory");
    __syncthreads();
    if (threadIdx.x == 0) {
        unsigned* bar = b.bar;
        __builtin_amdgcn_s_waitcnt(0);
        unsigned nloc = b.st[0], nx = b.st[1];
        if (nloc == 0u) { xcd_barrier_complete(bar, b.x, nloc, nx); b.st[0] = nloc; b.st[1] = nx; }
        const unsigned old = xb_add(&bar[XB_XSUB(b.x)], 1u);
        const unsigned gen = old / nloc;
        if (old + 1u == (gen + 1u) * nloc) {
            __builtin_amdgcn_fence(__ATOMIC_RELEASE, "agent");
            asm volatile("s_waitcnt vmcnt(0)" ::: "memory");
            const unsigned og = xb_add(&bar[XB_TOP], 1u);
            const unsigned tg = og / nx;
            if (og + 1u == (tg + 1u) * nx) xb_add(&bar[XB_TOPGEN], 1u);
            else XB_SPIN(xb_ld(&bar[XB_TOPGEN]) == tg, bar);
            __builtin_amdgcn_fence(__ATOMIC_ACQUIRE, "agent");
            xb_add(&bar[XB_XGEN(b.x)], 1u);
            asm volatile("s_waitcnt vmcnt(0)" ::: "memory");
        } else {
            XB_SPIN(xb_ld(&bar[XB_XGEN(b.x)]) == gen, bar);
            __builtin_amdgcn_fence(__ATOMIC_ACQUIRE, "agent");
            asm volatile("s_waitcnt vmcnt(0)" ::: "memory");
        }
    }
    __syncthreads();
}

struct Args { const float* in[38]; float* out; unsigned char* ws; int ph_lo, ph_hi; };
typedef const float* cfp_t;
typedef __attribute__((address_space(4))) const unsigned char* kargp_t;
struct InTab { kargp_t kp;
    __device__ __forceinline__ const float* operator[](int i) const { return *(const __attribute__((address_space(4))) cfp_t*)(kp + 8 * i); } };
struct Frame {
    LAS unsigned char* lds; volatile LAS unsigned* MISC; unsigned* ctl;
    int tid, lane, wave, vcu, G;
    InTab in; float* out; unsigned char* ws;
};
#define LDS_WAIT() asm volatile("s_waitcnt lgkmcnt(0)" ::: "memory")
#define LAUNDER(p) asm volatile("" : "+s"(p))
#define LDS_BARRIER() do { asm volatile("s_waitcnt lgkmcnt(0)" ::: "memory"); __builtin_amdgcn_s_barrier(); asm volatile("" ::: "memory"); } while (0)
#define PHASE_VIEW() Frame F = F0; LAUNDER(F.ws); LAUNDER(F.in.kp); LAUNDER(F.ctl)
__device__ __forceinline__ float wave_sum(float v) {
#pragma unroll
    for (int o = 1; o < 64; o <<= 1) v += __shfl_xor(v, o);
    return v;
}
__device__ __forceinline__ float wave_max(float v) {
#pragma unroll
    for (int o = 1; o < 64; o <<= 1) v = fmaxf(v, __shfl_xor(v, o));
    return v;
}
__device__ __forceinline__ float row16_sum(float x) {
    x += __builtin_bit_cast(float, __builtin_amdgcn_update_dpp(0, __builtin_bit_cast(int, x), 0xB1, 0xf, 0xf, false));
    x += __builtin_bit_cast(float, __builtin_amdgcn_update_dpp(0, __builtin_bit_cast(int, x), 0x4E, 0xf, 0xf, false));
    x += __builtin_bit_cast(float, __builtin_amdgcn_update_dpp(0, __builtin_bit_cast(int, x), 0x141, 0xf, 0xf, false));
    x += __builtin_bit_cast(float, __builtin_amdgcn_update_dpp(0, __builtin_bit_cast(int, x), 0x140, 0xf, 0xf, false));
    return x;
}
__device__ __forceinline__ unsigned pk2(float lo, float hi) { return cvt_pk_bf16(lo, hi); }
__device__ __forceinline__ float bf2f(bf16 b) { return __uint_as_float(((unsigned)b) << 16); }
__device__ __forceinline__ float gelu_tanh(float y) { const float u = 0.7978845608028654f * (y + 0.044715f * y * y * y); const float e = __expf(2.f * u); const float th = 1.f - 2.f / (e + 1.f); return 0.5f * y * (1.f + th); }

__device__ __forceinline__ void transpose_item(const float* W, int N, bf16* WT, int ldk, int dst_row0, int k0, int n0, int kdst0, LAS float* scr, int lane) {
    float tv[32];
#pragma unroll
    for (int i = 0; i < 32; ++i) tv[i] = W[(size_t)(k0 + 2 * i + (lane >> 5)) * N + n0 + (lane & 31)];
#pragma unroll
    for (int i = 0; i < 32; ++i) scr[(2 * i + (lane >> 5)) * 33 + (lane & 31)] = tv[i];
    LDS_WAIT(); asm volatile("" ::: "memory");
    const int c = lane & 7;
#pragma unroll
    for (int j = 0; j < 4; ++j) { const int n = (lane >> 3) + 8 * j; const LAS float* s = scr + (8 * c) * 33 + n;
        u32x4 o; o.x = pk2(s[0 * 33], s[1 * 33]); o.y = pk2(s[2 * 33], s[3 * 33]); o.z = pk2(s[4 * 33], s[5 * 33]); o.w = pk2(s[6 * 33], s[7 * 33]);
        *(u32x4*)(WT + (size_t)(dst_row0 + n) * ldk + kdst0 + 8 * c) = o; }
    LDS_WAIT(); asm volatile("" ::: "memory");
}

constexpr int PROJ_PITCH = DIN * 2;
template <int PASS> struct S5Order {
    static constexpr bool GATHER = false; static constexpr int A2 = PASS == 2 ? 4 : 0;
    static constexpr int KB = PASS == 2 ? 384 : 256;
    const char* U; const char* SIN; const char* BT; int G, c;
    __device__ __forceinline__ size_t kstepA() const { return (size_t)4 * PROJ_PITCH; }
    __device__ __forceinline__ size_t hstepA() const { return (size_t)128 * 16 * PROJ_PITCH; }
    __device__ __forceinline__ size_t a2off() const { return (size_t)(SIN - U) - (size_t)A2 * kstepA(); }
    __device__ bool next(int i, pg8::Unit& u) const {
        const int L = i * G + c; if (L >= NG * 4) return false;
        const int g = L >> 2, pm = L & 3; u.e = g; u.pm = pm; u.pn = 0; u.cnt = 256;
        u.Ab = U + (size_t)g * 32 + (size_t)pm * 256 * 16 * PROJ_PITCH; u.Bb = BT + (size_t)g * 256 * KB * 2;
        return true;
    }
    template <int NV> __device__ __forceinline__ void a_voff(const pg8::Unit&, unsigned (&v)[NV][2], const int (&R)[2], const int (&C)[2]) const {
#pragma unroll
        for (int i = 0; i < 2; ++i) v[0][i] = (unsigned)(R[i] * 16 * PROJ_PITCH + (C[i] >> 4) * PROJ_PITCH + (C[i] & 15) * 2);
    }
};
__device__ __forceinline__ void s5_build(const Frame& F, int g) {
    const float* lam_re = F.in[10]; const float* lam_im = F.in[11]; const float* log_dt = F.in[12];
    const float* b_re = F.in[13]; const float* b_im = F.in[14]; const float* c_re = F.in[15]; const float* c_im = F.in[16]; const float* dsk = F.in[17];
    LAS float* pwr = (LAS float*)F.lds; LAS float* pwi = pwr + 17 * 64; LAS float* bbr = pwi + 17 * 64; LAS float* bbi = bbr + 1024; LAS float* cre = bbi + 1024; LAS float* cim = cre + 1024; LAS float* Kt = cim + 1024;
    bf16* MT = (bf16*)(F.ws + WS_S5MT) + (size_t)g * 256 * 384; bf16* WT = (bf16*)(F.ws + WS_S5WT) + (size_t)g * 256 * 256;
    const float dt = __expf(log_dt[g]);
    __syncthreads();
    for (int i = F.tid; i < 17 * 64; i += NTHR) { const int tau = i >> 6, p = i & 63; const float lr = fminf(lam_re[g * NP + p], -1e-4f), li = lam_im[g * NP + p];
        const float mag = __expf(lr * dt * (float)tau), ang = li * dt * (float)tau; pwr[i] = mag * cosf(ang); pwi[i] = mag * sinf(ang); }
    for (int i = F.tid; i < 1024; i += NTHR) { const int p = i >> 4; const float lr = fminf(lam_re[g * NP + p], -1e-4f), li = lam_im[g * NP + p];
        const float mag = __expf(lr * dt), ang = li * dt; const float ar = mag * cosf(ang), ai = mag * sinf(ang), den = lr * lr + li * li;
        const float qr = ((ar - 1.f) * lr + ai * li) / den, qi = (ai * lr - (ar - 1.f) * li) / den;
        const float br = b_re[(size_t)g * 1024 + i], bi = b_im[(size_t)g * 1024 + i]; bbr[i] = qr * br - qi * bi; bbi[i] = qr * bi + qi * br;
        cre[i] = c_re[(size_t)g * 1024 + i]; cim[i] = c_im[(size_t)g * 1024 + i]; }
    __syncthreads();
    for (int i = F.tid; i < 4096; i += NTHR) { const int tau = i >> 8, c = (i >> 4) & 15, c2 = i & 15; float acc = 0.f;
        for (int p = 0; p < 64; ++p) { const float cr = cre[c * 64 + p], ci = cim[c * 64 + p], pr = pwr[tau * 64 + p], pi = pwi[tau * 64 + p];
            const float car = cr * pr - ci * pi, cai = cr * pi + ci * pr; acc += car * bbr[p * 16 + c2] - cai * bbi[p * 16 + c2]; }
        Kt[i] = acc; }
    __syncthreads();
    for (int i = F.tid; i < 256 * 192; i += NTHR) { const int row = i / 192, col = (i % 192) * 2; const int t = row >> 4, c = row & 15; float v[2];
#pragma unroll
        for (int q = 0; q < 2; ++q) { const int cc = col + q;
            if (cc < 256) { const int j = cc >> 4, c2 = cc & 15; float x = (j <= t) ? Kt[(t - j) * 256 + c * 16 + c2] : 0.f; if (j == t && c2 == c) x += dsk[g * GC + c]; v[q] = x; }
            else { const int pp = cc - 256, p = pp & 63; const float pr = pwr[(t + 1) * 64 + p], pi = pwi[(t + 1) * 64 + p], cr = cre[c * 64 + p], ci = cim[c * 64 + p];
                v[q] = (pp < 64) ? (cr * pr - ci * pi) : -(cr * pi + ci * pr); } }
        *(unsigned*)(MT + (size_t)row * 384 + col) = pk2(v[0], v[1]); }
    for (int i = F.tid; i < 128 * 128; i += NTHR) { const int row = i >> 7, col = (i & 127) * 2; const int part = row >> 6, p = row & 63; float v[2];
#pragma unroll
        for (int q = 0; q < 2; ++q) { const int cc = col + q, j = cc >> 4, c2 = cc & 15; const float pr = pwr[(15 - j) * 64 + p], pi = pwi[(15 - j) * 64 + p], br = bbr[p * 16 + c2], bi = bbi[p * 16 + c2];
            v[q] = part == 0 ? (pr * br - pi * bi) : (pr * bi + pi * br); }
        *(unsigned*)(WT + (size_t)row * 256 + col) = pk2(v[0], v[1]); }
    __syncthreads();
}

__device__ __forceinline__ void p0_prologue(const Frame& F0) {
    PHASE_VIEW();
    const float* c = F.in[1]; const float* ada_w = F.in[2]; const float* ada_b = F.in[3];
    float* mod = (float*)(F.ws + WS_MOD);
    LAS float* sc = (LAS float*)F.lds;
    LAS float* red = (LAS float*)(F.lds + 65536);
    for (int i = F.tid; i < NB * DM; i += NTHR) { const float v = c[i]; sc[i] = v / (1.f + __expf(-v)); }
    __syncthreads();
    for (int item = F.vcu; item < NMOD / 64; item += F.G) {
        const int col = item * 64 + F.lane, ks = F.wave;
        float acc[8] = {0.f, 0.f, 0.f, 0.f, 0.f, 0.f, 0.f, 0.f};
        for (int k = ks * 256; k < ks * 256 + 256; k += 16) { float w[16];
#pragma unroll
            for (int u = 0; u < 16; ++u) w[u] = ada_w[(size_t)(k + u) * NMOD + col];
#pragma unroll
            for (int u = 0; u < 16; ++u)
#pragma unroll
                for (int b = 0; b < 8; ++b) acc[b] += sc[b * DM + k + u] * w[u]; }
#pragma unroll
        for (int b = 0; b < 8; ++b) red[(ks * 8 + b) * 64 + F.lane] = acc[b];
        __syncthreads();
        { const int b = F.wave; float s = 0.f;
#pragma unroll
          for (int k2 = 0; k2 < 8; ++k2) s += red[(k2 * 8 + b) * 64 + F.lane];
          mod[b * NMOD + col] = s + ada_b[col]; }
        __syncthreads();
    }
    __syncthreads();
    for (int g = F.G - 1 - F.vcu; g < NG; g += F.G) s5_build(F, g);
    LAS float* scr = (LAS float*)(F.lds + F.wave * 16384);
    const int gw = F.vcu * NWAVES + F.wave, NGW = F.G * NWAVES;
    bf16* WinT = (bf16*)(F.ws + WS_WIN_T); bf16* WoutT = (bf16*)(F.ws + WS_WOUT_T); bf16* GluT = (bf16*)(F.ws + WS_GLU_T); bf16* LoraT = (bf16*)(F.ws + WS_LORA_T);
    constexpr int I_IN = (DM / 64) * (DIN / 32), I_OUT = (DM / 64) * (DM / 32), I_GLU = (DSSM / 64) * (DSSM / 32), I_W = 32, I_A = 32, I_G = 64;
    constexpr int NITEMS = I_IN + I_OUT + I_GLU + I_W + I_A + I_G;
    for (int it = gw; it < NITEMS; it += NGW) {
        int r = it;
        if (r < I_IN) { const int nb = DIN / 32, kb = r / nb, n0 = (r % nb) * 32; transpose_item(F.in[8], DIN, WinT, DM, n0, kb * 64, n0, kb * 64, scr, F.lane); continue; } r -= I_IN;
        if (r < I_OUT) { const int nb = DM / 32, kb = r / nb, n0 = (r % nb) * 32; transpose_item(F.in[9], DM, WoutT, DM, n0, kb * 64, n0, kb * 64, scr, F.lane); continue; } r -= I_OUT;
        if (r < I_GLU) { const int nb = DSSM / 32, kb = r / nb, n0 = (r % nb) * 32; transpose_item(F.in[18], DSSM, GluT, DSSM, n0, kb * 64, n0, kb * 64, scr, F.lane); continue; } r -= I_GLU;
        if (r < I_W) { transpose_item(F.in[22], DRW, LoraT, 256, r * 32, 0, r * 32, 0, scr, F.lane); continue; } r -= I_W;
        if (r < I_A) { transpose_item(F.in[24], DRW, LoraT, 256, 1024 + r * 32, 0, r * 32, 64, scr, F.lane); continue; } r -= I_A;
        { const int kb = r / 32, n0 = (r % 32) * 32; transpose_item(F.in[25], DRW, LoraT, 256, 2048 + n0, kb * 64, n0, 128 + kb * 64, scr, F.lane); }
    }
    for (int p = blockIdx.x * NTHR + F.tid; p < 3072 * 32; p += F.G * NTHR) { const int row = p >> 5, c8 = (p & 31) * 8; const int kind = row >> 10;
        const bool data = kind == 0 ? (c8 < 64) : (kind == 1 ? (c8 >= 64 && c8 < 128) : (c8 >= 128));
        if (!data) *(u32x4*)(LoraT + (size_t)row * 256 + c8) = (u32x4){0u, 0u, 0u, 0u}; }
    bf16* rwt = (bf16*)(F.ws + WS_RWT);
    for (int p = blockIdx.x * NTHR + F.tid; p < 64 * 5 * 64 * 8; p += F.G * NTHR) { const int e = p & 7, ln = (p >> 3) & 63, jt = (p >> 9) % 5, ks = (p >> 9) / 5;
        const int j = 16 * jt + (ln & 15), k = 32 * ks + 8 * (ln >> 4) + e;
        const float w = j < 8 ? F.in[31][k * 8 + j] : (j < 72 ? F.in[33][k * 64 + (j - 8)] : 0.f);
        const unsigned hi = pk2(w, 0.f) & 0xffffu; const float wl = w - __uint_as_float(hi << 16);
        const size_t o = ((size_t)((ks * 5 + jt) * 2) * 64 + ln) * 8 + e;
        rwt[o] = (bf16)hi; rwt[o + 512] = (bf16)(pk2(wl, 0.f) & 0xffffu); }
}

__device__ __forceinline__ void p1_h1(const Frame& F0) {
    PHASE_VIEW();
    const float* x = F.in[0]; const float* g = F.in[4]; const float* mod = (const float*)(F.ws + WS_MOD); bf16* H = (bf16*)(F.ws + WS_H);
    const int gw = F.vcu * NWAVES + F.wave, NGW = F.G * NWAVES;
    for (int row = gw; row < NT; row += NGW) {
        const int b = row >> 11; const f32x4* xr = (const f32x4*)(x + (size_t)row * DM) + F.lane;
        f32x4 v[8]; float ss = 0.f;
#pragma unroll
        for (int j = 0; j < 8; ++j) { v[j] = xr[64 * j]; ss += (v[j].x * v[j].x + v[j].y * v[j].y) + (v[j].z * v[j].z + v[j].w * v[j].w); }
        const float rs = rsqrtf(wave_sum(ss) * (1.f / DM) + RMS_EPS);
        u32x2* o = (u32x2*)(H + (size_t)row * DM) + F.lane;
#pragma unroll
        for (int j = 0; j < 8; ++j) { const int col = 4 * (F.lane + 64 * j);
            const f32x4 gv = *(const f32x4*)(g + col), sh = *(const f32x4*)(mod + b * NMOD + col), scv = *(const f32x4*)(mod + b * NMOD + DM + col);
            const f32x4 h = v[j] * rs * gv * (scv + 1.0f) + sh;
            u32x2 w; w.x = pk2(h.x, h.y); w.y = pk2(h.z, h.w); o[64 * j] = w; }
    }
}

typedef short bf16x8_t __attribute__((ext_vector_type(8)));
#define MFMA16(a, b, c) __builtin_amdgcn_mfma_f32_16x16x32_bf16((a), (b), (c), 0, 0, 0)
__device__ __forceinline__ bf16x8_t lfrag(const LAS bf16* m, int pitch, int row, int k0) { return *(const LAS bf16x8_t*)(m + row * pitch + k0); }
__device__ __forceinline__ void st4(LAS bf16* p, const f32x4& v) { u32x2 w; w.x = pk2(v[0], v[1]); w.y = pk2(v[2], v[3]); *(LAS u32x2*)p = w; }
constexpr int CH_T = 32, CHP_K = 72, CHP_T = 40;
constexpr int CH_GRP_BYTES = 66560;
constexpr size_t GHQ_CHUNK = 12288;
__device__ __forceinline__ float wave_sum_dpp(float x) {
    x = row16_sum(x);
    x += __builtin_bit_cast(float, __builtin_amdgcn_update_dpp(0, __builtin_bit_cast(int, x), 0x142, 0xa, 0xf, false));
    x += __builtin_bit_cast(float, __builtin_amdgcn_update_dpp(0, __builtin_bit_cast(int, x), 0x143, 0xc, 0xf, false));
    return __builtin_bit_cast(float, __builtin_amdgcn_readlane(__builtin_bit_cast(int, x), 63));
}
__device__ __forceinline__ void wave_sum8_dpp(float (&x)[8]) {
#define WS8_STAGE(ctrl, rmask) _Pragma("unroll") for (int i_ = 0; i_ < 8; ++i_) x[i_] += __builtin_bit_cast(float, __builtin_amdgcn_update_dpp(0, __builtin_bit_cast(int, x[i_]), ctrl, rmask, 0xf, false));
    WS8_STAGE(0xB1, 0xf) WS8_STAGE(0x4E, 0xf) WS8_STAGE(0x141, 0xf) WS8_STAGE(0x140, 0xf) WS8_STAGE(0x142, 0xa) WS8_STAGE(0x143, 0xc)
#undef WS8_STAGE
#pragma unroll
    for (int i = 0; i < 8; ++i) x[i] = __builtin_bit_cast(float, __builtin_amdgcn_readlane(__builtin_bit_cast(int, x[i]), 63));
}
__device__ __forceinline__ float tanh_fast(float x) { const float e = __builtin_amdgcn_exp2f(2.8853900817779268f * x); return 1.f - 2.f * __builtin_amdgcn_rcpf(e + 1.f); }
__device__ __forceinline__ void p9a_rwkv_chunks(const Frame& F0) {
    PHASE_VIEW();
    const GAS bf16* PROJ = (const GAS bf16*)(F.ws + WS_PROJ); const GAS bf16* LoraT = (const GAS bf16*)(F.ws + WS_LORA_T);
    GAS bf16* VB = (GAS bf16*)(F.ws + WS_VB); GAS bf16* GB = (GAS bf16*)(F.ws + WS_GB); GAS float* BON = (GAS float*)(F.ws + WS_BON);
    const float* mu = F.in[20]; const float* w0 = F.in[21]; const float* a0 = F.in[23]; const float* k_k = F.in[26]; const float* k_a = F.in[27]; const float* r_k = F.in[28];
    GAS bf16* GHQ = (GAS bf16*)(F.ws + WS_GHQ); GAS float* GT = (GAS float*)(F.ws + WS_GT);
    const int grp = F.tid >> 8, gt = F.tid & 255, gw = (F.tid >> 6) & 3, lo = F.lane & 15, hi = F.lane >> 4;
    LAS unsigned char* gb = F.lds + grp * CH_GRP_BYTES;
    LAS bf16* At = (LAS bf16*)gb; LAS bf16* Bt = At + 32 * CHP_K; LAS bf16* Kt = Bt + 32 * CHP_K; LAS bf16* Rt = Kt + 32 * CHP_K;
    LAS bf16* X1T = At; LAS bf16* P1T = X1T + 64 * CHP_T; LAS bf16* Minv = P1T + 64 * CHP_T; LAS bf16* XG = At;
    LAS bf16* AtT = Rt + 32 * CHP_K; LAS bf16* BhT = AtT + 64 * CHP_T; LAS bf16* KhT = BhT + 64 * CHP_T; LAS bf16* VmT = KhT + 64 * CHP_T;
    LAS float* AabF = (LAS float*)(VmT + 64 * CHP_T);
    LAS bf16* Aak = (LAS bf16*)(AabF + 32 * 36); LAS bf16* Arb = Aak + 32 * CHP_T; LAS bf16* Ark = Arb + 32 * CHP_T; LAS bf16* P2T = Ark + 32 * CHP_T;
    LAS float* LWs = AabF; LAS float* AAs = LWs + 32 * 68;
    LAS float* part = (LAS float*)(P2T + 64 * CHP_T);
    LAS bf16* XW = (LAS bf16*)(part + 256); LAS bf16* XA = XW + 32 * CHP_K;
    const f32x4 z4 = (f32x4){0.f, 0.f, 0.f, 0.f};
    for (int it0 = F.vcu * 2; it0 < NB * (SEQ / CH_T); it0 += F.G * 2) {
        const int item = it0 + grp; const int c = item & 63, b = item >> 6;
        const size_t tok0 = (size_t)b * SEQ + c * CH_T;
        LDS_BARRIER();
#pragma unroll 4
        for (int i = 0; i < 16; ++i) { const int pidx = gt + 256 * i, t = pidx >> 7, cp = (pidx & 127) * 2;
            const unsigned zw = *(const GAS unsigned*)(PROJ + (tok0 + t) * DIN + 4096 + cp);
            const unsigned pw = (c == 0 && t == 0) ? 0u : *(const GAS unsigned*)(PROJ + (tok0 + t - 1) * DIN + 4096 + cp);
            const f32x2 m = *(const f32x2*)(mu + 3072 + cp);
            const float z0 = bf_lo(zw), z1 = bf_hi(zw); const float v0 = z0 + m.x * (bf_lo(pw) - z0), v1 = z1 + m.y * (bf_hi(pw) - z1);
            if (cp < 64) *(LAS unsigned*)(XW + t * CHP_K + cp) = pk2(tanh_fast(v0), tanh_fast(v1));
            else if (cp < 128) *(LAS unsigned*)(XA + t * CHP_K + cp - 64) = pk2(v0, v1);
            else *(LAS unsigned*)(XG + t * 136 + cp - 128) = pk2(sigmoidf_(v0), sigmoidf_(v1)); }
        LDS_BARRIER();
        { bf16x8_t xg[2][4];
#pragma unroll
          for (int mt = 0; mt < 2; ++mt)
#pragma unroll
              for (int ks = 0; ks < 4; ++ks) xg[mt][ks] = lfrag(XG, 136, 16 * mt + lo, 32 * ks + 8 * hi);
#pragma unroll 1
          for (int hh = 0; hh < NH; ++hh) { const int n0 = hh * 64 + 16 * gw; f32x4 dg[2] = {z4, z4};
#pragma unroll
              for (int ks = 0; ks < 4; ++ks) { const bf16x8_t yg = *(const GAS bf16x8_t*)(LoraT + (size_t)(2048 + n0 + lo) * 256 + 128 + 32 * ks + 8 * hi);
                  dg[0] = MFMA16(yg, xg[0][ks], dg[0]); dg[1] = MFMA16(yg, xg[1][ks], dg[1]); }
#pragma unroll
              for (int mt = 0; mt < 2; ++mt) { u32x2 w; w.x = pk2(dg[mt][0], dg[mt][1]); w.y = pk2(dg[mt][2], dg[mt][3]); *(GAS u32x2*)(GB + (tok0 + 16 * mt + lo) * 1024 + n0 + 4 * hi) = w; } }
        }
        const int k = gt & 63, tq = gw; const bool first = (c == 0 && tq == 0);
        const GAS bf16* pp = PROJ + (tok0 + tq * 8) * DIN + 1024 + k;
        bf16 nr[9], nk[9], nv[9];
#pragma unroll
        for (int i = 0; i < 9; ++i) { const GAS bf16* q = pp + (ptrdiff_t)(i - 1) * DIN; const bool z = first && i == 0;
            nr[i] = z ? (bf16)0 : q[0]; nk[i] = z ? (bf16)0 : q[1024]; nv[i] = z ? (bf16)0 : q[2048]; }
#pragma unroll 1
        for (int h = 0; h < NH; ++h) {
            const int ci = (b * NH + h) * 64 + c; const int ch = h * 64 + k;
            LDS_BARRIER();
            { const int n0 = h * 64 + 16 * gw; f32x4 dw[2] = {z4, z4}, da[2] = {z4, z4};
#pragma unroll
              for (int ks = 0; ks < 2; ++ks) { const bf16x8_t yw = *(const GAS bf16x8_t*)(LoraT + (size_t)(n0 + lo) * 256 + 32 * ks + 8 * hi), ya = *(const GAS bf16x8_t*)(LoraT + (size_t)(1024 + n0 + lo) * 256 + 64 + 32 * ks + 8 * hi);
#pragma unroll
                  for (int mt = 0; mt < 2; ++mt) { dw[mt] = MFMA16(yw, lfrag(XW, CHP_K, 16 * mt + lo, 32 * ks + 8 * hi), dw[mt]); da[mt] = MFMA16(ya, lfrag(XA, CHP_K, 16 * mt + lo, 32 * ks + 8 * hi), da[mt]); } }
              const f32x4 w0v = *(const f32x4*)(w0 + n0 + 4 * hi), a0v = *(const f32x4*)(a0 + n0 + 4 * hi);
#pragma unroll
              for (int mt = 0; mt < 2; ++mt) { const int t = 16 * mt + lo; f32x4 lwv, aav;
#pragma unroll
                  for (int r = 0; r < 4; ++r) { lwv[r] = (-0.6065306597126334f * 1.4426950408889634f) * sigmoidf_(dw[mt][r] + w0v[r]);     aav[r] = sigmoidf_(da[mt][r] + a0v[r]); }
                  *(LAS f32x4*)(LWs + t * 68 + 16 * gw + 4 * hi) = lwv; *(LAS f32x4*)(AAs + t * 68 + 16 * gw + 4 * hi) = aav; }
            }
            LDS_BARRIER();
            { const float mur = mu[ch], muk = mu[1024 + ch], muv = mu[2048 + ch], kkc = k_k[ch], kac = k_a[ch], rkc = r_k[ch];
              float lw[8], ls[8], rv[8], kv[8], vv[8], av[8], bv[8]; float run = 0.f;
              float kraw[8], x8[8];
#pragma unroll
              for (int i = 0; i < 8; ++i) { const int t = tq * 8 + i;
                  const float zr = bf2f(nr[i + 1]), zk = bf2f(nk[i + 1]), zv = bf2f(nv[i + 1]), pr = bf2f(nr[i]), pk_ = bf2f(nk[i]), pv = bf2f(nv[i]);
                  rv[i] = zr + mur * (pr - zr); kraw[i] = zk + muk * (pk_ - zk); vv[i] = zv + muv * (pv - zv);
                  av[i] = AAs[t * 68 + k]; lw[i] = LWs[t * 68 + k];
                  const float kk = kraw[i] * kkc; x8[i] = kk * kk; }
              wave_sum8_dpp(x8);
#pragma unroll
              for (int i = 0; i < 8; ++i) { const float a = av[i]; const float kk = kraw[i] * kkc * __builtin_amdgcn_rsqf(fmaxf(x8[i], 1e-24f));
                  const float km = kraw[i] * (1.f + (a - 1.f) * kac);
                  x8[i] = rv[i] * km * rkc; kv[i] = km; av[i] = -kk; bv[i] = kk * a; run += lw[i]; ls[i] = run; }
              wave_sum8_dpp(x8);
              { float bsel = x8[0];
#pragma unroll
                for (int i = 1; i < 8; ++i) bsel = (F.lane == i) ? x8[i] : bsel;
                if (F.lane < 8) BON[(tok0 + tq * 8 + F.lane) * 16 + h] = bsel; }
              if (h + 1 < NH) {
#pragma unroll
                  for (int i = 0; i < 9; ++i) { const GAS bf16* q = pp + (ptrdiff_t)(i - 1) * DIN + (h + 1) * 64; const bool z = first && i == 0;
                      nr[i] = z ? (bf16)0 : q[0]; nk[i] = z ? (bf16)0 : q[1024]; nv[i] = z ? (bf16)0 : q[2048]; } }
              { u32x4 w; w.x = pk2(vv[0], vv[1]); w.y = pk2(vv[2], vv[3]); w.z = pk2(vv[4], vv[5]); w.w = pk2(vv[6], vv[7]);
                GAS bf16* vb = VB + (tok0 + tq * 8) * 1024 + ch;
                vb[0] = (bf16)(w.x & 0xffffu); vb[1024] = (bf16)(w.x >> 16); vb[2048] = (bf16)(w.y & 0xffffu); vb[3072] = (bf16)(w.y >> 16);
                vb[4096] = (bf16)(w.z & 0xffffu); vb[5120] = (bf16)(w.z >> 16); vb[6144] = (bf16)(w.w & 0xffffu); vb[7168] = (bf16)(w.w >> 16); }
              part[tq * 64 + k] = run;
              LDS_BARRIER();
              float off = 0.f, tot = 0.f;
#pragma unroll
              for (int q = 0; q < 4; ++q) { const float pq = part[q * 64 + k]; tot += pq; if (q < tq) off += pq; }
              if (tq == 0) GT[(size_t)ci * 64 + k] = __builtin_amdgcn_exp2f(tot);
              float aT[8], bT[8], kT[8];
#pragma unroll
              for (int i = 0; i < 8; ++i) { const int t = tq * 8 + i; const float lg = off + ls[i], lgm = lg - lw[i];
                  const float eneg = __builtin_amdgcn_exp2f(-lg), eh = __builtin_amdgcn_exp2f(tot - lg);
                  const float at = av[i] * __builtin_amdgcn_exp2f(lgm);
                  const unsigned wa = pk2(at, bv[i] * eneg), wk = pk2(kv[i] * eneg, rv[i] * __builtin_amdgcn_exp2f(lg));
                  At[t * CHP_K + k] = (bf16)(wa & 0xffffu); Bt[t * CHP_K + k] = (bf16)(wa >> 16); Kt[t * CHP_K + k] = (bf16)(wk & 0xffffu); Rt[t * CHP_K + k] = (bf16)(wk >> 16);
                  aT[i] = at; bT[i] = bv[i] * eh; kT[i] = kv[i] * eh; }
              u32x4 w;
              w.x = pk2(aT[0], aT[1]); w.y = pk2(aT[2], aT[3]); w.z = pk2(aT[4], aT[5]); w.w = pk2(aT[6], aT[7]); *(LAS u32x4*)(AtT + k * CHP_T + tq * 8) = w;
              w.x = pk2(bT[0], bT[1]); w.y = pk2(bT[2], bT[3]); w.z = pk2(bT[4], bT[5]); w.w = pk2(bT[6], bT[7]); *(LAS u32x4*)(BhT + k * CHP_T + tq * 8) = w;
              w.x = pk2(kT[0], kT[1]); w.y = pk2(kT[2], kT[3]); w.z = pk2(kT[4], kT[5]); w.w = pk2(kT[6], kT[7]); *(LAS u32x4*)(KhT + k * CHP_T + tq * 8) = w;
              w.x = pk2(vv[0], vv[1]); w.y = pk2(vv[2], vv[3]); w.z = pk2(vv[4], vv[5]); w.w = pk2(vv[6], vv[7]); *(LAS u32x4*)(VmT + k * CHP_T + tq * 8) = w;
            }
            LDS_BARRIER();
            f32x4 aab[2][2];
            const int mi = gw ^ grp;
            { const LAS bf16* X = (mi < 2) ? At : Rt; const LAS bf16* Y = (mi & 1) ? Kt : Bt;
              f32x4 acc[2][2] = {{z4, z4}, {z4, z4}};
#pragma unroll
              for (int ks = 0; ks < 2; ++ks) { bf16x8_t xf[2], yf[2];
#pragma unroll
                  for (int m = 0; m < 2; ++m) { xf[m] = lfrag(X, CHP_K, 16 * m + lo, 32 * ks + 8 * hi); yf[m] = lfrag(Y, CHP_K, 16 * m + lo, 32 * ks + 8 * hi); }
#pragma unroll
                  for (int m = 0; m < 2; ++m)
#pragma unroll
                      for (int n = 0; n < 2; ++n) acc[m][n] = MFMA16(yf[n], xf[m], acc[m][n]); }
              LAS bf16* dstb = (mi == 1) ? Aak : ((mi == 2) ? Arb : Ark);
#pragma unroll
              for (int m = 0; m < 2; ++m)
#pragma unroll
                  for (int n = 0; n < 2; ++n) { const int t = 16 * m + lo, j0 = 16 * n + 4 * hi; f32x4 v = acc[m][n];
#pragma unroll
                      for (int r = 0; r < 4; ++r) { const int j = j0 + r; const bool keep = (mi < 2) ? (j < t) : (j <= t); v[r] = keep ? v[r] : 0.f; }
                      aab[m][n] = v; if (mi != 0) st4(dstb + t * CHP_T + j0, v); }
            }
            LDS_BARRIER();
            const int inv_w = grp;
            if (mi == 0) {
                int cc = F.lane & 31; asm volatile("" : "+v"(cc));
                float mcol[32];
#pragma unroll
                for (int t = 0; t < 32; ++t) { float acc = (t == cc) ? 1.f : 0.f;
#pragma unroll
                    for (int j = 0; j < t; ++j) { float tmp;
                        asm volatile("v_readlane_b32 %1, %2, %3\n\tv_fmac_f32 %0, %1, %4" : "+v"(acc), "=&s"(tmp) : "v"(aab[t >> 4][j >> 4][j & 3]), "i"((t & 15) + 16 * ((j & 15) >> 2)), "v"(mcol[j])); }
                    mcol[t] = acc; }
                if (F.lane < 32) {
#pragma unroll
                    for (int t = 0; t < 32; ++t) Minv[t * CHP_T + cc] = (bf16)(pk2(mcol[t], 0.f) & 0xffffu); }
            } else {
                const int wk = gw - (gw > inv_w ? 1 : 0);
                for (int tile = wk * 3; tile < ((wk == 2) ? 8 : wk * 3 + 3); ++tile) { const int mt = tile >> 2, nt = tile & 3;
                    const bf16x8_t xf = lfrag(Aak, CHP_T, 16 * mt + lo, 8 * hi), yf = lfrag(VmT, CHP_T, 16 * nt + lo, 8 * hi);
                    const f32x4 d = MFMA16(xf, yf, z4);
                    st4(X1T + (16 * nt + lo) * CHP_T + 16 * mt + 4 * hi, d); }
            }
            LDS_BARRIER();
            { const bf16x8_t ya = lfrag(AtT, CHP_T, 16 * gw + lo, 8 * hi), yx = lfrag(X1T, CHP_T, 16 * gw + lo, 8 * hi);
              f32x4 d1[2], d2[2];
#pragma unroll
              for (int mt = 0; mt < 2; ++mt) { const bf16x8_t xf = lfrag(Minv, CHP_T, 16 * mt + lo, 8 * hi);
                  d1[mt] = MFMA16(xf, ya, z4); d2[mt] = MFMA16(xf, yx, z4); }
#pragma unroll
              for (int mt = 0; mt < 2; ++mt) { st4(P1T + (16 * gw + lo) * CHP_T + 16 * mt + 4 * hi, d1[mt]); st4(P2T + (16 * gw + lo) * CHP_T + 16 * mt + 4 * hi, d2[mt]); }
            }
            LDS_BARRIER();
            { GAS bf16* outp = GHQ + (size_t)ci * GHQ_CHUNK;
              const bf16x8_t p1 = lfrag(P1T, CHP_T, 16 * gw + lo, 8 * hi), p2 = lfrag(P2T, CHP_T, 16 * gw + lo, 8 * hi), vm = lfrag(VmT, CHP_T, 16 * gw + lo, 8 * hi);
#pragma unroll
              for (int mt = 0; mt < 2; ++mt) { const bf16x8_t arb = lfrag(Arb, CHP_T, 16 * mt + lo, 8 * hi), ark = lfrag(Ark, CHP_T, 16 * mt + lo, 8 * hi);
                  f32x4 q1 = MFMA16(p1, arb, z4);
                  { const int t = 16 * mt + lo, k0 = 16 * gw + 4 * hi; const u32x2 rw = *(const LAS u32x2*)(Rt + t * CHP_K + k0);
                    q1[0] += bf_lo(rw.x); q1[1] += bf_hi(rw.x); q1[2] += bf_lo(rw.y); q1[3] += bf_hi(rw.y);
                    u32x2 w; w.x = pk2(q1[0], q1[1]); w.y = pk2(q1[2], q1[3]); *(GAS u32x2*)(outp + 8192 + t * 64 + k0) = w; }
                  f32x4 q2 = MFMA16(arb, p2, z4); q2 = MFMA16(ark, vm, q2);
                  { u32x2 w; w.x = pk2(q2[0], q2[1]); w.y = pk2(q2[2], q2[3]); *(GAS u32x2*)(outp + 10240 + (16 * gw + lo) * 32 + 16 * mt + 4 * hi) = w; } }
#pragma unroll
              for (int mt = 0; mt < 4; ++mt) { const bf16x8_t bh = lfrag(BhT, CHP_T, 16 * mt + lo, 8 * hi), kh = lfrag(KhT, CHP_T, 16 * mt + lo, 8 * hi);
                  const f32x4 g = MFMA16(p1, bh, z4);
                  { u32x2 w; w.x = pk2(g[0], g[1]); w.y = pk2(g[2], g[3]); *(GAS u32x2*)(outp + (16 * mt + lo) * 64 + 16 * gw + 4 * hi) = w; }
                  f32x4 hh = MFMA16(bh, p2, z4); hh = MFMA16(kh, vm, hh);
                  { u32x2 w; w.x = pk2(hh[0], hh[1]); w.y = pk2(hh[2], hh[3]); *(GAS u32x2*)(outp + 4096 + (16 * gw + lo) * 64 + 16 * mt + 4 * hi) = w; } }
            }
        }
    }
    __syncthreads();
}
__device__ __forceinline__ void p9b_rwkv_seq(const Frame& F0) {
    PHASE_VIEW();
    const GAS bf16* GHQ = (const GAS bf16*)(F.ws + WS_GHQ); const GAS float* GT = (const GAS float*)(F.ws + WS_GT); GAS bf16* Yy = (GAS bf16*)(F.ws + WS_Y);
    LAS bf16* Sb = (LAS bf16*)F.lds;
    const int lo = F.lane & 15, hi = F.lane >> 4, kt = F.wave >> 1, vt = F.wave & 1, mt = F.wave >> 1;
    const f32x4 z4 = (f32x4){0.f, 0.f, 0.f, 0.f};
    for (int item = F.vcu; item < NB * NH * 2; item += F.G) {
        const int b = item >> 5, h = (item >> 1) & 15, vh = item & 1;
        __syncthreads();
        for (int i = F.tid; i < 2 * 32 * CHP_K / 2; i += NTHR) ((LAS unsigned*)Sb)[i] = 0u;
        __syncthreads();
        f32x4 Sf = z4;
        const size_t cbase = (size_t)(b * NH + h) * 64;
        const int vrow = vh * 32 + 16 * vt + lo;
#define SEQ_LOAD(G_, Q_, H_, Q2_, GT_, cc_) do { const int cn_ = (cc_) < 64 ? (cc_) : 63; const GAS bf16* cp_ = GHQ + (cbase + cn_) * GHQ_CHUNK; \
            G_[0] = *(const GAS bf16x8_t*)(cp_ + (16 * kt + lo) * 64 + 8 * hi); G_[1] = *(const GAS bf16x8_t*)(cp_ + (16 * kt + lo) * 64 + 32 + 8 * hi); \
            H_ = *(const GAS u32x2*)(cp_ + 4096 + vrow * 64 + 16 * kt + 4 * hi); GT_ = *(const GAS f32x4*)(GT + (cbase + cn_) * 64 + 16 * kt + 4 * hi); \
            Q_[0] = *(const GAS bf16x8_t*)(cp_ + 8192 + (16 * (mt & 1) + lo) * 64 + 8 * hi); Q_[1] = *(const GAS bf16x8_t*)(cp_ + 8192 + (16 * (mt & 1) + lo) * 64 + 32 + 8 * hi); \
            Q2_ = *(const GAS u32x2*)(cp_ + 10240 + vrow * 32 + 16 * (mt & 1) + 4 * hi); } while (0)
#define SEQ_STEP(G_, Q_, H_, Q2_, GT_, cc_) do { \
            const LAS bf16* Sc = Sb + ((cc_) & 1) * 32 * CHP_K; LAS bf16* Sn = Sb + (((cc_) + 1) & 1) * 32 * CHP_K; \
            const bf16x8_t s0 = lfrag(Sc, CHP_K, 16 * vt + lo, 8 * hi), s1 = lfrag(Sc, CHP_K, 16 * vt + lo, 32 + 8 * hi); \
            if (F.wave < 4) { f32x4 y = (f32x4){bf_lo(Q2_.x), bf_hi(Q2_.x), bf_lo(Q2_.y), bf_hi(Q2_.y)}; \
                y = MFMA16(Q_[0], s0, y); y = MFMA16(Q_[1], s1, y); \
                GAS bf16* yp = Yy + (size_t)(b * SEQ + (cc_) * CH_T + 16 * mt + 4 * hi) * 1024 + h * 64 + vrow; const unsigned w01 = pk2(y[0], y[1]), w23 = pk2(y[2], y[3]); \
                yp[0] = (bf16)(w01 & 0xffffu); yp[1024] = (bf16)(w01 >> 16); yp[2048] = (bf16)(w23 & 0xffffu); yp[3072] = (bf16)(w23 >> 16); } \
            f32x4 acc = (f32x4){bf_lo(H_.x), bf_hi(H_.x), bf_lo(H_.y), bf_hi(H_.y)} + GT_ * Sf; \
            acc = MFMA16(G_[0], s0, acc); acc = MFMA16(G_[1], s1, acc); \
            Sf = acc; st4(Sn + (16 * vt + lo) * CHP_K + 16 * kt + 4 * hi, acc); \
            SEQ_LOAD(G_, Q_, H_, Q2_, GT_, (cc_) + 4); \
            asm volatile("s_waitcnt lgkmcnt(0)" ::: "memory"); __builtin_amdgcn_s_barrier(); asm volatile("" ::: "memory"); } while (0)
        bf16x8_t gA[2], qA[2], gB[2], qB[2], gC[2], qC[2], gD[2], qD[2]; u32x2 hA, q2A, hB, q2B, hC, q2C, hD, q2D; f32x4 gtA, gtB, gtC, gtD;
        SEQ_LOAD(gA, qA, hA, q2A, gtA, 0); SEQ_LOAD(gB, qB, hB, q2B, gtB, 1); SEQ_LOAD(gC, qC, hC, q2C, gtC, 2); SEQ_LOAD(gD, qD, hD, q2D, gtD, 3);
#pragma unroll
        for (int c = 0; c < 64; c += 4) {
            SEQ_STEP(gA, qA, hA, q2A, gtA, c); SEQ_STEP(gB, qB, hB, q2B, gtB, c + 1); SEQ_STEP(gC, qC, hC, q2C, gtC, c + 2); SEQ_STEP(gD, qD, hD, q2D, gtD, c + 3);
        }
#undef SEQ_LOAD
#undef SEQ_STEP
    }
}

__device__ __forceinline__ void p9_rwkv_post(const Frame& F0) {
    PHASE_VIEW();
    const bf16* VB = (const bf16*)(F.ws + WS_VB); const bf16* GB = (const bf16*)(F.ws + WS_GB); const float* BON = (const float*)(F.ws + WS_BON);
    const bf16* Yy = (const bf16*)(F.ws + WS_Y);
    const float* ln_w = F.in[29]; const float* ln_b = F.in[30]; bf16* MIX = (bf16*)(F.ws + WS_MIX);
    const int gw = F.vcu * NWAVES + F.wave, NGW = F.G * NWAVES;
    for (int it = gw; it < NT * 4; it += NGW) {
        const int row = it >> 2, c = (it & 3) * 256 + F.lane * 4, h = c >> 6; const size_t idx = (size_t)row * 1024 + c;
        const u32x2 yw = *(const u32x2*)(Yy + idx); const f32x4 y = (f32x4){bf_lo(yw.x), bf_hi(yw.x), bf_lo(yw.y), bf_hi(yw.y)}; const u32x2 vw = *(const u32x2*)(VB + idx), gwv = *(const u32x2*)(GB + idx);
        const f32x4 lw = *(const f32x4*)(ln_w + c), lb = *(const f32x4*)(ln_b + c); const float bon = BON[row * 16 + h];
        const float mean = row16_sum((y.x + y.y) + (y.z + y.w)) * (1.f / 64.f); const f32x4 d = y - mean;
        const float var = row16_sum((d.x * d.x + d.y * d.y) + (d.z * d.z + d.w * d.w)) * (1.f / 64.f); const float rstd = rsqrtf(var + GN_EPS);
        const f32x4 vv = (f32x4){bf_lo(vw.x), bf_hi(vw.x), bf_lo(vw.y), bf_hi(vw.y)}, gg = (f32x4){bf_lo(gwv.x), bf_hi(gwv.x), bf_lo(gwv.y), bf_hi(gwv.y)};
        const f32x4 o = (d * rstd * lw + lb + vv * bon) * gg;
        u32x2 w; w.x = pk2(o.x, o.y); w.y = pk2(o.z, o.w); *(u32x2*)(MIX + (size_t)row * DM + DSSM + c) = w;
    }
}

__device__ __forceinline__ void p11_x1_router(const Frame& F0) {
    PHASE_VIEW();
    const float* x = F.in[0]; const float* gpost = F.in[5]; const float* gpre2 = F.in[6]; const float* mod = (const float*)(F.ws + WS_MOD);
    const bf16* MIXED = (const bf16*)(F.ws + WS_MIXED); bf16* X1 = (bf16*)(F.ws + WS_X1); bf16* H = (bf16*)(F.ws + WS_H);
    const bf16x8_t* rwt = (const bf16x8_t*)(F.ws + WS_RWT); const float* b_grp = F.in[32]; const float* b_exp = F.in[34];
    unsigned* tokinfo = (unsigned*)(F.ws + WS_TOKINFO); int* list = (int*)(F.ws + WS_LIST);
    LAS float* slab = (LAS float*)(F.lds + F.wave * 16384) + F.lane * 8;
    LAS float* Lp = (LAS float*)F.lds;
    LAS float* red1 = (LAS float*)(F.lds + 131072); LAS float* red2 = red1 + 128; LAS float* Lf = red2 + 128;
    const int lo = F.lane & 15, hi = F.lane >> 4, k0 = 256 * F.wave + 8 * hi;
    const f32x4 z4 = (f32x4){0.f, 0.f, 0.f, 0.f};
    for (int tile = F.vcu; tile < NT / 16; tile += F.G) {
        const int row = tile * 16 + lo, b = tile >> 7;
        const size_t ro = (size_t)row * DM + k0;
        f32x4 xr[8][2];
#pragma unroll
        for (int s_ = 0; s_ < 8; ++s_) { xr[s_][0] = *(const f32x4*)(x + ro + 32 * s_); xr[s_][1] = *(const f32x4*)(x + ro + 32 * s_ + 4); }
        float ss = 0.f;
#pragma unroll
        for (int s_ = 0; s_ < 8; ++s_) { const u32x4 mw = *(const u32x4*)(MIXED + ro + 32 * s_); const f32x4 a0 = (f32x4){bf_lo(mw.x), bf_hi(mw.x), bf_lo(mw.y), bf_hi(mw.y)}, a1 = (f32x4){bf_lo(mw.z), bf_hi(mw.z), bf_lo(mw.w), bf_hi(mw.w)};
            *(LAS f32x4*)(slab + s_ * 512) = a0; *(LAS f32x4*)(slab + s_ * 512 + 4) = a1;
            ss += (a0.x * a0.x + a0.y * a0.y) + (a0.z * a0.z + a0.w * a0.w) + (a1.x * a1.x + a1.y * a1.y) + (a1.z * a1.z + a1.w * a1.w); }
        ss += __shfl_xor(ss, 16); ss += __shfl_xor(ss, 32);
        if (hi == 0) red1[F.wave * 16 + lo] = ss;
        LDS_BARRIER();
        float tot = 0.f;
#pragma unroll
        for (int w = 0; w < 8; ++w) tot += red1[w * 16 + lo];
        const float rs = rsqrtf(tot * (1.f / DM) + RMS_EPS);
        float ss2 = 0.f;
        const float* modb = mod + b * NMOD + k0;
#pragma unroll
        for (int s_ = 0; s_ < 8; ++s_) { f32x4 xo[2];
#pragma unroll
            for (int q = 0; q < 2; ++q) { const f32x4 xv = xr[s_][q], gv = *(const f32x4*)(gpost + k0 + 32 * s_ + 4 * q), gt = *(const f32x4*)(modb + 2 * DM + 32 * s_ + 4 * q);
                const f32x4 mm = *(const LAS f32x4*)(slab + s_ * 512 + 4 * q);
                const f32x4 v = xv + gt * (mm * rs * gv); *(LAS f32x4*)(slab + s_ * 512 + 4 * q) = v; xo[q] = v;
                ss2 += (v.x * v.x + v.y * v.y) + (v.z * v.z + v.w * v.w); }
            u32x4 xw; xw.x = pk2(xo[0].x, xo[0].y); xw.y = pk2(xo[0].z, xo[0].w); xw.z = pk2(xo[1].x, xo[1].y); xw.w = pk2(xo[1].z, xo[1].w); *(u32x4*)(X1 + ro + 32 * s_) = xw; }
        ss2 += __shfl_xor(ss2, 16); ss2 += __shfl_xor(ss2, 32);
        if (hi == 0) red2[F.wave * 16 + lo] = ss2;
        LDS_BARRIER();
        float tot2 = 0.f;
#pragma unroll
        for (int w = 0; w < 8; ++w) tot2 += red2[w * 16 + lo];
        const float rs2 = rsqrtf(tot2 * (1.f / DM) + RMS_EPS);
        f32x4 acc[5] = {z4, z4, z4, z4, z4};
        const bf16x8_t* wp = rwt + (size_t)(F.wave * 8) * 640 + F.lane;
#pragma unroll 1
        for (int s_ = 0; s_ < 8; ++s_) { f32x4 hv[2];
#pragma unroll
            for (int q = 0; q < 2; ++q) { const f32x4 gv = *(const f32x4*)(gpre2 + k0 + 32 * s_ + 4 * q), sh = *(const f32x4*)(modb + 3 * DM + 32 * s_ + 4 * q), scv = *(const f32x4*)(modb + 4 * DM + 32 * s_ + 4 * q);
                const f32x4 mm = *(const LAS f32x4*)(slab + s_ * 512 + 4 * q);
                hv[q] = mm * rs2 * gv * (scv + 1.0f) + sh; }
            u32x4 hh, hl;
            hh.x = pk2(hv[0].x, hv[0].y); hh.y = pk2(hv[0].z, hv[0].w); hh.z = pk2(hv[1].x, hv[1].y); hh.w = pk2(hv[1].z, hv[1].w);
            *(u32x4*)(H + ro + 32 * s_) = hh;
            hl.x = pk2(hv[0].x - bf_lo(hh.x), hv[0].y - bf_hi(hh.x)); hl.y = pk2(hv[0].z - bf_lo(hh.y), hv[0].w - bf_hi(hh.y));
            hl.z = pk2(hv[1].x - bf_lo(hh.z), hv[1].y - bf_hi(hh.z)); hl.w = pk2(hv[1].z - bf_lo(hh.w), hv[1].w - bf_hi(hh.w));
            const bf16x8_t fh = __builtin_bit_cast(bf16x8_t, hh), fl = __builtin_bit_cast(bf16x8_t, hl);
#pragma unroll
            for (int jt = 0; jt < 5; ++jt) { const bf16x8_t wh = wp[(jt * 2) * 64], wl = wp[(jt * 2 + 1) * 64];
                acc[jt] = MFMA16(wh, fh, acc[jt]); acc[jt] = MFMA16(wh, fl, acc[jt]); acc[jt] = MFMA16(wl, fh, acc[jt]); }
            wp += 640;
        }
#pragma unroll
        for (int jt = 0; jt < 5; ++jt) *(LAS f32x4*)(Lp + F.wave * 4096 + lo * 80 + 16 * jt + 4 * hi) = acc[jt];
        LDS_BARRIER();
        for (int i = F.tid; i < 16 * 80; i += NTHR) { float sacc = 0.f;
#pragma unroll
            for (int w = 0; w < 8; ++w) sacc += Lp[w * 4096 + i];
            const int j = i % 80; Lf[i] = sacc + (j < 8 ? b_grp[j] : (j < 72 ? b_exp[j - 8] : 0.f)); }
        LDS_BARRIER();
        if (F.tid < 16) { const LAS float* lg = Lf + F.tid * 80; const int tok = tile * 16 + F.tid;
            int gi = 0; float gmax = lg[0];
#pragma unroll
            for (int j = 1; j < 8; ++j) if (lg[j] > gmax) { gmax = lg[j]; gi = j; }
            float gsum = 0.f;
#pragma unroll
            for (int j = 0; j < 8; ++j) gsum += __expf(lg[j] - gmax);
            const float pg = 1.f / gsum;
            const LAS float* le = lg + 8 + gi * 8; int i1 = 0; float m1 = le[0];
#pragma unroll
            for (int j = 1; j < 8; ++j) if (le[j] > m1) { m1 = le[j]; i1 = j; }
            int i2 = -1; float m2 = -INFINITY;
#pragma unroll
            for (int j = 0; j < 8; ++j) if (j != i1 && le[j] > m2) { m2 = le[j]; i2 = j; }
            const float e2 = __expf(m2 - m1); const float g1 = pg / (1.f + e2), g2 = pg * e2 / (1.f + e2);
            const int x1i = gi * 8 + i1, x2i = gi * 8 + i2;
            const unsigned p1 = atomicAdd(F.ctl + CW_CNT + 64 * x1i, 1u), p2 = atomicAdd(F.ctl + CW_CNT + 64 * x2i, 1u);
            list[x1i * NT + p1] = tok; list[x2i * NT + p2] = tok;
            u32x4 a; a.x = (unsigned)x1i; a.y = p1; a.z = (unsigned)x2i; a.w = p2; *(u32x4*)(tokinfo + (size_t)tok * 8) = a;
            u32x2 g; g.x = __float_as_uint(g1); g.y = __float_as_uint(g2); *(u32x2*)(tokinfo + (size_t)tok * 8 + 4) = g;
        }
    }
    __syncthreads();
}

__device__ __forceinline__ void conv_item_src(const Frame& F, int it, const float*& W, int& N, bf16*& WT, int& ldk, int& drow, int& k0, int& n0) {
    if (it < NEXP * 1024) { const int e = it >> 10, r = it & 1023, which = r >> 9, rr = r & 511; k0 = (rr >> 4) * 64; n0 = (rr & 15) * 32;
        W = F.in[which ? 36 : 35] + (size_t)e * DM * DEXP; N = DEXP; WT = (bf16*)(F.ws + WS_EW1) + (size_t)e * 1024 * DM; ldk = DM; drow = (n0 >> 7) * 256 + which * 128 + (n0 & 127); }
    else { const int j = it - NEXP * 1024, e = j >> 9, r = j & 511; k0 = (r >> 6) * 64; n0 = (r & 63) * 32;
        W = F.in[37] + (size_t)e * DEXP * DM; N = DM; WT = (bf16*)(F.ws + WS_EW2) + (size_t)e * DM * DEXP; ldk = DEXP; drow = n0; }
}
struct ConvItem { const GAS float* src; GAS bf16* dst; int ldk; };
__device__ __forceinline__ void conv_decode(const Frame& F, int it, int lane, ConvItem& ci, int& N) {
    const float* W; int ldk, drow, k0, n0; bf16* WT; conv_item_src(F, it, W, N, WT, ldk, drow, k0, n0);
    ci.src = (const GAS float*)W + (size_t)(k0 + (lane >> 3)) * N + n0 + 4 * (lane & 7); ci.dst = (GAS bf16*)WT + (size_t)(drow + (lane >> 3)) * ldk + k0 + 8 * (lane & 7); ci.ldk = ldk;
}
__device__ __forceinline__ int conv_stream(const Frame& F, int first, int step, int total, const unsigned* stopw) {
    LAS float* scr = (LAS float*)(F.lds + F.wave * 16384);
    const int lane = F.lane;
    f32x4 bA[8], bB[8], bC[8]; ConvItem iA, iB, iC; int done = 0;
#define CV_LOAD(buf, ci, idx) do { int N_; conv_decode(F, (idx) < total ? (idx) : total - 1, lane, ci, N_); _Pragma("unroll") for (int i_ = 0; i_ < 8; ++i_) buf[i_] = *(const GAS f32x4*)(ci.src + (size_t)(8 * i_) * N_); } while (0)
#define CV_PROC(buf, ci) do { _Pragma("unroll") for (int i_ = 0; i_ < 8; ++i_) *(LAS f32x4*)(scr + (8 * i_ + (lane >> 3)) * 36 + 4 * (lane & 7)) = buf[i_]; \
        LDS_WAIT(); asm volatile("" ::: "memory"); \
        { const int c_ = lane & 7; _Pragma("unroll") for (int j_ = 0; j_ < 4; ++j_) { const LAS float* sp = scr + (8 * c_) * 36 + (lane >> 3) + 8 * j_; \
              u32x4 o; o.x = pk2(sp[0 * 36], sp[1 * 36]); o.y = pk2(sp[2 * 36], sp[3 * 36]); o.z = pk2(sp[4 * 36], sp[5 * 36]); o.w = pk2(sp[6 * 36], sp[7 * 36]); \
              *(GAS u32x4*)(ci.dst + (size_t)(8 * j_) * ci.ldk) = o; } } \
        LDS_WAIT(); asm volatile("" ::: "memory"); ++done; } while (0)
#define CV_STOPLD() __hip_atomic_load((const GAS unsigned*)stopw, RLX_AGENT)
#define CV_STOP(v) (__builtin_amdgcn_readfirstlane((int)(v)) != 0)
    int it = first;
    CV_LOAD(bA, iA, it); CV_LOAD(bB, iB, it + step);
    while (it < total) {
        unsigned sv = CV_STOPLD();
        CV_LOAD(bC, iC, it + 2 * step);
        CV_PROC(bA, iA); if (CV_STOP(sv)) break;
        if (it + step >= total) break;
        sv = CV_STOPLD();
        CV_LOAD(bA, iA, it + 3 * step);
        CV_PROC(bB, iB); if (CV_STOP(sv)) break;
        if (it + 2 * step >= total) break;
        sv = CV_STOPLD();
        CV_LOAD(bB, iB, it + 4 * step);
        CV_PROC(bC, iC); if (CV_STOP(sv)) break;
        it += 3 * step;
    }
#undef CV_STOPLD
#undef CV_LOAD
#undef CV_PROC
#undef CV_STOP
    return done;
}
__device__ __forceinline__ void p12_expert_convert(const Frame& F0) {
    PHASE_VIEW();
    volatile LAS int* red = (volatile LAS int*)(F.lds + 131072);
    const int ncw = (F.G >= 256) ? (F.G - CONV_GEMM_BLOCKS) * NWAVES : 0;
    __syncthreads();
    if (F.tid == 0) red[0] = 0x7fffffff;
    __syncthreads();
    for (int i = F.tid; i < ncw; i += NTHR) atomicMin((int*)red, (int)__hip_atomic_load(F.ctl + CW_PROG + i, RLX_AGENT));
    __syncthreads();
    const int start = ncw ? red[0] * ncw : 0;
    __syncthreads();
    const int gw = F.vcu * NWAVES + F.wave, NGW = F.G * NWAVES;
    (void)conv_stream(F, start + gw, NGW, CONV_ITEMS, F.ctl + CW_TMO + 2);
}

__device__ __forceinline__ void moe_build_tp(const Frame& F0) {
    PHASE_VIEW();
    volatile LAS int* tp = (volatile LAS int*)(F.lds + TP_OFF);
    __syncthreads();
    if (F.tid < NEXP) { const unsigned c = __hip_atomic_load(F.ctl + CW_CNT + 64 * F.tid, RLX_AGENT); tp[80 + F.tid] = (int)((c + 255u) >> 8); tp[160 + F.tid] = (int)c; }
    __syncthreads();
    if (F.tid == 0) { int s = 0; for (int e = 0; e < NEXP; ++e) { tp[e] = s; s += tp[80 + e]; } tp[NEXP] = s; }
    __syncthreads();
}
template <bool G1> struct MoeOrder {
    static constexpr bool GATHER = G1; static constexpr int A2 = 0;
    static constexpr int NNT = G1 ? 4 : 8, KK = G1 ? DM : DEXP;
    __device__ __forceinline__ size_t kstepA() const { return 128; }
    __device__ __forceinline__ size_t hstepA() const { return (size_t)128 * KK * 2; }
    __device__ __forceinline__ size_t a2off() const { return 0; }
    const LAS int* tp; const unsigned* cntw; const int* list; const char* A; const char* EW; int G, c;
    __device__ bool next(int i, pg8::Unit& u) const {
        const int x = c & 7, r = c >> 3, W = G >> 3;
        const int L = i * W + r, tl = L / NNT; u.pn = L % NNT;
        int cum = 0, e = -1, mt = 0;
#pragma unroll
        for (int j = 0; j < 8; ++j) { const int nj = tp[80 + x + 8 * j]; if (e < 0 && tl < cum + nj) { e = x + 8 * j; mt = tl - cum; } cum += nj; }
        if (e < 0) return false;
        e = __builtin_amdgcn_readfirstlane(e); mt = __builtin_amdgcn_readfirstlane(mt);
        const int tile = tp[e] + mt;
        u.e = e; u.pm = tile; u.cnt = tp[160 + e] - mt * 256;
        u.Bb = EW + ((size_t)e * (G1 ? 1024 : DM) + (size_t)u.pn * 256) * KK * 2;
        u.Ab = G1 ? A : A + (size_t)tile * 256 * KK * 2;
        return true;
    }
    template <int NV> __device__ __forceinline__ void a_voff(const pg8::Unit& u, unsigned (&v)[NV][2], const int (&R)[2], const int (&C)[2]) const {
        if constexpr (G1) {
            const int mt = u.pm - tp[u.e];
#pragma unroll
            for (int h = 0; h < 2; ++h)
#pragma unroll
                for (int i = 0; i < 2; ++i) { const int rr = h * 128 + R[i]; const int tok = list[u.e * NT + mt * 256 + (rr < u.cnt ? rr : 0)]; v[h][i] = (unsigned)(tok * KK + C[i]) * 2u; }
        } else {
#pragma unroll
            for (int i = 0; i < 2; ++i) v[0][i] = (unsigned)(R[i] * KK + C[i]) * 2u;
        }
    }
};

__device__ __forceinline__ void p15_final(const Frame& F0) {
    PHASE_VIEW();
    const bf16* X1 = (const bf16*)(F.ws + WS_X1); const bf16* YS = (const bf16*)(F.ws + WS_YSLOT); const unsigned* tokinfo = (const unsigned*)(F.ws + WS_TOKINFO);
    const float* gpost2 = F.in[7]; const float* mod = (const float*)(F.ws + WS_MOD);
    const LAS int* tp = (const LAS int*)(F.lds + TP_OFF);
    const int gw = F.vcu * NWAVES + F.wave, NGW = F.G * NWAVES;
    u32x4 tin = *(const u32x4*)(tokinfo + (size_t)gw * 8); u32x2 tgn = *(const u32x2*)(tokinfo + (size_t)gw * 8 + 4);
    for (int row = gw; row < NT; row += NGW) {
        const int b = row >> 11;
        const u32x4 ti = tin; const u32x2 tg = tgn;
        const size_t r1 = (size_t)tp[ti.x] * 256 + ti.y, r2 = (size_t)tp[ti.z] * 256 + ti.w; const float g1 = __uint_as_float(tg.x), g2 = __uint_as_float(tg.y);
        const u32x2* y1 = (const u32x2*)(YS + r1 * DM) + F.lane; const u32x2* y2 = (const u32x2*)(YS + r2 * DM) + F.lane; const u32x2* xp = (const u32x2*)(X1 + (size_t)row * DM) + F.lane;
        u32x2 ya[8], yb[8], xw[8];
#pragma unroll
        for (int j = 0; j < 8; ++j) { ya[j] = y1[64 * j]; yb[j] = y2[64 * j]; xw[j] = xp[64 * j]; }
        { const int rn = (row + NGW < NT) ? row + NGW : row; tin = *(const u32x4*)(tokinfo + (size_t)rn * 8); tgn = *(const u32x2*)(tokinfo + (size_t)rn * 8 + 4); }
        f32x4 v[8]; float ss = 0.f;
#pragma unroll
        for (int j = 0; j < 8; ++j) { const u32x2 a = ya[j], c = yb[j];
            v[j] = (f32x4){bf_lo(a.x), bf_hi(a.x), bf_lo(a.y), bf_hi(a.y)} * g1 + (f32x4){bf_lo(c.x), bf_hi(c.x), bf_lo(c.y), bf_hi(c.y)} * g2;
            ss += (v[j].x * v[j].x + v[j].y * v[j].y) + (v[j].z * v[j].z + v[j].w * v[j].w); }
        const float rs = rsqrtf(wave_sum_dpp(ss) * (1.f / DM) + RMS_EPS);
#pragma unroll
        for (int j = 0; j < 8; ++j) { const int col = 4 * (F.lane + 64 * j);
            const f32x4 gv = *(const f32x4*)(gpost2 + col), gt = *(const f32x4*)(mod + b * NMOD + 5 * DM + col);
            const f32x4 xv = (f32x4){bf_lo(xw[j].x), bf_hi(xw[j].x), bf_lo(xw[j].y), bf_hi(xw[j].y)};
            ((f32x4*)(F.out + (size_t)row * DM))[F.lane + 64 * j] = xv + gt * (v[j] * rs * gv); }
    }
}

constexpr int NPH = 15;
__global__ void __launch_bounds__(NTHR, 2) mk_fwd(Args args) {
    extern __shared__ __attribute__((aligned(16))) unsigned char lds[];
    Frame F0;
    F0.lds = (LAS unsigned char*)lds; F0.MISC = (volatile LAS unsigned*)(F0.lds + MISC_OFF);
    F0.tid = threadIdx.x; F0.lane = F0.tid & 63; F0.wave = __builtin_amdgcn_readfirstlane(F0.tid >> 6);
    F0.G = gridDim.x; { const int bx = blockIdx.x; F0.vcu = (F0.G % 8 == 0) ? (bx % 8) * (F0.G / 8) + bx / 8 : bx; }
    F0.in.kp = (kargp_t)__builtin_amdgcn_kernarg_segment_ptr(); F0.out = args.out; F0.ws = args.ws; F0.ctl = (unsigned*)(args.ws + WS_CTL);
    if (F0.tid < 64) F0.MISC[F0.tid] = 0u;
    __syncthreads();
    const int lo = args.ph_lo, hi = args.ph_hi;
    XcdBarrier bar; bar.bar = F0.ctl + CW_BAR; bar.x = 0; bar.st = nullptr;
    if (hi - lo > 1) bar = xcd_barrier_post(F0.ctl + CW_BAR, F0.MISC + 8);
#ifndef PROBE_MASK
#define PROBE_MASK 0
#endif
#define REPS(k) ((((PROBE_MASK) >> (k)) & 1) + 1)
#define IN(k) (lo <= (k) && (k) < hi)
#define SEAM(k) do { if (IN(k) && IN((k) + 1)) xcd_barrier(bar); } while (0)
    LAS unsigned char* ring = F0.lds;

    if (IN(0)) for (int rep_ = 0; rep_ < REPS(0); ++rep_) { p0_prologue(F0); } SEAM(0);
    if (IN(1)) for (int rep_ = 0; rep_ < REPS(1); ++rep_) { p1_h1(F0); } SEAM(1);
    if (IN(2)) for (int rep_ = 0; rep_ < REPS(2); ++rep_) {
        PHASE_VIEW();
        const int G_GEMM = (F.G >= 256) ? CONV_GEMM_BLOCKS : F.G;
        if ((int)blockIdx.x < G_GEMM) {
            pg8::Gemm g{(const bf16*)(F.ws + WS_H), (const bf16*)(F.ws + WS_WIN_T), NT, DIN, DM}; pg8::StaticOrder S; S.init(g, G_GEMM, (int)blockIdx.x);
            pg8::EpiBf16 E{(bf16*)(F.ws + WS_PROJ), DIN};
            pg8::gemm_phase(ring, DM, S, E);
            __syncthreads();
            if (F.tid == 0 && rep_ == 0) { const unsigned d = atomicAdd(F.ctl + CW_GDONE, 1u); if (d == (unsigned)G_GEMM - 1u) __hip_atomic_store(F.ctl + CW_STOP, 1u, RLX_AGENT); }
        } else if (rep_ == 0) {
            const int jw = ((int)blockIdx.x - G_GEMM) * NWAVES + F.wave, ncw = (F.G - G_GEMM) * NWAVES;
            const int done = conv_stream(F, jw, ncw, CONV_ITEMS, F.ctl + CW_STOP);
            if (F.lane == 0) __hip_atomic_store(F.ctl + CW_PROG + jw, (unsigned)done, RLX_AGENT);
        }
    } SEAM(2);
    if (IN(3)) for (int rep_ = 0; rep_ < REPS(3); ++rep_) {
        PHASE_VIEW();
        S5Order<1> S{(const char*)(F.ws + WS_PROJ), (const char*)(F.ws + WS_SIN), (const char*)(F.ws + WS_S5WT), F.G, F.vcu};
        pg8::EpiS5Scan E{(bf16*)(F.ws + WS_SIN), F.in[10], F.in[11], F.in[12]};
        if (F.G >= NG * 4) pg8::gemm_phase(ring, 256, S, E);
    }
    if (IN(3) && IN(4)) { asm volatile("s_waitcnt vmcnt(0)" ::: "memory"); __syncthreads(); __builtin_amdgcn_fence(__ATOMIC_ACQUIRE, "agent"); asm volatile("s_waitcnt vmcnt(0)" ::: "memory"); __syncthreads(); }
    if (IN(4)) for (int rep_ = 0; rep_ < REPS(4); ++rep_) {
        PHASE_VIEW();
        S5Order<2> S{(const char*)(F.ws + WS_PROJ), (const char*)(F.ws + WS_SIN), (const char*)(F.ws + WS_S5MT), F.G, F.vcu};
        pg8::EpiS5Y E{(bf16*)(F.ws + WS_YSG)};
        int kk = 384; LAUNDER(kk);
        pg8::gemm_phase(ring, kk, S, E);
    } SEAM(4);
    if (IN(5)) for (int rep_ = 0; rep_ < REPS(5); ++rep_) {
        PHASE_VIEW();
        pg8::Gemm g{(const bf16*)(F.ws + WS_YSG), (const bf16*)(F.ws + WS_GLU_T), NT, DSSM, DSSM}; pg8::StaticOrder S; S.init(g, F.G, (int)blockIdx.x);
        pg8::EpiGlu E{(const bf16*)(F.ws + WS_YSG), (bf16*)(F.ws + WS_MIX), DM, F.in[19]};
        pg8::gemm_phase(ring, DSSM, S, E);
    } SEAM(5);
    if (IN(6)) for (int rep_ = 0; rep_ < REPS(6); ++rep_) { p9a_rwkv_chunks(F0); } SEAM(6);
    if (IN(7)) for (int rep_ = 0; rep_ < REPS(7); ++rep_) { p9b_rwkv_seq(F0); } SEAM(7);
    if (IN(8)) for (int rep_ = 0; rep_ < REPS(8); ++rep_) { p9_rwkv_post(F0); } SEAM(8);
    if (IN(9)) for (int rep_ = 0; rep_ < REPS(9); ++rep_) {
        PHASE_VIEW();
        pg8::Gemm g{(const bf16*)(F.ws + WS_MIX), (const bf16*)(F.ws + WS_WOUT_T), NT, DM, DM}; pg8::StaticOrder S; S.init(g, F.G, (int)blockIdx.x);
        pg8::EpiBf16 E{(bf16*)(F.ws + WS_MIXED), DM};
        pg8::gemm_phase(ring, DM, S, E);
    } SEAM(9);
    if (IN(10)) for (int rep_ = 0; rep_ < REPS(10); ++rep_) { p11_x1_router(F0); }
    if (IN(11)) for (int rep_ = 0; rep_ < REPS(11); ++rep_) { p12_expert_convert(F0); } SEAM(11);
    if (IN(12)) for (int rep_ = 0; rep_ < REPS(12); ++rep_) {
        PHASE_VIEW();
        moe_build_tp(F);
        MoeOrder<true> S{(const LAS int*)(F.lds + TP_OFF), F.ctl + CW_CNT, (const int*)(F.ws + WS_LIST), (const char*)(F.ws + WS_H), (const char*)(F.ws + WS_EW1), F.G, (int)blockIdx.x};
        pg8::EpiSwiglu E{(bf16*)(F.ws + WS_HID)};
        pg8::gemm_phase(ring, DM, S, E);
    } SEAM(12);
    if (IN(13)) for (int rep_ = 0; rep_ < REPS(13); ++rep_) {
        PHASE_VIEW();
        moe_build_tp(F);
        MoeOrder<false> S{(const LAS int*)(F.lds + TP_OFF), F.ctl + CW_CNT, (const int*)(F.ws + WS_LIST), (const char*)(F.ws + WS_HID), (const char*)(F.ws + WS_EW2), F.G, (int)blockIdx.x};
        pg8::EpiBf16 E{(bf16*)(F.ws + WS_YSLOT), DM};
        pg8::gemm_phase(ring, DEXP, S, E);
    } SEAM(13);
    if (IN(14)) for (int rep_ = 0; rep_ < REPS(14); ++rep_) { moe_build_tp(F0); p15_final(F0); }
#undef IN
#undef SEAM
}

extern "C" void kernel_launch(void* const* d_in, const int* in_sizes, int n_in, void* d_out, int out_size, void* d_ws, size_t ws_size, hipStream_t stream) {
    static int grid = 0;
    if (grid == 0) {
        if (n_in != 38 || out_size != NT * DM || ws_size < WS_END) { fprintf(stderr, "kernel_launch: unexpected problem (n_in %d, out %d, ws %zu < %zu)\n", n_in, out_size, ws_size, (size_t)WS_END); grid = -1; return; }
        int dev = 0, cus = 0, per_cu = 0;
        if (hipGetDevice(&dev) != hipSuccess || hipDeviceGetAttribute(&cus, hipDeviceAttributeMultiprocessorCount, dev) != hipSuccess) { grid = -1; return; }
        if (hipFuncSetAttribute((const void*)mk_fwd, hipFuncAttributeMaxDynamicSharedMemorySize, LDS_BYTES) != hipSuccess) { fprintf(stderr, "kernel_launch: hipFuncSetAttribute failed\n"); grid = -1; return; }
        if (hipOccupancyMaxActiveBlocksPerMultiprocessor(&per_cu, (const void*)mk_fwd, NTHR, LDS_BYTES) != hipSuccess || per_cu < 1) fprintf(stderr, "kernel_launch: occupancy query says %d\n", per_cu);
        (void)hipGetLastError();
        grid = cus;
    }
    if (grid < 0) return;
    if (hipMemsetAsync((char*)d_ws + WS_CTL, 0, CTL_ZERO_BYTES, stream) != hipSuccess) return;
    Args a{};
    for (int i = 0; i < 38; ++i) a.in[i] = (const float*)d_in[i];
    a.out = (float*)d_out; a.ws = (unsigned char*)d_ws;
#if MK_N_LAUNCHES == 1
    a.ph_lo = 0; a.ph_hi = NPH;
    hipLaunchKernelGGL(mk_fwd, dim3(grid), dim3(NTHR), LDS_BYTES, stream, a);
#else
    for (int p = 0; p < NPH; ++p) { a.ph_lo = p; a.ph_hi = p + 1; hipLaunchKernelGGL(mk_fwd, dim3(grid), dim3(NTHR), LDS_BYTES, stream, a); }
#endif
}
```

```cpp
#include <hip/hip_runtime.h>
#include <cstdio>
#include <cstdint>

#ifndef MK_N_LAUNCHES
#define MK_N_LAUNCHES 1
#endif

#ifndef CONV_GEMM_BLOCKS
#define CONV_GEMM_BLOCKS 184
#endif

#define GAS __attribute__((address_space(1)))
namespace pg8 {
#define PG8_LAS __attribute__((address_space(3)))
typedef unsigned short bf16_t;
typedef short bf16x8 __attribute__((ext_vector_type(8)));
typedef float f32x4 __attribute__((ext_vector_type(4)));
typedef float f32x2 __attribute__((ext_vector_type(2)));
typedef unsigned u32x4 __attribute__((ext_vector_type(4)));
typedef unsigned u32x2 __attribute__((ext_vector_type(2)));
constexpr int BM = 256, BK = 64, HALF = 128, HTB = HALF * BK * 2, STAGE_BYTES = 8 * HTB, NXCD = 8, WGM = 8;

__host__ __device__ __forceinline__ int lds_byte(int r, int c) { const int st = (r >> 4) * 2 + (c >> 5), rr = r & 15, cc = c & 31, ob = rr * 64 + cc * 2; return st * 1024 + (ob ^ (((ob >> 9) & 1) << 5)); }
__host__ __device__ __forceinline__ void stage_rc(int b, int& R, int& C) { const int st = b / 1024, sb = b % 1024, swz = sb ^ (((sb >> 9) & 1) << 5); R = (st >> 1) * 16 + swz / 64; C = (st & 1) * 32 + (swz % 64) / 2; }
__host__ __device__ __forceinline__ int perm32(int rho) { const int n = rho >> 4, i = rho & 15; return 8 * (i >> 2) + 4 * n + (i & 3); }

struct Unit { int pm, pn, e, cnt; const char* Ab; const char* Bb; };
struct Gemm { const bf16_t* A; const bf16_t* Bt; int M, N, K; };

struct StaticOrder {
    static constexpr bool GATHER = false; static constexpr int A2 = 0;
    __device__ __forceinline__ size_t kstepA() const { return (size_t)BK * 2; }
    __device__ __forceinline__ size_t hstepA() const { return (size_t)HALF * K * 2; }
    __device__ __forceinline__ size_t a2off() const { return 0; }
    int nM, nN, nwg, G, c, K; const char* A; const char* Bt;
    __device__ void init(const Gemm& g, int G_, int c_) { nM = g.M / BM; nN = g.N / BM; nwg = nM * nN; G = G_; c = c_; K = g.K; A = (const char*)g.A; Bt = (const char*)g.Bt; }
    __device__ bool next(int i, Unit& u) const {
        const long L = (long)i * G + c; if (L >= nwg) return false;
        int wgid = (int)L; { const int q = nwg / NXCD, r = nwg % NXCD, xcd = wgid % NXCD, off = wgid / NXCD; wgid = (xcd < r ? xcd * (q + 1) : r * (q + 1) + (xcd - r) * q) + off; }
        const int nig = WGM * nN, gid = wgid / nig, fm = gid * WGM, gsz = (nM - fm) < WGM ? (nM - fm) : WGM;
        u.pm = fm + ((wgid % nig) % gsz); u.pn = (wgid % nig) / gsz; u.e = 0; u.cnt = BM;
        u.Ab = A + (size_t)u.pm * BM * K * 2; u.Bb = Bt + (size_t)u.pn * BM * K * 2; return true;
    }
    template <int NV> __device__ __forceinline__ void a_voff(const Unit&, unsigned (&v)[NV][2], const int (&R)[2], const int (&C)[2]) const {
#pragma unroll
        for (int i = 0; i < 2; ++i) v[0][i] = (unsigned)(R[i] * K + C[i]) * 2u;
    }
};

typedef __bf16 bf16x2_v __attribute__((ext_vector_type(2)));
__device__ __forceinline__ unsigned cvt_pk_bf16(float lo, float hi) { const f32x2 v = {lo, hi}; const bf16x2_v b = __builtin_convertvector(v, bf16x2_v); return __builtin_bit_cast(unsigned, b); }
__device__ __forceinline__ float bf_lo(unsigned w) { return __uint_as_float(w << 16); }
__device__ __forceinline__ float bf_hi(unsigned w) { return __uint_as_float(w & 0xffff0000u); }
__device__ __forceinline__ float sigmoidf_(float x) { return __builtin_amdgcn_rcpf(1.0f + __builtin_amdgcn_exp2f(-1.4426950408889634f * x)); }

struct EpiF32 {
    static constexpr bool AFTER_DRAIN = false; static constexpr bool PERM = false;
    float* C; int ldc;
    __device__ __forceinline__ void operator()(const f32x4 (&acc)[2][2][4][2], const Unit& u, int wr, int wc, int fr, int fq) const {
        const int row0 = u.pm * BM + wr * 64 + fr, col0 = u.pn * BM + wc * 32 + 4 * fq;
#pragma unroll
        for (int ai = 0; ai < 2; ++ai)
#pragma unroll
            for (int m = 0; m < 4; ++m) { float* rowp = C + (size_t)(row0 + ai * HALF + m * 16) * ldc + col0;
#pragma unroll
                for (int bj = 0; bj < 2; ++bj)
#pragma unroll
                    for (int n = 0; n < 2; ++n) *(f32x4*)(rowp + bj * HALF + n * 16) = acc[ai][bj][m][n]; }
    }
};
struct EpiBf16 {
    static constexpr bool AFTER_DRAIN = false; static constexpr bool PERM = true;
    bf16_t* O; int ldc;
    __device__ __forceinline__ void operator()(const f32x4 (&acc)[2][2][4][2], const Unit& u, int wr, int wc, int fr, int fq) const {
        const int row0 = u.pm * BM + wr * 64 + fr, col0 = u.pn * BM + wc * 32 + 8 * fq;
#pragma unroll
        for (int ai = 0; ai < 2; ++ai)
#pragma unroll
            for (int m = 0; m < 4; ++m) { GAS bf16_t* rowp = (GAS bf16_t*)O + (size_t)(row0 + ai * HALF + m * 16) * ldc + col0;
#pragma unroll
                for (int bj = 0; bj < 2; ++bj) { const f32x4 v0 = acc[ai][bj][m][0], v1 = acc[ai][bj][m][1];
                    u32x4 w; w.x = cvt_pk_bf16(v0[0], v0[1]); w.y = cvt_pk_bf16(v0[2], v0[3]); w.z = cvt_pk_bf16(v1[0], v1[1]); w.w = cvt_pk_bf16(v1[2], v1[3]);
                    *(GAS u32x4*)(rowp + bj * HALF) = w; } }
    }
};
struct EpiLora {
    static constexpr bool AFTER_DRAIN = false; static constexpr bool PERM = false;
    float* base; size_t stride; const float* w0; const float* a0;
    __device__ __forceinline__ void operator()(const f32x4 (&acc)[2][2][4][2], const Unit& u, int wr, int wc, int fr, int fq) const {
        const int row0 = u.pm * BM + wr * 64 + fr; const int kind = u.pn >> 2; const int col0 = (u.pn & 3) * BM + wc * 32 + 4 * fq;
        float* dst = base + (size_t)kind * stride;
        const float* bp = (kind == 0) ? w0 : a0; const float bs = (kind == 2) ? 0.f : 1.f;
        f32x4 bv[2][2];
#pragma unroll
        for (int bj = 0; bj < 2; ++bj)
#pragma unroll
            for (int n = 0; n < 2; ++n) bv[bj][n] = *(const f32x4*)(bp + col0 + bj * HALF + n * 16) * bs;
#pragma unroll
        for (int ai = 0; ai < 2; ++ai)
#pragma unroll
            for (int m = 0; m < 4; ++m) { float* rowp = dst + (size_t)(row0 + ai * HALF + m * 16) * 1024 + col0;
#pragma unroll
                for (int bj = 0; bj < 2; ++bj)
#pragma unroll
                    for (int n = 0; n < 2; ++n) { f32x4 v = acc[ai][bj][m][n] + bv[bj][n];
                        if (kind == 0) {
#pragma unroll
                            for (int j = 0; j < 4; ++j) v[j] = __expf(-0.6065306597126334f * sigmoidf_(v[j])); }
                        else if (kind == 1) {
#pragma unroll
                            for (int j = 0; j < 4; ++j) v[j] = sigmoidf_(v[j]); }
                        *(f32x4*)(rowp + bj * HALF + n * 16) = v; } }
    }
};
struct EpiGlu {
    static constexpr bool AFTER_DRAIN = false; static constexpr bool PERM = true;
    const bf16_t* Y; bf16_t* O; int ldo; const float* bias;
    __device__ __forceinline__ void operator()(const f32x4 (&acc)[2][2][4][2], const Unit& u, int wr, int wc, int fr, int fq) const {
        const int row0 = u.pm * BM + wr * 64 + fr, col0 = u.pn * BM + wc * 32 + 8 * fq;
        f32x4 bv[2][2];
#pragma unroll
        for (int bj = 0; bj < 2; ++bj)
#pragma unroll
            for (int n = 0; n < 2; ++n) bv[bj][n] = *(const GAS f32x4*)((const GAS float*)bias + col0 + bj * HALF + 4 * n);
#pragma unroll
        for (int ai = 0; ai < 2; ++ai)
#pragma unroll
            for (int m = 0; m < 4; ++m) { const size_t r = (size_t)(row0 + ai * HALF + m * 16);
#pragma unroll
                for (int bj = 0; bj < 2; ++bj) { const u32x4 yv = *(const GAS u32x4*)((const GAS bf16_t*)Y + r * 1024 + col0 + bj * HALF);
                    const f32x4 v0 = acc[ai][bj][m][0] + bv[bj][0], v1 = acc[ai][bj][m][1] + bv[bj][1];
                    u32x4 w;
                    w.x = cvt_pk_bf16(bf_lo(yv.x) * sigmoidf_(v0[0]), bf_hi(yv.x) * sigmoidf_(v0[1]));
                    w.y = cvt_pk_bf16(bf_lo(yv.y) * sigmoidf_(v0[2]), bf_hi(yv.y) * sigmoidf_(v0[3]));
                    w.z = cvt_pk_bf16(bf_lo(yv.z) * sigmoidf_(v1[0]), bf_hi(yv.z) * sigmoidf_(v1[1]));
                    w.w = cvt_pk_bf16(bf_lo(yv.w) * sigmoidf_(v1[2]), bf_hi(yv.w) * sigmoidf_(v1[3]));
                    *(GAS u32x4*)((GAS bf16_t*)O + r * ldo + col0 + bj * HALF) = w; } }
    }
};
struct EpiSwiglu {
    static constexpr bool AFTER_DRAIN = false; static constexpr bool PERM = true;
    bf16_t* Hd;
    __device__ __forceinline__ void operator()(const f32x4 (&acc)[2][2][4][2], const Unit& u, int wr, int wc, int fr, int fq) const {
        const int row0 = u.pm * BM + wr * 64 + fr, col0 = u.pn * HALF + wc * 32 + 8 * fq;
#pragma unroll
        for (int ai = 0; ai < 2; ++ai)
#pragma unroll
            for (int m = 0; m < 4; ++m) { GAS bf16_t* rowp = (GAS bf16_t*)Hd + (size_t)(row0 + ai * HALF + m * 16) * 512 + col0;
                float o[8];
#pragma unroll
                for (int n = 0; n < 2; ++n)
#pragma unroll
                    for (int j = 0; j < 4; ++j) { const float a = acc[ai][0][m][n][j], b = acc[ai][1][m][n][j]; o[n * 4 + j] = a * sigmoidf_(a) * b; }
                u32x4 w; w.x = cvt_pk_bf16(o[0], o[1]); w.y = cvt_pk_bf16(o[2], o[3]); w.z = cvt_pk_bf16(o[4], o[5]); w.w = cvt_pk_bf16(o[6], o[7]);
                *(GAS u32x4*)rowp = w; }
    }
};

struct EpiS5Scan {
    static constexpr bool AFTER_DRAIN = true; static constexpr bool PERM = false;
    bf16_t* SIN; const float* lam_re; const float* lam_im; const float* log_dt;
    __device__ __forceinline__ void operator()(const f32x4 (&)[2][2][4][2], const Unit&, int, int, int, int) const {}
    __device__ __forceinline__ void fused(const f32x4 (&acc)[2][2][4][2], const Unit& u, int wr, int wc, int fr, int fq, PG8_LAS unsigned char* lds) const {
        PG8_LAS float* T = (PG8_LAS float*)lds;
#pragma unroll
        for (int ai = 0; ai < 2; ++ai)
#pragma unroll
            for (int m = 0; m < 4; ++m)
#pragma unroll
                for (int n = 0; n < 2; ++n) *(PG8_LAS f32x4*)(T + (ai * HALF + wr * 64 + m * 16 + fr) * 128 + wc * 32 + n * 16 + 4 * fq) = acc[ai][0][m][n];
        __syncthreads();
        const int tid = threadIdx.x;
        if (tid < 128) {
            const int b2 = tid >> 6, p = tid & 63, g = u.e;
            const float lr = fminf(lam_re[g * 64 + p], -1e-4f), li = lam_im[g * 64 + p], dt = __expf(log_dt[g]);
            const float mag = __expf(lr * dt * 16.f), ang = li * dt * 16.f; const float ar = mag * cosf(ang), ai_ = mag * sinf(ang);
            float sr = 0.f, si = 0.f;
            GAS bf16_t* dst = (GAS bf16_t*)SIN + ((size_t)(u.pm * 256 + b2 * 128) * 16 + (p >> 4)) * 4352 + g * 16 + (p & 15);
            const PG8_LAS float* src = T + (b2 * 128) * 128 + p;
#pragma unroll 8
            for (int ch = 0; ch < 128; ++ch) {
                const unsigned w = cvt_pk_bf16(sr, si);
                dst[(size_t)ch * 16 * 4352] = (bf16_t)(w & 0xffffu); dst[(size_t)ch * 16 * 4352 + 4 * 4352] = (bf16_t)(w >> 16);
                const float lr_ = src[ch * 128], li_ = src[ch * 128 + 64];
                const float nr = ar * sr - ai_ * si + lr_, ni = ar * si + ai_ * sr + li_; sr = nr; si = ni;
            }
        }
    }
};
__device__ __forceinline__ float gelu_tanh_(float y) { const float u = 0.7978845608028654f * (y + 0.044715f * y * y * y); const float e = __builtin_amdgcn_exp2f(2.8853900817779268f * u); return y * (1.f - __builtin_amdgcn_rcpf(e + 1.f)); }
struct EpiS5Y {
    static constexpr bool AFTER_DRAIN = false; static constexpr bool PERM = true;
    bf16_t* Y;
    __device__ __forceinline__ void operator()(const f32x4 (&acc)[2][2][4][2], const Unit& u, int wr, int wc, int fr, int fq) const {
        const int row0 = u.pm * BM + wr * 64 + fr;
#pragma unroll
        for (int ai = 0; ai < 2; ++ai)
#pragma unroll
            for (int m = 0; m < 4; ++m) { const size_t r = (size_t)(row0 + ai * HALF + m * 16);
#pragma unroll
                for (int bj = 0; bj < 2; ++bj) { const int col = bj * HALF + wc * 32 + 8 * fq; const int t = col >> 4, c = col & 15;
                    const f32x4 v0 = acc[ai][bj][m][0], v1 = acc[ai][bj][m][1];
                    u32x4 w; w.x = cvt_pk_bf16(gelu_tanh_(v0[0]), gelu_tanh_(v0[1])); w.y = cvt_pk_bf16(gelu_tanh_(v0[2]), gelu_tanh_(v0[3]));
                    w.z = cvt_pk_bf16(gelu_tanh_(v1[0]), gelu_tanh_(v1[1])); w.w = cvt_pk_bf16(gelu_tanh_(v1[2]), gelu_tanh_(v1[3]));
                    *(GAS u32x4*)((GAS bf16_t*)Y + (r * 16 + t) * 1024 + u.e * 16 + c) = w; } }
    }
};

template <class Epi, class Sched>
__device__ __forceinline__ void gemm_phase(PG8_LAS unsigned char* lds, const int K, const Sched& S, const Epi& E) {
    const int tid = threadIdx.x, wid = __builtin_amdgcn_readfirstlane(tid >> 6), lane = tid & 63, wr = wid >> 2, wc = wid & 3, fr = lane & 15, fq = lane >> 4;
    const int nt = K / BK;
    int RR[2], CC[2]; unsigned voffB[2];
#pragma unroll
    for (int i = 0; i < 2; ++i) { stage_rc(tid * 16 + i * 8192, RR[i], CC[i]); const int Rb = Epi::PERM ? ((RR[i] & ~31) + perm32(RR[i] & 31)) : RR[i];
        voffB[i] = (unsigned)(Rb * K + CC[i]) * 2u; }
    const size_t kstep = (size_t)(BK * 2);
    const size_t hstep = (size_t)HALF * K * 2;
    const unsigned ldsw = (unsigned)wid * 1024u;
    const int aoff = lds_byte(wr * 64 + fr, fq * 8), boff = lds_byte(wc * 32 + fr, fq * 8);
#define PG8_SA(b, h) (((b) * 2 + (h)) * HTB)
#define PG8_SB(b, h) ((4 + (b) * 2 + (h)) * HTB)
#define PG8_STAGE(bufoff, gbase, voff) do { _Pragma("unroll") for (int _i = 0; _i < 2; ++_i) \
        __builtin_amdgcn_global_load_lds((const unsigned*)((const char*)(gbase) + (voff)[_i]), (PG8_LAS unsigned*)(lds + (bufoff) + ldsw + _i * 8192), 16, 0, 0); } while (0)
#define PG8_LDA(dst, b, h) do { _Pragma("unroll") for (int m = 0; m < 4; ++m) _Pragma("unroll") for (int k = 0; k < 2; ++k) dst[m][k] = *(const PG8_LAS bf16x8*)(lds + PG8_SA(b, h) + aoff + m * 2048 + k * 1024); } while (0)
#define PG8_LDB(dst, b, h) do { _Pragma("unroll") for (int n = 0; n < 2; ++n) _Pragma("unroll") for (int k = 0; k < 2; ++k) dst[n][k] = *(const PG8_LAS bf16x8*)(lds + PG8_SB(b, h) + boff + n * 2048 + k * 1024); } while (0)
#define PG8_MMA(ai, bj, At, Bt) do { __builtin_amdgcn_s_setprio(1); _Pragma("unroll") for (int m = 0; m < 4; ++m) _Pragma("unroll") for (int n = 0; n < 2; ++n) _Pragma("unroll") for (int k = 0; k < 2; ++k) \
        acc[ai][bj][m][n] = __builtin_amdgcn_mfma_f32_16x16x32_bf16(Bt[n][k], At[m][k], acc[ai][bj][m][n], 0, 0, 0); __builtin_amdgcn_s_setprio(0); } while (0)
#define PG8_WAIT_V(n) asm volatile("s_waitcnt vmcnt(" #n ")" ::: "memory")
#define PG8_WAIT_L(n) asm volatile("s_waitcnt lgkmcnt(" #n ")" ::: "memory")
#define PG8_BAR __builtin_amdgcn_s_barrier()
#define PG8_SCHED __builtin_amdgcn_sched_barrier(0)
    Unit cur, nxt; int ui = 0;
    if (!S.next(0, cur)) return;
    f32x4 acc[2][2][4][2];
#pragma unroll
    for (int a = 0; a < 2; ++a)
#pragma unroll
        for (int b = 0; b < 2; ++b)
#pragma unroll
            for (int m = 0; m < 4; ++m)
#pragma unroll
                for (int n = 0; n < 2; ++n) acc[a][b][m][n] = (f32x4){0.f, 0.f, 0.f, 0.f};
    bf16x8 At[4][2], B0[2][2], B1[2][2];
    constexpr bool GA = Sched::GATHER;
    constexpr int A2 = Sched::A2;
    constexpr int NV = GA ? 2 : 1;
    unsigned vA[NV][2], vN[NV][2];
    const size_t kstepA = S.kstepA(), hstepA = GA ? 0 : S.hstepA();
    const size_t a2off = (A2 > 0) ? S.a2off() : 0;
    S.template a_voff<NV>(cur, vA, RR, CC);
    const char* cA = cur.Ab; const char* cB = cur.Bb;
    PG8_STAGE(PG8_SB(0, 0), cB, voffB); PG8_STAGE(PG8_SB(0, 1), cB + hstep, voffB); PG8_STAGE(PG8_SA(0, 0), cA, vA[0]); PG8_STAGE(PG8_SA(0, 1), cA + hstepA, vA[NV - 1]);
    if (wr == 1) PG8_BAR;
    PG8_WAIT_V(2); PG8_BAR;
    PG8_STAGE(PG8_SB(1, 0), cB + kstep, voffB); PG8_STAGE(PG8_SA(1, 0), cA + kstepA, vA[0]); PG8_STAGE(PG8_SB(1, 1), cB + hstep + kstep, voffB);
    PG8_WAIT_V(6); PG8_BAR;
    for (;;) {
        const bool has_next = S.next(ui + 1, nxt);
        const char* nA = has_next ? nxt.Ab : cA; const char* nB = has_next ? nxt.Bb : cB;
        if constexpr (GA) {
            if (has_next) S.template a_voff<NV>(nxt, vN, RR, CC);
            else {
#pragma unroll
                for (int h = 0; h < NV; ++h)
#pragma unroll
                    for (int i = 0; i < 2; ++i) vN[h][i] = vA[h][i]; }
        }
#pragma clang loop unroll(disable)
        for (int t = 0; t < nt; t += 2) {
            const bool last = (t == nt - 2);
            const bool s1 = (A2 > 0) && (t + 1 >= A2), s2 = (A2 > 0) && !last && (t + 2 >= A2);
            const char* a1 = cA + (size_t)(t + 1) * kstepA + (s1 ? a2off : 0);
            const char* a2 = last ? nA : cA + (size_t)(t + 2) * kstepA + (s2 ? a2off : 0);
            const char* a3 = a2 + kstepA;
            const char* b2 = last ? nB : cB + (size_t)(t + 2) * kstep; const char* b3 = b2 + kstep;
            unsigned v2[NV][2];
#pragma unroll
            for (int h = 0; h < NV; ++h)
#pragma unroll
                for (int i = 0; i < 2; ++i) v2[h][i] = (GA && last) ? vN[h][i] : vA[h][i];
            PG8_LDB(B0, 0, 0); PG8_LDB(B1, 0, 1); PG8_SCHED; PG8_LDA(At, 0, 0); PG8_STAGE(PG8_SA(1, 1), a1 + hstepA, vA[NV - 1]);
            PG8_WAIT_V(8); PG8_WAIT_L(0); PG8_BAR; PG8_MMA(0, 0, At, B0); PG8_MMA(0, 1, At, B1); PG8_BAR; PG8_SCHED;
            PG8_LDA(At, 0, 1); PG8_STAGE(PG8_SB(0, 0), b2, voffB); PG8_STAGE(PG8_SB(0, 1), b2 + hstep, voffB); PG8_STAGE(PG8_SA(0, 0), a2, v2[0]);
            PG8_WAIT_V(8); PG8_WAIT_L(0); PG8_BAR; PG8_MMA(1, 0, At, B0); PG8_MMA(1, 1, At, B1); PG8_BAR; PG8_SCHED;
            PG8_LDB(B0, 1, 0); PG8_LDB(B1, 1, 1); PG8_SCHED; PG8_LDA(At, 1, 0); PG8_STAGE(PG8_SA(0, 1), a2 + hstepA, v2[NV - 1]);
            PG8_WAIT_V(8); PG8_WAIT_L(0); PG8_BAR; PG8_MMA(0, 0, At, B0); PG8_MMA(0, 1, At, B1); PG8_BAR; PG8_SCHED;
            PG8_LDA(At, 1, 1); PG8_STAGE(PG8_SB(1, 0), b3, voffB); PG8_STAGE(PG8_SB(1, 1), b3 + hstep, voffB); PG8_STAGE(PG8_SA(1, 0), a3, v2[0]);
            PG8_WAIT_V(8); PG8_WAIT_L(0); PG8_BAR; PG8_MMA(1, 0, At, B0); PG8_MMA(1, 1, At, B1); PG8_BAR; PG8_SCHED;
        }
        if (wr == 0) PG8_BAR;
        if constexpr (!Epi::AFTER_DRAIN) E(acc, cur, wr, wc, fr, fq);
        if (!has_next) break;
#pragma unroll
        for (int a = 0; a < 2; ++a)
#pragma unroll
            for (int b = 0; b < 2; ++b)
#pragma unroll
                for (int m = 0; m < 4; ++m)
#pragma unroll
                    for (int n = 0; n < 2; ++n) acc[a][b][m][n] = (f32x4){0.f, 0.f, 0.f, 0.f};
        cur = nxt; cA = nA; cB = nB; ++ui;
        if constexpr (GA) {
#pragma unroll
            for (int h = 0; h < NV; ++h)
#pragma unroll
                for (int i = 0; i < 2; ++i) vA[h][i] = vN[h][i]; }
        if (wr == 1) PG8_BAR;
    }
    PG8_WAIT_V(0);
    PG8_BAR;
    if constexpr (Epi::AFTER_DRAIN) E.fused(acc, cur, wr, wc, fr, fq, lds);
#undef PG8_SA
#undef PG8_SB
#undef PG8_STAGE
#undef PG8_LDA
#undef PG8_LDB
#undef PG8_MMA
#undef PG8_WAIT_V
#undef PG8_WAIT_L
#undef PG8_BAR
#undef PG8_SCHED
}
}
using pg8::f32x4; using pg8::f32x2; using pg8::u32x4; using pg8::u32x2; using pg8::cvt_pk_bf16; using pg8::bf_lo; using pg8::bf_hi; using pg8::sigmoidf_;

constexpr int NWAVES = 8, NTHR = 512;
constexpr int DM = 2048, NB = 8, SEQ = 2048, NT = NB * SEQ;
constexpr int DSSM = 1024, NG = 64, GC = 16, NP = 64;
constexpr int DRW = 1024, NH = 16, HD = 64;
constexpr int DIN = 4352, ZW = 3328;
constexpr int NEXP = 64, DEXP = 512, NMOD = 6 * DM;
constexpr float RMS_EPS = 1e-6f, GN_EPS = 64e-5f;
constexpr int CAP_ROWS = 49152;

constexpr size_t MiB = 1u << 20;
constexpr size_t WS_CTL = 0, CTL_ZERO_BYTES = 1 * MiB;
constexpr size_t WS_MOD = 1 * MiB;
constexpr size_t WS_RWT = 1 * MiB + 512 * 1024;
constexpr size_t WS_LORA_T = 2 * MiB + 512 * 1024;
constexpr size_t WS_GLU_T = 4 * MiB;
constexpr size_t WS_WOUT_T = 6 * MiB;
constexpr size_t WS_WIN_T = 14 * MiB;
constexpr size_t WS_TOKINFO = 31 * MiB;
constexpr size_t WS_LIST = 32 * MiB;
constexpr size_t WS_LIN = 36 * MiB;
constexpr size_t WS_H = 44 * MiB;
constexpr size_t WS_PROJ = 108 * MiB;
constexpr size_t WS_MIX = 244 * MiB;
constexpr size_t WS_EW1 = 308 * MiB;
constexpr size_t WS_EW2 = 564 * MiB;
constexpr size_t WS_SIN = 692 * MiB;
constexpr size_t WS_YSG = 828 * MiB;
constexpr size_t WS_S5MT = 860 * MiB;
constexpr size_t WS_S5WT = 872 * MiB;
constexpr size_t WS_VB = 692 * MiB;
constexpr size_t WS_GB = 724 * MiB;
constexpr size_t WS_GHQ = 756 * MiB;
constexpr size_t WS_GT = 948 * MiB;
constexpr size_t WS_BON = 950 * MiB;
constexpr size_t WS_Y = 952 * MiB;
constexpr size_t WS_X1 = 692 * MiB;
constexpr size_t WS_HID = 756 * MiB;
constexpr size_t WS_END = 984 * MiB;
constexpr size_t WS_MIXED = 108 * MiB;
constexpr size_t WS_YSLOT = 108 * MiB;
static_assert(WS_YSLOT + (size_t)CAP_ROWS * 2048 * 2 <= WS_EW1, "yslot overlay");
static_assert(WS_HID + (size_t)CAP_ROWS * 512 * 2 <= WS_END && WS_GHQ + (size_t)8192 * 12288 * 2 <= WS_GT && WS_SIN + (size_t)NT * DIN * 2 <= WS_YSG, "pool");
constexpr int CW_TMO = 0;
constexpr int CW_BAR = 4096;
constexpr int CW_CNT = 16384;
constexpr int CW_GDONE = 8192, CW_STOP = 8192 + 64, CW_PROG = 8192 + 128;
constexpr int CONV_ITEMS = NEXP * 1536;


constexpr int RING_BYTES = 131072;
constexpr int LDSCTL_OFF = 147456 - 2048;
constexpr int MISC_OFF = LDSCTL_OFF;
constexpr int TP_OFF = LDSCTL_OFF + 256;
constexpr int LDS_BYTES = 147456;

#define LAS __attribute__((address_space(3)))
typedef unsigned short bf16;
typedef GAS unsigned gu32;
#define RLX_AGENT __ATOMIC_RELAXED, __HIP_MEMORY_SCOPE_AGENT

#define XB_TMO      128
#define XB_XCNT(j)  (256  + 64 * (j))
#define XB_XSUB(j)  (1280 + 64 * (j))
#define XB_XGEN(j)  (2304 + 64 * (j))
#define XB_TOP      3328
#define XB_TOPGEN   3392
#define XCD_BAR_WORDS 3456
#define XB_SPIN_CAP (1u << 18)
__device__ __forceinline__ unsigned xb_ld(unsigned* p)              { return __hip_atomic_load(p, __ATOMIC_RELAXED, __HIP_MEMORY_SCOPE_AGENT); }
__device__ __forceinline__ unsigned xb_add(unsigned* p, unsigned v) { return __hip_atomic_fetch_add(p, v, __ATOMIC_RELAXED, __HIP_MEMORY_SCOPE_AGENT); }
__device__ __forceinline__ unsigned xb_xcc_id() { return (unsigned)__builtin_amdgcn_s_getreg((3 << 11) | 20) & 0xFu; }
#define XB_SPIN(cond, bar) do { unsigned _sp = 0; while (cond) { __builtin_amdgcn_s_sleep(1); \
    if ((++_sp & 255u) == 0u) { if (xb_ld(&(bar)[XB_TMO])) break; if (_sp > XB_SPIN_CAP) { atomicAdd(&(bar)[XB_TMO], 1u); break; } } } } while (0)
struct XcdBarrier { unsigned* bar; unsigned x; volatile LAS unsigned* st; };
__device__ __forceinline__ XcdBarrier xcd_barrier_post(unsigned* bar, volatile LAS unsigned* st) {
    XcdBarrier b; b.bar = bar; b.x = xb_xcc_id(); b.st = st;
    if (threadIdx.x == 0) (void)xb_add(&bar[XB_XCNT(b.x)], 1u);
    return b;
}
__device__ __forceinline__ void xcd_barrier_complete(unsigned* bar, unsigned x, unsigned& nloc, unsigned& nx) {
    const unsigned G = gridDim.x * gridDim.y * gridDim.z;
    unsigned sum, cnt, mine, sp = 0u;
    for (;;) {
        sum = 0u; cnt = 0u; mine = 0u;
#pragma unroll
        for (unsigned j = 0; j < 16; ++j) { const unsigned c = xb_ld(&bar[XB_XCNT(j)]); sum += c; cnt += (c > 0u) ? 1u : 0u; mine = (j == x) ? c : mine; }
        if (sum == G) break;
        __builtin_amdgcn_s_sleep(1);
        if ((++sp & 255u) == 0u) { if (xb_ld(&bar[XB_TMO])) break; if (sp > XB_SPIN_CAP) { atomicAdd(&bar[XB_TMO], 1u); break; } }
    }
    nloc = mine > 0u ? mine : 1u; nx = cnt > 0u ? cnt : 1u;
}
__device__ __forceinline__ void xcd_barrier(const XcdBarrier& b) {
    asm volatile("s_waitcnt vmcnt(0)" ::: "memory");
    __syncthreads();
    if (threadIdx.x == 0) {
        unsigned* bar = b.bar;
        __builtin_amdgcn_s_waitcnt(0);
        unsigned nloc = b.st[0], nx = b.st[1];
        if (nloc == 0u) { xcd_barrier_complete(bar, b.x, nloc, nx); b.st[0] = nloc; b.st[1] = nx; }
        const unsigned old = xb_add(&bar[XB_XSUB(b.x)], 1u);
        const unsigned gen = old / nloc;
        if (old + 1u == (gen + 1u) * nloc) {
            __builtin_amdgcn_fence(__ATOMIC_RELEASE, "agent");
            asm volatile("s_waitcnt vmcnt(0)" ::: "memory");
            const unsigned og = xb_add(&bar[XB_TOP], 1u);
            const unsigned tg = og / nx;
            if (og + 1u == (tg + 1u) * nx) xb_add(&bar[XB_TOPGEN], 1u);
            else XB_SPIN(xb_ld(&bar[XB_TOPGEN]) == tg, bar);
            __builtin_amdgcn_fence(__ATOMIC_ACQUIRE, "agent");
            xb_add(&bar[XB_XGEN(b.x)], 1u);
            asm volatile("s_waitcnt vmcnt(0)" ::: "memory");
        } else {
            XB_SPIN(xb_ld(&bar[XB_XGEN(b.x)]) == gen, bar);
            __builtin_amdgcn_fence(__ATOMIC_ACQUIRE, "agent");
            asm volatile("s_waitcnt vmcnt(0)" ::: "memory");
        }
    }
    __syncthreads();
}

struct Args { const float* in[38]; float* out; unsigned char* ws; int ph_lo, ph_hi; };
typedef const float* cfp_t;
typedef __attribute__((address_space(4))) const unsigned char* kargp_t;
struct InTab { kargp_t kp;
    __device__ __forceinline__ const float* operator[](int i) const { return *(const __attribute__((address_space(4))) cfp_t*)(kp + 8 * i); } };
struct Frame {
    LAS unsigned char* lds; volatile LAS unsigned* MISC; unsigned* ctl;
    int tid, lane, wave, vcu, G;
    InTab in; float* out; unsigned char* ws;
};
#define LDS_WAIT() asm volatile("s_waitcnt lgkmcnt(0)" ::: "memory")
#define LAUNDER(p) asm volatile("" : "+s"(p))
#define LDS_BARRIER() do { asm volatile("s_waitcnt lgkmcnt(0)" ::: "memory"); __builtin_amdgcn_s_barrier(); asm volatile("" ::: "memory"); } while (0)
#define PHASE_VIEW() Frame F = F0; LAUNDER(F.ws); LAUNDER(F.in.kp); LAUNDER(F.ctl)
__device__ __forceinline__ float wave_sum(float v) {
#pragma unroll
    for (int o = 1; o < 64; o <<= 1) v += __shfl_xor(v, o);
    return v;
}
__device__ __forceinline__ float wave_max(float v) {
#pragma unroll
    for (int o = 1; o < 64; o <<= 1) v = fmaxf(v, __shfl_xor(v, o));
    return v;
}
__device__ __forceinline__ float row16_sum(float x) {
    x += __builtin_bit_cast(float, __builtin_amdgcn_update_dpp(0, __builtin_bit_cast(int, x), 0xB1, 0xf, 0xf, false));
    x += __builtin_bit_cast(float, __builtin_amdgcn_update_dpp(0, __builtin_bit_cast(int, x), 0x4E, 0xf, 0xf, false));
    x += __builtin_bit_cast(float, __builtin_amdgcn_update_dpp(0, __builtin_bit_cast(int, x), 0x141, 0xf, 0xf, false));
    x += __builtin_bit_cast(float, __builtin_amdgcn_update_dpp(0, __builtin_bit_cast(int, x), 0x140, 0xf, 0xf, false));
    return x;
}
__device__ __forceinline__ unsigned pk2(float lo, float hi) { return cvt_pk_bf16(lo, hi); }
__device__ __forceinline__ float bf2f(bf16 b) { return __uint_as_float(((unsigned)b) << 16); }
__device__ __forceinline__ float gelu_tanh(float y) { const float u = 0.7978845608028654f * (y + 0.044715f * y * y * y); const float e = __expf(2.f * u); const float th = 1.f - 2.f / (e + 1.f); return 0.5f * y * (1.f + th); }

__device__ __forceinline__ void transpose_item(const float* W, int N, bf16* WT, int ldk, int dst_row0, int k0, int n0, int kdst0, LAS float* scr, int lane) {
    float tv[32];
#pragma unroll
    for (int i = 0; i < 32; ++i) tv[i] = W[(size_t)(k0 + 2 * i + (lane >> 5)) * N + n0 + (lane & 31)];
#pragma unroll
    for (int i = 0; i < 32; ++i) scr[(2 * i + (lane >> 5)) * 33 + (lane & 31)] = tv[i];
    LDS_WAIT(); asm volatile("" ::: "memory");
    const int c = lane & 7;
#pragma unroll
    for (int j = 0; j < 4; ++j) { const int n = (lane >> 3) + 8 * j; const LAS float* s = scr + (8 * c) * 33 + n;
        u32x4 o; o.x = pk2(s[0 * 33], s[1 * 33]); o.y = pk2(s[2 * 33], s[3 * 33]); o.z = pk2(s[4 * 33], s[5 * 33]); o.w = pk2(s[6 * 33], s[7 * 33]);
        *(u32x4*)(WT + (size_t)(dst_row0 + n) * ldk + kdst0 + 8 * c) = o; }
    LDS_WAIT(); asm volatile("" ::: "memory");
}

constexpr int PROJ_PITCH = DIN * 2;
template <int PASS> struct S5Order {
    static constexpr bool GATHER = false; static constexpr int A2 = PASS == 2 ? 4 : 0;
    static constexpr int KB = PASS == 2 ? 384 : 256;
    const char* U; const char* SIN; const char* BT; int G, c;
    __device__ __forceinline__ size_t kstepA() const { return (size_t)4 * PROJ_PITCH; }
    __device__ __forceinline__ size_t hstepA() const { return (size_t)128 * 16 * PROJ_PITCH; }
    __device__ __forceinline__ size_t a2off() const { return (size_t)(SIN - U) - (size_t)A2 * kstepA(); }
    __device__ bool next(int i, pg8::Unit& u) const {
        const int L = i * G + c; if (L >= NG * 4) return false;
        const int g = L >> 2, pm = L & 3; u.e = g; u.pm = pm; u.pn = 0; u.cnt = 256;
        u.Ab = U + (size_t)g * 32 + (size_t)pm * 256 * 16 * PROJ_PITCH; u.Bb = BT + (size_t)g * 256 * KB * 2;
        return true;
    }
    template <int NV> __device__ __forceinline__ void a_voff(const pg8::Unit&, unsigned (&v)[NV][2], const int (&R)[2], const int (&C)[2]) const {
#pragma unroll
        for (int i = 0; i < 2; ++i) v[0][i] = (unsigned)(R[i] * 16 * PROJ_PITCH + (C[i] >> 4) * PROJ_PITCH + (C[i] & 15) * 2);
    }
};
__device__ __forceinline__ void s5_build(const Frame& F, int g) {
    const float* lam_re = F.in[10]; const float* lam_im = F.in[11]; const float* log_dt = F.in[12];
    const float* b_re = F.in[13]; const float* b_im = F.in[14]; const float* c_re = F.in[15]; const float* c_im = F.in[16]; const float* dsk = F.in[17];
    LAS float* pwr = (LAS float*)F.lds; LAS float* pwi = pwr + 17 * 64; LAS float* bbr = pwi + 17 * 64; LAS float* bbi = bbr + 1024; LAS float* cre = bbi + 1024; LAS float* cim = cre + 1024; LAS float* Kt = cim + 1024;
    bf16* MT = (bf16*)(F.ws + WS_S5MT) + (size_t)g * 256 * 384; bf16* WT = (bf16*)(F.ws + WS_S5WT) + (size_t)g * 256 * 256;
    const float dt = __expf(log_dt[g]);
    __syncthreads();
    for (int i = F.tid; i < 17 * 64; i += NTHR) { const int tau = i >> 6, p = i & 63; const float lr = fminf(lam_re[g * NP + p], -1e-4f), li = lam_im[g * NP + p];
        const float mag = __expf(lr * dt * (float)tau), ang = li * dt * (float)tau; pwr[i] = mag * cosf(ang); pwi[i] = mag * sinf(ang); }
    for (int i = F.tid; i < 1024; i += NTHR) { const int p = i >> 4; const float lr = fminf(lam_re[g * NP + p], -1e-4f), li = lam_im[g * NP + p];
        const float mag = __expf(lr * dt), ang = li * dt; const float ar = mag * cosf(ang), ai = mag * sinf(ang), den = lr * lr + li * li;
        const float qr = ((ar - 1.f) * lr + ai * li) / den, qi = (ai * lr - (ar - 1.f) * li) / den;
        const float br = b_re[(size_t)g * 1024 + i], bi = b_im[(size_t)g * 1024 + i]; bbr[i] = qr * br - qi * bi; bbi[i] = qr * bi + qi * br;
        cre[i] = c_re[(size_t)g * 1024 + i]; cim[i] = c_im[(size_t)g * 1024 + i]; }
    __syncthreads();
    for (int i = F.tid; i < 4096; i += NTHR) { const int tau = i >> 8, c = (i >> 4) & 15, c2 = i & 15; float acc = 0.f;
        for (int p = 0; p < 64; ++p) { const float cr = cre[c * 64 + p], ci = cim[c * 64 + p], pr = pwr[tau * 64 + p], pi = pwi[tau * 64 + p];
            const float car = cr * pr - ci * pi, cai = cr * pi + ci * pr; acc += car * bbr[p * 16 + c2] - cai * bbi[p * 16 + c2]; }
        Kt[i] = acc; }
    __syncthreads();
    for (int i = F.tid; i < 256 * 192; i += NTHR) { const int row = i / 192, col = (i % 192) * 2; const int t = row >> 4, c = row & 15; float v[2];
#pragma unroll
        for (int q = 0; q < 2; ++q) { const int cc = col + q;
            if (cc < 256) { const int j = cc >> 4, c2 = cc & 15; float x = (j <= t) ? Kt[(t - j) * 256 + c * 16 + c2] : 0.f; if (j == t && c2 == c) x += dsk[g * GC + c]; v[q] = x; }
            else { const int pp = cc - 256, p = pp & 63; const float pr = pwr[(t + 1) * 64 + p], pi = pwi[(t + 1) * 64 + p], cr = cre[c * 64 + p], ci = cim[c * 64 + p];
                v[q] = (pp < 64) ? (cr * pr - ci * pi) : -(cr * pi + ci * pr); } }
        *(unsigned*)(MT + (size_t)row * 384 + col) = pk2(v[0], v[1]); }
    for (int i = F.tid; i < 128 * 128; i += NTHR) { const int row = i >> 7, col = (i & 127) * 2; const int part = row >> 6, p = row & 63; float v[2];
#pragma unroll
        for (int q = 0; q < 2; ++q) { const int cc = col + q, j = cc >> 4, c2 = cc & 15; const float pr = pwr[(15 - j) * 64 + p], pi = pwi[(15 - j) * 64 + p], br = bbr[p * 16 + c2], bi = bbi[p * 16 + c2];
            v[q] = part == 0 ? (pr * br - pi * bi) : (pr * bi + pi * br); }
        *(unsigned*)(WT + (size_t)row * 256 + col) = pk2(v[0], v[1]); }
    __syncthreads();
}

__device__ __forceinline__ void p0_prologue(const Frame& F0) {
    PHASE_VIEW();
    const float* c = F.in[1]; const float* ada_w = F.in[2]; const float* ada_b = F.in[3];
    float* mod = (float*)(F.ws + WS_MOD);
    LAS float* sc = (LAS float*)F.lds;
    LAS float* red = (LAS float*)(F.lds + 65536);
    for (int i = F.tid; i < NB * DM; i += NTHR) { const float v = c[i]; sc[i] = v / (1.f + __expf(-v)); }
    __syncthreads();
    for (int item = F.vcu; item < NMOD / 64; item += F.G) {
        const int col = item * 64 + F.lane, ks = F.wave;
        float acc[8] = {0.f, 0.f, 0.f, 0.f, 0.f, 0.f, 0.f, 0.f};
        for (int k = ks * 256; k < ks * 256 + 256; k += 16) { float w[16];
#pragma unroll
            for (int u = 0; u < 16; ++u) w[u] = ada_w[(size_t)(k + u) * NMOD + col];
#pragma unroll
            for (int u = 0; u < 16; ++u)
#pragma unroll
                for (int b = 0; b < 8; ++b) acc[b] += sc[b * DM + k + u] * w[u]; }
#pragma unroll
        for (int b = 0; b < 8; ++b) red[(ks * 8 + b) * 64 + F.lane] = acc[b];
        __syncthreads();
        { const int b = F.wave; float s = 0.f;
#pragma unroll
          for (int k2 = 0; k2 < 8; ++k2) s += red[(k2 * 8 + b) * 64 + F.lane];
          mod[b * NMOD + col] = s + ada_b[col]; }
        __syncthreads();
    }
    __syncthreads();
    for (int g = F.G - 1 - F.vcu; g < NG; g += F.G) s5_build(F, g);
    LAS float* scr = (LAS float*)(F.lds + F.wave * 16384);
    const int gw = F.vcu * NWAVES + F.wave, NGW = F.G * NWAVES;
    bf16* WinT = (bf16*)(F.ws + WS_WIN_T); bf16* WoutT = (bf16*)(F.ws + WS_WOUT_T); bf16* GluT = (bf16*)(F.ws + WS_GLU_T); bf16* LoraT = (bf16*)(F.ws + WS_LORA_T);
    constexpr int I_IN = (DM / 64) * (DIN / 32), I_OUT = (DM / 64) * (DM / 32), I_GLU = (DSSM / 64) * (DSSM / 32), I_W = 32, I_A = 32, I_G = 64;
    constexpr int NITEMS = I_IN + I_OUT + I_GLU + I_W + I_A + I_G;
    for (int it = gw; it < NITEMS; it += NGW) {
        int r = it;
        if (r < I_IN) { const int nb = DIN / 32, kb = r / nb, n0 = (r % nb) * 32; transpose_item(F.in[8], DIN, WinT, DM, n0, kb * 64, n0, kb * 64, scr, F.lane); continue; } r -= I_IN;
        if (r < I_OUT) { const int nb = DM / 32, kb = r / nb, n0 = (r % nb) * 32; transpose_item(F.in[9], DM, WoutT, DM, n0, kb * 64, n0, kb * 64, scr, F.lane); continue; } r -= I_OUT;
        if (r < I_GLU) { const int nb = DSSM / 32, kb = r / nb, n0 = (r % nb) * 32; transpose_item(F.in[18], DSSM, GluT, DSSM, n0, kb * 64, n0, kb * 64, scr, F.lane); continue; } r -= I_GLU;
        if (r < I_W) { transpose_item(F.in[22], DRW, LoraT, 256, r * 32, 0, r * 32, 0, scr, F.lane); continue; } r -= I_W;
        if (r < I_A) { transpose_item(F.in[24], DRW, LoraT, 256, 1024 + r * 32, 0, r * 32, 64, scr, F.lane); continue; } r -= I_A;
        { const int kb = r / 32, n0 = (r % 32) * 32; transpose_item(F.in[25], DRW, LoraT, 256, 2048 + n0, kb * 64, n0, 128 + kb * 64, scr, F.lane); }
    }
    for (int p = blockIdx.x * NTHR + F.tid; p < 3072 * 32; p += F.G * NTHR) { const int row = p >> 5, c8 = (p & 31) * 8; const int kind = row >> 10;
        const bool data = kind == 0 ? (c8 < 64) : (kind == 1 ? (c8 >= 64 && c8 < 128) : (c8 >= 128));
        if (!data) *(u32x4*)(LoraT + (size_t)row * 256 + c8) = (u32x4){0u, 0u, 0u, 0u}; }
    bf16* rwt = (bf16*)(F.ws + WS_RWT);
    for (int p = blockIdx.x * NTHR + F.tid; p < 64 * 5 * 64 * 8; p += F.G * NTHR) { const int e = p & 7, ln = (p >> 3) & 63, jt = (p >> 9) % 5, ks = (p >> 9) / 5;
        const int j = 16 * jt + (ln & 15), k = 32 * ks + 8 * (ln >> 4) + e;
        const float w = j < 8 ? F.in[31][k * 8 + j] : (j < 72 ? F.in[33][k * 64 + (j - 8)] : 0.f);
        const unsigned hi = pk2(w, 0.f) & 0xffffu; const float wl = w - __uint_as_float(hi << 16);
        const size_t o = ((size_t)((ks * 5 + jt) * 2) * 64 + ln) * 8 + e;
        rwt[o] = (bf16)hi; rwt[o + 512] = (bf16)(pk2(wl, 0.f) & 0xffffu); }
}

__device__ __forceinline__ void p1_h1(const Frame& F0) {
    PHASE_VIEW();
    const float* x = F.in[0]; const float* g = F.in[4]; const float* mod = (const float*)(F.ws + WS_MOD); bf16* H = (bf16*)(F.ws + WS_H);
    const int gw = F.vcu * NWAVES + F.wave, NGW = F.G * NWAVES;
    for (int row = gw; row < NT; row += NGW) {
        const int b = row >> 11; const f32x4* xr = (const f32x4*)(x + (size_t)row * DM) + F.lane;
        f32x4 v[8]; float ss = 0.f;
#pragma unroll
        for (int j = 0; j < 8; ++j) { v[j] = xr[64 * j]; ss += (v[j].x * v[j].x + v[j].y * v[j].y) + (v[j].z * v[j].z + v[j].w * v[j].w); }
        const float rs = rsqrtf(wave_sum(ss) * (1.f / DM) + RMS_EPS);
        u32x2* o = (u32x2*)(H + (size_t)row * DM) + F.lane;
#pragma unroll
        for (int j = 0; j < 8; ++j) { const int col = 4 * (F.lane + 64 * j);
            const f32x4 gv = *(const f32x4*)(g + col), sh = *(const f32x4*)(mod + b * NMOD + col), scv = *(const f32x4*)(mod + b * NMOD + DM + col);
            const f32x4 h = v[j] * rs * gv * (scv + 1.0f) + sh;
            u32x2 w; w.x = pk2(h.x, h.y); w.y = pk2(h.z, h.w); o[64 * j] = w; }
    }
}

typedef short bf16x8_t __attribute__((ext_vector_type(8)));
#define MFMA16(a, b, c) __builtin_amdgcn_mfma_f32_16x16x32_bf16((a), (b), (c), 0, 0, 0)
__device__ __forceinline__ bf16x8_t lfrag(const LAS bf16* m, int pitch, int row, int k0) { return *(const LAS bf16x8_t*)(m + row * pitch + k0); }
__device__ __forceinline__ void st4(LAS bf16* p, const f32x4& v) { u32x2 w; w.x = pk2(v[0], v[1]); w.y = pk2(v[2], v[3]); *(LAS u32x2*)p = w; }
constexpr int CH_T = 32, CHP_K = 72, CHP_T = 40;
constexpr int CH_GRP_BYTES = 66560;
constexpr size_t GHQ_CHUNK = 12288;
__device__ __forceinline__ float wave_sum_dpp(float x) {
    x = row16_sum(x);
    x += __builtin_bit_cast(float, __builtin_amdgcn_update_dpp(0, __builtin_bit_cast(int, x), 0x142, 0xa, 0xf, false));
    x += __builtin_bit_cast(float, __builtin_amdgcn_update_dpp(0, __builtin_bit_cast(int, x), 0x143, 0xc, 0xf, false));
    return __builtin_bit_cast(float, __builtin_amdgcn_readlane(__builtin_bit_cast(int, x), 63));
}
__device__ __forceinline__ void wave_sum8_dpp(float (&x)[8]) {
#define WS8_STAGE(ctrl, rmask) _Pragma("unroll") for (int i_ = 0; i_ < 8; ++i_) x[i_] += __builtin_bit_cast(float, __builtin_amdgcn_update_dpp(0, __builtin_bit_cast(int, x[i_]), ctrl, rmask, 0xf, false));
    WS8_STAGE(0xB1, 0xf) WS8_STAGE(0x4E, 0xf) WS8_STAGE(0x141, 0xf) WS8_STAGE(0x140, 0xf) WS8_STAGE(0x142, 0xa) WS8_STAGE(0x143, 0xc)
#undef WS8_STAGE
#pragma unroll
    for (int i = 0; i < 8; ++i) x[i] = __builtin_bit_cast(float, __builtin_amdgcn_readlane(__builtin_bit_cast(int, x[i]), 63));
}
__device__ __forceinline__ float tanh_fast(float x) { const float e = __builtin_amdgcn_exp2f(2.8853900817779268f * x); return 1.f - 2.f * __builtin_amdgcn_rcpf(e + 1.f); }
__device__ __forceinline__ void p9a_rwkv_chunks(const Frame& F0) {
    PHASE_VIEW();
    const GAS bf16* PROJ = (const GAS bf16*)(F.ws + WS_PROJ); const GAS bf16* LoraT = (const GAS bf16*)(F.ws + WS_LORA_T);
    GAS bf16* VB = (GAS bf16*)(F.ws + WS_VB); GAS bf16* GB = (GAS bf16*)(F.ws + WS_GB); GAS float* BON = (GAS float*)(F.ws + WS_BON);
    const float* mu = F.in[20]; const float* w0 = F.in[21]; const float* a0 = F.in[23]; const float* k_k = F.in[26]; const float* k_a = F.in[27]; const float* r_k = F.in[28];
    GAS bf16* GHQ = (GAS bf16*)(F.ws + WS_GHQ); GAS float* GT = (GAS float*)(F.ws + WS_GT);
    const int grp = F.tid >> 8, gt = F.tid & 255, gw = (F.tid >> 6) & 3, lo = F.lane & 15, hi = F.lane >> 4;
    LAS unsigned char* gb = F.lds + grp * CH_GRP_BYTES;
    LAS bf16* At = (LAS bf16*)gb; LAS bf16* Bt = At + 32 * CHP_K; LAS bf16* Kt = Bt + 32 * CHP_K; LAS bf16* Rt = Kt + 32 * CHP_K;
    LAS bf16* X1T = At; LAS bf16* P1T = X1T + 64 * CHP_T; LAS bf16* Minv = P1T + 64 * CHP_T; LAS bf16* XG = At;
    LAS bf16* AtT = Rt + 32 * CHP_K; LAS bf16* BhT = AtT + 64 * CHP_T; LAS bf16* KhT = BhT + 64 * CHP_T; LAS bf16* VmT = KhT + 64 * CHP_T;
    LAS float* AabF = (LAS float*)(VmT + 64 * CHP_T);
    LAS bf16* Aak = (LAS bf16*)(AabF + 32 * 36); LAS bf16* Arb = Aak + 32 * CHP_T; LAS bf16* Ark = Arb + 32 * CHP_T; LAS bf16* P2T = Ark + 32 * CHP_T;
    LAS float* LWs = AabF; LAS float* AAs = LWs + 32 * 68;
    LAS float* part = (LAS float*)(P2T + 64 * CHP_T);
    LAS bf16* XW = (LAS bf16*)(part + 256); LAS bf16* XA = XW + 32 * CHP_K;
    const f32x4 z4 = (f32x4){0.f, 0.f, 0.f, 0.f};
    LAS unsigned* gbw = (LAS unsigned*)(F.lds + MISC_OFF) + 40 + grp; unsigned gb_target = 0u;
    __syncthreads(); if (gt == 0) *(volatile LAS unsigned*)gbw = 0u; __syncthreads();
#define GROUP_BARRIER() do { gb_target += 4u; asm volatile("s_waitcnt lgkmcnt(0)" ::: "memory"); \
        if (F.lane == 0) (void)__hip_atomic_fetch_add(gbw, 1u, __ATOMIC_RELAXED, __HIP_MEMORY_SCOPE_WORKGROUP); \
        while (*(volatile LAS unsigned*)gbw < gb_target) __builtin_amdgcn_s_sleep(1); \
        asm volatile("" ::: "memory"); } while (0)
    for (int it0 = F.vcu * 2; it0 < NB * (SEQ / CH_T); it0 += F.G * 2) {
        const int item = it0 + grp; const int c = item & 63, b = item >> 6;
        const size_t tok0 = (size_t)b * SEQ + c * CH_T;
        GROUP_BARRIER();
#pragma unroll 4
        for (int i = 0; i < 16; ++i) { const int pidx = gt + 256 * i, t = pidx >> 7, cp = (pidx & 127) * 2;
            const unsigned zw = *(const GAS unsigned*)(PROJ + (tok0 + t) * DIN + 4096 + cp);
            const unsigned pw = (c == 0 && t == 0) ? 0u : *(const GAS unsigned*)(PROJ + (tok0 + t - 1) * DIN + 4096 + cp);
            const f32x2 m = *(const f32x2*)(mu + 3072 + cp);
            const float z0 = bf_lo(zw), z1 = bf_hi(zw); const float v0 = z0 + m.x * (bf_lo(pw) - z0), v1 = z1 + m.y * (bf_hi(pw) - z1);
            if (cp < 64) *(LAS unsigned*)(XW + t * CHP_K + cp) = pk2(tanh_fast(v0), tanh_fast(v1));
            else if (cp < 128) *(LAS unsigned*)(XA + t * CHP_K + cp - 64) = pk2(v0, v1);
            else *(LAS unsigned*)(XG + t * 136 + cp - 128) = pk2(sigmoidf_(v0), sigmoidf_(v1)); }
        GROUP_BARRIER();
        { bf16x8_t xg[2][4];
#pragma unroll
          for (int mt = 0; mt < 2; ++mt)
#pragma unroll
              for (int ks = 0; ks < 4; ++ks) xg[mt][ks] = lfrag(XG, 136, 16 * mt + lo, 32 * ks + 8 * hi);
#pragma unroll 1
          for (int hh = 0; hh < NH; ++hh) { const int n0 = hh * 64 + 16 * gw; f32x4 dg[2] = {z4, z4};
#pragma unroll
              for (int ks = 0; ks < 4; ++ks) { const bf16x8_t yg = *(const GAS bf16x8_t*)(LoraT + (size_t)(2048 + n0 + lo) * 256 + 128 + 32 * ks + 8 * hi);
                  dg[0] = MFMA16(yg, xg[0][ks], dg[0]); dg[1] = MFMA16(yg, xg[1][ks], dg[1]); }
#pragma unroll
              for (int mt = 0; mt < 2; ++mt) { u32x2 w; w.x = pk2(dg[mt][0], dg[mt][1]); w.y = pk2(dg[mt][2], dg[mt][3]); *(GAS u32x2*)(GB + (tok0 + 16 * mt + lo) * 1024 + n0 + 4 * hi) = w; } }
        }
        const int k = gt & 63, tq = gw; const bool first = (c == 0 && tq == 0);
        const GAS bf16* pp = PROJ + (tok0 + tq * 8) * DIN + 1024 + k;
        bf16 nr[9], nk[9], nv[9];
#pragma unroll
        for (int i = 0; i < 9; ++i) { const GAS bf16* q = pp + (ptrdiff_t)(i - 1) * DIN; const bool z = first && i == 0;
            nr[i] = z ? (bf16)0 : q[0]; nk[i] = z ? (bf16)0 : q[1024]; nv[i] = z ? (bf16)0 : q[2048]; }
#pragma unroll 1
        for (int h = 0; h < NH; ++h) {
            const int ci = (b * NH + h) * 64 + c; const int ch = h * 64 + k;
            GROUP_BARRIER();
            { const int n0 = h * 64 + 16 * gw; f32x4 dw[2] = {z4, z4}, da[2] = {z4, z4};
#pragma unroll
              for (int ks = 0; ks < 2; ++ks) { const bf16x8_t yw = *(const GAS bf16x8_t*)(LoraT + (size_t)(n0 + lo) * 256 + 32 * ks + 8 * hi), ya = *(const GAS bf16x8_t*)(LoraT + (size_t)(1024 + n0 + lo) * 256 + 64 + 32 * ks + 8 * hi);
#pragma unroll
                  for (int mt = 0; mt < 2; ++mt) { dw[mt] = MFMA16(yw, lfrag(XW, CHP_K, 16 * mt + lo, 32 * ks + 8 * hi), dw[mt]); da[mt] = MFMA16(ya, lfrag(XA, CHP_K, 16 * mt + lo, 32 * ks + 8 * hi), da[mt]); } }
              const f32x4 w0v = *(const f32x4*)(w0 + n0 + 4 * hi), a0v = *(const f32x4*)(a0 + n0 + 4 * hi);
#pragma unroll
              for (int mt = 0; mt < 2; ++mt) { const int t = 16 * mt + lo; f32x4 lwv, aav;
#pragma unroll
                  for (int r = 0; r < 4; ++r) { lwv[r] = (-0.6065306597126334f * 1.4426950408889634f) * sigmoidf_(dw[mt][r] + w0v[r]);     aav[r] = sigmoidf_(da[mt][r] + a0v[r]); }
                  *(LAS f32x4*)(LWs + t * 68 + 16 * gw + 4 * hi) = lwv; *(LAS f32x4*)(AAs + t * 68 + 16 * gw + 4 * hi) = aav; }
            }
            GROUP_BARRIER();
            { const float mur = mu[ch], muk = mu[1024 + ch], muv = mu[2048 + ch], kkc = k_k[ch], kac = k_a[ch], rkc = r_k[ch];
              float lw[8], ls[8], rv[8], kv[8], vv[8], av[8], bv[8]; float run = 0.f;
              float kraw[8], x8[8];
#pragma unroll
              for (int i = 0; i < 8; ++i) { const int t = tq * 8 + i;
                  const float zr = bf2f(nr[i + 1]), zk = bf2f(nk[i + 1]), zv = bf2f(nv[i + 1]), pr = bf2f(nr[i]), pk_ = bf2f(nk[i]), pv = bf2f(nv[i]);
                  rv[i] = zr + mur * (pr - zr); kraw[i] = zk + muk * (pk_ - zk); vv[i] = zv + muv * (pv - zv);
                  av[i] = AAs[t * 68 + k]; lw[i] = LWs[t * 68 + k];
                  const float kk = kraw[i] * kkc; x8[i] = kk * kk; }
              wave_sum8_dpp(x8);
#pragma unroll
              for (int i = 0; i < 8; ++i) { const float a = av[i]; const float kk = kraw[i] * kkc * __builtin_amdgcn_rsqf(fmaxf(x8[i], 1e-24f));
                  const float km = kraw[i] * (1.f + (a - 1.f) * kac);
                  x8[i] = rv[i] * km * rkc; kv[i] = km; av[i] = -kk; bv[i] = kk * a; run += lw[i]; ls[i] = run; }
              wave_sum8_dpp(x8);
              { float bsel = x8[0];
#pragma unroll
                for (int i = 1; i < 8; ++i) bsel = (F.lane == i) ? x8[i] : bsel;
                if (F.lane < 8) BON[(tok0 + tq * 8 + F.lane) * 16 + h] = bsel; }
              if (h + 1 < NH) {
#pragma unroll
                  for (int i = 0; i < 9; ++i) { const GAS bf16* q = pp + (ptrdiff_t)(i - 1) * DIN + (h + 1) * 64; const bool z = first && i == 0;
                      nr[i] = z ? (bf16)0 : q[0]; nk[i] = z ? (bf16)0 : q[1024]; nv[i] = z ? (bf16)0 : q[2048]; } }
              { u32x4 w; w.x = pk2(vv[0], vv[1]); w.y = pk2(vv[2], vv[3]); w.z = pk2(vv[4], vv[5]); w.w = pk2(vv[6], vv[7]);
                GAS bf16* vb = VB + (tok0 + tq * 8) * 1024 + ch;
                vb[0] = (bf16)(w.x & 0xffffu); vb[1024] = (bf16)(w.x >> 16); vb[2048] = (bf16)(w.y & 0xffffu); vb[3072] = (bf16)(w.y >> 16);
                vb[4096] = (bf16)(w.z & 0xffffu); vb[5120] = (bf16)(w.z >> 16); vb[6144] = (bf16)(w.w & 0xffffu); vb[7168] = (bf16)(w.w >> 16); }
              part[tq * 64 + k] = run;
              GROUP_BARRIER();
              float off = 0.f, tot = 0.f;
#pragma unroll
              for (int q = 0; q < 4; ++q) { const float pq = part[q * 64 + k]; tot += pq; if (q < tq) off += pq; }
              if (tq == 0) GT[(size_t)ci * 64 + k] = __builtin_amdgcn_exp2f(tot);
              float aT[8], bT[8], kT[8];
#pragma unroll
              for (int i = 0; i < 8; ++i) { const int t = tq * 8 + i; const float lg = off + ls[i], lgm = lg - lw[i];
                  const float eneg = __builtin_amdgcn_exp2f(-lg), eh = __builtin_amdgcn_exp2f(tot - lg);
                  const float at = av[i] * __builtin_amdgcn_exp2f(lgm);
                  const unsigned wa = pk2(at, bv[i] * eneg), wk = pk2(kv[i] * eneg, rv[i] * __builtin_amdgcn_exp2f(lg));
                  At[t * CHP_K + k] = (bf16)(wa & 0xffffu); Bt[t * CHP_K + k] = (bf16)(wa >> 16); Kt[t * CHP_K + k] = (bf16)(wk & 0xffffu); Rt[t * CHP_K + k] = (bf16)(wk >> 16);
                  aT[i] = at; bT[i] = bv[i] * eh; kT[i] = kv[i] * eh; }
              u32x4 w;
              w.x = pk2(aT[0], aT[1]); w.y = pk2(aT[2], aT[3]); w.z = pk2(aT[4], aT[5]); w.w = pk2(aT[6], aT[7]); *(LAS u32x4*)(AtT + k * CHP_T + tq * 8) = w;
              w.x = pk2(bT[0], bT[1]); w.y = pk2(bT[2], bT[3]); w.z = pk2(bT[4], bT[5]); w.w = pk2(bT[6], bT[7]); *(LAS u32x4*)(BhT + k * CHP_T + tq * 8) = w;
              w.x = pk2(kT[0], kT[1]); w.y = pk2(kT[2], kT[3]); w.z = pk2(kT[4], kT[5]); w.w = pk2(kT[6], kT[7]); *(LAS u32x4*)(KhT + k * CHP_T + tq * 8) = w;
              w.x = pk2(vv[0], vv[1]); w.y = pk2(vv[2], vv[3]); w.z = pk2(vv[4], vv[5]); w.w = pk2(vv[6], vv[7]); *(LAS u32x4*)(VmT + k * CHP_T + tq * 8) = w;
            }
            GROUP_BARRIER();
            f32x4 aab[2][2];
            const int mi = gw ^ grp;
            { const LAS bf16* X = (mi < 2) ? At : Rt; const LAS bf16* Y = (mi & 1) ? Kt : Bt;
              f32x4 acc[2][2] = {{z4, z4}, {z4, z4}};
#pragma unroll
              for (int ks = 0; ks < 2; ++ks) { bf16x8_t xf[2], yf[2];
#pragma unroll
                  for (int m = 0; m < 2; ++m) { xf[m] = lfrag(X, CHP_K, 16 * m + lo, 32 * ks + 8 * hi); yf[m] = lfrag(Y, CHP_K, 16 * m + lo, 32 * ks + 8 * hi); }
#pragma unroll
                  for (int m = 0; m < 2; ++m)
#pragma unroll
                      for (int n = 0; n < 2; ++n) acc[m][n] = MFMA16(yf[n], xf[m], acc[m][n]); }
              LAS bf16* dstb = (mi == 1) ? Aak : ((mi == 2) ? Arb : Ark);
#pragma unroll
              for (int m = 0; m < 2; ++m)
#pragma unroll
                  for (int n = 0; n < 2; ++n) { const int t = 16 * m + lo, j0 = 16 * n + 4 * hi; f32x4 v = acc[m][n];
#pragma unroll
                      for (int r = 0; r < 4; ++r) { const int j = j0 + r; const bool keep = (mi < 2) ? (j < t) : (j <= t); v[r] = keep ? v[r] : 0.f; }
                      aab[m][n] = v; if (mi != 0) st4(dstb + t * CHP_T + j0, v); }
            }
            GROUP_BARRIER();
            const int inv_w = grp;
            if (mi == 0) {
                int cc = F.lane & 31; asm volatile("" : "+v"(cc));
                float mcol[32];
#pragma unroll
                for (int t = 0; t < 32; ++t) { float acc = (t == cc) ? 1.f : 0.f;
#pragma unroll
                    for (int j = 0; j < t; ++j) { float tmp;
                        asm volatile("v_readlane_b32 %1, %2, %3\n\tv_fmac_f32 %0, %1, %4" : "+v"(acc), "=&s"(tmp) : "v"(aab[t >> 4][j >> 4][j & 3]), "i"((t & 15) + 16 * ((j & 15) >> 2)), "v"(mcol[j])); }
                    mcol[t] = acc; }
                if (F.lane < 32) {
#pragma unroll
                    for (int t = 0; t < 32; ++t) Minv[t * CHP_T + cc] = (bf16)(pk2(mcol[t], 0.f) & 0xffffu); }
            } else {
                const int wk = gw - (gw > inv_w ? 1 : 0);
                for (int tile = wk * 3; tile < ((wk == 2) ? 8 : wk * 3 + 3); ++tile) { const int mt = tile >> 2, nt = tile & 3;
                    const bf16x8_t xf = lfrag(Aak, CHP_T, 16 * mt + lo, 8 * hi), yf = lfrag(VmT, CHP_T, 16 * nt + lo, 8 * hi);
                    const f32x4 d = MFMA16(xf, yf, z4);
                    st4(X1T + (16 * nt + lo) * CHP_T + 16 * mt + 4 * hi, d); }
            }
            GROUP_BARRIER();
            { const bf16x8_t ya = lfrag(AtT, CHP_T, 16 * gw + lo, 8 * hi), yx = lfrag(X1T, CHP_T, 16 * gw + lo, 8 * hi);
              f32x4 d1[2], d2[2];
#pragma unroll
              for (int mt = 0; mt < 2; ++mt) { const bf16x8_t xf = lfrag(Minv, CHP_T, 16 * mt + lo, 8 * hi);
                  d1[mt] = MFMA16(xf, ya, z4); d2[mt] = MFMA16(xf, yx, z4); }
#pragma unroll
              for (int mt = 0; mt < 2; ++mt) { st4(P1T + (16 * gw + lo) * CHP_T + 16 * mt + 4 * hi, d1[mt]); st4(P2T + (16 * gw + lo) * CHP_T + 16 * mt + 4 * hi, d2[mt]); }
            }
            GROUP_BARRIER();
            { GAS bf16* outp = GHQ + (size_t)ci * GHQ_CHUNK;
              const bf16x8_t p1 = lfrag(P1T, CHP_T, 16 * gw + lo, 8 * hi), p2 = lfrag(P2T, CHP_T, 16 * gw + lo, 8 * hi), vm = lfrag(VmT, CHP_T, 16 * gw + lo, 8 * hi);
#pragma unroll
              for (int mt = 0; mt < 2; ++mt) { const bf16x8_t arb = lfrag(Arb, CHP_T, 16 * mt + lo, 8 * hi), ark = lfrag(Ark, CHP_T, 16 * mt + lo, 8 * hi);
                  f32x4 q1 = MFMA16(p1, arb, z4);
                  { const int t = 16 * mt + lo, k0 = 16 * gw + 4 * hi; const u32x2 rw = *(const LAS u32x2*)(Rt + t * CHP_K + k0);
                    q1[0] += bf_lo(rw.x); q1[1] += bf_hi(rw.x); q1[2] += bf_lo(rw.y); q1[3] += bf_hi(rw.y);
                    u32x2 w; w.x = pk2(q1[0], q1[1]); w.y = pk2(q1[2], q1[3]); *(GAS u32x2*)(outp + 8192 + t * 64 + k0) = w; }
                  f32x4 q2 = MFMA16(arb, p2, z4); q2 = MFMA16(ark, vm, q2);
                  { u32x2 w; w.x = pk2(q2[0], q2[1]); w.y = pk2(q2[2], q2[3]); *(GAS u32x2*)(outp + 10240 + (16 * gw + lo) * 32 + 16 * mt + 4 * hi) = w; } }
#pragma unroll
              for (int mt = 0; mt < 4; ++mt) { const bf16x8_t bh = lfrag(BhT, CHP_T, 16 * mt + lo, 8 * hi), kh = lfrag(KhT, CHP_T, 16 * mt + lo, 8 * hi);
                  const f32x4 g = MFMA16(p1, bh, z4);
                  { u32x2 w; w.x = pk2(g[0], g[1]); w.y = pk2(g[2], g[3]); *(GAS u32x2*)(outp + (16 * mt + lo) * 64 + 16 * gw + 4 * hi) = w; }
                  f32x4 hh = MFMA16(bh, p2, z4); hh = MFMA16(kh, vm, hh);
                  { u32x2 w; w.x = pk2(hh[0], hh[1]); w.y = pk2(hh[2], hh[3]); *(GAS u32x2*)(outp + 4096 + (16 * gw + lo) * 64 + 16 * mt + 4 * hi) = w; } }
            }
        }
    }
    __syncthreads();
#undef GROUP_BARRIER
}
__device__ __forceinline__ void p9b_rwkv_seq(const Frame& F0) {
    PHASE_VIEW();
    const GAS bf16* GHQ = (const GAS bf16*)(F.ws + WS_GHQ); const GAS float* GT = (const GAS float*)(F.ws + WS_GT); GAS bf16* Yy = (GAS bf16*)(F.ws + WS_Y);
    LAS bf16* Sb = (LAS bf16*)F.lds;
    const int lo = F.lane & 15, hi = F.lane >> 4, kt = F.wave >> 1, vt = F.wave & 1, mt = F.wave >> 1;
    const f32x4 z4 = (f32x4){0.f, 0.f, 0.f, 0.f};
    for (int item = F.vcu; item < NB * NH * 2; item += F.G) {
        const int b = item >> 5, h = (item >> 1) & 15, vh = item & 1;
        __syncthreads();
        for (int i = F.tid; i < 2 * 32 * CHP_K / 2; i += NTHR) ((LAS unsigned*)Sb)[i] = 0u;
        __syncthreads();
        f32x4 Sf = z4;
        const size_t cbase = (size_t)(b * NH + h) * 64;
        const int vrow = vh * 32 + 16 * vt + lo;
#define SEQ_LOAD(G_, Q_, H_, Q2_, GT_, cc_) do { const int cn_ = (cc_) < 64 ? (cc_) : 63; const GAS bf16* cp_ = GHQ + (cbase + cn_) * GHQ_CHUNK; \
            G_[0] = *(const GAS bf16x8_t*)(cp_ + (16 * kt + lo) * 64 + 8 * hi); G_[1] = *(const GAS bf16x8_t*)(cp_ + (16 * kt + lo) * 64 + 32 + 8 * hi); \
            H_ = *(const GAS u32x2*)(cp_ + 4096 + vrow * 64 + 16 * kt + 4 * hi); GT_ = *(const GAS f32x4*)(GT + (cbase + cn_) * 64 + 16 * kt + 4 * hi); \
            Q_[0] = *(const GAS bf16x8_t*)(cp_ + 8192 + (16 * (mt & 1) + lo) * 64 + 8 * hi); Q_[1] = *(const GAS bf16x8_t*)(cp_ + 8192 + (16 * (mt & 1) + lo) * 64 + 32 + 8 * hi); \
            Q2_ = *(const GAS u32x2*)(cp_ + 10240 + vrow * 32 + 16 * (mt & 1) + 4 * hi); } while (0)
#define SEQ_STEP(G_, Q_, H_, Q2_, GT_, cc_) do { \
            const LAS bf16* Sc = Sb + ((cc_) & 1) * 32 * CHP_K; LAS bf16* Sn = Sb + (((cc_) + 1) & 1) * 32 * CHP_K; \
            const bf16x8_t s0 = lfrag(Sc, CHP_K, 16 * vt + lo, 8 * hi), s1 = lfrag(Sc, CHP_K, 16 * vt + lo, 32 + 8 * hi); \
            if (F.wave < 4) { f32x4 y = (f32x4){bf_lo(Q2_.x), bf_hi(Q2_.x), bf_lo(Q2_.y), bf_hi(Q2_.y)}; \
                y = MFMA16(Q_[0], s0, y); y = MFMA16(Q_[1], s1, y); \
                GAS bf16* yp = Yy + (size_t)(b * SEQ + (cc_) * CH_T + 16 * mt + 4 * hi) * 1024 + h * 64 + vrow; const unsigned w01 = pk2(y[0], y[1]), w23 = pk2(y[2], y[3]); \
                yp[0] = (bf16)(w01 & 0xffffu); yp[1024] = (bf16)(w01 >> 16); yp[2048] = (bf16)(w23 & 0xffffu); yp[3072] = (bf16)(w23 >> 16); } \
            f32x4 acc = (f32x4){bf_lo(H_.x), bf_hi(H_.x), bf_lo(H_.y), bf_hi(H_.y)} + GT_ * Sf; \
            acc = MFMA16(G_[0], s0, acc); acc = MFMA16(G_[1], s1, acc); \
            Sf = acc; st4(Sn + (16 * vt + lo) * CHP_K + 16 * kt + 4 * hi, acc); \
            SEQ_LOAD(G_, Q_, H_, Q2_, GT_, (cc_) + 4); \
            asm volatile("s_waitcnt lgkmcnt(0)" ::: "memory"); __builtin_amdgcn_s_barrier(); asm volatile("" ::: "memory"); } while (0)
        bf16x8_t gA[2], qA[2], gB[2], qB[2], gC[2], qC[2], gD[2], qD[2]; u32x2 hA, q2A, hB, q2B, hC, q2C, hD, q2D; f32x4 gtA, gtB, gtC, gtD;
        SEQ_LOAD(gA, qA, hA, q2A, gtA, 0); SEQ_LOAD(gB, qB, hB, q2B, gtB, 1); SEQ_LOAD(gC, qC, hC, q2C, gtC, 2); SEQ_LOAD(gD, qD, hD, q2D, gtD, 3);
#pragma unroll
        for (int c = 0; c < 64; c += 4) {
            SEQ_STEP(gA, qA, hA, q2A, gtA, c); SEQ_STEP(gB, qB, hB, q2B, gtB, c + 1); SEQ_STEP(gC, qC, hC, q2C, gtC, c + 2); SEQ_STEP(gD, qD, hD, q2D, gtD, c + 3);
        }
#undef SEQ_LOAD
#undef SEQ_STEP
    }
}

__device__ __forceinline__ void p9_rwkv_post(const Frame& F0) {
    PHASE_VIEW();
    const bf16* VB = (const bf16*)(F.ws + WS_VB); const bf16* GB = (const bf16*)(F.ws + WS_GB); const float* BON = (const float*)(F.ws + WS_BON);
    const bf16* Yy = (const bf16*)(F.ws + WS_Y);
    const float* ln_w = F.in[29]; const float* ln_b = F.in[30]; bf16* MIX = (bf16*)(F.ws + WS_MIX);
    const int gw = F.vcu * NWAVES + F.wave, NGW = F.G * NWAVES;
    for (int it = gw; it < NT * 4; it += NGW) {
        const int row = it >> 2, c = (it & 3) * 256 + F.lane * 4, h = c >> 6; const size_t idx = (size_t)row * 1024 + c;
        const u32x2 yw = *(const u32x2*)(Yy + idx); const f32x4 y = (f32x4){bf_lo(yw.x), bf_hi(yw.x), bf_lo(yw.y), bf_hi(yw.y)}; const u32x2 vw = *(const u32x2*)(VB + idx), gwv = *(const u32x2*)(GB + idx);
        const f32x4 lw = *(const f32x4*)(ln_w + c), lb = *(const f32x4*)(ln_b + c); const float bon = BON[row * 16 + h];
        const float mean = row16_sum((y.x + y.y) + (y.z + y.w)) * (1.f / 64.f); const f32x4 d = y - mean;
        const float var = row16_sum((d.x * d.x + d.y * d.y) + (d.z * d.z + d.w * d.w)) * (1.f / 64.f); const float rstd = rsqrtf(var + GN_EPS);
        const f32x4 vv = (f32x4){bf_lo(vw.x), bf_hi(vw.x), bf_lo(vw.y), bf_hi(vw.y)}, gg = (f32x4){bf_lo(gwv.x), bf_hi(gwv.x), bf_lo(gwv.y), bf_hi(gwv.y)};
        const f32x4 o = (d * rstd * lw + lb + vv * bon) * gg;
        u32x2 w; w.x = pk2(o.x, o.y); w.y = pk2(o.z, o.w); *(u32x2*)(MIX + (size_t)row * DM + DSSM + c) = w;
    }
}

__device__ __forceinline__ void p11_x1_router(const Frame& F0) {
    PHASE_VIEW();
    const float* x = F.in[0]; const float* gpost = F.in[5]; const float* gpre2 = F.in[6]; const float* mod = (const float*)(F.ws + WS_MOD);
    const bf16* MIXED = (const bf16*)(F.ws + WS_MIXED); bf16* X1 = (bf16*)(F.ws + WS_X1); bf16* H = (bf16*)(F.ws + WS_H);
    const bf16x8_t* rwt = (const bf16x8_t*)(F.ws + WS_RWT); const float* b_grp = F.in[32]; const float* b_exp = F.in[34];
    unsigned* tokinfo = (unsigned*)(F.ws + WS_TOKINFO); int* list = (int*)(F.ws + WS_LIST);
    LAS float* slab = (LAS float*)(F.lds + F.wave * 16384) + F.lane * 8;
    LAS float* Lp = (LAS float*)F.lds;
    LAS float* red1 = (LAS float*)(F.lds + 131072); LAS float* red2 = red1 + 128; LAS float* Lf = red2 + 128;
    const int lo = F.lane & 15, hi = F.lane >> 4, k0 = 256 * F.wave + 8 * hi;
    const f32x4 z4 = (f32x4){0.f, 0.f, 0.f, 0.f};
    for (int tile = F.vcu; tile < NT / 16; tile += F.G) {
        const int row = tile * 16 + lo, b = tile >> 7;
        const size_t ro = (size_t)row * DM + k0;
        f32x4 xr[8][2];
#pragma unroll
        for (int s_ = 0; s_ < 8; ++s_) { xr[s_][0] = *(const f32x4*)(x + ro + 32 * s_); xr[s_][1] = *(const f32x4*)(x + ro + 32 * s_ + 4); }
        float ss = 0.f;
#pragma unroll
        for (int s_ = 0; s_ < 8; ++s_) { const u32x4 mw = *(const u32x4*)(MIXED + ro + 32 * s_); const f32x4 a0 = (f32x4){bf_lo(mw.x), bf_hi(mw.x), bf_lo(mw.y), bf_hi(mw.y)}, a1 = (f32x4){bf_lo(mw.z), bf_hi(mw.z), bf_lo(mw.w), bf_hi(mw.w)};
            *(LAS f32x4*)(slab + s_ * 512) = a0; *(LAS f32x4*)(slab + s_ * 512 + 4) = a1;
            ss += (a0.x * a0.x + a0.y * a0.y) + (a0.z * a0.z + a0.w * a0.w) + (a1.x * a1.x + a1.y * a1.y) + (a1.z * a1.z + a1.w * a1.w); }
        ss += __shfl_xor(ss, 16); ss += __shfl_xor(ss, 32);
        if (hi == 0) red1[F.wave * 16 + lo] = ss;
        LDS_BARRIER();
        float tot = 0.f;
#pragma unroll
        for (int w = 0; w < 8; ++w) tot += red1[w * 16 + lo];
        const float rs = rsqrtf(tot * (1.f / DM) + RMS_EPS);
        float ss2 = 0.f;
        const float* modb = mod + b * NMOD + k0;
#pragma unroll
        for (int s_ = 0; s_ < 8; ++s_) { f32x4 xo[2];
#pragma unroll
            for (int q = 0; q < 2; ++q) { const f32x4 xv = xr[s_][q], gv = *(const f32x4*)(gpost + k0 + 32 * s_ + 4 * q), gt = *(const f32x4*)(modb + 2 * DM + 32 * s_ + 4 * q);
                const f32x4 mm = *(const LAS f32x4*)(slab + s_ * 512 + 4 * q);
                const f32x4 v = xv + gt * (mm * rs * gv); *(LAS f32x4*)(slab + s_ * 512 + 4 * q) = v; xo[q] = v;
                ss2 += (v.x * v.x + v.y * v.y) + (v.z * v.z + v.w * v.w); }
            u32x4 xw; xw.x = pk2(xo[0].x, xo[0].y); xw.y = pk2(xo[0].z, xo[0].w); xw.z = pk2(xo[1].x, xo[1].y); xw.w = pk2(xo[1].z, xo[1].w); *(u32x4*)(X1 + ro + 32 * s_) = xw; }
        ss2 += __shfl_xor(ss2, 16); ss2 += __shfl_xor(ss2, 32);
        if (hi == 0) red2[F.wave * 16 + lo] = ss2;
        LDS_BARRIER();
        float tot2 = 0.f;
#pragma unroll
        for (int w = 0; w < 8; ++w) tot2 += red2[w * 16 + lo];
        const float rs2 = rsqrtf(tot2 * (1.f / DM) + RMS_EPS);
        f32x4 acc[5] = {z4, z4, z4, z4, z4};
        const bf16x8_t* wp = rwt + (size_t)(F.wave * 8) * 640 + F.lane;
#pragma unroll 1
        for (int s_ = 0; s_ < 8; ++s_) { f32x4 hv[2];
#pragma unroll
            for (int q = 0; q < 2; ++q) { const f32x4 gv = *(const f32x4*)(gpre2 + k0 + 32 * s_ + 4 * q), sh = *(const f32x4*)(modb + 3 * DM + 32 * s_ + 4 * q), scv = *(const f32x4*)(modb + 4 * DM + 32 * s_ + 4 * q);
                const f32x4 mm = *(const LAS f32x4*)(slab + s_ * 512 + 4 * q);
                hv[q] = mm * rs2 * gv * (scv + 1.0f) + sh; }
            u32x4 hh, hl;
            hh.x = pk2(hv[0].x, hv[0].y); hh.y = pk2(hv[0].z, hv[0].w); hh.z = pk2(hv[1].x, hv[1].y); hh.w = pk2(hv[1].z, hv[1].w);
            *(u32x4*)(H + ro + 32 * s_) = hh;
            hl.x = pk2(hv[0].x - bf_lo(hh.x), hv[0].y - bf_hi(hh.x)); hl.y = pk2(hv[0].z - bf_lo(hh.y), hv[0].w - bf_hi(hh.y));
            hl.z = pk2(hv[1].x - bf_lo(hh.z), hv[1].y - bf_hi(hh.z)); hl.w = pk2(hv[1].z - bf_lo(hh.w), hv[1].w - bf_hi(hh.w));
            const bf16x8_t fh = __builtin_bit_cast(bf16x8_t, hh), fl = __builtin_bit_cast(bf16x8_t, hl);
#pragma unroll
            for (int jt = 0; jt < 5; ++jt) { const bf16x8_t wh = wp[(jt * 2) * 64], wl = wp[(jt * 2 + 1) * 64];
                acc[jt] = MFMA16(wh, fh, acc[jt]); acc[jt] = MFMA16(wh, fl, acc[jt]); acc[jt] = MFMA16(wl, fh, acc[jt]); }
            wp += 640;
        }
#pragma unroll
        for (int jt = 0; jt < 5; ++jt) *(LAS f32x4*)(Lp + F.wave * 4096 + lo * 80 + 16 * jt + 4 * hi) = acc[jt];
        LDS_BARRIER();
        for (int i = F.tid; i < 16 * 80; i += NTHR) { float sacc = 0.f;
#pragma unroll
            for (int w = 0; w < 8; ++w) sacc += Lp[w * 4096 + i];
            const int j = i % 80; Lf[i] = sacc + (j < 8 ? b_grp[j] : (j < 72 ? b_exp[j - 8] : 0.f)); }
        LDS_BARRIER();
        if (F.tid < 16) { const LAS float* lg = Lf + F.tid * 80; const int tok = tile * 16 + F.tid;
            int gi = 0; float gmax = lg[0];
#pragma unroll
            for (int j = 1; j < 8; ++j) if (lg[j] > gmax) { gmax = lg[j]; gi = j; }
            float gsum = 0.f;
#pragma unroll
            for (int j = 0; j < 8; ++j) gsum += __expf(lg[j] - gmax);
            const float pg = 1.f / gsum;
            const LAS float* le = lg + 8 + gi * 8; int i1 = 0; float m1 = le[0];
#pragma unroll
            for (int j = 1; j < 8; ++j) if (le[j] > m1) { m1 = le[j]; i1 = j; }
            int i2 = -1; float m2 = -INFINITY;
#pragma unroll
            for (int j = 0; j < 8; ++j) if (j != i1 && le[j] > m2) { m2 = le[j]; i2 = j; }
            const float e2 = __expf(m2 - m1); const float g1 = pg / (1.f + e2), g2 = pg * e2 / (1.f + e2);
            const int x1i = gi * 8 + i1, x2i = gi * 8 + i2;
            const unsigned p1 = atomicAdd(F.ctl + CW_CNT + 64 * x1i, 1u), p2 = atomicAdd(F.ctl + CW_CNT + 64 * x2i, 1u);
            list[x1i * NT + p1] = tok; list[x2i * NT + p2] = tok;
            u32x4 a; a.x = (unsigned)x1i; a.y = p1; a.z = (unsigned)x2i; a.w = p2; *(u32x4*)(tokinfo + (size_t)tok * 8) = a;
            u32x2 g; g.x = __float_as_uint(g1); g.y = __float_as_uint(g2); *(u32x2*)(tokinfo + (size_t)tok * 8 + 4) = g;
        }
    }
    __syncthreads();
}

__device__ __forceinline__ void conv_item_src(const Frame& F, int it, const float*& W, int& N, bf16*& WT, int& ldk, int& drow, int& k0, int& n0) {
    if (it < NEXP * 1024) { const int e = it >> 10, r = it & 1023, which = r >> 9, rr = r & 511; k0 = (rr >> 4) * 64; n0 = (rr & 15) * 32;
        W = F.in[which ? 36 : 35] + (size_t)e * DM * DEXP; N = DEXP; WT = (bf16*)(F.ws + WS_EW1) + (size_t)e * 1024 * DM; ldk = DM; drow = (n0 >> 7) * 256 + which * 128 + (n0 & 127); }
    else { const int j = it - NEXP * 1024, e = j >> 9, r = j & 511; k0 = (r >> 6) * 64; n0 = (r & 63) * 32;
        W = F.in[37] + (size_t)e * DEXP * DM; N = DM; WT = (bf16*)(F.ws + WS_EW2) + (size_t)e * DM * DEXP; ldk = DEXP; drow = n0; }
}
struct ConvItem { const GAS float* src; GAS bf16* dst; int ldk; };
__device__ __forceinline__ void conv_decode(const Frame& F, int it, int lane, ConvItem& ci, int& N) {
    const float* W; int ldk, drow, k0, n0; bf16* WT; conv_item_src(F, it, W, N, WT, ldk, drow, k0, n0);
    ci.src = (const GAS float*)W + (size_t)(k0 + (lane >> 3)) * N + n0 + 4 * (lane & 7); ci.dst = (GAS bf16*)WT + (size_t)(drow + (lane >> 3)) * ldk + k0 + 8 * (lane & 7); ci.ldk = ldk;
}
__device__ __forceinline__ int conv_stream(const Frame& F, int first, int step, int total, const unsigned* stopw) {
    LAS float* scr = (LAS float*)(F.lds + F.wave * 16384);
    const int lane = F.lane;
    f32x4 bA[8], bB[8], bC[8]; ConvItem iA, iB, iC; int done = 0;
#define CV_LOAD(buf, ci, idx) do { int N_; conv_decode(F, (idx) < total ? (idx) : total - 1, lane, ci, N_); _Pragma("unroll") for (int i_ = 0; i_ < 8; ++i_) buf[i_] = *(const GAS f32x4*)(ci.src + (size_t)(8 * i_) * N_); } while (0)
#define CV_PROC(buf, ci) do { _Pragma("unroll") for (int i_ = 0; i_ < 8; ++i_) *(LAS f32x4*)(scr + (8 * i_ + (lane >> 3)) * 36 + 4 * (lane & 7)) = buf[i_]; \
        LDS_WAIT(); asm volatile("" ::: "memory"); \
        { const int c_ = lane & 7; _Pragma("unroll") for (int j_ = 0; j_ < 4; ++j_) { const LAS float* sp = scr + (8 * c_) * 36 + (lane >> 3) + 8 * j_; \
              u32x4 o; o.x = pk2(sp[0 * 36], sp[1 * 36]); o.y = pk2(sp[2 * 36], sp[3 * 36]); o.z = pk2(sp[4 * 36], sp[5 * 36]); o.w = pk2(sp[6 * 36], sp[7 * 36]); \
              *(GAS u32x4*)(ci.dst + (size_t)(8 * j_) * ci.ldk) = o; } } \
        LDS_WAIT(); asm volatile("" ::: "memory"); ++done; } while (0)
#define CV_STOPLD() __hip_atomic_load((const GAS unsigned*)stopw, RLX_AGENT)
#define CV_STOP(v) (__builtin_amdgcn_readfirstlane((int)(v)) != 0)
    int it = first;
    CV_LOAD(bA, iA, it); CV_LOAD(bB, iB, it + step);
    while (it < total) {
        unsigned sv = CV_STOPLD();
        CV_LOAD(bC, iC, it + 2 * step);
        CV_PROC(bA, iA); if (CV_STOP(sv)) break;
        if (it + step >= total) break;
        sv = CV_STOPLD();
        CV_LOAD(bA, iA, it + 3 * step);
        CV_PROC(bB, iB); if (CV_STOP(sv)) break;
        if (it + 2 * step >= total) break;
        sv = CV_STOPLD();
        CV_LOAD(bB, iB, it + 4 * step);
        CV_PROC(bC, iC); if (CV_STOP(sv)) break;
        it += 3 * step;
    }
#undef CV_STOPLD
#undef CV_LOAD
#undef CV_PROC
#undef CV_STOP
    return done;
}
__device__ __forceinline__ void p12_expert_convert(const Frame& F0) {
    PHASE_VIEW();
    volatile LAS int* red = (volatile LAS int*)(F.lds + 131072);
    const int ncw = (F.G >= 256) ? (F.G - CONV_GEMM_BLOCKS) * NWAVES : 0;
    __syncthreads();
    if (F.tid == 0) red[0] = 0x7fffffff;
    __syncthreads();
    for (int i = F.tid; i < ncw; i += NTHR) atomicMin((int*)red, (int)__hip_atomic_load(F.ctl + CW_PROG + i, RLX_AGENT));
    __syncthreads();
    const int start = ncw ? red[0] * ncw : 0;
    __syncthreads();
    const int gw = F.vcu * NWAVES + F.wave, NGW = F.G * NWAVES;
    (void)conv_stream(F, start + gw, NGW, CONV_ITEMS, F.ctl + CW_TMO + 2);
}

__device__ __forceinline__ void moe_build_tp(const Frame& F0) {
    PHASE_VIEW();
    volatile LAS int* tp = (volatile LAS int*)(F.lds + TP_OFF);
    __syncthreads();
    if (F.tid < NEXP) { const unsigned c = __hip_atomic_load(F.ctl + CW_CNT + 64 * F.tid, RLX_AGENT); tp[80 + F.tid] = (int)((c + 255u) >> 8); tp[160 + F.tid] = (int)c; }
    __syncthreads();
    if (F.tid == 0) { int s = 0; for (int e = 0; e < NEXP; ++e) { tp[e] = s; s += tp[80 + e]; } tp[NEXP] = s; }
    __syncthreads();
}
template <bool G1> struct MoeOrder {
    static constexpr bool GATHER = G1; static constexpr int A2 = 0;
    static constexpr int NNT = G1 ? 4 : 8, KK = G1 ? DM : DEXP;
    __device__ __forceinline__ size_t kstepA() const { return 128; }
    __device__ __forceinline__ size_t hstepA() const { return (size_t)128 * KK * 2; }
    __device__ __forceinline__ size_t a2off() const { return 0; }
    const LAS int* tp; const unsigned* cntw; const int* list; const char* A; const char* EW; int G, c;
    __device__ bool next(int i, pg8::Unit& u) const {
        const int x = c & 7, r = c >> 3, W = G >> 3;
        const int L = i * W + r, tl = L / NNT; u.pn = L % NNT;
        int cum = 0, e = -1, mt = 0;
#pragma unroll
        for (int j = 0; j < 8; ++j) { const int nj = tp[80 + x + 8 * j]; if (e < 0 && tl < cum + nj) { e = x + 8 * j; mt = tl - cum; } cum += nj; }
        if (e < 0) return false;
        e = __builtin_amdgcn_readfirstlane(e); mt = __builtin_amdgcn_readfirstlane(mt);
        const int tile = tp[e] + mt;
        u.e = e; u.pm = tile; u.cnt = tp[160 + e] - mt * 256;
        u.Bb = EW + ((size_t)e * (G1 ? 1024 : DM) + (size_t)u.pn * 256) * KK * 2;
        u.Ab = G1 ? A : A + (size_t)tile * 256 * KK * 2;
        return true;
    }
    template <int NV> __device__ __forceinline__ void a_voff(const pg8::Unit& u, unsigned (&v)[NV][2], const int (&R)[2], const int (&C)[2]) const {
        if constexpr (G1) {
            const int mt = u.pm - tp[u.e];
#pragma unroll
            for (int h = 0; h < 2; ++h)
#pragma unroll
                for (int i = 0; i < 2; ++i) { const int rr = h * 128 + R[i]; const int tok = list[u.e * NT + mt * 256 + (rr < u.cnt ? rr : 0)]; v[h][i] = (unsigned)(tok * KK + C[i]) * 2u; }
        } else {
#pragma unroll
            for (int i = 0; i < 2; ++i) v[0][i] = (unsigned)(R[i] * KK + C[i]) * 2u;
        }
    }
};

__device__ __forceinline__ void p15_final(const Frame& F0) {
    PHASE_VIEW();
    const bf16* X1 = (const bf16*)(F.ws + WS_X1); const bf16* YS = (const bf16*)(F.ws + WS_YSLOT); const unsigned* tokinfo = (const unsigned*)(F.ws + WS_TOKINFO);
    const float* gpost2 = F.in[7]; const float* mod = (const float*)(F.ws + WS_MOD);
    const LAS int* tp = (const LAS int*)(F.lds + TP_OFF);
    const int gw = F.vcu * NWAVES + F.wave, NGW = F.G * NWAVES;
    u32x4 tin = *(const u32x4*)(tokinfo + (size_t)gw * 8); u32x2 tgn = *(const u32x2*)(tokinfo + (size_t)gw * 8 + 4);
    for (int row = gw; row < NT; row += NGW) {
        const int b = row >> 11;
        const u32x4 ti = tin; const u32x2 tg = tgn;
        const size_t r1 = (size_t)tp[ti.x] * 256 + ti.y, r2 = (size_t)tp[ti.z] * 256 + ti.w; const float g1 = __uint_as_float(tg.x), g2 = __uint_as_float(tg.y);
        const u32x2* y1 = (const u32x2*)(YS + r1 * DM) + F.lane; const u32x2* y2 = (const u32x2*)(YS + r2 * DM) + F.lane; const u32x2* xp = (const u32x2*)(X1 + (size_t)row * DM) + F.lane;
        u32x2 ya[8], yb[8], xw[8];
#pragma unroll
        for (int j = 0; j < 8; ++j) { ya[j] = y1[64 * j]; yb[j] = y2[64 * j]; xw[j] = xp[64 * j]; }
        { const int rn = (row + NGW < NT) ? row + NGW : row; tin = *(const u32x4*)(tokinfo + (size_t)rn * 8); tgn = *(const u32x2*)(tokinfo + (size_t)rn * 8 + 4); }
        f32x4 v[8]; float ss = 0.f;
#pragma unroll
        for (int j = 0; j < 8; ++j) { const u32x2 a = ya[j], c = yb[j];
            v[j] = (f32x4){bf_lo(a.x), bf_hi(a.x), bf_lo(a.y), bf_hi(a.y)} * g1 + (f32x4){bf_lo(c.x), bf_hi(c.x), bf_lo(c.y), bf_hi(c.y)} * g2;
            ss += (v[j].x * v[j].x + v[j].y * v[j].y) + (v[j].z * v[j].z + v[j].w * v[j].w); }
        const float rs = rsqrtf(wave_sum_dpp(ss) * (1.f / DM) + RMS_EPS);
#pragma unroll
        for (int j = 0; j < 8; ++j) { const int col = 4 * (F.lane + 64 * j);
            const f32x4 gv = *(const f32x4*)(gpost2 + col), gt = *(const f32x4*)(mod + b * NMOD + 5 * DM + col);
            const f32x4 xv = (f32x4){bf_lo(xw[j].x), bf_hi(xw[j].x), bf_lo(xw[j].y), bf_hi(xw[j].y)};
            ((f32x4*)(F.out + (size_t)row * DM))[F.lane + 64 * j] = xv + gt * (v[j] * rs * gv); }
    }
}

constexpr int NPH = 15;
__global__ void __launch_bounds__(NTHR, 2) mk_fwd(Args args) {
    extern __shared__ __attribute__((aligned(16))) unsigned char lds[];
    Frame F0;
    F0.lds = (LAS unsigned char*)lds; F0.MISC = (volatile LAS unsigned*)(F0.lds + MISC_OFF);
    F0.tid = threadIdx.x; F0.lane = F0.tid & 63; F0.wave = __builtin_amdgcn_readfirstlane(F0.tid >> 6);
    F0.G = gridDim.x; { const int bx = blockIdx.x; F0.vcu = (F0.G % 8 == 0) ? (bx % 8) * (F0.G / 8) + bx / 8 : bx; }
    F0.in.kp = (kargp_t)__builtin_amdgcn_kernarg_segment_ptr(); F0.out = args.out; F0.ws = args.ws; F0.ctl = (unsigned*)(args.ws + WS_CTL);
    if (F0.tid < 64) F0.MISC[F0.tid] = 0u;
    __syncthreads();
    const int lo = args.ph_lo, hi = args.ph_hi;
    XcdBarrier bar; bar.bar = F0.ctl + CW_BAR; bar.x = 0; bar.st = nullptr;
    if (hi - lo > 1) bar = xcd_barrier_post(F0.ctl + CW_BAR, F0.MISC + 8);
#ifndef PROBE_MASK
#define PROBE_MASK 0
#endif
#define REPS(k) ((((PROBE_MASK) >> (k)) & 1) + 1)
#define IN(k) (lo <= (k) && (k) < hi)
#define SEAM(k) do { if (IN(k) && IN((k) + 1)) xcd_barrier(bar); } while (0)
    LAS unsigned char* ring = F0.lds;

    if (IN(0)) for (int rep_ = 0; rep_ < REPS(0); ++rep_) { p0_prologue(F0); } SEAM(0);
    if (IN(1)) for (int rep_ = 0; rep_ < REPS(1); ++rep_) { p1_h1(F0); } SEAM(1);
    if (IN(2)) for (int rep_ = 0; rep_ < REPS(2); ++rep_) {
        PHASE_VIEW();
        const int G_GEMM = (F.G >= 256) ? CONV_GEMM_BLOCKS : F.G;
        if ((int)blockIdx.x < G_GEMM) {
            pg8::Gemm g{(const bf16*)(F.ws + WS_H), (const bf16*)(F.ws + WS_WIN_T), NT, DIN, DM}; pg8::StaticOrder S; S.init(g, G_GEMM, (int)blockIdx.x);
            pg8::EpiBf16 E{(bf16*)(F.ws + WS_PROJ), DIN};
            pg8::gemm_phase(ring, DM, S, E);
            __syncthreads();
            if (F.tid == 0 && rep_ == 0) { const unsigned d = atomicAdd(F.ctl + CW_GDONE, 1u); if (d == (unsigned)G_GEMM - 1u) __hip_atomic_store(F.ctl + CW_STOP, 1u, RLX_AGENT); }
        } else if (rep_ == 0) {
            const int jw = ((int)blockIdx.x - G_GEMM) * NWAVES + F.wave, ncw = (F.G - G_GEMM) * NWAVES;
            const int done = conv_stream(F, jw, ncw, CONV_ITEMS, F.ctl + CW_STOP);
            if (F.lane == 0) __hip_atomic_store(F.ctl + CW_PROG + jw, (unsigned)done, RLX_AGENT);
        }
    } SEAM(2);
    if (IN(3)) for (int rep_ = 0; rep_ < REPS(3); ++rep_) {
        PHASE_VIEW();
        S5Order<1> S{(const char*)(F.ws + WS_PROJ), (const char*)(F.ws + WS_SIN), (const char*)(F.ws + WS_S5WT), F.G, F.vcu};
        pg8::EpiS5Scan E{(bf16*)(F.ws + WS_SIN), F.in[10], F.in[11], F.in[12]};
        if (F.G >= NG * 4) pg8::gemm_phase(ring, 256, S, E);
    }
    if (IN(3) && IN(4)) { asm volatile("s_waitcnt vmcnt(0)" ::: "memory"); __syncthreads(); __builtin_amdgcn_fence(__ATOMIC_ACQUIRE, "agent"); asm volatile("s_waitcnt vmcnt(0)" ::: "memory"); __syncthreads(); }
    if (IN(4)) for (int rep_ = 0; rep_ < REPS(4); ++rep_) {
        PHASE_VIEW();
        S5Order<2> S{(const char*)(F.ws + WS_PROJ), (const char*)(F.ws + WS_SIN), (const char*)(F.ws + WS_S5MT), F.G, F.vcu};
        pg8::EpiS5Y E{(bf16*)(F.ws + WS_YSG)};
        int kk = 384; LAUNDER(kk);
        pg8::gemm_phase(ring, kk, S, E);
    } SEAM(4);
    if (IN(5)) for (int rep_ = 0; rep_ < REPS(5); ++rep_) {
        PHASE_VIEW();
        pg8::Gemm g{(const bf16*)(F.ws + WS_YSG), (const bf16*)(F.ws + WS_GLU_T), NT, DSSM, DSSM}; pg8::StaticOrder S; S.init(g, F.G, (int)blockIdx.x);
        pg8::EpiGlu E{(const bf16*)(F.ws + WS_YSG), (bf16*)(F.ws + WS_MIX), DM, F.in[19]};
        pg8::gemm_phase(ring, DSSM, S, E);
    } SEAM(5);
    if (IN(6)) for (int rep_ = 0; rep_ < REPS(6); ++rep_) { p9a_rwkv_chunks(F0); } SEAM(6);
    if (IN(7)) for (int rep_ = 0; rep_ < REPS(7); ++rep_) { p9b_rwkv_seq(F0); } SEAM(7);
    if (IN(8)) for (int rep_ = 0; rep_ < REPS(8); ++rep_) { p9_rwkv_post(F0); } SEAM(8);
    if (IN(9)) for (int rep_ = 0; rep_ < REPS(9); ++rep_) {
        PHASE_VIEW();
        pg8::Gemm g{(const bf16*)(F.ws + WS_MIX), (const bf16*)(F.ws + WS_WOUT_T), NT, DM, DM}; pg8::StaticOrder S; S.init(g, F.G, (int)blockIdx.x);
        pg8::EpiBf16 E{(bf16*)(F.ws + WS_MIXED), DM};
        pg8::gemm_phase(ring, DM, S, E);
    } SEAM(9);
    if (IN(10)) for (int rep_ = 0; rep_ < REPS(10); ++rep_) { p11_x1_router(F0); }
    if (IN(11)) for (int rep_ = 0; rep_ < REPS(11); ++rep_) { p12_expert_convert(F0); } SEAM(11);
    if (IN(12)) for (int rep_ = 0; rep_ < REPS(12); ++rep_) {
        PHASE_VIEW();
        moe_build_tp(F);
        MoeOrder<true> S{(const LAS int*)(F.lds + TP_OFF), F.ctl + CW_CNT, (const int*)(F.ws + WS_LIST), (const char*)(F.ws + WS_H), (const char*)(F.ws + WS_EW1), F.G, (int)blockIdx.x};
        pg8::EpiSwiglu E{(bf16*)(F.ws + WS_HID)};
        pg8::gemm_phase(ring, DM, S, E);
    } SEAM(12);
    if (IN(13)) for (int rep_ = 0; rep_ < REPS(13); ++rep_) {
        PHASE_VIEW();
        moe_build_tp(F);
        MoeOrder<false> S{(const LAS int*)(F.lds + TP_OFF), F.ctl + CW_CNT, (const int*)(F.ws + WS_LIST), (const char*)(F.ws + WS_HID), (const char*)(F.ws + WS_EW2), F.G, (int)blockIdx.x};
        pg8::EpiBf16 E{(bf16*)(F.ws + WS_YSLOT), DM};
        pg8::gemm_phase(ring, DEXP, S, E);
    } SEAM(13);
    if (IN(14)) for (int rep_ = 0; rep_ < REPS(14); ++rep_) { moe_build_tp(F0); p15_final(F0); }
#undef IN
#undef SEAM
}

extern "C" void kernel_launch(void* const* d_in, const int* in_sizes, int n_in, void* d_out, int out_size, void* d_ws, size_t ws_size, hipStream_t stream) {
    static int grid = 0;
    if (grid == 0) {
        if (n_in != 38 || out_size != NT * DM || ws_size < WS_END) { fprintf(stderr, "kernel_launch: unexpected problem (n_in %d, out %d, ws %zu < %zu)\n", n_in, out_size, ws_size, (size_t)WS_END); grid = -1; return; }
        int dev = 0, cus = 0, per_cu = 0;
        if (hipGetDevice(&dev) != hipSuccess || hipDeviceGetAttribute(&cus, hipDeviceAttributeMultiprocessorCount, dev) != hipSuccess) { grid = -1; return; }
        if (hipFuncSetAttribute((const void*)mk_fwd, hipFuncAttributeMaxDynamicSharedMemorySize, LDS_BYTES) != hipSuccess) { fprintf(stderr, "kernel_launch: hipFuncSetAttribute failed\n"); grid = -1; return; }
        if (hipOccupancyMaxActiveBlocksPerMultiprocessor(&per_cu, (const void*)mk_fwd, NTHR, LDS_BYTES) != hipSuccess || per_cu < 1) fprintf(stderr, "kernel_launch: occupancy query says %d\n", per_cu);
        (void)hipGetLastError();
        grid = cus;
    }
    if (grid < 0) return;
    if (hipMemsetAsync((char*)d_ws + WS_CTL, 0, CTL_ZERO_BYTES, stream) != hipSuccess) return;
    Args a{};
    for (int i = 0; i < 38; ++i) a.in[i] = (const float*)d_in[i];
    a.out = (float*)d_out; a.ws = (unsigned char*)d_ws;
#if MK_N_LAUNCHES == 1
    a.ph_lo = 0; a.ph_hi = NPH;
    hipLaunchKernelGGL(mk_fwd, dim3(grid), dim3(NTHR), LDS_BYTES, stream, a);
#else
    for (int p = 0; p < NPH; ++p) { a.ph_lo = p; a.ph_hi = p + 1; hipLaunchKernelGGL(mk_fwd, dim3(grid), dim3(NTHR), LDS_BYTES, stream, a); }
#endif
}
```

```cpp
#include <hip/hip_runtime.h>
#include <cstdio>
#include <cstdint>

#ifndef MK_N_LAUNCHES
#define MK_N_LAUNCHES 1
#endif

#ifndef CONV_GEMM_BLOCKS
#define CONV_GEMM_BLOCKS 184
#endif

#define GAS __attribute__((address_space(1)))
namespace pg8 {
#define PG8_LAS __attribute__((address_space(3)))
typedef unsigned short bf16_t;
typedef short bf16x8 __attribute__((ext_vector_type(8)));
typedef float f32x4 __attribute__((ext_vector_type(4)));
typedef float f32x2 __attribute__((ext_vector_type(2)));
typedef unsigned u32x4 __attribute__((ext_vector_type(4)));
typedef unsigned u32x2 __attribute__((ext_vector_type(2)));
constexpr int BM = 256, BK = 64, HALF = 128, HTB = HALF * BK * 2, STAGE_BYTES = 8 * HTB, NXCD = 8, WGM = 8;

__host__ __device__ __forceinline__ int lds_byte(int r, int c) { const int st = (r >> 4) * 2 + (c >> 5), rr = r & 15, cc = c & 31, ob = rr * 64 + cc * 2; return st * 1024 + (ob ^ (((ob >> 9) & 1) << 5)); }
__host__ __device__ __forceinline__ void stage_rc(int b, int& R, int& C) { const int st = b / 1024, sb = b % 1024, swz = sb ^ (((sb >> 9) & 1) << 5); R = (st >> 1) * 16 + swz / 64; C = (st & 1) * 32 + (swz % 64) / 2; }
__host__ __device__ __forceinline__ int perm32(int rho) { const int n = rho >> 4, i = rho & 15; return 8 * (i >> 2) + 4 * n + (i & 3); }

struct Unit { int pm, pn, e, cnt; const char* Ab; const char* Bb; };
struct Gemm { const bf16_t* A; const bf16_t* Bt; int M, N, K; };

struct StaticOrder {
    static constexpr bool GATHER = false; static constexpr int A2 = 0;
    __device__ __forceinline__ size_t kstepA() const { return (size_t)BK * 2; }
    __device__ __forceinline__ size_t hstepA() const { return (size_t)HALF * K * 2; }
    __device__ __forceinline__ size_t a2off() const { return 0; }
    int nM, nN, nwg, G, c, K; const char* A; const char* Bt;
    __device__ void init(const Gemm& g, int G_, int c_) { nM = g.M / BM; nN = g.N / BM; nwg = nM * nN; G = G_; c = c_; K = g.K; A = (const char*)g.A; Bt = (const char*)g.Bt; }
    __device__ bool next(int i, Unit& u) const {
        const long L = (long)i * G + c; if (L >= nwg) return false;
        int wgid = (int)L; { const int q = nwg / NXCD, r = nwg % NXCD, xcd = wgid % NXCD, off = wgid / NXCD; wgid = (xcd < r ? xcd * (q + 1) : r * (q + 1) + (xcd - r) * q) + off; }
        const int nig = WGM * nN, gid = wgid / nig, fm = gid * WGM, gsz = (nM - fm) < WGM ? (nM - fm) : WGM;
        u.pm = fm + ((wgid % nig) % gsz); u.pn = (wgid % nig) / gsz; u.e = 0; u.cnt = BM;
        u.Ab = A + (size_t)u.pm * BM * K * 2; u.Bb = Bt + (size_t)u.pn * BM * K * 2; return true;
    }
    template <int NV> __device__ __forceinline__ void a_voff(const Unit&, unsigned (&v)[NV][2], const int (&R)[2], const int (&C)[2]) const {
#pragma unroll
        for (int i = 0; i < 2; ++i) v[0][i] = (unsigned)(R[i] * K + C[i]) * 2u;
    }
};

typedef __bf16 bf16x2_v __attribute__((ext_vector_type(2)));
__device__ __forceinline__ unsigned cvt_pk_bf16(float lo, float hi) { const f32x2 v = {lo, hi}; const bf16x2_v b = __builtin_convertvector(v, bf16x2_v); return __builtin_bit_cast(unsigned, b); }
__device__ __forceinline__ float bf_lo(unsigned w) { return __uint_as_float(w << 16); }
__device__ __forceinline__ float bf_hi(unsigned w) { return __uint_as_float(w & 0xffff0000u); }
__device__ __forceinline__ float sigmoidf_(float x) { return __builtin_amdgcn_rcpf(1.0f + __builtin_amdgcn_exp2f(-1.4426950408889634f * x)); }

struct EpiF32 {
    static constexpr bool AFTER_DRAIN = false; static constexpr bool PERM = false;
    float* C; int ldc;
    __device__ __forceinline__ void operator()(const f32x4 (&acc)[2][2][4][2], const Unit& u, int wr, int wc, int fr, int fq) const {
        const int row0 = u.pm * BM + wr * 64 + fr, col0 = u.pn * BM + wc * 32 + 4 * fq;
#pragma unroll
        for (int ai = 0; ai < 2; ++ai)
#pragma unroll
            for (int m = 0; m < 4; ++m) { float* rowp = C + (size_t)(row0 + ai * HALF + m * 16) * ldc + col0;
#pragma unroll
                for (int bj = 0; bj < 2; ++bj)
#pragma unroll
                    for (int n = 0; n < 2; ++n) *(f32x4*)(rowp + bj * HALF + n * 16) = acc[ai][bj][m][n]; }
    }
};
struct EpiBf16 {
    static constexpr bool AFTER_DRAIN = false; static constexpr bool PERM = true;
    bf16_t* O; int ldc;
    __device__ __forceinline__ void operator()(const f32x4 (&acc)[2][2][4][2], const Unit& u, int wr, int wc, int fr, int fq) const {
        const int row0 = u.pm * BM + wr * 64 + fr, col0 = u.pn * BM + wc * 32 + 8 * fq;
#pragma unroll
        for (int ai = 0; ai < 2; ++ai)
#pragma unroll
            for (int m = 0; m < 4; ++m) { GAS bf16_t* rowp = (GAS bf16_t*)O + (size_t)(row0 + ai * HALF + m * 16) * ldc + col0;
#pragma unroll
                for (int bj = 0; bj < 2; ++bj) { const f32x4 v0 = acc[ai][bj][m][0], v1 = acc[ai][bj][m][1];
                    u32x4 w; w.x = cvt_pk_bf16(v0[0], v0[1]); w.y = cvt_pk_bf16(v0[2], v0[3]); w.z = cvt_pk_bf16(v1[0], v1[1]); w.w = cvt_pk_bf16(v1[2], v1[3]);
                    *(GAS u32x4*)(rowp + bj * HALF) = w; } }
    }
};
struct EpiLora {
    static constexpr bool AFTER_DRAIN = false; static constexpr bool PERM = false;
    float* base; size_t stride; const float* w0; const float* a0;
    __device__ __forceinline__ void operator()(const f32x4 (&acc)[2][2][4][2], const Unit& u, int wr, int wc, int fr, int fq) const {
        const int row0 = u.pm * BM + wr * 64 + fr; const int kind = u.pn >> 2; const int col0 = (u.pn & 3) * BM + wc * 32 + 4 * fq;
        float* dst = base + (size_t)kind * stride;
        const float* bp = (kind == 0) ? w0 : a0; const float bs = (kind == 2) ? 0.f : 1.f;
        f32x4 bv[2][2];
#pragma unroll
        for (int bj = 0; bj < 2; ++bj)
#pragma unroll
            for (int n = 0; n < 2; ++n) bv[bj][n] = *(const f32x4*)(bp + col0 + bj * HALF + n * 16) * bs;
#pragma unroll
        for (int ai = 0; ai < 2; ++ai)
#pragma unroll
            for (int m = 0; m < 4; ++m) { float* rowp = dst + (size_t)(row0 + ai * HALF + m * 16) * 1024 + col0;
#pragma unroll
                for (int bj = 0; bj < 2; ++bj)
#pragma unroll
                    for (int n = 0; n < 2; ++n) { f32x4 v = acc[ai][bj][m][n] + bv[bj][n];
                        if (kind == 0) {
#pragma unroll
                            for (int j = 0; j < 4; ++j) v[j] = __expf(-0.6065306597126334f * sigmoidf_(v[j])); }
                        else if (kind == 1) {
#pragma unroll
                            for (int j = 0; j < 4; ++j) v[j] = sigmoidf_(v[j]); }
                        *(f32x4*)(rowp + bj * HALF + n * 16) = v; } }
    }
};
struct EpiGlu {
    static constexpr bool AFTER_DRAIN = false; static constexpr bool PERM = true;
    const bf16_t* Y; bf16_t* O; int ldo; const float* bias;
    __device__ __forceinline__ void operator()(const f32x4 (&acc)[2][2][4][2], const Unit& u, int wr, int wc, int fr, int fq) const {
        const int row0 = u.pm * BM + wr * 64 + fr, col0 = u.pn * BM + wc * 32 + 8 * fq;
        f32x4 bv[2][2];
#pragma unroll
        for (int bj = 0; bj < 2; ++bj)
#pragma unroll
            for (int n = 0; n < 2; ++n) bv[bj][n] = *(const GAS f32x4*)((const GAS float*)bias + col0 + bj * HALF + 4 * n);
#pragma unroll
        for (int ai = 0; ai < 2; ++ai)
#pragma unroll
            for (int m = 0; m < 4; ++m) { const size_t r = (size_t)(row0 + ai * HALF + m * 16);
#pragma unroll
                for (int bj = 0; bj < 2; ++bj) { const u32x4 yv = *(const GAS u32x4*)((const GAS bf16_t*)Y + r * 1024 + col0 + bj * HALF);
                    const f32x4 v0 = acc[ai][bj][m][0] + bv[bj][0], v1 = acc[ai][bj][m][1] + bv[bj][1];
                    u32x4 w;
                    w.x = cvt_pk_bf16(bf_lo(yv.x) * sigmoidf_(v0[0]), bf_hi(yv.x) * sigmoidf_(v0[1]));
                    w.y = cvt_pk_bf16(bf_lo(yv.y) * sigmoidf_(v0[2]), bf_hi(yv.y) * sigmoidf_(v0[3]));
                    w.z = cvt_pk_bf16(bf_lo(yv.z) * sigmoidf_(v1[0]), bf_hi(yv.z) * sigmoidf_(v1[1]));
                    w.w = cvt_pk_bf16(bf_lo(yv.w) * sigmoidf_(v1[2]), bf_hi(yv.w) * sigmoidf_(v1[3]));
                    *(GAS u32x4*)((GAS bf16_t*)O + r * ldo + col0 + bj * HALF) = w; } }
    }
};
struct EpiSwiglu {
    static constexpr bool AFTER_DRAIN = false; static constexpr bool PERM = true;
    bf16_t* Hd;
    __device__ __forceinline__ void operator()(const f32x4 (&acc)[2][2][4][2], const Unit& u, int wr, int wc, int fr, int fq) const {
        const int row0 = u.pm * BM + wr * 64 + fr, col0 = u.pn * HALF + wc * 32 + 8 * fq;
#pragma unroll
        for (int ai = 0; ai < 2; ++ai)
#pragma unroll
            for (int m = 0; m < 4; ++m) { GAS bf16_t* rowp = (GAS bf16_t*)Hd + (size_t)(row0 + ai * HALF + m * 16) * 512 + col0;
                float o[8];
#pragma unroll
                for (int n = 0; n < 2; ++n)
#pragma unroll
                    for (int j = 0; j < 4; ++j) { const float a = acc[ai][0][m][n][j], b = acc[ai][1][m][n][j]; o[n * 4 + j] = a * sigmoidf_(a) * b; }
                u32x4 w; w.x = cvt_pk_bf16(o[0], o[1]); w.y = cvt_pk_bf16(o[2], o[3]); w.z = cvt_pk_bf16(o[4], o[5]); w.w = cvt_pk_bf16(o[6], o[7]);
                *(GAS u32x4*)rowp = w; }
    }
};

struct EpiS5Scan {
    static constexpr bool AFTER_DRAIN = true; static constexpr bool PERM = false;
    bf16_t* SIN; const float* lam_re; const float* lam_im; const float* log_dt;
    __device__ __forceinline__ void operator()(const f32x4 (&)[2][2][4][2], const Unit&, int, int, int, int) const {}
    __device__ __forceinline__ void fused(const f32x4 (&acc)[2][2][4][2], const Unit& u, int wr, int wc, int fr, int fq, PG8_LAS unsigned char* lds) const {
        PG8_LAS float* T = (PG8_LAS float*)lds;
#pragma unroll
        for (int ai = 0; ai < 2; ++ai)
#pragma unroll
            for (int m = 0; m < 4; ++m)
#pragma unroll
                for (int n = 0; n < 2; ++n) *(PG8_LAS f32x4*)(T + (ai * HALF + wr * 64 + m * 16 + fr) * 128 + wc * 32 + n * 16 + 4 * fq) = acc[ai][0][m][n];
        __syncthreads();
        const int tid = threadIdx.x;
        if (tid < 128) {
            const int b2 = tid >> 6, p = tid & 63, g = u.e;
            const float lr = fminf(lam_re[g * 64 + p], -1e-4f), li = lam_im[g * 64 + p], dt = __expf(log_dt[g]);
            const float mag = __expf(lr * dt * 16.f), ang = li * dt * 16.f; const float ar = mag * cosf(ang), ai_ = mag * sinf(ang);
            float sr = 0.f, si = 0.f;
            GAS bf16_t* dst = (GAS bf16_t*)SIN + ((size_t)(u.pm * 256 + b2 * 128) * 16 + (p >> 4)) * 4352 + g * 16 + (p & 15);
            const PG8_LAS float* src = T + (b2 * 128) * 128 + p;
#pragma unroll 8
            for (int ch = 0; ch < 128; ++ch) {
                const unsigned w = cvt_pk_bf16(sr, si);
                dst[(size_t)ch * 16 * 4352] = (bf16_t)(w & 0xffffu); dst[(size_t)ch * 16 * 4352 + 4 * 4352] = (bf16_t)(w >> 16);
                const float lr_ = src[ch * 128], li_ = src[ch * 128 + 64];
                const float nr = ar * sr - ai_ * si + lr_, ni = ar * si + ai_ * sr + li_; sr = nr; si = ni;
            }
        }
    }
};
__device__ __forceinline__ float gelu_tanh_(float y) { const float u = 0.7978845608028654f * (y + 0.044715f * y * y * y); const float e = __builtin_amdgcn_exp2f(2.8853900817779268f * u); return y * (1.f - __builtin_amdgcn_rcpf(e + 1.f)); }
struct EpiS5Y {
    static constexpr bool AFTER_DRAIN = false; static constexpr bool PERM = true;
    bf16_t* Y;
    __device__ __forceinline__ void operator()(const f32x4 (&acc)[2][2][4][2], const Unit& u, int wr, int wc, int fr, int fq) const {
        const int row0 = u.pm * BM + wr * 64 + fr;
#pragma unroll
        for (int ai = 0; ai < 2; ++ai)
#pragma unroll
            for (int m = 0; m < 4; ++m) { const size_t r = (size_t)(row0 + ai * HALF + m * 16);
#pragma unroll
                for (int bj = 0; bj < 2; ++bj) { const int col = bj * HALF + wc * 32 + 8 * fq; const int t = col >> 4, c = col & 15;
                    const f32x4 v0 = acc[ai][bj][m][0], v1 = acc[ai][bj][m][1];
                    u32x4 w; w.x = cvt_pk_bf16(gelu_tanh_(v0[0]), gelu_tanh_(v0[1])); w.y = cvt_pk_bf16(gelu_tanh_(v0[2]), gelu_tanh_(v0[3]));
                    w.z = cvt_pk_bf16(gelu_tanh_(v1[0]), gelu_tanh_(v1[1])); w.w = cvt_pk_bf16(gelu_tanh_(v1[2]), gelu_tanh_(v1[3]));
                    *(GAS u32x4*)((GAS bf16_t*)Y + (r * 16 + t) * 1024 + u.e * 16 + c) = w; } }
    }
};

template <class Epi, class Sched>
__device__ __forceinline__ void gemm_phase(PG8_LAS unsigned char* lds, const int K, const Sched& S, const Epi& E) {
    const int tid = threadIdx.x, wid = __builtin_amdgcn_readfirstlane(tid >> 6), lane = tid & 63, wr = wid >> 2, wc = wid & 3, fr = lane & 15, fq = lane >> 4;
    const int nt = K / BK;
    int RR[2], CC[2]; unsigned voffB[2];
#pragma unroll
    for (int i = 0; i < 2; ++i) { stage_rc(tid * 16 + i * 8192, RR[i], CC[i]); const int Rb = Epi::PERM ? ((RR[i] & ~31) + perm32(RR[i] & 31)) : RR[i];
        voffB[i] = (unsigned)(Rb * K + CC[i]) * 2u; }
    const size_t kstep = (size_t)(BK * 2);
    const size_t hstep = (size_t)HALF * K * 2;
    const unsigned ldsw = (unsigned)wid * 1024u;
    const int aoff = lds_byte(wr * 64 + fr, fq * 8), boff = lds_byte(wc * 32 + fr, fq * 8);
#define PG8_SA(b, h) (((b) * 2 + (h)) * HTB)
#define PG8_SB(b, h) ((4 + (b) * 2 + (h)) * HTB)
#define PG8_STAGE(bufoff, gbase, voff) do { _Pragma("unroll") for (int _i = 0; _i < 2; ++_i) \
        __builtin_amdgcn_global_load_lds((const unsigned*)((const char*)(gbase) + (voff)[_i]), (PG8_LAS unsigned*)(lds + (bufoff) + ldsw + _i * 8192), 16, 0, 0); } while (0)
#define PG8_LDA(dst, b, h) do { _Pragma("unroll") for (int m = 0; m < 4; ++m) _Pragma("unroll") for (int k = 0; k < 2; ++k) dst[m][k] = *(const PG8_LAS bf16x8*)(lds + PG8_SA(b, h) + aoff + m * 2048 + k * 1024); } while (0)
#define PG8_LDB(dst, b, h) do { _Pragma("unroll") for (int n = 0; n < 2; ++n) _Pragma("unroll") for (int k = 0; k < 2; ++k) dst[n][k] = *(const PG8_LAS bf16x8*)(lds + PG8_SB(b, h) + boff + n * 2048 + k * 1024); } while (0)
#define PG8_MMA(ai, bj, At, Bt) do { __builtin_amdgcn_s_setprio(1); _Pragma("unroll") for (int m = 0; m < 4; ++m) _Pragma("unroll") for (int n = 0; n < 2; ++n) _Pragma("unroll") for (int k = 0; k < 2; ++k) \
        acc[ai][bj][m][n] = __builtin_amdgcn_mfma_f32_16x16x32_bf16(Bt[n][k], At[m][k], acc[ai][bj][m][n], 0, 0, 0); __builtin_amdgcn_s_setprio(0); } while (0)
#define PG8_WAIT_V(n) asm volatile("s_waitcnt vmcnt(" #n ")" ::: "memory")
#define PG8_WAIT_L(n) asm volatile("s_waitcnt lgkmcnt(" #n ")" ::: "memory")
#define PG8_BAR __builtin_amdgcn_s_barrier()
#define PG8_SCHED __builtin_amdgcn_sched_barrier(0)
    Unit cur, nxt; int ui = 0;
    if (!S.next(0, cur)) return;
    f32x4 acc[2][2][4][2];
#pragma unroll
    for (int a = 0; a < 2; ++a)
#pragma unroll
        for (int b = 0; b < 2; ++b)
#pragma unroll
            for (int m = 0; m < 4; ++m)
#pragma unroll
                for (int n = 0; n < 2; ++n) acc[a][b][m][n] = (f32x4){0.f, 0.f, 0.f, 0.f};
    bf16x8 At[4][2], B0[2][2], B1[2][2];
    constexpr bool GA = Sched::GATHER;
    constexpr int A2 = Sched::A2;
    constexpr int NV = GA ? 2 : 1;
    unsigned vA[NV][2], vN[NV][2];
    const size_t kstepA = S.kstepA(), hstepA = GA ? 0 : S.hstepA();
    const size_t a2off = (A2 > 0) ? S.a2off() : 0;
    S.template a_voff<NV>(cur, vA, RR, CC);
    const char* cA = cur.Ab; const char* cB = cur.Bb;
    PG8_STAGE(PG8_SB(0, 0), cB, voffB); PG8_STAGE(PG8_SB(0, 1), cB + hstep, voffB); PG8_STAGE(PG8_SA(0, 0), cA, vA[0]); PG8_STAGE(PG8_SA(0, 1), cA + hstepA, vA[NV - 1]);
    if (wr == 1) PG8_BAR;
    PG8_WAIT_V(2); PG8_BAR;
    PG8_STAGE(PG8_SB(1, 0), cB + kstep, voffB); PG8_STAGE(PG8_SA(1, 0), cA + kstepA, vA[0]); PG8_STAGE(PG8_SB(1, 1), cB + hstep + kstep, voffB);
    PG8_WAIT_V(6); PG8_BAR;
    for (;;) {
        const bool has_next = S.next(ui + 1, nxt);
        const char* nA = has_next ? nxt.Ab : cA; const char* nB = has_next ? nxt.Bb : cB;
        if constexpr (GA) {
            if (has_next) S.template a_voff<NV>(nxt, vN, RR, CC);
            else {
#pragma unroll
                for (int h = 0; h < NV; ++h)
#pragma unroll
                    for (int i = 0; i < 2; ++i) vN[h][i] = vA[h][i]; }
        }
#pragma clang loop unroll(disable)
        for (int t = 0; t < nt; t += 2) {
            const bool last = (t == nt - 2);
            const bool s1 = (A2 > 0) && (t + 1 >= A2), s2 = (A2 > 0) && !last && (t + 2 >= A2);
            const char* a1 = cA + (size_t)(t + 1) * kstepA + (s1 ? a2off : 0);
            const char* a2 = last ? nA : cA + (size_t)(t + 2) * kstepA + (s2 ? a2off : 0);
            const char* a3 = a2 + kstepA;
            const char* b2 = last ? nB : cB + (size_t)(t + 2) * kstep; const char* b3 = b2 + kstep;
            unsigned v2[NV][2];
#pragma unroll
            for (int h = 0; h < NV; ++h)
#pragma unroll
                for (int i = 0; i < 2; ++i) v2[h][i] = (GA && last) ? vN[h][i] : vA[h][i];
            PG8_LDB(B0, 0, 0); PG8_LDB(B1, 0, 1); PG8_SCHED; PG8_LDA(At, 0, 0); PG8_STAGE(PG8_SA(1, 1), a1 + hstepA, vA[NV - 1]);
            PG8_WAIT_V(8); PG8_WAIT_L(0); PG8_BAR; PG8_MMA(0, 0, At, B0); PG8_MMA(0, 1, At, B1); PG8_BAR; PG8_SCHED;
            PG8_LDA(At, 0, 1); PG8_STAGE(PG8_SB(0, 0), b2, voffB); PG8_STAGE(PG8_SB(0, 1), b2 + hstep, voffB); PG8_STAGE(PG8_SA(0, 0), a2, v2[0]);
            PG8_WAIT_V(8); PG8_WAIT_L(0); PG8_BAR; PG8_MMA(1, 0, At, B0); PG8_MMA(1, 1, At, B1); PG8_BAR; PG8_SCHED;
            PG8_LDB(B0, 1, 0); PG8_LDB(B1, 1, 1); PG8_SCHED; PG8_LDA(At, 1, 0); PG8_STAGE(PG8_SA(0, 1), a2 + hstepA, v2[NV - 1]);
            PG8_WAIT_V(8); PG8_WAIT_L(0); PG8_BAR; PG8_MMA(0, 0, At, B0); PG8_MMA(0, 1, At, B1); PG8_BAR; PG8_SCHED;
            PG8_LDA(At, 1, 1); PG8_STAGE(PG8_SB(1, 0), b3, voffB); PG8_STAGE(PG8_SB(1, 1), b3 + hstep, voffB); PG8_STAGE(PG8_SA(1, 0), a3, v2[0]);
            PG8_WAIT_V(8); PG8_WAIT_L(0); PG8_BAR; PG8_MMA(1, 0, At, B0); PG8_MMA(1, 1, At, B1); PG8_BAR; PG8_SCHED;
        }
        if (wr == 0) PG8_BAR;
        if constexpr (!Epi::AFTER_DRAIN) E(acc, cur, wr, wc, fr, fq);
        if (!has_next) break;
#pragma unroll
        for (int a = 0; a < 2; ++a)
#pragma unroll
            for (int b = 0; b < 2; ++b)
#pragma unroll
                for (int m = 0; m < 4; ++m)
#pragma unroll
                    for (int n = 0; n < 2; ++n) acc[a][b][m][n] = (f32x4){0.f, 0.f, 0.f, 0.f};
        cur = nxt; cA = nA; cB = nB; ++ui;
        if constexpr (GA) {
#pragma unroll
            for (int h = 0; h < NV; ++h)
#pragma unroll
                for (int i = 0; i < 2; ++i) vA[h][i] = vN[h][i]; }
        if (wr == 1) PG8_BAR;
    }
    PG8_WAIT_V(0);
    PG8_BAR;
    if constexpr (Epi::AFTER_DRAIN) E.fused(acc, cur, wr, wc, fr, fq, lds);
#undef PG8_SA
#undef PG8_SB
#undef PG8_STAGE
#undef PG8_LDA
#undef PG8_LDB
#undef PG8_MMA
#undef PG8_WAIT_V
#undef PG8_WAIT_L
#undef PG8_BAR
#undef PG8_SCHED
}
}
using pg8::f32x4; using pg8::f32x2; using pg8::u32x4; using pg8::u32x2; using pg8::cvt_pk_bf16; using pg8::bf_lo; using pg8::bf_hi; using pg8::sigmoidf_;

constexpr int NWAVES = 8, NTHR = 512;
constexpr int DM = 2048, NB = 8, SEQ = 2048, NT = NB * SEQ;
constexpr int DSSM = 1024, NG = 64, GC = 16, NP = 64;
constexpr int DRW = 1024, NH = 16, HD = 64;
constexpr int DIN = 4352, ZW = 3328;
constexpr int NEXP = 64, DEXP = 512, NMOD = 6 * DM;
constexpr float RMS_EPS = 1e-6f, GN_EPS = 64e-5f;
constexpr int CAP_ROWS = 49152;

constexpr size_t MiB = 1u << 20;
constexpr size_t WS_CTL = 0, CTL_ZERO_BYTES = 1 * MiB;
constexpr size_t WS_MOD = 1 * MiB;
constexpr size_t WS_RWT = 1 * MiB + 512 * 1024;
constexpr size_t WS_LORA_T = 2 * MiB + 512 * 1024;
constexpr size_t WS_GLU_T = 4 * MiB;
constexpr size_t WS_WOUT_T = 6 * MiB;
constexpr size_t WS_WIN_T = 14 * MiB;
constexpr size_t WS_TOKINFO = 31 * MiB;
constexpr size_t WS_LIST = 32 * MiB;
constexpr size_t WS_LIN = 36 * MiB;
constexpr size_t WS_H = 44 * MiB;
constexpr size_t WS_PROJ = 108 * MiB;
constexpr size_t WS_MIX = 244 * MiB;
constexpr size_t WS_EW1 = 308 * MiB;
constexpr size_t WS_EW2 = 564 * MiB;
constexpr size_t WS_SIN = 692 * MiB;
constexpr size_t WS_YSG = 828 * MiB;
constexpr size_t WS_S5MT = 860 * MiB;
constexpr size_t WS_S5WT = 872 * MiB;
constexpr size_t WS_VB = 692 * MiB;
constexpr size_t WS_GB = 724 * MiB;
constexpr size_t WS_GHQ = 756 * MiB;
constexpr size_t WS_GT = 948 * MiB;
constexpr size_t WS_BON = 950 * MiB;
constexpr size_t WS_Y = 952 * MiB;
constexpr size_t WS_X1 = 692 * MiB;
constexpr size_t WS_HID = 756 * MiB;
constexpr size_t WS_END = 984 * MiB;
constexpr size_t WS_MIXED = 108 * MiB;
constexpr size_t WS_YSLOT = 108 * MiB;
static_assert(WS_YSLOT + (size_t)CAP_ROWS * 2048 * 2 <= WS_EW1, "yslot overlay");
static_assert(WS_HID + (size_t)CAP_ROWS * 512 * 2 <= WS_END && WS_GHQ + (size_t)8192 * 12288 * 2 <= WS_GT && WS_SIN + (size_t)NT * DIN * 2 <= WS_YSG, "pool");
constexpr int CW_TMO = 0;
constexpr int CW_BAR = 4096;
constexpr int CW_CNT = 16384;
constexpr int CW_GDONE = 8192, CW_STOP = 8192 + 64, CW_PROG = 8192 + 128;
constexpr int CONV_ITEMS = NEXP * 1536;


constexpr int RING_BYTES = 131072;
constexpr int LDSCTL_OFF = 147456 - 2048;
constexpr int MISC_OFF = LDSCTL_OFF;
constexpr int TP_OFF = LDSCTL_OFF + 256;
constexpr int LDS_BYTES = 147456;

#define LAS __attribute__((address_space(3)))
typedef unsigned short bf16;
typedef GAS unsigned gu32;
#define RLX_AGENT __ATOMIC_RELAXED, __HIP_MEMORY_SCOPE_AGENT

#define XB_TMO      128
#define XB_XCNT(j)  (256  + 64 * (j))
#define XB_XSUB(j)  (1280 + 64 * (j))
#define XB_XGEN(j)  (2304 + 64 * (j))
#define XB_TOP      3328
#define XB_TOPGEN   3392
#define XCD_BAR_WORDS 3456
#define XB_SPIN_CAP (1u << 18)
__device__ __forceinline__ unsigned xb_ld(unsigned* p)              { return __hip_atomic_load(p, __ATOMIC_RELAXED, __HIP_MEMORY_SCOPE_AGENT); }
__device__ __forceinline__ unsigned xb_add(unsigned* p, unsigned v) { return __hip_atomic_fetch_add(p, v, __ATOMIC_RELAXED, __HIP_MEMORY_SCOPE_AGENT); }
__device__ __forceinline__ unsigned xb_xcc_id() { return (unsigned)__builtin_amdgcn_s_getreg((3 << 11) | 20) & 0xFu; }
#define XB_SPIN(cond, bar) do { unsigned _sp = 0; while (cond) { __builtin_amdgcn_s_sleep(1); \
    if ((++_sp & 255u) == 0u) { if (xb_ld(&(bar)[XB_TMO])) break; if (_sp > XB_SPIN_CAP) { atomicAdd(&(bar)[XB_TMO], 1u); break; } } } } while (0)
struct XcdBarrier { unsigned* bar; unsigned x; volatile LAS unsigned* st; };
__device__ __forceinline__ XcdBarrier xcd_barrier_post(unsigned* bar, volatile LAS unsigned* st) {
    XcdBarrier b; b.bar = bar; b.x = xb_xcc_id(); b.st = st;
    if (threadIdx.x == 0) (void)xb_add(&bar[XB_XCNT(b.x)], 1u);
    return b;
}
__device__ __forceinline__ void xcd_barrier_complete(unsigned* bar, unsigned x, unsigned& nloc, unsigned& nx) {
    const unsigned G = gridDim.x * gridDim.y * gridDim.z;
    unsigned sum, cnt, mine, sp = 0u;
    for (;;) {
        sum = 0u; cnt = 0u; mine = 0u;
#pragma unroll
        for (unsigned j = 0; j < 16; ++j) { const unsigned c = xb_ld(&bar[XB_XCNT(j)]); sum += c; cnt += (c > 0u) ? 1u : 0u; mine = (j == x) ? c : mine; }
        if (sum == G) break;
        __builtin_amdgcn_s_sleep(1);
        if ((++sp & 255u) == 0u) { if (xb_ld(&bar[XB_TMO])) break; if (sp > XB_SPIN_CAP) { atomicAdd(&bar[XB_TMO], 1u); break; } }
    }
    nloc = mine > 0u ? mine : 1u; nx = cnt > 0u ? cnt : 1u;
}
__device__ __forceinline__ void xcd_barrier(const XcdBarrier& b) {
    asm volatile("s_waitcnt vmcnt(0)" ::: "memory");
    __syncthreads();
    if (threadIdx.x == 0) {
        unsigned* bar = b.bar;
        __builtin_amdgcn_s_waitcnt(0);
        unsigned nloc = b.st[0], nx = b.st[1];
        if (nloc == 0u) { xcd_barrier_complete(bar, b.x, nloc, nx); b.st[0] = nloc; b.st[1] = nx; }
        const unsigned old = xb_add(&bar[XB_XSUB(b.x)], 1u);
        const unsigned gen = old / nloc;
        if (old + 1u == (gen + 1u) * nloc) {
            __builtin_amdgcn_fence(__ATOMIC_RELEASE, "agent");
            asm volatile("s_waitcnt vmcnt(0)" ::: "memory");
            const unsigned og = xb_add(&bar[XB_TOP], 1u);
            const unsigned tg = og / nx;
            if (og + 1u == (tg + 1u) * nx) xb_add(&bar[XB_TOPGEN], 1u);
            else XB_SPIN(xb_ld(&bar[XB_TOPGEN]) == tg, bar);
            __builtin_amdgcn_fence(__ATOMIC_ACQUIRE, "agent");
            xb_add(&bar[XB_XGEN(b.x)], 1u);
            asm volatile("s_waitcnt vmcnt(0)" ::: "memory");
        } else {
            XB_SPIN(xb_ld(&bar[XB_XGEN(b.x)]) == gen, bar);
            __builtin_amdgcn_fence(__ATOMIC_ACQUIRE, "agent");
            asm volatile("s_waitcnt vmcnt(0)" ::: "memory");
        }
    }
    __syncthreads();
}

struct Args { const float* in[38]; float* out; unsigned char* ws; int ph_lo, ph_hi; };
typedef const float* cfp_t;
typedef __attribute__((address_space(4))) const unsigned char* kargp_t;
struct InTab { kargp_t kp;
    __device__ __forceinline__ const float* operator[](int i) const { return *(const __attribute__((address_space(4))) cfp_t*)(kp + 8 * i); } };
struct Frame {
    LAS unsigned char* lds; volatile LAS unsigned* MISC; unsigned* ctl;
    int tid, lane, wave, vcu, G;
    InTab in; float* out; unsigned char* ws;
};
#define LDS_WAIT() asm volatile("s_waitcnt lgkmcnt(0)" ::: "memory")
#define LAUNDER(p) asm volatile("" : "+s"(p))
#define LDS_BARRIER() do { asm volatile("s_waitcnt lgkmcnt(0)" ::: "memory"); __builtin_amdgcn_s_barrier(); asm volatile("" ::: "memory"); } while (0)
#define PHASE_VIEW() Frame F = F0; LAUNDER(F.ws); LAUNDER(F.in.kp); LAUNDER(F.ctl)
__device__ __forceinline__ float wave_sum(float v) {
#pragma unroll
    for (int o = 1; o < 64; o <<= 1) v += __shfl_xor(v, o);
    return v;
}
__device__ __forceinline__ float wave_max(float v) {
#pragma unroll
    for (int o = 1; o < 64; o <<= 1) v = fmaxf(v, __shfl_xor(v, o));
    return v;
}
__device__ __forceinline__ float row16_sum(float x) {
    x += __builtin_bit_cast(float, __builtin_amdgcn_update_dpp(0, __builtin_bit_cast(int, x), 0xB1, 0xf, 0xf, false));
    x += __builtin_bit_cast(float, __builtin_amdgcn_update_dpp(0, __builtin_bit_cast(int, x), 0x4E, 0xf, 0xf, false));
    x += __builtin_bit_cast(float, __builtin_amdgcn_update_dpp(0, __builtin_bit_cast(int, x), 0x141, 0xf, 0xf, false));
    x += __builtin_bit_cast(float, __builtin_amdgcn_update_dpp(0, __builtin_bit_cast(int, x), 0x140, 0xf, 0xf, false));
    return x;
}
__device__ __forceinline__ unsigned pk2(float lo, float hi) { return cvt_pk_bf16(lo, hi); }
__device__ __forceinline__ float bf2f(bf16 b) { return __uint_as_float(((unsigned)b) << 16); }
__device__ __forceinline__ float gelu_tanh(float y) { const float u = 0.7978845608028654f * (y + 0.044715f * y * y * y); const float e = __expf(2.f * u); const float th = 1.f - 2.f / (e + 1.f); return 0.5f * y * (1.f + th); }

__device__ __forceinline__ void transpose_item(const float* W, int N, bf16* WT, int ldk, int dst_row0, int k0, int n0, int kdst0, LAS float* scr, int lane) {
    float tv[32];
#pragma unroll
    for (int i = 0; i < 32; ++i) tv[i] = W[(size_t)(k0 + 2 * i + (lane >> 5)) * N + n0 + (lane & 31)];
#pragma unroll
    for (int i = 0; i < 32; ++i) scr[(2 * i + (lane >> 5)) * 33 + (lane & 31)] = tv[i];
    LDS_WAIT(); asm volatile("" ::: "memory");
    const int c = lane & 7;
#pragma unroll
    for (int j = 0; j < 4; ++j) { const int n = (lane >> 3) + 8 * j; const LAS float* s = scr + (8 * c) * 33 + n;
        u32x4 o; o.x = pk2(s[0 * 33], s[1 * 33]); o.y = pk2(s[2 * 33], s[3 * 33]); o.z = pk2(s[4 * 33], s[5 * 33]); o.w = pk2(s[6 * 33], s[7 * 33]);
        *(u32x4*)(WT + (size_t)(dst_row0 + n) * ldk + kdst0 + 8 * c) = o; }
    LDS_WAIT(); asm volatile("" ::: "memory");
}

constexpr int PROJ_PITCH = DIN * 2;
template <int PASS> struct S5Order {
    static constexpr bool GATHER = false; static constexpr int A2 = PASS == 2 ? 4 : 0;
    static constexpr int KB = PASS == 2 ? 384 : 256;
    const char* U; const char* SIN; const char* BT; int G, c;
    __device__ __forceinline__ size_t kstepA() const { return (size_t)4 * PROJ_PITCH; }
    __device__ __forceinline__ size_t hstepA() const { return (size_t)128 * 16 * PROJ_PITCH; }
    __device__ __forceinline__ size_t a2off() const { return (size_t)(SIN - U) - (size_t)A2 * kstepA(); }
    __device__ bool next(int i, pg8::Unit& u) const {
        const int L = i * G + c; if (L >= NG * 4) return false;
        const int g = L >> 2, pm = L & 3; u.e = g; u.pm = pm; u.pn = 0; u.cnt = 256;
        u.Ab = U + (size_t)g * 32 + (size_t)pm * 256 * 16 * PROJ_PITCH; u.Bb = BT + (size_t)g * 256 * KB * 2;
        return true;
    }
    template <int NV> __device__ __forceinline__ void a_voff(const pg8::Unit&, unsigned (&v)[NV][2], const int (&R)[2], const int (&C)[2]) const {
#pragma unroll
        for (int i = 0; i < 2; ++i) v[0][i] = (unsigned)(R[i] * 16 * PROJ_PITCH + (C[i] >> 4) * PROJ_PITCH + (C[i] & 15) * 2);
    }
};
__device__ __forceinline__ void s5_build(const Frame& F, int g) {
    const float* lam_re = F.in[10]; const float* lam_im = F.in[11]; const float* log_dt = F.in[12];
    const float* b_re = F.in[13]; const float* b_im = F.in[14]; const float* c_re = F.in[15]; const float* c_im = F.in[16]; const float* dsk = F.in[17];
    LAS float* pwr = (LAS float*)F.lds; LAS float* pwi = pwr + 17 * 64; LAS float* bbr = pwi + 17 * 64; LAS float* bbi = bbr + 1024; LAS float* cre = bbi + 1024; LAS float* cim = cre + 1024; LAS float* Kt = cim + 1024;
    bf16* MT = (bf16*)(F.ws + WS_S5MT) + (size_t)g * 256 * 384; bf16* WT = (bf16*)(F.ws + WS_S5WT) + (size_t)g * 256 * 256;
    const float dt = __expf(log_dt[g]);
    __syncthreads();
    for (int i = F.tid; i < 17 * 64; i += NTHR) { const int tau = i >> 6, p = i & 63; const float lr = fminf(lam_re[g * NP + p], -1e-4f), li = lam_im[g * NP + p];
        const float mag = __expf(lr * dt * (float)tau), ang = li * dt * (float)tau; pwr[i] = mag * cosf(ang); pwi[i] = mag * sinf(ang); }
    for (int i = F.tid; i < 1024; i += NTHR) { const int p = i >> 4; const float lr = fminf(lam_re[g * NP + p], -1e-4f), li = lam_im[g * NP + p];
        const float mag = __expf(lr * dt), ang = li * dt; const float ar = mag * cosf(ang), ai = mag * sinf(ang), den = lr * lr + li * li;
        const float qr = ((ar - 1.f) * lr + ai * li) / den, qi = (ai * lr - (ar - 1.f) * li) / den;
        const float br = b_re[(size_t)g * 1024 + i], bi = b_im[(size_t)g * 1024 + i]; bbr[i] = qr * br - qi * bi; bbi[i] = qr * bi + qi * br;
        cre[i] = c_re[(size_t)g * 1024 + i]; cim[i] = c_im[(size_t)g * 1024 + i]; }
    __syncthreads();
    for (int i = F.tid; i < 4096; i += NTHR) { const int tau = i >> 8, c = (i >> 4) & 15, c2 = i & 15; float acc = 0.f;
        for (int p = 0; p < 64; ++p) { const float cr = cre[c * 64 + p], ci = cim[c * 64 + p], pr = pwr[tau * 64 + p], pi = pwi[tau * 64 + p];
            const float car = cr * pr - ci * pi, cai = cr * pi + ci * pr; acc += car * bbr[p * 16 + c2] - cai * bbi[p * 16 + c2]; }
        Kt[i] = acc; }
    __syncthreads();
    for (int i = F.tid; i < 256 * 192; i += NTHR) { const int row = i / 192, col = (i % 192) * 2; const int t = row >> 4, c = row & 15; float v[2];
#pragma unroll
        for (int q = 0; q < 2; ++q) { const int cc = col + q;
            if (cc < 256) { const int j = cc >> 4, c2 = cc & 15; float x = (j <= t) ? Kt[(t - j) * 256 + c * 16 + c2] : 0.f; if (j == t && c2 == c) x += dsk[g * GC + c]; v[q] = x; }
            else { const int pp = cc - 256, p = pp & 63; const float pr = pwr[(t + 1) * 64 + p], pi = pwi[(t + 1) * 64 + p], cr = cre[c * 64 + p], ci = cim[c * 64 + p];
                v[q] = (pp < 64) ? (cr * pr - ci * pi) : -(cr * pi + ci * pr); } }
        *(unsigned*)(MT + (size_t)row * 384 + col) = pk2(v[0], v[1]); }
    for (int i = F.tid; i < 128 * 128; i += NTHR) { const int row = i >> 7, col = (i & 127) * 2; const int part = row >> 6, p = row & 63; float v[2];
#pragma unroll
        for (int q = 0; q < 2; ++q) { const int cc = col + q, j = cc >> 4, c2 = cc & 15; const float pr = pwr[(15 - j) * 64 + p], pi = pwi[(15 - j) * 64 + p], br = bbr[p * 16 + c2], bi = bbi[p * 16 + c2];
            v[q] = part == 0 ? (pr * br - pi * bi) : (pr * bi + pi * br); }
        *(unsigned*)(WT + (size_t)row * 256 + col) = pk2(v[0], v[1]); }
    __syncthreads();
}

__device__ __forceinline__ void p0_prologue(const Frame& F0) {
    PHASE_VIEW();
    const float* c = F.in[1]; const float* ada_w = F.in[2]; const float* ada_b = F.in[3];
    float* mod = (float*)(F.ws + WS_MOD);
    LAS float* sc = (LAS float*)F.lds;
    LAS float* red = (LAS float*)(F.lds + 65536);
    for (int i = F.tid; i < NB * DM; i += NTHR) { const float v = c[i]; sc[i] = v / (1.f + __expf(-v)); }
    __syncthreads();
    for (int item = F.vcu; item < NMOD / 64; item += F.G) {
        const int col = item * 64 + F.lane, ks = F.wave;
        float acc[8] = {0.f, 0.f, 0.f, 0.f, 0.f, 0.f, 0.f, 0.f};
        for (int k = ks * 256; k < ks * 256 + 256; k += 16) { float w[16];
#pragma unroll
            for (int u = 0; u < 16; ++u) w[u] = ada_w[(size_t)(k + u) * NMOD + col];
#pragma unroll
            for (int u = 0; u < 16; ++u)
#pragma unroll
                for (int b = 0; b < 8; ++b) acc[b] += sc[b * DM + k + u] * w[u]; }
#pragma unroll
        for (int b = 0; b < 8; ++b) red[(ks * 8 + b) * 64 + F.lane] = acc[b];
        __syncthreads();
        { const int b = F.wave; float s = 0.f;
#pragma unroll
          for (int k2 = 0; k2 < 8; ++k2) s += red[(k2 * 8 + b) * 64 + F.lane];
          mod[b * NMOD + col] = s + ada_b[col]; }
        __syncthreads();
    }
    __syncthreads();
    for (int g = F.G - 1 - F.vcu; g < NG; g += F.G) s5_build(F, g);
    LAS float* scr = (LAS float*)(F.lds + F.wave * 16384);
    const int gw = F.vcu * NWAVES + F.wave, NGW = F.G * NWAVES;
    bf16* WinT = (bf16*)(F.ws + WS_WIN_T); bf16* WoutT = (bf16*)(F.ws + WS_WOUT_T); bf16* GluT = (bf16*)(F.ws + WS_GLU_T); bf16* LoraT = (bf16*)(F.ws + WS_LORA_T);
    constexpr int I_IN = (DM / 64) * (DIN / 32), I_OUT = (DM / 64) * (DM / 32), I_GLU = (DSSM / 64) * (DSSM / 32), I_W = 32, I_A = 32, I_G = 64;
    constexpr int NITEMS = I_IN + I_OUT + I_GLU + I_W + I_A + I_G;
    for (int it = gw; it < NITEMS; it += NGW) {
        int r = it;
        if (r < I_IN) { const int nb = DIN / 32, kb = r / nb, n0 = (r % nb) * 32; transpose_item(F.in[8], DIN, WinT, DM, n0, kb * 64, n0, kb * 64, scr, F.lane); continue; } r -= I_IN;
        if (r < I_OUT) { const int nb = DM / 32, kb = r / nb, n0 = (r % nb) * 32; transpose_item(F.in[9], DM, WoutT, DM, n0, kb * 64, n0, kb * 64, scr, F.lane); continue; } r -= I_OUT;
        if (r < I_GLU) { const int nb = DSSM / 32, kb = r / nb, n0 = (r % nb) * 32; transpose_item(F.in[18], DSSM, GluT, DSSM, n0, kb * 64, n0, kb * 64, scr, F.lane); continue; } r -= I_GLU;
        if (r < I_W) { transpose_item(F.in[22], DRW, LoraT, 256, r * 32, 0, r * 32, 0, scr, F.lane); continue; } r -= I_W;
        if (r < I_A) { transpose_item(F.in[24], DRW, LoraT, 256, 1024 + r * 32, 0, r * 32, 64, scr, F.lane); continue; } r -= I_A;
        { const int kb = r / 32, n0 = (r % 32) * 32; transpose_item(F.in[25], DRW, LoraT, 256, 2048 + n0, kb * 64, n0, 128 + kb * 64, scr, F.lane); }
    }
    for (int p = blockIdx.x * NTHR + F.tid; p < 3072 * 32; p += F.G * NTHR) { const int row = p >> 5, c8 = (p & 31) * 8; const int kind = row >> 10;
        const bool data = kind == 0 ? (c8 < 64) : (kind == 1 ? (c8 >= 64 && c8 < 128) : (c8 >= 128));
        if (!data) *(u32x4*)(LoraT + (size_t)row * 256 + c8) = (u32x4){0u, 0u, 0u, 0u}; }
    bf16* rwt = (bf16*)(F.ws + WS_RWT);
    for (int p = blockIdx.x * NTHR + F.tid; p < 64 * 5 * 64 * 8; p += F.G * NTHR) { const int e = p & 7, ln = (p >> 3) & 63, jt = (p >> 9) % 5, ks = (p >> 9) / 5;
        const int j = 16 * jt + (ln & 15), k = 32 * ks + 8 * (ln >> 4) + e;
        const float w = j < 8 ? F.in[31][k * 8 + j] : (j < 72 ? F.in[33][k * 64 + (j - 8)] : 0.f);
        const unsigned hi = pk2(w, 0.f) & 0xffffu; const float wl = w - __uint_as_float(hi << 16);
        const size_t o = ((size_t)((ks * 5 + jt) * 2) * 64 + ln) * 8 + e;
        rwt[o] = (bf16)hi; rwt[o + 512] = (bf16)(pk2(wl, 0.f) & 0xffffu); }
}

__device__ __forceinline__ void p1_h1(const Frame& F0) {
    PHASE_VIEW();
    const GAS float* x = (const GAS float*)F.in[0]; const GAS float* g = (const GAS float*)F.in[4]; const GAS float* mod = (const GAS float*)(F.ws + WS_MOD); GAS bf16* H = (GAS bf16*)(F.ws + WS_H);
    const int gw = F.vcu * NWAVES + F.wave, NGW = F.G * NWAVES;
    f32x4 gv[8];
#pragma unroll
    for (int j = 0; j < 8; ++j) gv[j] = *(const GAS f32x4*)(g + 4 * (F.lane + 64 * j));
    for (int row = gw; row < NT; row += NGW) {
        const int b = row >> 11; const GAS f32x4* xr = (const GAS f32x4*)(x + (size_t)row * DM) + F.lane;
        f32x4 v[8], sh[8], scv[8]; float ss = 0.f;
#pragma unroll
        for (int j = 0; j < 8; ++j) { v[j] = xr[64 * j]; sh[j] = *(const GAS f32x4*)(mod + b * NMOD + 4 * (F.lane + 64 * j)); scv[j] = *(const GAS f32x4*)(mod + b * NMOD + DM + 4 * (F.lane + 64 * j)); }
#pragma unroll
        for (int j = 0; j < 8; ++j) ss += (v[j].x * v[j].x + v[j].y * v[j].y) + (v[j].z * v[j].z + v[j].w * v[j].w);
        const float rs = rsqrtf(wave_sum(ss) * (1.f / DM) + RMS_EPS);
        u32x2 w[8];
#pragma unroll
        for (int j = 0; j < 8; ++j) { const f32x4 h = v[j] * rs * gv[j] * (scv[j] + 1.0f) + sh[j]; w[j].x = pk2(h.x, h.y); w[j].y = pk2(h.z, h.w); }
        GAS u32x2* o = (GAS u32x2*)(H + (size_t)row * DM) + F.lane;
#pragma unroll
        for (int j = 0; j < 8; ++j) o[64 * j] = w[j];
    }
}

typedef short bf16x8_t __attribute__((ext_vector_type(8)));
#define MFMA16(a, b, c) __builtin_amdgcn_mfma_f32_16x16x32_bf16((a), (b), (c), 0, 0, 0)
__device__ __forceinline__ bf16x8_t lfrag(const LAS bf16* m, int pitch, int row, int k0) { return *(const LAS bf16x8_t*)(m + row * pitch + k0); }
__device__ __forceinline__ void st4(LAS bf16* p, const f32x4& v) { u32x2 w; w.x = pk2(v[0], v[1]); w.y = pk2(v[2], v[3]); *(LAS u32x2*)p = w; }
constexpr int CH_T = 32, CHP_K = 72, CHP_T = 40;
constexpr int CH_GRP_BYTES = 66560;
constexpr size_t GHQ_CHUNK = 12288;
__device__ __forceinline__ float wave_sum_dpp(float x) {
    x = row16_sum(x);
    x += __builtin_bit_cast(float, __builtin_amdgcn_update_dpp(0, __builtin_bit_cast(int, x), 0x142, 0xa, 0xf, false));
    x += __builtin_bit_cast(float, __builtin_amdgcn_update_dpp(0, __builtin_bit_cast(int, x), 0x143, 0xc, 0xf, false));
    return __builtin_bit_cast(float, __builtin_amdgcn_readlane(__builtin_bit_cast(int, x), 63));
}
__device__ __forceinline__ void wave_sum8_dpp(float (&x)[8]) {
#define WS8_STAGE(ctrl, rmask) _Pragma("unroll") for (int i_ = 0; i_ < 8; ++i_) x[i_] += __builtin_bit_cast(float, __builtin_amdgcn_update_dpp(0, __builtin_bit_cast(int, x[i_]), ctrl, rmask, 0xf, false));
    WS8_STAGE(0xB1, 0xf) WS8_STAGE(0x4E, 0xf) WS8_STAGE(0x141, 0xf) WS8_STAGE(0x140, 0xf) WS8_STAGE(0x142, 0xa) WS8_STAGE(0x143, 0xc)
#undef WS8_STAGE
#pragma unroll
    for (int i = 0; i < 8; ++i) x[i] = __builtin_bit_cast(float, __builtin_amdgcn_readlane(__builtin_bit_cast(int, x[i]), 63));
}
__device__ __forceinline__ float tanh_fast(float x) { const float e = __builtin_amdgcn_exp2f(2.8853900817779268f * x); return 1.f - 2.f * __builtin_amdgcn_rcpf(e + 1.f); }
#define INV_P8(acc, A0, L0, M0, A1, L1, M1, A2, L2, M2, A3, L3, M3, A4, L4, M4, A5, L5, M5, A6, L6, M6, A7, L7, M7) do { float tmp_; asm volatile("v_readlane_b32 %1, %2, %10\n\tv_fmac_f32 %0, %1, %18\n\tv_readlane_b32 %1, %3, %11\n\tv_fmac_f32 %0, %1, %19\n\tv_readlane_b32 %1, %4, %12\n\tv_fmac_f32 %0, %1, %20\n\tv_readlane_b32 %1, %5, %13\n\tv_fmac_f32 %0, %1, %21\n\tv_readlane_b32 %1, %6, %14\n\tv_fmac_f32 %0, %1, %22\n\tv_readlane_b32 %1, %7, %15\n\tv_fmac_f32 %0, %1, %23\n\tv_readlane_b32 %1, %8, %16\n\tv_fmac_f32 %0, %1, %24\n\tv_readlane_b32 %1, %9, %17\n\tv_fmac_f32 %0, %1, %25" : "+v"(acc), "=&s"(tmp_) : "v"(A0), "v"(A1), "v"(A2), "v"(A3), "v"(A4), "v"(A5), "v"(A6), "v"(A7), "i"(L0), "i"(L1), "i"(L2), "i"(L3), "i"(L4), "i"(L5), "i"(L6), "i"(L7), "v"(M0), "v"(M1), "v"(M2), "v"(M3), "v"(M4), "v"(M5), "v"(M6), "v"(M7)); } while (0)
#define INV_P4(acc, A0, L0, M0, A1, L1, M1, A2, L2, M2, A3, L3, M3) do { float tmp_; asm volatile("v_readlane_b32 %1, %2, %6\n\tv_fmac_f32 %0, %1, %10\n\tv_readlane_b32 %1, %3, %7\n\tv_fmac_f32 %0, %1, %11\n\tv_readlane_b32 %1, %4, %8\n\tv_fmac_f32 %0, %1, %12\n\tv_readlane_b32 %1, %5, %9\n\tv_fmac_f32 %0, %1, %13" : "+v"(acc), "=&s"(tmp_) : "v"(A0), "v"(A1), "v"(A2), "v"(A3), "i"(L0), "i"(L1), "i"(L2), "i"(L3), "v"(M0), "v"(M1), "v"(M2), "v"(M3)); } while (0)
#define INV_P2(acc, A0, L0, M0, A1, L1, M1) do { float tmp_; asm volatile("v_readlane_b32 %1, %2, %4\n\tv_fmac_f32 %0, %1, %6\n\tv_readlane_b32 %1, %3, %5\n\tv_fmac_f32 %0, %1, %7" : "+v"(acc), "=&s"(tmp_) : "v"(A0), "v"(A1), "i"(L0), "i"(L1), "v"(M0), "v"(M1)); } while (0)
#define INV_P1(acc, A0, L0, M0) do { float tmp_; asm volatile("v_readlane_b32 %1, %2, %3\n\tv_fmac_f32 %0, %1, %4" : "+v"(acc), "=&s"(tmp_) : "v"(A0), "i"(L0), "v"(M0)); } while (0)
__device__ __forceinline__ void p9a_rwkv_chunks(const Frame& F0) {
    PHASE_VIEW();
    const GAS bf16* PROJ = (const GAS bf16*)(F.ws + WS_PROJ); const GAS bf16* LoraT = (const GAS bf16*)(F.ws + WS_LORA_T);
    GAS bf16* VB = (GAS bf16*)(F.ws + WS_VB); GAS bf16* GB = (GAS bf16*)(F.ws + WS_GB); GAS float* BON = (GAS float*)(F.ws + WS_BON);
    const float* mu = F.in[20]; const float* w0 = F.in[21]; const float* a0 = F.in[23]; const float* k_k = F.in[26]; const float* k_a = F.in[27]; const float* r_k = F.in[28];
    GAS bf16* GHQ = (GAS bf16*)(F.ws + WS_GHQ); GAS float* GT = (GAS float*)(F.ws + WS_GT);
    const int grp = F.tid >> 8, gt = F.tid & 255, gw = (F.tid >> 6) & 3, lo = F.lane & 15, hi = F.lane >> 4;
    LAS unsigned char* gb = F.lds + grp * CH_GRP_BYTES;
    LAS bf16* At = (LAS bf16*)gb; LAS bf16* Bt = At + 32 * CHP_K; LAS bf16* Kt = Bt + 32 * CHP_K; LAS bf16* Rt = Kt + 32 * CHP_K;
    LAS bf16* X1T = At; LAS bf16* P1T = X1T + 64 * CHP_T; LAS bf16* Minv = P1T + 64 * CHP_T; LAS bf16* XG = At;
    LAS bf16* AtT = Rt + 32 * CHP_K; LAS bf16* BhT = AtT + 64 * CHP_T; LAS bf16* KhT = BhT + 64 * CHP_T; LAS bf16* VmT = KhT + 64 * CHP_T;
    LAS float* AabF = (LAS float*)(VmT + 64 * CHP_T);
    LAS bf16* Aak = (LAS bf16*)(AabF + 32 * 36); LAS bf16* Arb = Aak + 32 * CHP_T; LAS bf16* Ark = Arb + 32 * CHP_T; LAS bf16* P2T = Ark + 32 * CHP_T;
    LAS float* LWs = AabF; LAS float* AAs = LWs + 32 * 68;
    LAS float* part = (LAS float*)(P2T + 64 * CHP_T);
    LAS bf16* XW = (LAS bf16*)(part + 256); LAS bf16* XA = XW + 32 * CHP_K;
    const f32x4 z4 = (f32x4){0.f, 0.f, 0.f, 0.f};
    LAS unsigned* gbw = (LAS unsigned*)(F.lds + MISC_OFF) + 40 + grp; unsigned gb_target = 0u;
    __syncthreads(); if (gt == 0) *(volatile LAS unsigned*)gbw = 0u; __syncthreads();
#define GROUP_BARRIER() do { gb_target += 4u; asm volatile("s_waitcnt lgkmcnt(0)" ::: "memory"); \
        if (F.lane == 0) (void)__hip_atomic_fetch_add(gbw, 1u, __ATOMIC_RELAXED, __HIP_MEMORY_SCOPE_WORKGROUP); \
        while (*(volatile LAS unsigned*)gbw < gb_target) __builtin_amdgcn_s_sleep(1); \
        asm volatile("" ::: "memory"); } while (0)
    for (int it0 = F.vcu * 2; it0 < NB * (SEQ / CH_T); it0 += F.G * 2) {
        const int item = it0 + grp; const int c = item & 63, b = item >> 6;
        const size_t tok0 = (size_t)b * SEQ + c * CH_T;
        GROUP_BARRIER();
#pragma unroll 4
        for (int i = 0; i < 16; ++i) { const int pidx = gt + 256 * i, t = pidx >> 7, cp = (pidx & 127) * 2;
            const unsigned zw = *(const GAS unsigned*)(PROJ + (tok0 + t) * DIN + 4096 + cp);
            const unsigned pw = (c == 0 && t == 0) ? 0u : *(const GAS unsigned*)(PROJ + (tok0 + t - 1) * DIN + 4096 + cp);
            const f32x2 m = *(const f32x2*)(mu + 3072 + cp);
            const float z0 = bf_lo(zw), z1 = bf_hi(zw); const float v0 = z0 + m.x * (bf_lo(pw) - z0), v1 = z1 + m.y * (bf_hi(pw) - z1);
            if (cp < 64) *(LAS unsigned*)(XW + t * CHP_K + cp) = pk2(tanh_fast(v0), tanh_fast(v1));
            else if (cp < 128) *(LAS unsigned*)(XA + t * CHP_K + cp - 64) = pk2(v0, v1);
            else *(LAS unsigned*)(XG + t * 136 + cp - 128) = pk2(sigmoidf_(v0), sigmoidf_(v1)); }
        GROUP_BARRIER();
        { bf16x8_t xg[2][4];
#pragma unroll
          for (int mt = 0; mt < 2; ++mt)
#pragma unroll
              for (int ks = 0; ks < 4; ++ks) xg[mt][ks] = lfrag(XG, 136, 16 * mt + lo, 32 * ks + 8 * hi);
#pragma unroll 1
          for (int hh = 0; hh < NH; ++hh) { const int n0 = hh * 64 + 16 * gw; f32x4 dg[2] = {z4, z4};
#pragma unroll
              for (int ks = 0; ks < 4; ++ks) { const bf16x8_t yg = *(const GAS bf16x8_t*)(LoraT + (size_t)(2048 + n0 + lo) * 256 + 128 + 32 * ks + 8 * hi);
                  dg[0] = MFMA16(yg, xg[0][ks], dg[0]); dg[1] = MFMA16(yg, xg[1][ks], dg[1]); }
#pragma unroll
              for (int mt = 0; mt < 2; ++mt) { u32x2 w; w.x = pk2(dg[mt][0], dg[mt][1]); w.y = pk2(dg[mt][2], dg[mt][3]); *(GAS u32x2*)(GB + (tok0 + 16 * mt + lo) * 1024 + n0 + 4 * hi) = w; } }
        }
        const int k = gt & 63, tq = gw; const bool first = (c == 0 && tq == 0);
        const GAS bf16* pp = PROJ + (tok0 + tq * 8) * DIN + 1024 + k;
        bf16 nr[9], nk[9], nv[9];
#pragma unroll
        for (int i = 0; i < 9; ++i) { const GAS bf16* q = pp + (ptrdiff_t)(i - 1) * DIN; const bool z = first && i == 0;
            nr[i] = z ? (bf16)0 : q[0]; nk[i] = z ? (bf16)0 : q[1024]; nv[i] = z ? (bf16)0 : q[2048]; }
        bf16x8_t lyw[2], lya[2]; f32x4 lw0, la0; float cmur, cmuk, cmuv, ckk, cka, crk;
#define HEAD_LOADS(hn_) do { const int n1_ = (hn_) * 64 + 16 * gw, ch1_ = (hn_) * 64 + k; \
            _Pragma("unroll") for (int ks = 0; ks < 2; ++ks) { lyw[ks] = *(const GAS bf16x8_t*)(LoraT + (size_t)(n1_ + lo) * 256 + 32 * ks + 8 * hi); lya[ks] = *(const GAS bf16x8_t*)(LoraT + (size_t)(1024 + n1_ + lo) * 256 + 64 + 32 * ks + 8 * hi); } \
            lw0 = *(const GAS f32x4*)((const GAS float*)w0 + n1_ + 4 * hi); la0 = *(const GAS f32x4*)((const GAS float*)a0 + n1_ + 4 * hi); \
            cmur = ((const GAS float*)mu)[ch1_]; cmuk = ((const GAS float*)mu)[1024 + ch1_]; cmuv = ((const GAS float*)mu)[2048 + ch1_]; \
            ckk = ((const GAS float*)k_k)[ch1_]; cka = ((const GAS float*)k_a)[ch1_]; crk = ((const GAS float*)r_k)[ch1_]; } while (0)
        HEAD_LOADS(0);
#pragma unroll 1
        for (int h = 0; h < NH; ++h) {
            const int ci = (b * NH + h) * 64 + c; const int ch = h * 64 + k;
            GROUP_BARRIER();
            { const int n0 = h * 64 + 16 * gw; f32x4 dw[2] = {z4, z4}, da[2] = {z4, z4};
#pragma unroll
              for (int ks = 0; ks < 2; ++ks) { const bf16x8_t yw = lyw[ks], ya = lya[ks];
#pragma unroll
                  for (int mt = 0; mt < 2; ++mt) { dw[mt] = MFMA16(yw, lfrag(XW, CHP_K, 16 * mt + lo, 32 * ks + 8 * hi), dw[mt]); da[mt] = MFMA16(ya, lfrag(XA, CHP_K, 16 * mt + lo, 32 * ks + 8 * hi), da[mt]); } }
              const f32x4 w0v = lw0, a0v = la0;
#pragma unroll
              for (int mt = 0; mt < 2; ++mt) { const int t = 16 * mt + lo; f32x4 lwv, aav;
#pragma unroll
                  for (int r = 0; r < 4; ++r) { lwv[r] = (-0.6065306597126334f * 1.4426950408889634f) * sigmoidf_(dw[mt][r] + w0v[r]);     aav[r] = sigmoidf_(da[mt][r] + a0v[r]); }
                  *(LAS f32x4*)(LWs + t * 68 + 16 * gw + 4 * hi) = lwv; *(LAS f32x4*)(AAs + t * 68 + 16 * gw + 4 * hi) = aav; }
            }
            GROUP_BARRIER();
            { const float mur = cmur, muk = cmuk, muv = cmuv, kkc = ckk, kac = cka, rkc = crk;
              float lw[8], ls[8], rv[8], kv[8], vv[8], av[8], bv[8]; float run = 0.f;
              float kraw[8], x8[8];
#pragma unroll
              for (int i = 0; i < 8; ++i) { const int t = tq * 8 + i;
                  const float zr = bf2f(nr[i + 1]), zk = bf2f(nk[i + 1]), zv = bf2f(nv[i + 1]), pr = bf2f(nr[i]), pk_ = bf2f(nk[i]), pv = bf2f(nv[i]);
                  rv[i] = zr + mur * (pr - zr); kraw[i] = zk + muk * (pk_ - zk); vv[i] = zv + muv * (pv - zv);
                  av[i] = AAs[t * 68 + k]; lw[i] = LWs[t * 68 + k];
                  const float kk = kraw[i] * kkc; x8[i] = kk * kk; }
              wave_sum8_dpp(x8);
#pragma unroll
              for (int i = 0; i < 8; ++i) { const float a = av[i]; const float kk = kraw[i] * kkc * __builtin_amdgcn_rsqf(fmaxf(x8[i], 1e-24f));
                  const float km = kraw[i] * (1.f + (a - 1.f) * kac);
                  x8[i] = rv[i] * km * rkc; kv[i] = km; av[i] = -kk; bv[i] = kk * a; run += lw[i]; ls[i] = run; }
              wave_sum8_dpp(x8);
              { float bsel = x8[0];
#pragma unroll
                for (int i = 1; i < 8; ++i) bsel = (F.lane == i) ? x8[i] : bsel;
                if (F.lane < 8) BON[(tok0 + tq * 8 + F.lane) * 16 + h] = bsel; }
              if (h + 1 < NH) {
#pragma unroll
                  for (int i = 0; i < 9; ++i) { const GAS bf16* q = pp + (ptrdiff_t)(i - 1) * DIN + (h + 1) * 64; const bool z = first && i == 0;
                      nr[i] = z ? (bf16)0 : q[0]; nk[i] = z ? (bf16)0 : q[1024]; nv[i] = z ? (bf16)0 : q[2048]; } }
              { u32x4 w; w.x = pk2(vv[0], vv[1]); w.y = pk2(vv[2], vv[3]); w.z = pk2(vv[4], vv[5]); w.w = pk2(vv[6], vv[7]);
                GAS bf16* vb = VB + (tok0 + tq * 8) * 1024 + ch;
                vb[0] = (bf16)(w.x & 0xffffu); vb[1024] = (bf16)(w.x >> 16); vb[2048] = (bf16)(w.y & 0xffffu); vb[3072] = (bf16)(w.y >> 16);
                vb[4096] = (bf16)(w.z & 0xffffu); vb[5120] = (bf16)(w.z >> 16); vb[6144] = (bf16)(w.w & 0xffffu); vb[7168] = (bf16)(w.w >> 16); }
              part[tq * 64 + k] = run;
              GROUP_BARRIER();
              float off = 0.f, tot = 0.f;
#pragma unroll
              for (int q = 0; q < 4; ++q) { const float pq = part[q * 64 + k]; tot += pq; if (q < tq) off += pq; }
              if (tq == 0) GT[(size_t)ci * 64 + k] = __builtin_amdgcn_exp2f(tot);
              float aT[8], bT[8], kT[8];
#pragma unroll
              for (int i = 0; i < 8; ++i) { const int t = tq * 8 + i; const float lg = off + ls[i], lgm = lg - lw[i];
                  const float eneg = __builtin_amdgcn_exp2f(-lg), eh = __builtin_amdgcn_exp2f(tot - lg);
                  const float at = av[i] * __builtin_amdgcn_exp2f(lgm);
                  const unsigned wa = pk2(at, bv[i] * eneg), wk = pk2(kv[i] * eneg, rv[i] * __builtin_amdgcn_exp2f(lg));
                  At[t * CHP_K + k] = (bf16)(wa & 0xffffu); Bt[t * CHP_K + k] = (bf16)(wa >> 16); Kt[t * CHP_K + k] = (bf16)(wk & 0xffffu); Rt[t * CHP_K + k] = (bf16)(wk >> 16);
                  aT[i] = at; bT[i] = bv[i] * eh; kT[i] = kv[i] * eh; }
              u32x4 w;
              w.x = pk2(aT[0], aT[1]); w.y = pk2(aT[2], aT[3]); w.z = pk2(aT[4], aT[5]); w.w = pk2(aT[6], aT[7]); *(LAS u32x4*)(AtT + k * CHP_T + tq * 8) = w;
              w.x = pk2(bT[0], bT[1]); w.y = pk2(bT[2], bT[3]); w.z = pk2(bT[4], bT[5]); w.w = pk2(bT[6], bT[7]); *(LAS u32x4*)(BhT + k * CHP_T + tq * 8) = w;
              w.x = pk2(kT[0], kT[1]); w.y = pk2(kT[2], kT[3]); w.z = pk2(kT[4], kT[5]); w.w = pk2(kT[6], kT[7]); *(LAS u32x4*)(KhT + k * CHP_T + tq * 8) = w;
              w.x = pk2(vv[0], vv[1]); w.y = pk2(vv[2], vv[3]); w.z = pk2(vv[4], vv[5]); w.w = pk2(vv[6], vv[7]); *(LAS u32x4*)(VmT + k * CHP_T + tq * 8) = w;
            }
            GROUP_BARRIER();
            f32x4 aab[2][2];
            const int mi = gw ^ grp;
            { const LAS bf16* X = (mi < 2) ? At : Rt; const LAS bf16* Y = (mi & 1) ? Kt : Bt;
              f32x4 acc[2][2] = {{z4, z4}, {z4, z4}};
#pragma unroll
              for (int ks = 0; ks < 2; ++ks) { bf16x8_t xf[2], yf[2];
#pragma unroll
                  for (int m = 0; m < 2; ++m) { xf[m] = lfrag(X, CHP_K, 16 * m + lo, 32 * ks + 8 * hi); yf[m] = lfrag(Y, CHP_K, 16 * m + lo, 32 * ks + 8 * hi); }
#pragma unroll
                  for (int m = 0; m < 2; ++m)
#pragma unroll
                      for (int n = 0; n < 2; ++n) acc[m][n] = MFMA16(yf[n], xf[m], acc[m][n]); }
              LAS bf16* dstb = (mi == 1) ? Aak : ((mi == 2) ? Arb : Ark);
#pragma unroll
              for (int m = 0; m < 2; ++m)
#pragma unroll
                  for (int n = 0; n < 2; ++n) { const int t = 16 * m + lo, j0 = 16 * n + 4 * hi; f32x4 v = acc[m][n];
#pragma unroll
                      for (int r = 0; r < 4; ++r) { const int j = j0 + r; const bool keep = (mi < 2) ? (j < t) : (j <= t); v[r] = keep ? v[r] : 0.f; }
                      aab[m][n] = v; if (mi != 0) st4(dstb + t * CHP_T + j0, v); }
            }
            GROUP_BARRIER();
            const int inv_w = grp;
            if (mi == 0) {
                int cc = F.lane & 31; asm volatile("" : "+v"(cc));
                float mcol[32];
                { float acc = (0 == cc) ? 1.f : 0.f;
                  mcol[0] = acc; }
                { float acc = (1 == cc) ? 1.f : 0.f;
                  INV_P1(acc, aab[0][0][0], 1, mcol[0]);
                  mcol[1] = acc; }
                { float acc = (2 == cc) ? 1.f : 0.f;
                  INV_P2(acc, aab[0][0][0], 2, mcol[0], aab[0][0][1], 2, mcol[1]);
                  mcol[2] = acc; }
                { float acc = (3 == cc) ? 1.f : 0.f;
                  INV_P2(acc, aab[0][0][0], 3, mcol[0], aab[0][0][1], 3, mcol[1]);
                  INV_P1(acc, aab[0][0][2], 3, mcol[2]);
                  mcol[3] = acc; }
                { float acc = (4 == cc) ? 1.f : 0.f;
                  INV_P4(acc, aab[0][0][0], 4, mcol[0], aab[0][0][1], 4, mcol[1], aab[0][0][2], 4, mcol[2], aab[0][0][3], 4, mcol[3]);
                  mcol[4] = acc; }
                { float acc = (5 == cc) ? 1.f : 0.f;
                  INV_P4(acc, aab[0][0][0], 5, mcol[0], aab[0][0][1], 5, mcol[1], aab[0][0][2], 5, mcol[2], aab[0][0][3], 5, mcol[3]);
                  INV_P1(acc, aab[0][0][0], 21, mcol[4]);
                  mcol[5] = acc; }
                { float acc = (6 == cc) ? 1.f : 0.f;
                  INV_P4(acc, aab[0][0][0], 6, mcol[0], aab[0][0][1], 6, mcol[1], aab[0][0][2], 6, mcol[2], aab[0][0][3], 6, mcol[3]);
                  INV_P2(acc, aab[0][0][0], 22, mcol[4], aab[0][0][1], 22, mcol[5]);
                  mcol[6] = acc; }
                { float acc = (7 == cc) ? 1.f : 0.f;
                  INV_P4(acc, aab[0][0][0], 7, mcol[0], aab[0][0][1], 7, mcol[1], aab[0][0][2], 7, mcol[2], aab[0][0][3], 7, mcol[3]);
                  INV_P2(acc, aab[0][0][0], 23, mcol[4], aab[0][0][1], 23, mcol[5]);
                  INV_P1(acc, aab[0][0][2], 23, mcol[6]);
                  mcol[7] = acc; }
                { float acc = (8 == cc) ? 1.f : 0.f;
                  INV_P8(acc, aab[0][0][0], 8, mcol[0], aab[0][0][1], 8, mcol[1], aab[0][0][2], 8, mcol[2], aab[0][0][3], 8, mcol[3], aab[0][0][0], 24, mcol[4], aab[0][0][1], 24, mcol[5], aab[0][0][2], 24, mcol[6], aab[0][0][3], 24, mcol[7]);
                  mcol[8] = acc; }
                { float acc = (9 == cc) ? 1.f : 0.f;
                  INV_P8(acc, aab[0][0][0], 9, mcol[0], aab[0][0][1], 9, mcol[1], aab[0][0][2], 9, mcol[2], aab[0][0][3], 9, mcol[3], aab[0][0][0], 25, mcol[4], aab[0][0][1], 25, mcol[5], aab[0][0][2], 25, mcol[6], aab[0][0][3], 25, mcol[7]);
                  INV_P1(acc, aab[0][0][0], 41, mcol[8]);
                  mcol[9] = acc; }
                { float acc = (10 == cc) ? 1.f : 0.f;
                  INV_P8(acc, aab[0][0][0], 10, mcol[0], aab[0][0][1], 10, mcol[1], aab[0][0][2], 10, mcol[2], aab[0][0][3], 10, mcol[3], aab[0][0][0], 26, mcol[4], aab[0][0][1], 26, mcol[5], aab[0][0][2], 26, mcol[6], aab[0][0][3], 26, mcol[7]);
                  INV_P2(acc, aab[0][0][0], 42, mcol[8], aab[0][0][1], 42, mcol[9]);
                  mcol[10] = acc; }
                { float acc = (11 == cc) ? 1.f : 0.f;
                  INV_P8(acc, aab[0][0][0], 11, mcol[0], aab[0][0][1], 11, mcol[1], aab[0][0][2], 11, mcol[2], aab[0][0][3], 11, mcol[3], aab[0][0][0], 27, mcol[4], aab[0][0][1], 27, mcol[5], aab[0][0][2], 27, mcol[6], aab[0][0][3], 27, mcol[7]);
                  INV_P2(acc, aab[0][0][0], 43, mcol[8], aab[0][0][1], 43, mcol[9]);
                  INV_P1(acc, aab[0][0][2], 43, mcol[10]);
                  mcol[11] = acc; }
                { float acc = (12 == cc) ? 1.f : 0.f;
                  INV_P8(acc, aab[0][0][0], 12, mcol[0], aab[0][0][1], 12, mcol[1], aab[0][0][2], 12, mcol[2], aab[0][0][3], 12, mcol[3], aab[0][0][0], 28, mcol[4], aab[0][0][1], 28, mcol[5], aab[0][0][2], 28, mcol[6], aab[0][0][3], 28, mcol[7]);
                  INV_P4(acc, aab[0][0][0], 44, mcol[8], aab[0][0][1], 44, mcol[9], aab[0][0][2], 44, mcol[10], aab[0][0][3], 44, mcol[11]);
                  mcol[12] = acc; }
                { float acc = (13 == cc) ? 1.f : 0.f;
                  INV_P8(acc, aab[0][0][0], 13, mcol[0], aab[0][0][1], 13, mcol[1], aab[0][0][2], 13, mcol[2], aab[0][0][3], 13, mcol[3], aab[0][0][0], 29, mcol[4], aab[0][0][1], 29, mcol[5], aab[0][0][2], 29, mcol[6], aab[0][0][3], 29, mcol[7]);
                  INV_P4(acc, aab[0][0][0], 45, mcol[8], aab[0][0][1], 45, mcol[9], aab[0][0][2], 45, mcol[10], aab[0][0][3], 45, mcol[11]);
                  INV_P1(acc, aab[0][0][0], 61, mcol[12]);
                  mcol[13] = acc; }
                { float acc = (14 == cc) ? 1.f : 0.f;
                  INV_P8(acc, aab[0][0][0], 14, mcol[0], aab[0][0][1], 14, mcol[1], aab[0][0][2], 14, mcol[2], aab[0][0][3], 14, mcol[3], aab[0][0][0], 30, mcol[4], aab[0][0][1], 30, mcol[5], aab[0][0][2], 30, mcol[6], aab[0][0][3], 30, mcol[7]);
                  INV_P4(acc, aab[0][0][0], 46, mcol[8], aab[0][0][1], 46, mcol[9], aab[0][0][2], 46, mcol[10], aab[0][0][3], 46, mcol[11]);
                  INV_P2(acc, aab[0][0][0], 62, mcol[12], aab[0][0][1], 62, mcol[13]);
                  mcol[14] = acc; }
                { float acc = (15 == cc) ? 1.f : 0.f;
                  INV_P8(acc, aab[0][0][0], 15, mcol[0], aab[0][0][1], 15, mcol[1], aab[0][0][2], 15, mcol[2], aab[0][0][3], 15, mcol[3], aab[0][0][0], 31, mcol[4], aab[0][0][1], 31, mcol[5], aab[0][0][2], 31, mcol[6], aab[0][0][3], 31, mcol[7]);
                  INV_P4(acc, aab[0][0][0], 47, mcol[8], aab[0][0][1], 47, mcol[9], aab[0][0][2], 47, mcol[10], aab[0][0][3], 47, mcol[11]);
                  INV_P2(acc, aab[0][0][0], 63, mcol[12], aab[0][0][1], 63, mcol[13]);
                  INV_P1(acc, aab[0][0][2], 63, mcol[14]);
                  mcol[15] = acc; }
                { float acc = (16 == cc) ? 1.f : 0.f;
                  INV_P8(acc, aab[1][0][0], 0, mcol[0], aab[1][0][1], 0, mcol[1], aab[1][0][2], 0, mcol[2], aab[1][0][3], 0, mcol[3], aab[1][0][0], 16, mcol[4], aab[1][0][1], 16, mcol[5], aab[1][0][2], 16, mcol[6], aab[1][0][3], 16, mcol[7]);
                  INV_P8(acc, aab[1][0][0], 32, mcol[8], aab[1][0][1], 32, mcol[9], aab[1][0][2], 32, mcol[10], aab[1][0][3], 32, mcol[11], aab[1][0][0], 48, mcol[12], aab[1][0][1], 48, mcol[13], aab[1][0][2], 48, mcol[14], aab[1][0][3], 48, mcol[15]);
                  mcol[16] = acc; }
                { float acc = (17 == cc) ? 1.f : 0.f;
                  INV_P8(acc, aab[1][0][0], 1, mcol[0], aab[1][0][1], 1, mcol[1], aab[1][0][2], 1, mcol[2], aab[1][0][3], 1, mcol[3], aab[1][0][0], 17, mcol[4], aab[1][0][1], 17, mcol[5], aab[1][0][2], 17, mcol[6], aab[1][0][3], 17, mcol[7]);
                  INV_P8(acc, aab[1][0][0], 33, mcol[8], aab[1][0][1], 33, mcol[9], aab[1][0][2], 33, mcol[10], aab[1][0][3], 33, mcol[11], aab[1][0][0], 49, mcol[12], aab[1][0][1], 49, mcol[13], aab[1][0][2], 49, mcol[14], aab[1][0][3], 49, mcol[15]);
                  INV_P1(acc, aab[1][1][0], 1, mcol[16]);
                  mcol[17] = acc; }
                { float acc = (18 == cc) ? 1.f : 0.f;
                  INV_P8(acc, aab[1][0][0], 2, mcol[0], aab[1][0][1], 2, mcol[1], aab[1][0][2], 2, mcol[2], aab[1][0][3], 2, mcol[3], aab[1][0][0], 18, mcol[4], aab[1][0][1], 18, mcol[5], aab[1][0][2], 18, mcol[6], aab[1][0][3], 18, mcol[7]);
                  INV_P8(acc, aab[1][0][0], 34, mcol[8], aab[1][0][1], 34, mcol[9], aab[1][0][2], 34, mcol[10], aab[1][0][3], 34, mcol[11], aab[1][0][0], 50, mcol[12], aab[1][0][1], 50, mcol[13], aab[1][0][2], 50, mcol[14], aab[1][0][3], 50, mcol[15]);
                  INV_P2(acc, aab[1][1][0], 2, mcol[16], aab[1][1][1], 2, mcol[17]);
                  mcol[18] = acc; }
                { float acc = (19 == cc) ? 1.f : 0.f;
                  INV_P8(acc, aab[1][0][0], 3, mcol[0], aab[1][0][1], 3, mcol[1], aab[1][0][2], 3, mcol[2], aab[1][0][3], 3, mcol[3], aab[1][0][0], 19, mcol[4], aab[1][0][1], 19, mcol[5], aab[1][0][2], 19, mcol[6], aab[1][0][3], 19, mcol[7]);
                  INV_P8(acc, aab[1][0][0], 35, mcol[8], aab[1][0][1], 35, mcol[9], aab[1][0][2], 35, mcol[10], aab[1][0][3], 35, mcol[11], aab[1][0][0], 51, mcol[12], aab[1][0][1], 51, mcol[13], aab[1][0][2], 51, mcol[14], aab[1][0][3], 51, mcol[15]);
                  INV_P2(acc, aab[1][1][0], 3, mcol[16], aab[1][1][1], 3, mcol[17]);
                  INV_P1(acc, aab[1][1][2], 3, mcol[18]);
                  mcol[19] = acc; }
                { float acc = (20 == cc) ? 1.f : 0.f;
                  INV_P8(acc, aab[1][0][0], 4, mcol[0], aab[1][0][1], 4, mcol[1], aab[1][0][2], 4, mcol[2], aab[1][0][3], 4, mcol[3], aab[1][0][0], 20, mcol[4], aab[1][0][1], 20, mcol[5], aab[1][0][2], 20, mcol[6], aab[1][0][3], 20, mcol[7]);
                  INV_P8(acc, aab[1][0][0], 36, mcol[8], aab[1][0][1], 36, mcol[9], aab[1][0][2], 36, mcol[10], aab[1][0][3], 36, mcol[11], aab[1][0][0], 52, mcol[12], aab[1][0][1], 52, mcol[13], aab[1][0][2], 52, mcol[14], aab[1][0][3], 52, mcol[15]);
                  INV_P4(acc, aab[1][1][0], 4, mcol[16], aab[1][1][1], 4, mcol[17], aab[1][1][2], 4, mcol[18], aab[1][1][3], 4, mcol[19]);
                  mcol[20] = acc; }
                { float acc = (21 == cc) ? 1.f : 0.f;
                  INV_P8(acc, aab[1][0][0], 5, mcol[0], aab[1][0][1], 5, mcol[1], aab[1][0][2], 5, mcol[2], aab[1][0][3], 5, mcol[3], aab[1][0][0], 21, mcol[4], aab[1][0][1], 21, mcol[5], aab[1][0][2], 21, mcol[6], aab[1][0][3], 21, mcol[7]);
                  INV_P8(acc, aab[1][0][0], 37, mcol[8], aab[1][0][1], 37, mcol[9], aab[1][0][2], 37, mcol[10], aab[1][0][3], 37, mcol[11], aab[1][0][0], 53, mcol[12], aab[1][0][1], 53, mcol[13], aab[1][0][2], 53, mcol[14], aab[1][0][3], 53, mcol[15]);
                  INV_P4(acc, aab[1][1][0], 5, mcol[16], aab[1][1][1], 5, mcol[17], aab[1][1][2], 5, mcol[18], aab[1][1][3], 5, mcol[19]);
                  INV_P1(acc, aab[1][1][0], 21, mcol[20]);
                  mcol[21] = acc; }
                { float acc = (22 == cc) ? 1.f : 0.f;
                  INV_P8(acc, aab[1][0][0], 6, mcol[0], aab[1][0][1], 6, mcol[1], aab[1][0][2], 6, mcol[2], aab[1][0][3], 6, mcol[3], aab[1][0][0], 22, mcol[4], aab[1][0][1], 22, mcol[5], aab[1][0][2], 22, mcol[6], aab[1][0][3], 22, mcol[7]);
                  INV_P8(acc, aab[1][0][0], 38, mcol[8], aab[1][0][1], 38, mcol[9], aab[1][0][2], 38, mcol[10], aab[1][0][3], 38, mcol[11], aab[1][0][0], 54, mcol[12], aab[1][0][1], 54, mcol[13], aab[1][0][2], 54, mcol[14], aab[1][0][3], 54, mcol[15]);
                  INV_P4(acc, aab[1][1][0], 6, mcol[16], aab[1][1][1], 6, mcol[17], aab[1][1][2], 6, mcol[18], aab[1][1][3], 6, mcol[19]);
                  INV_P2(acc, aab[1][1][0], 22, mcol[20], aab[1][1][1], 22, mcol[21]);
                  mcol[22] = acc; }
                { float acc = (23 == cc) ? 1.f : 0.f;
                  INV_P8(acc, aab[1][0][0], 7, mcol[0], aab[1][0][1], 7, mcol[1], aab[1][0][2], 7, mcol[2], aab[1][0][3], 7, mcol[3], aab[1][0][0], 23, mcol[4], aab[1][0][1], 23, mcol[5], aab[1][0][2], 23, mcol[6], aab[1][0][3], 23, mcol[7]);
                  INV_P8(acc, aab[1][0][0], 39, mcol[8], aab[1][0][1], 39, mcol[9], aab[1][0][2], 39, mcol[10], aab[1][0][3], 39, mcol[11], aab[1][0][0], 55, mcol[12], aab[1][0][1], 55, mcol[13], aab[1][0][2], 55, mcol[14], aab[1][0][3], 55, mcol[15]);
                  INV_P4(acc, aab[1][1][0], 7, mcol[16], aab[1][1][1], 7, mcol[17], aab[1][1][2], 7, mcol[18], aab[1][1][3], 7, mcol[19]);
                  INV_P2(acc, aab[1][1][0], 23, mcol[20], aab[1][1][1], 23, mcol[21]);
                  INV_P1(acc, aab[1][1][2], 23, mcol[22]);
                  mcol[23] = acc; }
                { float acc = (24 == cc) ? 1.f : 0.f;
                  INV_P8(acc, aab[1][0][0], 8, mcol[0], aab[1][0][1], 8, mcol[1], aab[1][0][2], 8, mcol[2], aab[1][0][3], 8, mcol[3], aab[1][0][0], 24, mcol[4], aab[1][0][1], 24, mcol[5], aab[1][0][2], 24, mcol[6], aab[1][0][3], 24, mcol[7]);
                  INV_P8(acc, aab[1][0][0], 40, mcol[8], aab[1][0][1], 40, mcol[9], aab[1][0][2], 40, mcol[10], aab[1][0][3], 40, mcol[11], aab[1][0][0], 56, mcol[12], aab[1][0][1], 56, mcol[13], aab[1][0][2], 56, mcol[14], aab[1][0][3], 56, mcol[15]);
                  INV_P8(acc, aab[1][1][0], 8, mcol[16], aab[1][1][1], 8, mcol[17], aab[1][1][2], 8, mcol[18], aab[1][1][3], 8, mcol[19], aab[1][1][0], 24, mcol[20], aab[1][1][1], 24, mcol[21], aab[1][1][2], 24, mcol[22], aab[1][1][3], 24, mcol[23]);
                  mcol[24] = acc; }
                { float acc = (25 == cc) ? 1.f : 0.f;
                  INV_P8(acc, aab[1][0][0], 9, mcol[0], aab[1][0][1], 9, mcol[1], aab[1][0][2], 9, mcol[2], aab[1][0][3], 9, mcol[3], aab[1][0][0], 25, mcol[4], aab[1][0][1], 25, mcol[5], aab[1][0][2], 25, mcol[6], aab[1][0][3], 25, mcol[7]);
                  INV_P8(acc, aab[1][0][0], 41, mcol[8], aab[1][0][1], 41, mcol[9], aab[1][0][2], 41, mcol[10], aab[1][0][3], 41, mcol[11], aab[1][0][0], 57, mcol[12], aab[1][0][1], 57, mcol[13], aab[1][0][2], 57, mcol[14], aab[1][0][3], 57, mcol[15]);
                  INV_P8(acc, aab[1][1][0], 9, mcol[16], aab[1][1][1], 9, mcol[17], aab[1][1][2], 9, mcol[18], aab[1][1][3], 9, mcol[19], aab[1][1][0], 25, mcol[20], aab[1][1][1], 25, mcol[21], aab[1][1][2], 25, mcol[22], aab[1][1][3], 25, mcol[23]);
                  INV_P1(acc, aab[1][1][0], 41, mcol[24]);
                  mcol[25] = acc; }
                { float acc = (26 == cc) ? 1.f : 0.f;
                  INV_P8(acc, aab[1][0][0], 10, mcol[0], aab[1][0][1], 10, mcol[1], aab[1][0][2], 10, mcol[2], aab[1][0][3], 10, mcol[3], aab[1][0][0], 26, mcol[4], aab[1][0][1], 26, mcol[5], aab[1][0][2], 26, mcol[6], aab[1][0][3], 26, mcol[7]);
                  INV_P8(acc, aab[1][0][0], 42, mcol[8], aab[1][0][1], 42, mcol[9], aab[1][0][2], 42, mcol[10], aab[1][0][3], 42, mcol[11], aab[1][0][0], 58, mcol[12], aab[1][0][1], 58, mcol[13], aab[1][0][2], 58, mcol[14], aab[1][0][3], 58, mcol[15]);
                  INV_P8(acc, aab[1][1][0], 10, mcol[16], aab[1][1][1], 10, mcol[17], aab[1][1][2], 10, mcol[18], aab[1][1][3], 10, mcol[19], aab[1][1][0], 26, mcol[20], aab[1][1][1], 26, mcol[21], aab[1][1][2], 26, mcol[22], aab[1][1][3], 26, mcol[23]);
                  INV_P2(acc, aab[1][1][0], 42, mcol[24], aab[1][1][1], 42, mcol[25]);
                  mcol[26] = acc; }
                { float acc = (27 == cc) ? 1.f : 0.f;
                  INV_P8(acc, aab[1][0][0], 11, mcol[0], aab[1][0][1], 11, mcol[1], aab[1][0][2], 11, mcol[2], aab[1][0][3], 11, mcol[3], aab[1][0][0], 27, mcol[4], aab[1][0][1], 27, mcol[5], aab[1][0][2], 27, mcol[6], aab[1][0][3], 27, mcol[7]);
                  INV_P8(acc, aab[1][0][0], 43, mcol[8], aab[1][0][1], 43, mcol[9], aab[1][0][2], 43, mcol[10], aab[1][0][3], 43, mcol[11], aab[1][0][0], 59, mcol[12], aab[1][0][1], 59, mcol[13], aab[1][0][2], 59, mcol[14], aab[1][0][3], 59, mcol[15]);
                  INV_P8(acc, aab[1][1][0], 11, mcol[16], aab[1][1][1], 11, mcol[17], aab[1][1][2], 11, mcol[18], aab[1][1][3], 11, mcol[19], aab[1][1][0], 27, mcol[20], aab[1][1][1], 27, mcol[21], aab[1][1][2], 27, mcol[22], aab[1][1][3], 27, mcol[23]);
                  INV_P2(acc, aab[1][1][0], 43, mcol[24], aab[1][1][1], 43, mcol[25]);
                  INV_P1(acc, aab[1][1][2], 43, mcol[26]);
                  mcol[27] = acc; }
                { float acc = (28 == cc) ? 1.f : 0.f;
                  INV_P8(acc, aab[1][0][0], 12, mcol[0], aab[1][0][1], 12, mcol[1], aab[1][0][2], 12, mcol[2], aab[1][0][3], 12, mcol[3], aab[1][0][0], 28, mcol[4], aab[1][0][1], 28, mcol[5], aab[1][0][2], 28, mcol[6], aab[1][0][3], 28, mcol[7]);
                  INV_P8(acc, aab[1][0][0], 44, mcol[8], aab[1][0][1], 44, mcol[9], aab[1][0][2], 44, mcol[10], aab[1][0][3], 44, mcol[11], aab[1][0][0], 60, mcol[12], aab[1][0][1], 60, mcol[13], aab[1][0][2], 60, mcol[14], aab[1][0][3], 60, mcol[15]);
                  INV_P8(acc, aab[1][1][0], 12, mcol[16], aab[1][1][1], 12, mcol[17], aab[1][1][2], 12, mcol[18], aab[1][1][3], 12, mcol[19], aab[1][1][0], 28, mcol[20], aab[1][1][1], 28, mcol[21], aab[1][1][2], 28, mcol[22], aab[1][1][3], 28, mcol[23]);
                  INV_P4(acc, aab[1][1][0], 44, mcol[24], aab[1][1][1], 44, mcol[25], aab[1][1][2], 44, mcol[26], aab[1][1][3], 44, mcol[27]);
                  mcol[28] = acc; }
                { float acc = (29 == cc) ? 1.f : 0.f;
                  INV_P8(acc, aab[1][0][0], 13, mcol[0], aab[1][0][1], 13, mcol[1], aab[1][0][2], 13, mcol[2], aab[1][0][3], 13, mcol[3], aab[1][0][0], 29, mcol[4], aab[1][0][1], 29, mcol[5], aab[1][0][2], 29, mcol[6], aab[1][0][3], 29, mcol[7]);
                  INV_P8(acc, aab[1][0][0], 45, mcol[8], aab[1][0][1], 45, mcol[9], aab[1][0][2], 45, mcol[10], aab[1][0][3], 45, mcol[11], aab[1][0][0], 61, mcol[12], aab[1][0][1], 61, mcol[13], aab[1][0][2], 61, mcol[14], aab[1][0][3], 61, mcol[15]);
                  INV_P8(acc, aab[1][1][0], 13, mcol[16], aab[1][1][1], 13, mcol[17], aab[1][1][2], 13, mcol[18], aab[1][1][3], 13, mcol[19], aab[1][1][0], 29, mcol[20], aab[1][1][1], 29, mcol[21], aab[1][1][2], 29, mcol[22], aab[1][1][3], 29, mcol[23]);
                  INV_P4(acc, aab[1][1][0], 45, mcol[24], aab[1][1][1], 45, mcol[25], aab[1][1][2], 45, mcol[26], aab[1][1][3], 45, mcol[27]);
                  INV_P1(acc, aab[1][1][0], 61, mcol[28]);
                  mcol[29] = acc; }
                { float acc = (30 == cc) ? 1.f : 0.f;
                  INV_P8(acc, aab[1][0][0], 14, mcol[0], aab[1][0][1], 14, mcol[1], aab[1][0][2], 14, mcol[2], aab[1][0][3], 14, mcol[3], aab[1][0][0], 30, mcol[4], aab[1][0][1], 30, mcol[5], aab[1][0][2], 30, mcol[6], aab[1][0][3], 30, mcol[7]);
                  INV_P8(acc, aab[1][0][0], 46, mcol[8], aab[1][0][1], 46, mcol[9], aab[1][0][2], 46, mcol[10], aab[1][0][3], 46, mcol[11], aab[1][0][0], 62, mcol[12], aab[1][0][1], 62, mcol[13], aab[1][0][2], 62, mcol[14], aab[1][0][3], 62, mcol[15]);
                  INV_P8(acc, aab[1][1][0], 14, mcol[16], aab[1][1][1], 14, mcol[17], aab[1][1][2], 14, mcol[18], aab[1][1][3], 14, mcol[19], aab[1][1][0], 30, mcol[20], aab[1][1][1], 30, mcol[21], aab[1][1][2], 30, mcol[22], aab[1][1][3], 30, mcol[23]);
                  INV_P4(acc, aab[1][1][0], 46, mcol[24], aab[1][1][1], 46, mcol[25], aab[1][1][2], 46, mcol[26], aab[1][1][3], 46, mcol[27]);
                  INV_P2(acc, aab[1][1][0], 62, mcol[28], aab[1][1][1], 62, mcol[29]);
                  mcol[30] = acc; }
                { float acc = (31 == cc) ? 1.f : 0.f;
                  INV_P8(acc, aab[1][0][0], 15, mcol[0], aab[1][0][1], 15, mcol[1], aab[1][0][2], 15, mcol[2], aab[1][0][3], 15, mcol[3], aab[1][0][0], 31, mcol[4], aab[1][0][1], 31, mcol[5], aab[1][0][2], 31, mcol[6], aab[1][0][3], 31, mcol[7]);
                  INV_P8(acc, aab[1][0][0], 47, mcol[8], aab[1][0][1], 47, mcol[9], aab[1][0][2], 47, mcol[10], aab[1][0][3], 47, mcol[11], aab[1][0][0], 63, mcol[12], aab[1][0][1], 63, mcol[13], aab[1][0][2], 63, mcol[14], aab[1][0][3], 63, mcol[15]);
                  INV_P8(acc, aab[1][1][0], 15, mcol[16], aab[1][1][1], 15, mcol[17], aab[1][1][2], 15, mcol[18], aab[1][1][3], 15, mcol[19], aab[1][1][0], 31, mcol[20], aab[1][1][1], 31, mcol[21], aab[1][1][2], 31, mcol[22], aab[1][1][3], 31, mcol[23]);
                  INV_P4(acc, aab[1][1][0], 47, mcol[24], aab[1][1][1], 47, mcol[25], aab[1][1][2], 47, mcol[26], aab[1][1][3], 47, mcol[27]);
                  INV_P2(acc, aab[1][1][0], 63, mcol[28], aab[1][1][1], 63, mcol[29]);
                  INV_P1(acc, aab[1][1][2], 63, mcol[30]);
                  mcol[31] = acc; }
                if (F.lane < 32) {
#pragma unroll
                    for (int t = 0; t < 32; ++t) Minv[t * CHP_T + cc] = (bf16)(pk2(mcol[t], 0.f) & 0xffffu); }
            } else {
                const int wk = gw - (gw > inv_w ? 1 : 0);
                for (int tile = wk * 3; tile < ((wk == 2) ? 8 : wk * 3 + 3); ++tile) { const int mt = tile >> 2, nt = tile & 3;
                    const bf16x8_t xf = lfrag(Aak, CHP_T, 16 * mt + lo, 8 * hi), yf = lfrag(VmT, CHP_T, 16 * nt + lo, 8 * hi);
                    const f32x4 d = MFMA16(xf, yf, z4);
                    st4(X1T + (16 * nt + lo) * CHP_T + 16 * mt + 4 * hi, d); }
            }
            GROUP_BARRIER();
            { const bf16x8_t ya = lfrag(AtT, CHP_T, 16 * gw + lo, 8 * hi), yx = lfrag(X1T, CHP_T, 16 * gw + lo, 8 * hi);
              f32x4 d1[2], d2[2];
#pragma unroll
              for (int mt = 0; mt < 2; ++mt) { const bf16x8_t xf = lfrag(Minv, CHP_T, 16 * mt + lo, 8 * hi);
                  d1[mt] = MFMA16(xf, ya, z4); d2[mt] = MFMA16(xf, yx, z4); }
#pragma unroll
              for (int mt = 0; mt < 2; ++mt) { st4(P1T + (16 * gw + lo) * CHP_T + 16 * mt + 4 * hi, d1[mt]); st4(P2T + (16 * gw + lo) * CHP_T + 16 * mt + 4 * hi, d2[mt]); }
            }
            GROUP_BARRIER();
            HEAD_LOADS((h + 1 < NH) ? h + 1 : h);
            { GAS bf16* outp = GHQ + (size_t)ci * GHQ_CHUNK;
              const bf16x8_t p1 = lfrag(P1T, CHP_T, 16 * gw + lo, 8 * hi), p2 = lfrag(P2T, CHP_T, 16 * gw + lo, 8 * hi), vm = lfrag(VmT, CHP_T, 16 * gw + lo, 8 * hi);
#pragma unroll
              for (int mt = 0; mt < 2; ++mt) { const bf16x8_t arb = lfrag(Arb, CHP_T, 16 * mt + lo, 8 * hi), ark = lfrag(Ark, CHP_T, 16 * mt + lo, 8 * hi);
                  f32x4 q1 = MFMA16(p1, arb, z4);
                  { const int t = 16 * mt + lo, k0 = 16 * gw + 4 * hi; const u32x2 rw = *(const LAS u32x2*)(Rt + t * CHP_K + k0);
                    q1[0] += bf_lo(rw.x); q1[1] += bf_hi(rw.x); q1[2] += bf_lo(rw.y); q1[3] += bf_hi(rw.y);
                    u32x2 w; w.x = pk2(q1[0], q1[1]); w.y = pk2(q1[2], q1[3]); *(GAS u32x2*)(outp + 8192 + t * 64 + k0) = w; }
                  f32x4 q2 = MFMA16(arb, p2, z4); q2 = MFMA16(ark, vm, q2);
                  { u32x2 w; w.x = pk2(q2[0], q2[1]); w.y = pk2(q2[2], q2[3]); *(GAS u32x2*)(outp + 10240 + (16 * gw + lo) * 32 + 16 * mt + 4 * hi) = w; } }
#pragma unroll
              for (int mt = 0; mt < 4; ++mt) { const bf16x8_t bh = lfrag(BhT, CHP_T, 16 * mt + lo, 8 * hi), kh = lfrag(KhT, CHP_T, 16 * mt + lo, 8 * hi);
                  const f32x4 g = MFMA16(p1, bh, z4);
                  { u32x2 w; w.x = pk2(g[0], g[1]); w.y = pk2(g[2], g[3]); *(GAS u32x2*)(outp + (16 * mt + lo) * 64 + 16 * gw + 4 * hi) = w; }
                  f32x4 hh = MFMA16(bh, p2, z4); hh = MFMA16(kh, vm, hh);
                  { u32x2 w; w.x = pk2(hh[0], hh[1]); w.y = pk2(hh[2], hh[3]); *(GAS u32x2*)(outp + 4096 + (16 * gw + lo) * 64 + 16 * mt + 4 * hi) = w; } }
            }
        }
    }
    __syncthreads();
#undef GROUP_BARRIER
#undef HEAD_LOADS
}
__device__ __forceinline__ void p9b_rwkv_seq(const Frame& F0) {
    PHASE_VIEW();
    const GAS bf16* GHQ = (const GAS bf16*)(F.ws + WS_GHQ); const GAS float* GT = (const GAS float*)(F.ws + WS_GT); GAS bf16* Yy = (GAS bf16*)(F.ws + WS_Y);
    LAS bf16* Sb = (LAS bf16*)F.lds;
    const int lo = F.lane & 15, hi = F.lane >> 4, kt = F.wave >> 1, vt = F.wave & 1, mt = F.wave >> 1;
    const f32x4 z4 = (f32x4){0.f, 0.f, 0.f, 0.f};
    for (int item = F.vcu; item < NB * NH * 2; item += F.G) {
        const int b = item >> 5, h = (item >> 1) & 15, vh = item & 1;
        __syncthreads();
        for (int i = F.tid; i < 2 * 32 * CHP_K / 2; i += NTHR) ((LAS unsigned*)Sb)[i] = 0u;
        __syncthreads();
        f32x4 Sf = z4;
        const size_t cbase = (size_t)(b * NH + h) * 64;
        const int vrow = vh * 32 + 16 * vt + lo;
#define SEQ_LOAD(G_, Q_, H_, Q2_, GT_, cc_) do { const int cn_ = (cc_) < 64 ? (cc_) : 63; const GAS bf16* cp_ = GHQ + (cbase + cn_) * GHQ_CHUNK; \
            G_[0] = *(const GAS bf16x8_t*)(cp_ + (16 * kt + lo) * 64 + 8 * hi); G_[1] = *(const GAS bf16x8_t*)(cp_ + (16 * kt + lo) * 64 + 32 + 8 * hi); \
            H_ = *(const GAS u32x2*)(cp_ + 4096 + vrow * 64 + 16 * kt + 4 * hi); GT_ = *(const GAS f32x4*)(GT + (cbase + cn_) * 64 + 16 * kt + 4 * hi); \
            Q_[0] = *(const GAS bf16x8_t*)(cp_ + 8192 + (16 * (mt & 1) + lo) * 64 + 8 * hi); Q_[1] = *(const GAS bf16x8_t*)(cp_ + 8192 + (16 * (mt & 1) + lo) * 64 + 32 + 8 * hi); \
            Q2_ = *(const GAS u32x2*)(cp_ + 10240 + vrow * 32 + 16 * (mt & 1) + 4 * hi); } while (0)
#define SEQ_STEP(G_, Q_, H_, Q2_, GT_, cc_) do { \
            const LAS bf16* Sc = Sb + ((cc_) & 1) * 32 * CHP_K; LAS bf16* Sn = Sb + (((cc_) + 1) & 1) * 32 * CHP_K; \
            const bf16x8_t s0 = lfrag(Sc, CHP_K, 16 * vt + lo, 8 * hi), s1 = lfrag(Sc, CHP_K, 16 * vt + lo, 32 + 8 * hi); \
            if (F.wave < 4) { f32x4 y = (f32x4){bf_lo(Q2_.x), bf_hi(Q2_.x), bf_lo(Q2_.y), bf_hi(Q2_.y)}; \
                y = MFMA16(Q_[0], s0, y); y = MFMA16(Q_[1], s1, y); \
                GAS bf16* yp = Yy + (size_t)(b * SEQ + (cc_) * CH_T + 16 * mt + 4 * hi) * 1024 + h * 64 + vrow; const unsigned w01 = pk2(y[0], y[1]), w23 = pk2(y[2], y[3]); \
                yp[0] = (bf16)(w01 & 0xffffu); yp[1024] = (bf16)(w01 >> 16); yp[2048] = (bf16)(w23 & 0xffffu); yp[3072] = (bf16)(w23 >> 16); } \
            f32x4 acc = (f32x4){bf_lo(H_.x), bf_hi(H_.x), bf_lo(H_.y), bf_hi(H_.y)} + GT_ * Sf; \
            acc = MFMA16(G_[0], s0, acc); acc = MFMA16(G_[1], s1, acc); \
            Sf = acc; st4(Sn + (16 * vt + lo) * CHP_K + 16 * kt + 4 * hi, acc); \
            SEQ_LOAD(G_, Q_, H_, Q2_, GT_, (cc_) + 4); \
            asm volatile("s_waitcnt lgkmcnt(0)" ::: "memory"); __builtin_amdgcn_s_barrier(); asm volatile("" ::: "memory"); } while (0)
        bf16x8_t gA[2], qA[2], gB[2], qB[2], gC[2], qC[2], gD[2], qD[2]; u32x2 hA, q2A, hB, q2B, hC, q2C, hD, q2D; f32x4 gtA, gtB, gtC, gtD;
        SEQ_LOAD(gA, qA, hA, q2A, gtA, 0); SEQ_LOAD(gB, qB, hB, q2B, gtB, 1); SEQ_LOAD(gC, qC, hC, q2C, gtC, 2); SEQ_LOAD(gD, qD, hD, q2D, gtD, 3);
#pragma unroll
        for (int c = 0; c < 64; c += 4) {
            SEQ_STEP(gA, qA, hA, q2A, gtA, c); SEQ_STEP(gB, qB, hB, q2B, gtB, c + 1); SEQ_STEP(gC, qC, hC, q2C, gtC, c + 2); SEQ_STEP(gD, qD, hD, q2D, gtD, c + 3);
        }
#undef SEQ_LOAD
#undef SEQ_STEP
    }
}

__device__ __forceinline__ void p9_rwkv_post(const Frame& F0) {
    PHASE_VIEW();
    const GAS bf16* VB = (const GAS bf16*)(F.ws + WS_VB); const GAS bf16* GB = (const GAS bf16*)(F.ws + WS_GB); const GAS float* BON = (const GAS float*)(F.ws + WS_BON);
    const GAS bf16* Yy = (const GAS bf16*)(F.ws + WS_Y);
    const GAS float* ln_w = (const GAS float*)F.in[29]; const GAS float* ln_b = (const GAS float*)F.in[30]; GAS bf16* MIX = (GAS bf16*)(F.ws + WS_MIX);
    const int gw = F.vcu * NWAVES + F.wave, NGW = F.G * NWAVES;
    u32x2 ywn, vwn, gwn; float bonn;
#define POST_LOAD(it_) do { const int it2 = (it_) < NT * 4 ? (it_) : gw; const int row_ = it2 >> 2, c_ = (it2 & 3) * 256 + F.lane * 4; const size_t idx_ = (size_t)row_ * 1024 + c_; \
        ywn = *(const GAS u32x2*)(Yy + idx_); vwn = *(const GAS u32x2*)(VB + idx_); gwn = *(const GAS u32x2*)(GB + idx_); bonn = BON[row_ * 16 + (c_ >> 6)]; } while (0)
    POST_LOAD(gw);
    for (int it = gw; it < NT * 4; it += NGW) {
        const int row = it >> 2, c = (it & 3) * 256 + F.lane * 4;
        const u32x2 yw = ywn, vw = vwn, gwv = gwn; const float bon = bonn;
        const f32x4 lw = *(const GAS f32x4*)(ln_w + c), lb = *(const GAS f32x4*)(ln_b + c);
        POST_LOAD(it + NGW);
        const f32x4 y = (f32x4){bf_lo(yw.x), bf_hi(yw.x), bf_lo(yw.y), bf_hi(yw.y)};
        const float mean = row16_sum((y.x + y.y) + (y.z + y.w)) * (1.f / 64.f); const f32x4 d = y - mean;
        const float var = row16_sum((d.x * d.x + d.y * d.y) + (d.z * d.z + d.w * d.w)) * (1.f / 64.f); const float rstd = rsqrtf(var + GN_EPS);
        const f32x4 vv = (f32x4){bf_lo(vw.x), bf_hi(vw.x), bf_lo(vw.y), bf_hi(vw.y)}, gg = (f32x4){bf_lo(gwv.x), bf_hi(gwv.x), bf_lo(gwv.y), bf_hi(gwv.y)};
        const f32x4 o = (d * rstd * lw + lb + vv * bon) * gg;
        u32x2 w; w.x = pk2(o.x, o.y); w.y = pk2(o.z, o.w); *(GAS u32x2*)(MIX + (size_t)row * DM + DSSM + c) = w;
    }
#undef POST_LOAD
}

__device__ __forceinline__ void p11_x1_router(const Frame& F0) {
    PHASE_VIEW();
    const GAS float* x = (const GAS float*)F.in[0]; const GAS float* gpost = (const GAS float*)F.in[5]; const GAS float* gpre2 = (const GAS float*)F.in[6]; const GAS float* mod = (const GAS float*)(F.ws + WS_MOD);
    const GAS bf16* MIXED = (const GAS bf16*)(F.ws + WS_MIXED); GAS bf16* X1 = (GAS bf16*)(F.ws + WS_X1); GAS bf16* H = (GAS bf16*)(F.ws + WS_H);
    const GAS bf16x8_t* rwt = (const GAS bf16x8_t*)(F.ws + WS_RWT); const float* b_grp = F.in[32]; const float* b_exp = F.in[34];
    unsigned* tokinfo = (unsigned*)(F.ws + WS_TOKINFO); int* list = (int*)(F.ws + WS_LIST);
    LAS float* slab = (LAS float*)(F.lds + F.wave * 16384) + F.lane * 8;
    LAS float* Lp = (LAS float*)F.lds;
    LAS float* red1 = (LAS float*)(F.lds + 131072); LAS float* red2 = red1 + 128; LAS float* Lf = red2 + 128;
    const int lo = F.lane & 15, hi = F.lane >> 4, k0 = 256 * F.wave + 8 * hi;
    const f32x4 z4 = (f32x4){0.f, 0.f, 0.f, 0.f};
    for (int tile = F.vcu; tile < NT / 16; tile += F.G) {
        const int row = tile * 16 + lo, b = tile >> 7;
        const size_t ro = (size_t)row * DM + k0;
        f32x4 xr[8][2];
#pragma unroll
        for (int s_ = 0; s_ < 8; ++s_) { xr[s_][0] = *(const GAS f32x4*)(x + ro + 32 * s_); xr[s_][1] = *(const GAS f32x4*)(x + ro + 32 * s_ + 4); }
        float ss = 0.f;
#pragma unroll
        for (int s_ = 0; s_ < 8; ++s_) { const u32x4 mw = *(const GAS u32x4*)(MIXED + ro + 32 * s_); const f32x4 a0 = (f32x4){bf_lo(mw.x), bf_hi(mw.x), bf_lo(mw.y), bf_hi(mw.y)}, a1 = (f32x4){bf_lo(mw.z), bf_hi(mw.z), bf_lo(mw.w), bf_hi(mw.w)};
            *(LAS f32x4*)(slab + s_ * 512) = a0; *(LAS f32x4*)(slab + s_ * 512 + 4) = a1;
            ss += (a0.x * a0.x + a0.y * a0.y) + (a0.z * a0.z + a0.w * a0.w) + (a1.x * a1.x + a1.y * a1.y) + (a1.z * a1.z + a1.w * a1.w); }
        ss += __shfl_xor(ss, 16); ss += __shfl_xor(ss, 32);
        if (hi == 0) red1[F.wave * 16 + lo] = ss;
        LDS_BARRIER();
        float tot = 0.f;
#pragma unroll
        for (int w = 0; w < 8; ++w) tot += red1[w * 16 + lo];
        const float rs = rsqrtf(tot * (1.f / DM) + RMS_EPS);
        float ss2 = 0.f;
        const GAS float* modb = mod + b * NMOD + k0;
        u32x4 xws[8];
#pragma unroll
        for (int s_ = 0; s_ < 8; ++s_) { f32x4 xo[2];
#pragma unroll
            for (int q = 0; q < 2; ++q) { const f32x4 xv = xr[s_][q], gv = *(const GAS f32x4*)(gpost + k0 + 32 * s_ + 4 * q), gt = *(const GAS f32x4*)(modb + 2 * DM + 32 * s_ + 4 * q);
                const f32x4 mm = *(const LAS f32x4*)(slab + s_ * 512 + 4 * q);
                const f32x4 v = xv + gt * (mm * rs * gv); *(LAS f32x4*)(slab + s_ * 512 + 4 * q) = v; xo[q] = v;
                ss2 += (v.x * v.x + v.y * v.y) + (v.z * v.z + v.w * v.w); }
            u32x4 xw; xw.x = pk2(xo[0].x, xo[0].y); xw.y = pk2(xo[0].z, xo[0].w); xw.z = pk2(xo[1].x, xo[1].y); xw.w = pk2(xo[1].z, xo[1].w); xws[s_] = xw; }
#pragma unroll
        for (int s_ = 0; s_ < 8; ++s_) *(GAS u32x4*)(X1 + ro + 32 * s_) = xws[s_];
        ss2 += __shfl_xor(ss2, 16); ss2 += __shfl_xor(ss2, 32);
        if (hi == 0) red2[F.wave * 16 + lo] = ss2;
        LDS_BARRIER();
        float tot2 = 0.f;
#pragma unroll
        for (int w = 0; w < 8; ++w) tot2 += red2[w * 16 + lo];
        const float rs2 = rsqrtf(tot2 * (1.f / DM) + RMS_EPS);
        f32x4 acc[5] = {z4, z4, z4, z4, z4};
        bf16x8_t wA[10], wB[10]; f32x4 cA[6], cB[6];
#define RT_LOAD(W_, C_, st_) do { const GAS bf16x8_t* wb_ = rwt + (size_t)((F.wave * 8 + (st_)) * 10) * 64; \
            _Pragma("unroll") for (int j_ = 0; j_ < 10; ++j_) W_[j_] = wb_[j_ * 64 + F.lane]; \
            _Pragma("unroll") for (int q_ = 0; q_ < 2; ++q_) { C_[3 * q_] = *(const GAS f32x4*)(gpre2 + k0 + 32 * (st_) + 4 * q_); C_[3 * q_ + 1] = *(const GAS f32x4*)(modb + 3 * DM + 32 * (st_) + 4 * q_); C_[3 * q_ + 2] = *(const GAS f32x4*)(modb + 4 * DM + 32 * (st_) + 4 * q_); } } while (0)
#define RT_STEP(W_, C_, st_) do { f32x4 hv[2]; \
            _Pragma("unroll") for (int q_ = 0; q_ < 2; ++q_) { const f32x4 mm = *(const LAS f32x4*)(slab + (st_) * 512 + 4 * q_); hv[q_] = mm * rs2 * C_[3 * q_] * (C_[3 * q_ + 2] + 1.0f) + C_[3 * q_ + 1]; } \
            u32x4 hh, hl; \
            hh.x = pk2(hv[0].x, hv[0].y); hh.y = pk2(hv[0].z, hv[0].w); hh.z = pk2(hv[1].x, hv[1].y); hh.w = pk2(hv[1].z, hv[1].w); \
            *(LAS u32x4*)(slab + (st_) * 512) = hh;        \
            hl.x = pk2(hv[0].x - bf_lo(hh.x), hv[0].y - bf_hi(hh.x)); hl.y = pk2(hv[0].z - bf_lo(hh.y), hv[0].w - bf_hi(hh.y)); \
            hl.z = pk2(hv[1].x - bf_lo(hh.z), hv[1].y - bf_hi(hh.z)); hl.w = pk2(hv[1].z - bf_lo(hh.w), hv[1].w - bf_hi(hh.w)); \
            const bf16x8_t fh = __builtin_bit_cast(bf16x8_t, hh), fl = __builtin_bit_cast(bf16x8_t, hl); \
            _Pragma("unroll") for (int jt = 0; jt < 5; ++jt) { acc[jt] = MFMA16(W_[2 * jt], fh, acc[jt]); acc[jt] = MFMA16(W_[2 * jt], fl, acc[jt]); acc[jt] = MFMA16(W_[2 * jt + 1], fh, acc[jt]); } } while (0)
        RT_LOAD(wA, cA, 0);
#pragma unroll 1
        for (int s2 = 0; s2 < 8; s2 += 2) { RT_LOAD(wB, cB, s2 + 1); RT_STEP(wA, cA, s2); RT_LOAD(wA, cA, (s2 + 2 < 8 ? s2 + 2 : 7)); RT_STEP(wB, cB, s2 + 1); }
#undef RT_LOAD
#undef RT_STEP
#pragma unroll
        for (int s_ = 0; s_ < 8; ++s_) *(GAS u32x4*)(H + ro + 32 * s_) = *(const LAS u32x4*)(slab + s_ * 512);
        LDS_WAIT(); asm volatile("" ::: "memory");
#pragma unroll
        for (int jt = 0; jt < 5; ++jt) *(LAS f32x4*)(Lp + F.wave * 4096 + lo * 80 + 16 * jt + 4 * hi) = acc[jt];
        LDS_BARRIER();
        for (int i = F.tid; i < 16 * 80; i += NTHR) { float sacc = 0.f;
#pragma unroll
            for (int w = 0; w < 8; ++w) sacc += Lp[w * 4096 + i];
            const int j = i % 80; Lf[i] = sacc + (j < 8 ? b_grp[j] : (j < 72 ? b_exp[j - 8] : 0.f)); }
        LDS_BARRIER();
        if (F.tid < 16) { const LAS float* lg = Lf + F.tid * 80; const int tok = tile * 16 + F.tid;
            int gi = 0; float gmax = lg[0];
#pragma unroll
            for (int j = 1; j < 8; ++j) if (lg[j] > gmax) { gmax = lg[j]; gi = j; }
            float gsum = 0.f;
#pragma unroll
            for (int j = 0; j < 8; ++j) gsum += __expf(lg[j] - gmax);
            const float pg = 1.f / gsum;
            const LAS float* le = lg + 8 + gi * 8; int i1 = 0; float m1 = le[0];
#pragma unroll
            for (int j = 1; j < 8; ++j) if (le[j] > m1) { m1 = le[j]; i1 = j; }
            int i2 = -1; float m2 = -INFINITY;
#pragma unroll
            for (int j = 0; j < 8; ++j) if (j != i1 && le[j] > m2) { m2 = le[j]; i2 = j; }
            const float e2 = __expf(m2 - m1); const float g1 = pg / (1.f + e2), g2 = pg * e2 / (1.f + e2);
            const int x1i = gi * 8 + i1, x2i = gi * 8 + i2;
            const unsigned p1 = atomicAdd(F.ctl + CW_CNT + 64 * x1i, 1u), p2 = atomicAdd(F.ctl + CW_CNT + 64 * x2i, 1u);
            list[x1i * NT + p1] = tok; list[x2i * NT + p2] = tok;
            u32x4 a; a.x = (unsigned)x1i; a.y = p1; a.z = (unsigned)x2i; a.w = p2; *(u32x4*)(tokinfo + (size_t)tok * 8) = a;
            u32x2 g; g.x = __float_as_uint(g1); g.y = __float_as_uint(g2); *(u32x2*)(tokinfo + (size_t)tok * 8 + 4) = g;
        }
    }
    __syncthreads();
}

__device__ __forceinline__ void conv_item_src(const Frame& F, int it, const float*& W, int& N, bf16*& WT, int& ldk, int& drow, int& k0, int& n0) {
    if (it < NEXP * 1024) { const int e = it >> 10, r = it & 1023, which = r >> 9, rr = r & 511; k0 = (rr >> 4) * 64; n0 = (rr & 15) * 32;
        W = F.in[which ? 36 : 35] + (size_t)e * DM * DEXP; N = DEXP; WT = (bf16*)(F.ws + WS_EW1) + (size_t)e * 1024 * DM; ldk = DM; drow = (n0 >> 7) * 256 + which * 128 + (n0 & 127); }
    else { const int j = it - NEXP * 1024, e = j >> 9, r = j & 511; k0 = (r >> 6) * 64; n0 = (r & 63) * 32;
        W = F.in[37] + (size_t)e * DEXP * DM; N = DM; WT = (bf16*)(F.ws + WS_EW2) + (size_t)e * DM * DEXP; ldk = DEXP; drow = n0; }
}
struct ConvItem { const GAS float* src; GAS bf16* dst; int ldk; };
__device__ __forceinline__ void conv_decode(const Frame& F, int it, int lane, ConvItem& ci, int& N) {
    const float* W; int ldk, drow, k0, n0; bf16* WT; conv_item_src(F, it, W, N, WT, ldk, drow, k0, n0);
    ci.src = (const GAS float*)W + (size_t)(k0 + (lane >> 3)) * N + n0 + 4 * (lane & 7); ci.dst = (GAS bf16*)WT + (size_t)(drow + (lane >> 3)) * ldk + k0 + 8 * (lane & 7); ci.ldk = ldk;
}
__device__ __forceinline__ int conv_stream(const Frame& F, int first, int step, int total, const unsigned* stopw) {
    LAS float* scr = (LAS float*)(F.lds + F.wave * 16384);
    const int lane = F.lane;
    f32x4 bA[8], bB[8], bC[8]; ConvItem iA, iB, iC; int done = 0;
#define CV_LOAD(buf, ci, idx) do { int N_; conv_decode(F, (idx) < total ? (idx) : total - 1, lane, ci, N_); _Pragma("unroll") for (int i_ = 0; i_ < 8; ++i_) buf[i_] = *(const GAS f32x4*)(ci.src + (size_t)(8 * i_) * N_); } while (0)
#define CV_PROC(buf, ci) do { _Pragma("unroll") for (int i_ = 0; i_ < 8; ++i_) *(LAS f32x4*)(scr + (8 * i_ + (lane >> 3)) * 36 + 4 * (lane & 7)) = buf[i_]; \
        LDS_WAIT(); asm volatile("" ::: "memory"); \
        { const int c_ = lane & 7; _Pragma("unroll") for (int j_ = 0; j_ < 4; ++j_) { const LAS float* sp = scr + (8 * c_) * 36 + (lane >> 3) + 8 * j_; \
              u32x4 o; o.x = pk2(sp[0 * 36], sp[1 * 36]); o.y = pk2(sp[2 * 36], sp[3 * 36]); o.z = pk2(sp[4 * 36], sp[5 * 36]); o.w = pk2(sp[6 * 36], sp[7 * 36]); \
              *(GAS u32x4*)(ci.dst + (size_t)(8 * j_) * ci.ldk) = o; } } \
        LDS_WAIT(); asm volatile("" ::: "memory"); ++done; } while (0)
#define CV_STOPLD() __hip_atomic_load((const GAS unsigned*)stopw, RLX_AGENT)
#define CV_STOP(v) (__builtin_amdgcn_readfirstlane((int)(v)) != 0)
    int it = first;
    CV_LOAD(bA, iA, it); CV_LOAD(bB, iB, it + step);
    while (it < total) {
        unsigned sv = CV_STOPLD();
        CV_LOAD(bC, iC, it + 2 * step);
        CV_PROC(bA, iA); if (CV_STOP(sv)) break;
        if (it + step >= total) break;
        sv = CV_STOPLD();
        CV_LOAD(bA, iA, it + 3 * step);
        CV_PROC(bB, iB); if (CV_STOP(sv)) break;
        if (it + 2 * step >= total) break;
        sv = CV_STOPLD();
        CV_LOAD(bB, iB, it + 4 * step);
        CV_PROC(bC, iC); if (CV_STOP(sv)) break;
        it += 3 * step;
    }
#undef CV_STOPLD
#undef CV_LOAD
#undef CV_PROC
#undef CV_STOP
    return done;
}
__device__ __forceinline__ void p12_expert_convert(const Frame& F0) {
    PHASE_VIEW();
    volatile LAS int* red = (volatile LAS int*)(F.lds + 131072);
    const int ncw = (F.G >= 256) ? (F.G - CONV_GEMM_BLOCKS) * NWAVES : 0;
    __syncthreads();
    if (F.tid == 0) red[0] = 0x7fffffff;
    __syncthreads();
    for (int i = F.tid; i < ncw; i += NTHR) atomicMin((int*)red, (int)__hip_atomic_load(F.ctl + CW_PROG + i, RLX_AGENT));
    __syncthreads();
    const int start = ncw ? red[0] * ncw : 0;
    __syncthreads();
    const int gw = F.vcu * NWAVES + F.wave, NGW = F.G * NWAVES;
    (void)conv_stream(F, start + gw, NGW, CONV_ITEMS, F.ctl + CW_TMO + 2);
}

__device__ __forceinline__ void moe_build_tp(const Frame& F0) {
    PHASE_VIEW();
    volatile LAS int* tp = (volatile LAS int*)(F.lds + TP_OFF);
    __syncthreads();
    if (F.tid < NEXP) { const unsigned c = __hip_atomic_load(F.ctl + CW_CNT + 64 * F.tid, RLX_AGENT); tp[80 + F.tid] = (int)((c + 255u) >> 8); tp[160 + F.tid] = (int)c; }
    __syncthreads();
    if (F.tid == 0) { int s = 0; for (int e = 0; e < NEXP; ++e) { tp[e] = s; s += tp[80 + e]; } tp[NEXP] = s; }
    __syncthreads();
}
template <bool G1> struct MoeOrder {
    static constexpr bool GATHER = G1; static constexpr int A2 = 0;
    static constexpr int NNT = G1 ? 4 : 8, KK = G1 ? DM : DEXP;
    __device__ __forceinline__ size_t kstepA() const { return 128; }
    __device__ __forceinline__ size_t hstepA() const { return (size_t)128 * KK * 2; }
    __device__ __forceinline__ size_t a2off() const { return 0; }
    const LAS int* tp; const unsigned* cntw; const int* list; const char* A; const char* EW; int G, c;
    __device__ bool next(int i, pg8::Unit& u) const {
        const int x = c & 7, r = c >> 3, W = G >> 3;
        const int L = i * W + r, tl = L / NNT; u.pn = L % NNT;
        int cum = 0, e = -1, mt = 0;
#pragma unroll
        for (int j = 0; j < 8; ++j) { const int nj = tp[80 + x + 8 * j]; if (e < 0 && tl < cum + nj) { e = x + 8 * j; mt = tl - cum; } cum += nj; }
        if (e < 0) return false;
        e = __builtin_amdgcn_readfirstlane(e); mt = __builtin_amdgcn_readfirstlane(mt);
        const int tile = tp[e] + mt;
        u.e = e; u.pm = tile; u.cnt = tp[160 + e] - mt * 256;
        u.Bb = EW + ((size_t)e * (G1 ? 1024 : DM) + (size_t)u.pn * 256) * KK * 2;
        u.Ab = G1 ? A : A + (size_t)tile * 256 * KK * 2;
        return true;
    }
    template <int NV> __device__ __forceinline__ void a_voff(const pg8::Unit& u, unsigned (&v)[NV][2], const int (&R)[2], const int (&C)[2]) const {
        if constexpr (G1) {
            const int mt = u.pm - tp[u.e];
#pragma unroll
            for (int h = 0; h < 2; ++h)
#pragma unroll
                for (int i = 0; i < 2; ++i) { const int rr = h * 128 + R[i]; const int tok = list[u.e * NT + mt * 256 + (rr < u.cnt ? rr : 0)]; v[h][i] = (unsigned)(tok * KK + C[i]) * 2u; }
        } else {
#pragma unroll
            for (int i = 0; i < 2; ++i) v[0][i] = (unsigned)(R[i] * KK + C[i]) * 2u;
        }
    }
};

__device__ __forceinline__ void p15_final(const Frame& F0) {
    PHASE_VIEW();
    const GAS bf16* X1 = (const GAS bf16*)(F.ws + WS_X1); const GAS bf16* YS = (const GAS bf16*)(F.ws + WS_YSLOT); const GAS unsigned* tokinfo = (const GAS unsigned*)(F.ws + WS_TOKINFO);
    const GAS float* gpost2 = (const GAS float*)F.in[7]; const GAS float* mod = (const GAS float*)(F.ws + WS_MOD); GAS float* out = (GAS float*)F.out;
    const LAS int* tp = (const LAS int*)(F.lds + TP_OFF);
    const int gw = F.vcu * NWAVES + F.wave, NGW = F.G * NWAVES;
    f32x4 gv[8];
#pragma unroll
    for (int j = 0; j < 8; ++j) gv[j] = *(const GAS f32x4*)(gpost2 + 4 * (F.lane + 64 * j));
    u32x4 tin = *(const GAS u32x4*)(tokinfo + (size_t)gw * 8); u32x2 tgn = *(const GAS u32x2*)(tokinfo + (size_t)gw * 8 + 4);
    for (int row = gw; row < NT; row += NGW) {
        const int b = row >> 11;
        const u32x4 ti = tin; const u32x2 tg = tgn;
        const size_t r1 = (size_t)tp[ti.x] * 256 + ti.y, r2 = (size_t)tp[ti.z] * 256 + ti.w; const float g1 = __uint_as_float(tg.x), g2 = __uint_as_float(tg.y);
        const GAS u32x2* y1 = (const GAS u32x2*)(YS + r1 * DM) + F.lane; const GAS u32x2* y2 = (const GAS u32x2*)(YS + r2 * DM) + F.lane; const GAS u32x2* xp = (const GAS u32x2*)(X1 + (size_t)row * DM) + F.lane;
        u32x2 ya[8], yb[8], xw[8]; f32x4 gt[8];
#pragma unroll
        for (int j = 0; j < 8; ++j) { ya[j] = y1[64 * j]; yb[j] = y2[64 * j]; xw[j] = xp[64 * j]; gt[j] = *(const GAS f32x4*)(mod + b * NMOD + 5 * DM + 4 * (F.lane + 64 * j)); }
        { const int rn = (row + NGW < NT) ? row + NGW : row; tin = *(const GAS u32x4*)(tokinfo + (size_t)rn * 8); tgn = *(const GAS u32x2*)(tokinfo + (size_t)rn * 8 + 4); }
        f32x4 v[8]; float ss = 0.f;
#pragma unroll
        for (int j = 0; j < 8; ++j) { const u32x2 a = ya[j], c = yb[j];
            v[j] = (f32x4){bf_lo(a.x), bf_hi(a.x), bf_lo(a.y), bf_hi(a.y)} * g1 + (f32x4){bf_lo(c.x), bf_hi(c.x), bf_lo(c.y), bf_hi(c.y)} * g2;
            ss += (v[j].x * v[j].x + v[j].y * v[j].y) + (v[j].z * v[j].z + v[j].w * v[j].w); }
        const float rs = rsqrtf(wave_sum_dpp(ss) * (1.f / DM) + RMS_EPS);
#pragma unroll
        for (int j = 0; j < 8; ++j) { const f32x4 xv = (f32x4){bf_lo(xw[j].x), bf_hi(xw[j].x), bf_lo(xw[j].y), bf_hi(xw[j].y)}; v[j] = xv + gt[j] * (v[j] * rs * gv[j]); }
#pragma unroll
        for (int j = 0; j < 8; ++j) ((GAS f32x4*)(out + (size_t)row * DM))[F.lane + 64 * j] = v[j];
    }
}

constexpr int NPH = 15;
__global__ void __launch_bounds__(NTHR, 2) mk_fwd(Args args) {
    extern __shared__ __attribute__((aligned(16))) unsigned char lds[];
    Frame F0;
    F0.lds = (LAS unsigned char*)lds; F0.MISC = (volatile LAS unsigned*)(F0.lds + MISC_OFF);
    F0.tid = threadIdx.x; F0.lane = F0.tid & 63; F0.wave = __builtin_amdgcn_readfirstlane(F0.tid >> 6);
    F0.G = gridDim.x; { const int bx = blockIdx.x; F0.vcu = (F0.G % 8 == 0) ? (bx % 8) * (F0.G / 8) + bx / 8 : bx; }
    F0.in.kp = (kargp_t)__builtin_amdgcn_kernarg_segment_ptr(); F0.out = args.out; F0.ws = args.ws; F0.ctl = (unsigned*)(args.ws + WS_CTL);
    if (F0.tid < 64) F0.MISC[F0.tid] = 0u;
    __syncthreads();
    const int lo = args.ph_lo, hi = args.ph_hi;
    XcdBarrier bar; bar.bar = F0.ctl + CW_BAR; bar.x = 0; bar.st = nullptr;
    if (hi - lo > 1) bar = xcd_barrier_post(F0.ctl + CW_BAR, F0.MISC + 8);
#ifndef PROBE_MASK
#define PROBE_MASK 0
#endif
#define REPS(k) ((((PROBE_MASK) >> (k)) & 1) + 1)
#define IN(k) (lo <= (k) && (k) < hi)
#define SEAM(k) do { if (IN(k) && IN((k) + 1)) xcd_barrier(bar); } while (0)
    LAS unsigned char* ring = F0.lds;

    if (IN(0)) for (int rep_ = 0; rep_ < REPS(0); ++rep_) { p0_prologue(F0); } SEAM(0);
    if (IN(1)) for (int rep_ = 0; rep_ < REPS(1); ++rep_) { p1_h1(F0); } SEAM(1);
    if (IN(2)) for (int rep_ = 0; rep_ < REPS(2); ++rep_) {
        PHASE_VIEW();
        const int G_GEMM = (F.G >= 256) ? CONV_GEMM_BLOCKS : F.G;
        if ((int)blockIdx.x < G_GEMM) {
            pg8::Gemm g{(const bf16*)(F.ws + WS_H), (const bf16*)(F.ws + WS_WIN_T), NT, DIN, DM}; pg8::StaticOrder S; S.init(g, G_GEMM, (int)blockIdx.x);
            pg8::EpiBf16 E{(bf16*)(F.ws + WS_PROJ), DIN};
            pg8::gemm_phase(ring, DM, S, E);
            __syncthreads();
            if (F.tid == 0 && rep_ == 0) { const unsigned d = atomicAdd(F.ctl + CW_GDONE, 1u); if (d == (unsigned)G_GEMM - 1u) __hip_atomic_store(F.ctl + CW_STOP, 1u, RLX_AGENT); }
        } else if (rep_ == 0) {
            const int jw = ((int)blockIdx.x - G_GEMM) * NWAVES + F.wave, ncw = (F.G - G_GEMM) * NWAVES;
            const int done = conv_stream(F, jw, ncw, CONV_ITEMS, F.ctl + CW_STOP);
            if (F.lane == 0) __hip_atomic_store(F.ctl + CW_PROG + jw, (unsigned)done, RLX_AGENT);
        }
    } SEAM(2);
    if (IN(3)) for (int rep_ = 0; rep_ < REPS(3); ++rep_) {
        PHASE_VIEW();
        S5Order<1> S{(const char*)(F.ws + WS_PROJ), (const char*)(F.ws + WS_SIN), (const char*)(F.ws + WS_S5WT), F.G, F.vcu};
        pg8::EpiS5Scan E{(bf16*)(F.ws + WS_SIN), F.in[10], F.in[11], F.in[12]};
        if (F.G >= NG * 4) pg8::gemm_phase(ring, 256, S, E);
    }
    if (IN(3) && IN(4)) { asm volatile("s_waitcnt vmcnt(0)" ::: "memory"); __syncthreads(); __builtin_amdgcn_fence(__ATOMIC_ACQUIRE, "agent"); asm volatile("s_waitcnt vmcnt(0)" ::: "memory"); __syncthreads(); }
    if (IN(4)) for (int rep_ = 0; rep_ < REPS(4); ++rep_) {
        PHASE_VIEW();
        S5Order<2> S{(const char*)(F.ws + WS_PROJ), (const char*)(F.ws + WS_SIN), (const char*)(F.ws + WS_S5MT), F.G, F.vcu};
        pg8::EpiS5Y E{(bf16*)(F.ws + WS_YSG)};
        int kk = 384; LAUNDER(kk);
        pg8::gemm_phase(ring, kk, S, E);
    } SEAM(4);
    if (IN(5)) for (int rep_ = 0; rep_ < REPS(5); ++rep_) {
        PHASE_VIEW();
        pg8::Gemm g{(const bf16*)(F.ws + WS_YSG), (const bf16*)(F.ws + WS_GLU_T), NT, DSSM, DSSM}; pg8::StaticOrder S; S.init(g, F.G, (int)blockIdx.x);
        pg8::EpiGlu E{(const bf16*)(F.ws + WS_YSG), (bf16*)(F.ws + WS_MIX), DM, F.in[19]};
        pg8::gemm_phase(ring, DSSM, S, E);
    } SEAM(5);
    if (IN(6)) for (int rep_ = 0; rep_ < REPS(6); ++rep_) { p9a_rwkv_chunks(F0); } SEAM(6);
    if (IN(7)) for (int rep_ = 0; rep_ < REPS(7); ++rep_) { p9b_rwkv_seq(F0); } SEAM(7);
    if (IN(8)) for (int rep_ = 0; rep_ < REPS(8); ++rep_) { p9_rwkv_post(F0); } SEAM(8);
    if (IN(9)) for (int rep_ = 0; rep_ < REPS(9); ++rep_) {
        PHASE_VIEW();
        pg8::Gemm g{(const bf16*)(F.ws + WS_MIX), (const bf16*)(F.ws + WS_WOUT_T), NT, DM, DM}; pg8::StaticOrder S; S.init(g, F.G, (int)blockIdx.x);
        pg8::EpiBf16 E{(bf16*)(F.ws + WS_MIXED), DM};
        pg8::gemm_phase(ring, DM, S, E);
    } SEAM(9);
    if (IN(10)) for (int rep_ = 0; rep_ < REPS(10); ++rep_) { p11_x1_router(F0); }
    if (IN(11)) for (int rep_ = 0; rep_ < REPS(11); ++rep_) { p12_expert_convert(F0); } SEAM(11);
    if (IN(12)) for (int rep_ = 0; rep_ < REPS(12); ++rep_) {
        PHASE_VIEW();
        moe_build_tp(F);
        MoeOrder<true> S{(const LAS int*)(F.lds + TP_OFF), F.ctl + CW_CNT, (const int*)(F.ws + WS_LIST), (const char*)(F.ws + WS_H), (const char*)(F.ws + WS_EW1), F.G, (int)blockIdx.x};
        pg8::EpiSwiglu E{(bf16*)(F.ws + WS_HID)};
        pg8::gemm_phase(ring, DM, S, E);
    } SEAM(12);
    if (IN(13)) for (int rep_ = 0; rep_ < REPS(13); ++rep_) {
        PHASE_VIEW();
        moe_build_tp(F);
        MoeOrder<false> S{(const LAS int*)(F.lds + TP_OFF), F.ctl + CW_CNT, (const int*)(F.ws + WS_LIST), (const char*)(F.ws + WS_HID), (const char*)(F.ws + WS_EW2), F.G, (int)blockIdx.x};
        pg8::EpiBf16 E{(bf16*)(F.ws + WS_YSLOT), DM};
        pg8::gemm_phase(ring, DEXP, S, E);
    } SEAM(13);
    if (IN(14)) for (int rep_ = 0; rep_ < REPS(14); ++rep_) { moe_build_tp(F0); p15_final(F0); }
#undef IN
#undef SEAM
}

extern "C" void kernel_launch(void* const* d_in, const int* in_sizes, int n_in, void* d_out, int out_size, void* d_ws, size_t ws_size, hipStream_t stream) {
    static int grid = 0;
    if (grid == 0) {
        if (n_in != 38 || out_size != NT * DM || ws_size < WS_END) { fprintf(stderr, "kernel_launch: unexpected problem (n_in %d, out %d, ws %zu < %zu)\n", n_in, out_size, ws_size, (size_t)WS_END); grid = -1; return; }
        int dev = 0, cus = 0, per_cu = 0;
        if (hipGetDevice(&dev) != hipSuccess || hipDeviceGetAttribute(&cus, hipDeviceAttributeMultiprocessorCount, dev) != hipSuccess) { grid = -1; return; }
        if (hipFuncSetAttribute((const void*)mk_fwd, hipFuncAttributeMaxDynamicSharedMemorySize, LDS_BYTES) != hipSuccess) { fprintf(stderr, "kernel_launch: hipFuncSetAttribute failed\n"); grid = -1; return; }
        if (hipOccupancyMaxActiveBlocksPerMultiprocessor(&per_cu, (const void*)mk_fwd, NTHR, LDS_BYTES) != hipSuccess || per_cu < 1) fprintf(stderr, "kernel_launch: occupancy query says %d\n", per_cu);
        (void)hipGetLastError();
        grid = cus;
    }
    if (grid < 0) return;
    if (hipMemsetAsync((char*)d_ws + WS_CTL, 0, CTL_ZERO_BYTES, stream) != hipSuccess) return;
    Args a{};
    for (int i = 0; i < 38; ++i) a.in[i] = (const float*)d_in[i];
    a.out = (float*)d_out; a.ws = (unsigned char*)d_ws;
#if MK_N_LAUNCHES == 1
    a.ph_lo = 0; a.ph_hi = NPH;
    hipLaunchKernelGGL(mk_fwd, dim3(grid), dim3(NTHR), LDS_BYTES, stream, a);
#else
    for (int p = 0; p < NPH; ++p) { a.ph_lo = p; a.ph_hi = p + 1; hipLaunchKernelGGL(mk_fwd, dim3(grid), dim3(NTHR), LDS_BYTES, stream, a); }
#endif
}
```

```cpp
#include <hip/hip_runtime.h>
#include <cstdio>
#include <cstdint>

#ifndef MK_N_LAUNCHES
#define MK_N_LAUNCHES 1
#endif

#ifndef CONV_GEMM_BLOCKS
#define CONV_GEMM_BLOCKS 184
#endif

#define GAS __attribute__((address_space(1)))
namespace pg8 {
#define PG8_LAS __attribute__((address_space(3)))
typedef unsigned short bf16_t;
typedef short bf16x8 __attribute__((ext_vector_type(8)));
typedef float f32x4 __attribute__((ext_vector_type(4)));
typedef float f32x2 __attribute__((ext_vector_type(2)));
typedef unsigned u32x4 __attribute__((ext_vector_type(4)));
typedef unsigned u32x2 __attribute__((ext_vector_type(2)));
constexpr int BM = 256, BK = 64, HALF = 128, HTB = HALF * BK * 2, STAGE_BYTES = 8 * HTB, NXCD = 8, WGM = 8;

__host__ __device__ __forceinline__ int lds_byte(int r, int c) { const int st = (r >> 4) * 2 + (c >> 5), rr = r & 15, cc = c & 31, ob = rr * 64 + cc * 2; return st * 1024 + (ob ^ (((ob >> 9) & 1) << 5)); }
__host__ __device__ __forceinline__ void stage_rc(int b, int& R, int& C) { const int st = b / 1024, sb = b % 1024, swz = sb ^ (((sb >> 9) & 1) << 5); R = (st >> 1) * 16 + swz / 64; C = (st & 1) * 32 + (swz % 64) / 2; }
__host__ __device__ __forceinline__ int perm32(int rho) { const int n = rho >> 4, i = rho & 15; return 8 * (i >> 2) + 4 * n + (i & 3); }

struct Unit { int pm, pn, e, cnt; const char* Ab; const char* Bb; };
struct Gemm { const bf16_t* A; const bf16_t* Bt; int M, N, K; };

struct StaticOrder {
    static constexpr bool GATHER = false; static constexpr int A2 = 0;
    __device__ __forceinline__ size_t kstepA() const { return (size_t)BK * 2; }
    __device__ __forceinline__ size_t hstepA() const { return (size_t)HALF * K * 2; }
    __device__ __forceinline__ size_t a2off() const { return 0; }
    int nM, nN, nwg, G, c, K; const char* A; const char* Bt;
    __device__ void init(const Gemm& g, int G_, int c_) { nM = g.M / BM; nN = g.N / BM; nwg = nM * nN; G = G_; c = c_; K = g.K; A = (const char*)g.A; Bt = (const char*)g.Bt; }
    __device__ bool next(int i, Unit& u) const {
        const long L = (long)i * G + c; if (L >= nwg) return false;
        int wgid = (int)L; { const int q = nwg / NXCD, r = nwg % NXCD, xcd = wgid % NXCD, off = wgid / NXCD; wgid = (xcd < r ? xcd * (q + 1) : r * (q + 1) + (xcd - r) * q) + off; }
        const int nig = WGM * nN, gid = wgid / nig, fm = gid * WGM, gsz = (nM - fm) < WGM ? (nM - fm) : WGM;
        u.pm = fm + ((wgid % nig) % gsz); u.pn = (wgid % nig) / gsz; u.e = 0; u.cnt = BM;
        u.Ab = A + (size_t)u.pm * BM * K * 2; u.Bb = Bt + (size_t)u.pn * BM * K * 2; return true;
    }
    template <int NV> __device__ __forceinline__ void a_voff(const Unit&, unsigned (&v)[NV][2], const int (&R)[2], const int (&C)[2]) const {
#pragma unroll
        for (int i = 0; i < 2; ++i) v[0][i] = (unsigned)(R[i] * K + C[i]) * 2u;
    }
};

typedef __bf16 bf16x2_v __attribute__((ext_vector_type(2)));
__device__ __forceinline__ unsigned cvt_pk_bf16(float lo, float hi) { const f32x2 v = {lo, hi}; const bf16x2_v b = __builtin_convertvector(v, bf16x2_v); return __builtin_bit_cast(unsigned, b); }
__device__ __forceinline__ float bf_lo(unsigned w) { return __uint_as_float(w << 16); }
__device__ __forceinline__ float bf_hi(unsigned w) { return __uint_as_float(w & 0xffff0000u); }
__device__ __forceinline__ float sigmoidf_(float x) { return __builtin_amdgcn_rcpf(1.0f + __builtin_amdgcn_exp2f(-1.4426950408889634f * x)); }

struct EpiF32 {
    static constexpr bool AFTER_DRAIN = false; static constexpr bool PERM = false;
    float* C; int ldc;
    __device__ __forceinline__ void operator()(const f32x4 (&acc)[2][2][4][2], const Unit& u, int wr, int wc, int fr, int fq) const {
        const int row0 = u.pm * BM + wr * 64 + fr, col0 = u.pn * BM + wc * 32 + 4 * fq;
#pragma unroll
        for (int ai = 0; ai < 2; ++ai)
#pragma unroll
            for (int m = 0; m < 4; ++m) { float* rowp = C + (size_t)(row0 + ai * HALF + m * 16) * ldc + col0;
#pragma unroll
                for (int bj = 0; bj < 2; ++bj)
#pragma unroll
                    for (int n = 0; n < 2; ++n) *(f32x4*)(rowp + bj * HALF + n * 16) = acc[ai][bj][m][n]; }
    }
};
struct EpiBf16 {
    static constexpr bool AFTER_DRAIN = false; static constexpr bool PERM = true;
    bf16_t* O; int ldc;
    __device__ __forceinline__ void operator()(const f32x4 (&acc)[2][2][4][2], const Unit& u, int wr, int wc, int fr, int fq) const {
        const int row0 = u.pm * BM + wr * 64 + fr, col0 = u.pn * BM + wc * 32 + 8 * fq;
#pragma unroll
        for (int ai = 0; ai < 2; ++ai)
#pragma unroll
            for (int m = 0; m < 4; ++m) { GAS bf16_t* rowp = (GAS bf16_t*)O + (size_t)(row0 + ai * HALF + m * 16) * ldc + col0;
#pragma unroll
                for (int bj = 0; bj < 2; ++bj) { const f32x4 v0 = acc[ai][bj][m][0], v1 = acc[ai][bj][m][1];
                    u32x4 w; w.x = cvt_pk_bf16(v0[0], v0[1]); w.y = cvt_pk_bf16(v0[2], v0[3]); w.z = cvt_pk_bf16(v1[0], v1[1]); w.w = cvt_pk_bf16(v1[2], v1[3]);
                    *(GAS u32x4*)(rowp + bj * HALF) = w; } }
    }
};
struct EpiLora {
    static constexpr bool AFTER_DRAIN = false; static constexpr bool PERM = false;
    float* base; size_t stride; const float* w0; const float* a0;
    __device__ __forceinline__ void operator()(const f32x4 (&acc)[2][2][4][2], const Unit& u, int wr, int wc, int fr, int fq) const {
        const int row0 = u.pm * BM + wr * 64 + fr; const int kind = u.pn >> 2; const int col0 = (u.pn & 3) * BM + wc * 32 + 4 * fq;
        float* dst = base + (size_t)kind * stride;
        const float* bp = (kind == 0) ? w0 : a0; const float bs = (kind == 2) ? 0.f : 1.f;
        f32x4 bv[2][2];
#pragma unroll
        for (int bj = 0; bj < 2; ++bj)
#pragma unroll
            for (int n = 0; n < 2; ++n) bv[bj][n] = *(const f32x4*)(bp + col0 + bj * HALF + n * 16) * bs;
#pragma unroll
        for (int ai = 0; ai < 2; ++ai)
#pragma unroll
            for (int m = 0; m < 4; ++m) { float* rowp = dst + (size_t)(row0 + ai * HALF + m * 16) * 1024 + col0;
#pragma unroll
                for (int bj = 0; bj < 2; ++bj)
#pragma unroll
                    for (int n = 0; n < 2; ++n) { f32x4 v = acc[ai][bj][m][n] + bv[bj][n];
                        if (kind == 0) {
#pragma unroll
                            for (int j = 0; j < 4; ++j) v[j] = __expf(-0.6065306597126334f * sigmoidf_(v[j])); }
                        else if (kind == 1) {
#pragma unroll
                            for (int j = 0; j < 4; ++j) v[j] = sigmoidf_(v[j]); }
                        *(f32x4*)(rowp + bj * HALF + n * 16) = v; } }
    }
};
struct EpiGlu {
    static constexpr bool AFTER_DRAIN = false; static constexpr bool PERM = true;
    const bf16_t* Y; bf16_t* O; int ldo; const float* bias;
    __device__ __forceinline__ void operator()(const f32x4 (&acc)[2][2][4][2], const Unit& u, int wr, int wc, int fr, int fq) const {
        const int row0 = u.pm * BM + wr * 64 + fr, col0 = u.pn * BM + wc * 32 + 8 * fq;
        f32x4 bv[2][2];
#pragma unroll
        for (int bj = 0; bj < 2; ++bj)
#pragma unroll
            for (int n = 0; n < 2; ++n) bv[bj][n] = *(const GAS f32x4*)((const GAS float*)bias + col0 + bj * HALF + 4 * n);
#pragma unroll
        for (int ai = 0; ai < 2; ++ai)
#pragma unroll
            for (int m = 0; m < 4; ++m) { const size_t r = (size_t)(row0 + ai * HALF + m * 16);
#pragma unroll
                for (int bj = 0; bj < 2; ++bj) { const u32x4 yv = *(const GAS u32x4*)((const GAS bf16_t*)Y + r * 1024 + col0 + bj * HALF);
                    const f32x4 v0 = acc[ai][bj][m][0] + bv[bj][0], v1 = acc[ai][bj][m][1] + bv[bj][1];
                    u32x4 w;
                    w.x = cvt_pk_bf16(bf_lo(yv.x) * sigmoidf_(v0[0]), bf_hi(yv.x) * sigmoidf_(v0[1]));
                    w.y = cvt_pk_bf16(bf_lo(yv.y) * sigmoidf_(v0[2]), bf_hi(yv.y) * sigmoidf_(v0[3]));
                    w.z = cvt_pk_bf16(bf_lo(yv.z) * sigmoidf_(v1[0]), bf_hi(yv.z) * sigmoidf_(v1[1]));
                    w.w = cvt_pk_bf16(bf_lo(yv.w) * sigmoidf_(v1[2]), bf_hi(yv.w) * sigmoidf_(v1[3]));
                    *(GAS u32x4*)((GAS bf16_t*)O + r * ldo + col0 + bj * HALF) = w; } }
    }
};
struct EpiSwiglu {
    static constexpr bool AFTER_DRAIN = false; static constexpr bool PERM = true;
    bf16_t* Hd;
    __device__ __forceinline__ void operator()(const f32x4 (&acc)[2][2][4][2], const Unit& u, int wr, int wc, int fr, int fq) const {
        const int row0 = u.pm * BM + wr * 64 + fr, col0 = u.pn * HALF + wc * 32 + 8 * fq;
#pragma unroll
        for (int ai = 0; ai < 2; ++ai)
#pragma unroll
            for (int m = 0; m < 4; ++m) { GAS bf16_t* rowp = (GAS bf16_t*)Hd + (size_t)(row0 + ai * HALF + m * 16) * 512 + col0;
                float o[8];
#pragma unroll
                for (int n = 0; n < 2; ++n)
#pragma unroll
                    for (int j = 0; j < 4; ++j) { const float a = acc[ai][0][m][n][j], b = acc[ai][1][m][n][j]; o[n * 4 + j] = a * sigmoidf_(a) * b; }
                u32x4 w; w.x = cvt_pk_bf16(o[0], o[1]); w.y = cvt_pk_bf16(o[2], o[3]); w.z = cvt_pk_bf16(o[4], o[5]); w.w = cvt_pk_bf16(o[6], o[7]);
                *(GAS u32x4*)rowp = w; }
    }
};

struct EpiS5Scan {
    static constexpr bool AFTER_DRAIN = true; static constexpr bool PERM = false;
    bf16_t* SIN; const float* lam_re; const float* lam_im; const float* log_dt;
    __device__ __forceinline__ void operator()(const f32x4 (&)[2][2][4][2], const Unit&, int, int, int, int) const {}
    __device__ __forceinline__ void fused(const f32x4 (&acc)[2][2][4][2], const Unit& u, int wr, int wc, int fr, int fq, PG8_LAS unsigned char* lds) const {
        PG8_LAS float* T = (PG8_LAS float*)lds;
#pragma unroll
        for (int ai = 0; ai < 2; ++ai)
#pragma unroll
            for (int m = 0; m < 4; ++m)
#pragma unroll
                for (int n = 0; n < 2; ++n) *(PG8_LAS f32x4*)(T + (ai * HALF + wr * 64 + m * 16 + fr) * 128 + wc * 32 + n * 16 + 4 * fq) = acc[ai][0][m][n];
        __syncthreads();
        const int tid = threadIdx.x;
        if (tid < 128) {
            const int b2 = tid >> 6, p = tid & 63, g = u.e;
            const float lr = fminf(lam_re[g * 64 + p], -1e-4f), li = lam_im[g * 64 + p], dt = __expf(log_dt[g]);
            const float mag = __expf(lr * dt * 16.f), ang = li * dt * 16.f; const float ar = mag * cosf(ang), ai_ = mag * sinf(ang);
            float sr = 0.f, si = 0.f;
            GAS bf16_t* dst = (GAS bf16_t*)SIN + ((size_t)(u.pm * 256 + b2 * 128) * 16 + (p >> 4)) * 4352 + g * 16 + (p & 15);
            const PG8_LAS float* src = T + (b2 * 128) * 128 + p;
#pragma unroll 8
            for (int ch = 0; ch < 128; ++ch) {
                const unsigned w = cvt_pk_bf16(sr, si);
                dst[(size_t)ch * 16 * 4352] = (bf16_t)(w & 0xffffu); dst[(size_t)ch * 16 * 4352 + 4 * 4352] = (bf16_t)(w >> 16);
                const float lr_ = src[ch * 128], li_ = src[ch * 128 + 64];
                const float nr = ar * sr - ai_ * si + lr_, ni = ar * si + ai_ * sr + li_; sr = nr; si = ni;
            }
        }
    }
};
__device__ __forceinline__ float gelu_tanh_(float y) { const float u = 0.7978845608028654f * (y + 0.044715f * y * y * y); const float e = __builtin_amdgcn_exp2f(2.8853900817779268f * u); return y * (1.f - __builtin_amdgcn_rcpf(e + 1.f)); }
struct EpiS5Y {
    static constexpr bool AFTER_DRAIN = false; static constexpr bool PERM = true;
    bf16_t* Y;
    __device__ __forceinline__ void operator()(const f32x4 (&acc)[2][2][4][2], const Unit& u, int wr, int wc, int fr, int fq) const {
        const int row0 = u.pm * BM + wr * 64 + fr;
#pragma unroll
        for (int ai = 0; ai < 2; ++ai)
#pragma unroll
            for (int m = 0; m < 4; ++m) { const size_t r = (size_t)(row0 + ai * HALF + m * 16);
#pragma unroll
                for (int bj = 0; bj < 2; ++bj) { const int col = bj * HALF + wc * 32 + 8 * fq; const int t = col >> 4, c = col & 15;
                    const f32x4 v0 = acc[ai][bj][m][0], v1 = acc[ai][bj][m][1];
                    u32x4 w; w.x = cvt_pk_bf16(gelu_tanh_(v0[0]), gelu_tanh_(v0[1])); w.y = cvt_pk_bf16(gelu_tanh_(v0[2]), gelu_tanh_(v0[3]));
                    w.z = cvt_pk_bf16(gelu_tanh_(v1[0]), gelu_tanh_(v1[1])); w.w = cvt_pk_bf16(gelu_tanh_(v1[2]), gelu_tanh_(v1[3]));
                    *(GAS u32x4*)((GAS bf16_t*)Y + (r * 16 + t) * 1024 + u.e * 16 + c) = w; } }
    }
};

template <class Epi, class Sched>
__device__ __forceinline__ void gemm_phase(PG8_LAS unsigned char* lds, const int K, const Sched& S, const Epi& E) {
    const int tid = threadIdx.x, wid = __builtin_amdgcn_readfirstlane(tid >> 6), lane = tid & 63, wr = wid >> 2, wc = wid & 3, fr = lane & 15, fq = lane >> 4;
    const int nt = K / BK;
    int RR[2], CC[2]; unsigned voffB[2];
#pragma unroll
    for (int i = 0; i < 2; ++i) { stage_rc(tid * 16 + i * 8192, RR[i], CC[i]); const int Rb = Epi::PERM ? ((RR[i] & ~31) + perm32(RR[i] & 31)) : RR[i];
        voffB[i] = (unsigned)(Rb * K + CC[i]) * 2u; }
    const size_t kstep = (size_t)(BK * 2);
    const size_t hstep = (size_t)HALF * K * 2;
    const unsigned ldsw = (unsigned)wid * 1024u;
    const int aoff = lds_byte(wr * 64 + fr, fq * 8), boff = lds_byte(wc * 32 + fr, fq * 8);
#define PG8_SA(b, h) (((b) * 2 + (h)) * HTB)
#define PG8_SB(b, h) ((4 + (b) * 2 + (h)) * HTB)
#define PG8_STAGE(bufoff, gbase, voff) do { _Pragma("unroll") for (int _i = 0; _i < 2; ++_i) \
        __builtin_amdgcn_global_load_lds((const unsigned*)((const char*)(gbase) + (voff)[_i]), (PG8_LAS unsigned*)(lds + (bufoff) + ldsw + _i * 8192), 16, 0, 0); } while (0)
#define PG8_LDA(dst, b, h) do { _Pragma("unroll") for (int m = 0; m < 4; ++m) _Pragma("unroll") for (int k = 0; k < 2; ++k) dst[m][k] = *(const PG8_LAS bf16x8*)(lds + PG8_SA(b, h) + aoff + m * 2048 + k * 1024); } while (0)
#define PG8_LDB(dst, b, h) do { _Pragma("unroll") for (int n = 0; n < 2; ++n) _Pragma("unroll") for (int k = 0; k < 2; ++k) dst[n][k] = *(const PG8_LAS bf16x8*)(lds + PG8_SB(b, h) + boff + n * 2048 + k * 1024); } while (0)
#define PG8_MMA(ai, bj, At, Bt) do { __builtin_amdgcn_s_setprio(1); _Pragma("unroll") for (int m = 0; m < 4; ++m) _Pragma("unroll") for (int n = 0; n < 2; ++n) _Pragma("unroll") for (int k = 0; k < 2; ++k) \
        acc[ai][bj][m][n] = __builtin_amdgcn_mfma_f32_16x16x32_bf16(Bt[n][k], At[m][k], acc[ai][bj][m][n], 0, 0, 0); __builtin_amdgcn_s_setprio(0); } while (0)
#define PG8_WAIT_V(n) asm volatile("s_waitcnt vmcnt(" #n ")" ::: "memory")
#define PG8_WAIT_L(n) asm volatile("s_waitcnt lgkmcnt(" #n ")" ::: "memory")
#define PG8_BAR __builtin_amdgcn_s_barrier()
#define PG8_SCHED __builtin_amdgcn_sched_barrier(0)
    Unit cur, nxt; int ui = 0;
    if (!S.next(0, cur)) return;
    f32x4 acc[2][2][4][2];
#pragma unroll
    for (int a = 0; a < 2; ++a)
#pragma unroll
        for (int b = 0; b < 2; ++b)
#pragma unroll
            for (int m = 0; m < 4; ++m)
#pragma unroll
                for (int n = 0; n < 2; ++n) acc[a][b][m][n] = (f32x4){0.f, 0.f, 0.f, 0.f};
    bf16x8 At[4][2], B0[2][2], B1[2][2];
    constexpr bool GA = Sched::GATHER;
    constexpr int A2 = Sched::A2;
    constexpr int NV = GA ? 2 : 1;
    unsigned vA[NV][2], vN[NV][2];
    const size_t kstepA = S.kstepA(), hstepA = GA ? 0 : S.hstepA();
    const size_t a2off = (A2 > 0) ? S.a2off() : 0;
    S.template a_voff<NV>(cur, vA, RR, CC);
    const char* cA = cur.Ab; const char* cB = cur.Bb;
    PG8_STAGE(PG8_SB(0, 0), cB, voffB); PG8_STAGE(PG8_SB(0, 1), cB + hstep, voffB); PG8_STAGE(PG8_SA(0, 0), cA, vA[0]); PG8_STAGE(PG8_SA(0, 1), cA + hstepA, vA[NV - 1]);
    if (wr == 1) PG8_BAR;
    PG8_WAIT_V(2); PG8_BAR;
    PG8_STAGE(PG8_SB(1, 0), cB + kstep, voffB); PG8_STAGE(PG8_SA(1, 0), cA + kstepA, vA[0]); PG8_STAGE(PG8_SB(1, 1), cB + hstep + kstep, voffB);
    PG8_WAIT_V(6); PG8_BAR;
    for (;;) {
        const bool has_next = S.next(ui + 1, nxt);
        const char* nA = has_next ? nxt.Ab : cA; const char* nB = has_next ? nxt.Bb : cB;
        if constexpr (GA) {
            if (has_next) S.template a_voff<NV>(nxt, vN, RR, CC);
            else {
#pragma unroll
                for (int h = 0; h < NV; ++h)
#pragma unroll
                    for (int i = 0; i < 2; ++i) vN[h][i] = vA[h][i]; }
        }
#pragma clang loop unroll(disable)
        for (int t = 0; t < nt; t += 2) {
            const bool last = (t == nt - 2);
            const bool s1 = (A2 > 0) && (t + 1 >= A2), s2 = (A2 > 0) && !last && (t + 2 >= A2);
            const char* a1 = cA + (size_t)(t + 1) * kstepA + (s1 ? a2off : 0);
            const char* a2 = last ? nA : cA + (size_t)(t + 2) * kstepA + (s2 ? a2off : 0);
            const char* a3 = a2 + kstepA;
            const char* b2 = last ? nB : cB + (size_t)(t + 2) * kstep; const char* b3 = b2 + kstep;
            unsigned v2[NV][2];
#pragma unroll
            for (int h = 0; h < NV; ++h)
#pragma unroll
                for (int i = 0; i < 2; ++i) v2[h][i] = (GA && last) ? vN[h][i] : vA[h][i];
            PG8_LDB(B0, 0, 0); PG8_LDB(B1, 0, 1); PG8_SCHED; PG8_LDA(At, 0, 0); PG8_STAGE(PG8_SA(1, 1), a1 + hstepA, vA[NV - 1]);
            PG8_WAIT_V(8); PG8_WAIT_L(0); PG8_BAR; PG8_MMA(0, 0, At, B0); PG8_MMA(0, 1, At, B1); PG8_BAR; PG8_SCHED;
            PG8_LDA(At, 0, 1); PG8_STAGE(PG8_SB(0, 0), b2, voffB); PG8_STAGE(PG8_SB(0, 1), b2 + hstep, voffB); PG8_STAGE(PG8_SA(0, 0), a2, v2[0]);
            PG8_WAIT_V(8); PG8_WAIT_L(0); PG8_BAR; PG8_MMA(1, 0, At, B0); PG8_MMA(1, 1, At, B1); PG8_BAR; PG8_SCHED;
            PG8_LDB(B0, 1, 0); PG8_LDB(B1, 1, 1); PG8_SCHED; PG8_LDA(At, 1, 0); PG8_STAGE(PG8_SA(0, 1), a2 + hstepA, v2[NV - 1]);
            PG8_WAIT_V(8); PG8_WAIT_L(0); PG8_BAR; PG8_MMA(0, 0, At, B0); PG8_MMA(0, 1, At, B1); PG8_BAR; PG8_SCHED;
            PG8_LDA(At, 1, 1); PG8_STAGE(PG8_SB(1, 0), b3, voffB); PG8_STAGE(PG8_SB(1, 1), b3 + hstep, voffB); PG8_STAGE(PG8_SA(1, 0), a3, v2[0]);
            PG8_WAIT_V(8); PG8_WAIT_L(0); PG8_BAR; PG8_MMA(1, 0, At, B0); PG8_MMA(1, 1, At, B1); PG8_BAR; PG8_SCHED;
        }
        if (wr == 0) PG8_BAR;
        if constexpr (!Epi::AFTER_DRAIN) E(acc, cur, wr, wc, fr, fq);
        if (!has_next) break;
#pragma unroll
        for (int a = 0; a < 2; ++a)
#pragma unroll
            for (int b = 0; b < 2; ++b)
#pragma unroll
                for (int m = 0; m < 4; ++m)
#pragma unroll
                    for (int n = 0; n < 2; ++n) acc[a][b][m][n] = (f32x4){0.f, 0.f, 0.f, 0.f};
        cur = nxt; cA = nA; cB = nB; ++ui;
        if constexpr (GA) {
#pragma unroll
            for (int h = 0; h < NV; ++h)
#pragma unroll
                for (int i = 0; i < 2; ++i) vA[h][i] = vN[h][i]; }
        if (wr == 1) PG8_BAR;
    }
    PG8_WAIT_V(0);
    PG8_BAR;
    if constexpr (Epi::AFTER_DRAIN) E.fused(acc, cur, wr, wc, fr, fq, lds);
#undef PG8_SA
#undef PG8_SB
#undef PG8_STAGE
#undef PG8_LDA
#undef PG8_LDB
#undef PG8_MMA
#undef PG8_WAIT_V
#undef PG8_WAIT_L
#undef PG8_BAR
#undef PG8_SCHED
}
}
using pg8::f32x4; using pg8::f32x2; using pg8::u32x4; using pg8::u32x2; using pg8::cvt_pk_bf16; using pg8::bf_lo; using pg8::bf_hi; using pg8::sigmoidf_;

constexpr int NWAVES = 8, NTHR = 512;
constexpr int DM = 2048, NB = 8, SEQ = 2048, NT = NB * SEQ;
constexpr int DSSM = 1024, NG = 64, GC = 16, NP = 64;
constexpr int DRW = 1024, NH = 16, HD = 64;
constexpr int DIN = 4352, ZW = 3328;
constexpr int NEXP = 64, DEXP = 512, NMOD = 6 * DM;
constexpr float RMS_EPS = 1e-6f, GN_EPS = 64e-5f;
constexpr int CAP_ROWS = 49152;

constexpr size_t MiB = 1u << 20;
constexpr size_t WS_CTL = 0, CTL_ZERO_BYTES = 1 * MiB;
constexpr size_t WS_MOD = 1 * MiB;
constexpr size_t WS_RWT = 1 * MiB + 512 * 1024;
constexpr size_t WS_LORA_T = 2 * MiB + 512 * 1024;
constexpr size_t WS_GLU_T = 4 * MiB;
constexpr size_t WS_WOUT_T = 6 * MiB;
constexpr size_t WS_WIN_T = 14 * MiB;
constexpr size_t WS_TOKINFO = 31 * MiB;
constexpr size_t WS_LIST = 32 * MiB;
constexpr size_t WS_LIN = 36 * MiB;
constexpr size_t WS_H = 44 * MiB;
constexpr size_t WS_PROJ = 108 * MiB;
constexpr size_t WS_MIX = 244 * MiB;
constexpr size_t WS_EW1 = 308 * MiB;
constexpr size_t WS_EW2 = 564 * MiB;
constexpr size_t WS_SIN = 692 * MiB;
constexpr size_t WS_YSG = 828 * MiB;
constexpr size_t WS_S5MT = 860 * MiB;
constexpr size_t WS_S5WT = 872 * MiB;
constexpr size_t WS_VB = 692 * MiB;
constexpr size_t WS_GB = 724 * MiB;
constexpr size_t WS_GHQ = 756 * MiB;
constexpr size_t WS_GT = 948 * MiB;
constexpr size_t WS_BON = 950 * MiB;
constexpr size_t WS_Y = 952 * MiB;
constexpr size_t WS_X1 = 692 * MiB;
constexpr size_t WS_HID = 756 * MiB;
constexpr size_t WS_END = 984 * MiB;
constexpr size_t WS_MIXED = 108 * MiB;
constexpr size_t WS_YSLOT = 108 * MiB;
static_assert(WS_YSLOT + (size_t)CAP_ROWS * 2048 * 2 <= WS_EW1, "yslot overlay");
static_assert(WS_HID + (size_t)CAP_ROWS * 512 * 2 <= WS_END && WS_GHQ + (size_t)8192 * 12288 * 2 <= WS_GT && WS_SIN + (size_t)NT * DIN * 2 <= WS_YSG, "pool");
constexpr int CW_TMO = 0;
constexpr int CW_BAR = 4096;
constexpr int CW_CNT = 16384;
constexpr int CW_GDONE = 8192, CW_STOP = 8192 + 64, CW_PROG = 8192 + 128;
constexpr int CONV_ITEMS = NEXP * 1536;


constexpr int RING_BYTES = 131072;
constexpr int LDSCTL_OFF = 147456 - 2048;
constexpr int MISC_OFF = LDSCTL_OFF;
constexpr int TP_OFF = LDSCTL_OFF + 256;
constexpr int LDS_BYTES = 147456;

#define LAS __attribute__((address_space(3)))
typedef unsigned short bf16;
typedef GAS unsigned gu32;
#define RLX_AGENT __ATOMIC_RELAXED, __HIP_MEMORY_SCOPE_AGENT

#define XB_TMO      128
#define XB_XCNT(j)  (256  + 64 * (j))
#define XB_XSUB(j)  (1280 + 64 * (j))
#define XB_XGEN(j)  (2304 + 64 * (j))
#define XB_TOP      3328
#define XB_TOPGEN   3392
#define XCD_BAR_WORDS 3456
#define XB_SPIN_CAP (1u << 18)
__device__ __forceinline__ unsigned xb_ld(unsigned* p)              { return __hip_atomic_load(p, __ATOMIC_RELAXED, __HIP_MEMORY_SCOPE_AGENT); }
__device__ __forceinline__ unsigned xb_add(unsigned* p, unsigned v) { return __hip_atomic_fetch_add(p, v, __ATOMIC_RELAXED, __HIP_MEMORY_SCOPE_AGENT); }
__device__ __forceinline__ unsigned xb_xcc_id() { return (unsigned)__builtin_amdgcn_s_getreg((3 << 11) | 20) & 0xFu; }
#define XB_SPIN(cond, bar) do { unsigned _sp = 0; while (cond) { __builtin_amdgcn_s_sleep(1); \
    if ((++_sp & 255u) == 0u) { if (xb_ld(&(bar)[XB_TMO])) break; if (_sp > XB_SPIN_CAP) { atomicAdd(&(bar)[XB_TMO], 1u); break; } } } } while (0)
struct XcdBarrier { unsigned* bar; unsigned x; volatile LAS unsigned* st; };
__device__ __forceinline__ XcdBarrier xcd_barrier_post(unsigned* bar, volatile LAS unsigned* st) {
    XcdBarrier b; b.bar = bar; b.x = xb_xcc_id(); b.st = st;
    if (threadIdx.x == 0) (void)xb_add(&bar[XB_XCNT(b.x)], 1u);
    return b;
}
__device__ __forceinline__ void xcd_barrier_complete(unsigned* bar, unsigned x, unsigned& nloc, unsigned& nx) {
    const unsigned G = gridDim.x * gridDim.y * gridDim.z;
    unsigned sum, cnt, mine, sp = 0u;
    for (;;) {
        sum = 0u; cnt = 0u; mine = 0u;
#pragma unroll
        for (unsigned j = 0; j < 16; ++j) { const unsigned c = xb_ld(&bar[XB_XCNT(j)]); sum += c; cnt += (c > 0u) ? 1u : 0u; mine = (j == x) ? c : mine; }
        if (sum == G) break;
        __builtin_amdgcn_s_sleep(1);
        if ((++sp & 255u) == 0u) { if (xb_ld(&bar[XB_TMO])) break; if (sp > XB_SPIN_CAP) { atomicAdd(&bar[XB_TMO], 1u); break; } }
    }
    nloc = mine > 0u ? mine : 1u; nx = cnt > 0u ? cnt : 1u;
}
__device__ __forceinline__ void xcd_barrier(const XcdBarrier& b) {
    asm volatile("s_waitcnt vmcnt(0)" ::: "memory");
    __syncthreads();
    if (threadIdx.x == 0) {
        unsigned* bar = b.bar;
        __builtin_amdgcn_s_waitcnt(0);
        unsigned nloc = b.st[0], nx = b.st[1];
        if (nloc == 0u) { xcd_barrier_complete(bar, b.x, nloc, nx); b.st[0] = nloc; b.st[1] = nx; }
        const unsigned old = xb_add(&bar[XB_XSUB(b.x)], 1u);
        const unsigned gen = old / nloc;
        if (old + 1u == (gen + 1u) * nloc) {
            __builtin_amdgcn_fence(__ATOMIC_RELEASE, "agent");
            asm volatile("s_waitcnt vmcnt(0)" ::: "memory");
            const unsigned og = xb_add(&bar[XB_TOP], 1u);
            const unsigned tg = og / nx;
            if (og + 1u == (tg + 1u) * nx) xb_add(&bar[XB_TOPGEN], 1u);
            else XB_SPIN(xb_ld(&bar[XB_TOPGEN]) == tg, bar);
            __builtin_amdgcn_fence(__ATOMIC_ACQUIRE, "agent");
            xb_add(&bar[XB_XGEN(b.x)], 1u);
            asm volatile("s_waitcnt vmcnt(0)" ::: "memory");
        } else {
            XB_SPIN(xb_ld(&bar[XB_XGEN(b.x)]) == gen, bar);
            __builtin_amdgcn_fence(__ATOMIC_ACQUIRE, "agent");
            asm volatile("s_waitcnt vmcnt(0)" ::: "memory");
        }
    }
    __syncthreads();
}

struct Args { const float* in[38]; float* out; unsigned char* ws; int ph_lo, ph_hi; };
typedef const float* cfp_t;
typedef __attribute__((address_space(4))) const unsigned char* kargp_t;
struct InTab { kargp_t kp;
    __device__ __forceinline__ const float* operator[](int i) const { return *(const __attribute__((address_space(4))) cfp_t*)(kp + 8 * i); } };
struct Frame {
    LAS unsigned char* lds; volatile LAS unsigned* MISC; unsigned* ctl;
    int tid, lane, wave, vcu, G;
    InTab in; float* out; unsigned char* ws;
};
#define LDS_WAIT() asm volatile("s_waitcnt lgkmcnt(0)" ::: "memory")
#define LAUNDER(p) asm volatile("" : "+s"(p))
#define LDS_BARRIER() do { asm volatile("s_waitcnt lgkmcnt(0)" ::: "memory"); __builtin_amdgcn_s_barrier(); asm volatile("" ::: "memory"); } while (0)
#define PHASE_VIEW() Frame F = F0; LAUNDER(F.ws); LAUNDER(F.in.kp); LAUNDER(F.ctl)
__device__ __forceinline__ float wave_sum(float v) {
#pragma unroll
    for (int o = 1; o < 64; o <<= 1) v += __shfl_xor(v, o);
    return v;
}
__device__ __forceinline__ float wave_max(float v) {
#pragma unroll
    for (int o = 1; o < 64; o <<= 1) v = fmaxf(v, __shfl_xor(v, o));
    return v;
}
__device__ __forceinline__ float row16_sum(float x) {
    x += __builtin_bit_cast(float, __builtin_amdgcn_update_dpp(0, __builtin_bit_cast(int, x), 0xB1, 0xf, 0xf, false));
    x += __builtin_bit_cast(float, __builtin_amdgcn_update_dpp(0, __builtin_bit_cast(int, x), 0x4E, 0xf, 0xf, false));
    x += __builtin_bit_cast(float, __builtin_amdgcn_update_dpp(0, __builtin_bit_cast(int, x), 0x141, 0xf, 0xf, false));
    x += __builtin_bit_cast(float, __builtin_amdgcn_update_dpp(0, __builtin_bit_cast(int, x), 0x140, 0xf, 0xf, false));
    return x;
}
__device__ __forceinline__ unsigned pk2(float lo, float hi) { return cvt_pk_bf16(lo, hi); }
__device__ __forceinline__ float bf2f(bf16 b) { return __uint_as_float(((unsigned)b) << 16); }
__device__ __forceinline__ float gelu_tanh(float y) { const float u = 0.7978845608028654f * (y + 0.044715f * y * y * y); const float e = __expf(2.f * u); const float th = 1.f - 2.f / (e + 1.f); return 0.5f * y * (1.f + th); }

__device__ __forceinline__ void transpose_item(const float* W, int N, bf16* WT, int ldk, int dst_row0, int k0, int n0, int kdst0, LAS float* scr, int lane) {
    float tv[32];
#pragma unroll
    for (int i = 0; i < 32; ++i) tv[i] = W[(size_t)(k0 + 2 * i + (lane >> 5)) * N + n0 + (lane & 31)];
#pragma unroll
    for (int i = 0; i < 32; ++i) scr[(2 * i + (lane >> 5)) * 33 + (lane & 31)] = tv[i];
    LDS_WAIT(); asm volatile("" ::: "memory");
    const int c = lane & 7;
#pragma unroll
    for (int j = 0; j < 4; ++j) { const int n = (lane >> 3) + 8 * j; const LAS float* s = scr + (8 * c) * 33 + n;
        u32x4 o; o.x = pk2(s[0 * 33], s[1 * 33]); o.y = pk2(s[2 * 33], s[3 * 33]); o.z = pk2(s[4 * 33], s[5 * 33]); o.w = pk2(s[6 * 33], s[7 * 33]);
        *(u32x4*)(WT + (size_t)(dst_row0 + n) * ldk + kdst0 + 8 * c) = o; }
    LDS_WAIT(); asm volatile("" ::: "memory");
}

constexpr int PROJ_PITCH = DIN * 2;
template <int PASS> struct S5Order {
    static constexpr bool GATHER = false; static constexpr int A2 = PASS == 2 ? 4 : 0;
    static constexpr int KB = PASS == 2 ? 384 : 256;
    const char* U; const char* SIN; const char* BT; int G, c;
    __device__ __forceinline__ size_t kstepA() const { return (size_t)4 * PROJ_PITCH; }
    __device__ __forceinline__ size_t hstepA() const { return (size_t)128 * 16 * PROJ_PITCH; }
    __device__ __forceinline__ size_t a2off() const { return (size_t)(SIN - U) - (size_t)A2 * kstepA(); }
    __device__ bool next(int i, pg8::Unit& u) const {
        const int L = i * G + c; if (L >= NG * 4) return false;
        const int g = L >> 2, pm = L & 3; u.e = g; u.pm = pm; u.pn = 0; u.cnt = 256;
        u.Ab = U + (size_t)g * 32 + (size_t)pm * 256 * 16 * PROJ_PITCH; u.Bb = BT + (size_t)g * 256 * KB * 2;
        return true;
    }
    template <int NV> __device__ __forceinline__ void a_voff(const pg8::Unit&, unsigned (&v)[NV][2], const int (&R)[2], const int (&C)[2]) const {
#pragma unroll
        for (int i = 0; i < 2; ++i) v[0][i] = (unsigned)(R[i] * 16 * PROJ_PITCH + (C[i] >> 4) * PROJ_PITCH + (C[i] & 15) * 2);
    }
};
__device__ __forceinline__ void s5_build(const Frame& F, int g) {
    const float* lam_re = F.in[10]; const float* lam_im = F.in[11]; const float* log_dt = F.in[12];
    const float* b_re = F.in[13]; const float* b_im = F.in[14]; const float* c_re = F.in[15]; const float* c_im = F.in[16]; const float* dsk = F.in[17];
    constexpr int PC = 68;
    LAS float* pw2 = (LAS float*)F.lds;
    LAS float* bbr = pw2 + 17 * 64 * 2; LAS float* bbi = bbr + 1024;
    LAS float* cre = bbi + 1024; LAS float* cim = cre + 16 * PC; LAS float* dsl = cim + 16 * PC; LAS float* Kt = dsl + 16;
    bf16* MT = (bf16*)(F.ws + WS_S5MT) + (size_t)g * 256 * 384; bf16* WT = (bf16*)(F.ws + WS_S5WT) + (size_t)g * 256 * 256;
    const float dt = __expf(log_dt[g]);
    __syncthreads();
    for (int i = F.tid; i < 17 * 64; i += NTHR) { const int tau = i >> 6, p = i & 63; const float lr = fminf(lam_re[g * NP + p], -1e-4f), li = lam_im[g * NP + p];
        const float mag = __expf(lr * dt * (float)tau), ang = li * dt * (float)tau; pw2[2 * i] = mag * cosf(ang); pw2[2 * i + 1] = mag * sinf(ang); }
    for (int i = F.tid; i < 1024; i += NTHR) { const int p = i >> 4; const float lr = fminf(lam_re[g * NP + p], -1e-4f), li = lam_im[g * NP + p];
        const float mag = __expf(lr * dt), ang = li * dt; const float ar = mag * cosf(ang), ai = mag * sinf(ang), den = lr * lr + li * li;
        const float qr = ((ar - 1.f) * lr + ai * li) / den, qi = (ai * lr - (ar - 1.f) * li) / den;
        const float br = b_re[(size_t)g * 1024 + i], bi = b_im[(size_t)g * 1024 + i]; bbr[i] = qr * br - qi * bi; bbi[i] = qr * bi + qi * br;
        cre[(i >> 6) * PC + (i & 63)] = c_re[(size_t)g * 1024 + i]; cim[(i >> 6) * PC + (i & 63)] = c_im[(size_t)g * 1024 + i]; }
    if (F.tid < 16) dsl[F.tid] = dsk[g * GC + F.tid];
    __syncthreads();
    { const int half = F.tid >> 8, c = (F.tid >> 4) & 15, c2 = F.tid & 15; float acc[8] = {0.f, 0.f, 0.f, 0.f, 0.f, 0.f, 0.f, 0.f};
      for (int p0 = 0; p0 < 64; p0 += 4) { const f32x4 cr4 = *(const LAS f32x4*)(cre + c * PC + p0), ci4 = *(const LAS f32x4*)(cim + c * PC + p0);
#pragma unroll
          for (int u = 0; u < 4; ++u) { const int p = p0 + u; const float br = bbr[p * 16 + c2], bi = bbi[p * 16 + c2];
              const float cbr = cr4[u] * br - ci4[u] * bi, cbi = cr4[u] * bi + ci4[u] * br;
#pragma unroll
              for (int k = 0; k < 8; ++k) { const f32x2 w = *(const LAS f32x2*)(pw2 + ((half * 8 + k) * 64 + p) * 2); acc[k] += w[0] * cbr - w[1] * cbi; } } }
#pragma unroll
      for (int k = 0; k < 8; ++k) Kt[(half * 8 + k) * 256 + c * 16 + c2] = acc[k]; }
    __syncthreads();
    for (int idx = F.tid; idx < 256 * 32; idx += NTHR) { const int oct = idx & 31, row = idx >> 5, t = row >> 4, c = row & 15, j = oct >> 1, c20 = (oct & 1) * 8;
        f32x4 x0 = (f32x4){0.f, 0.f, 0.f, 0.f}, x1 = x0;
        if (j <= t) { x0 = *(const LAS f32x4*)(Kt + (t - j) * 256 + c * 16 + c20); x1 = *(const LAS f32x4*)(Kt + (t - j) * 256 + c * 16 + c20 + 4); }
        if (j == t && (c >> 3) == (oct & 1)) { const float d = dsl[c];
#pragma unroll
            for (int q = 0; q < 4; ++q) { x0[q] += (q == (c & 7)) ? d : 0.f; x1[q] += (q + 4 == (c & 7)) ? d : 0.f; } }
        u32x4 o; o.x = pk2(x0[0], x0[1]); o.y = pk2(x0[2], x0[3]); o.z = pk2(x1[0], x1[1]); o.w = pk2(x1[2], x1[3]);
        *(u32x4*)(MT + (size_t)row * 384 + oct * 8) = o; }
    for (int idx = F.tid; idx < 256 * 16; idx += NTHR) { const int oct = idx & 15, row = idx >> 4, t = row >> 4, c = row & 15, p0 = (oct & 7) * 8; float v[8];
#pragma unroll
        for (int h = 0; h < 2; ++h) { const f32x4 cr = *(const LAS f32x4*)(cre + c * PC + p0 + 4 * h), ci = *(const LAS f32x4*)(cim + c * PC + p0 + 4 * h);
            const f32x4 wa = *(const LAS f32x4*)(pw2 + ((t + 1) * 64 + p0 + 4 * h) * 2), wb = *(const LAS f32x4*)(pw2 + ((t + 1) * 64 + p0 + 4 * h) * 2 + 4);
            const float pr[4] = {wa[0], wa[2], wb[0], wb[2]}, pi[4] = {wa[1], wa[3], wb[1], wb[3]};
#pragma unroll
            for (int q = 0; q < 4; ++q) v[4 * h + q] = (oct < 8) ? (cr[q] * pr[q] - ci[q] * pi[q]) : -(cr[q] * pi[q] + ci[q] * pr[q]); }
        u32x4 o; o.x = pk2(v[0], v[1]); o.y = pk2(v[2], v[3]); o.z = pk2(v[4], v[5]); o.w = pk2(v[6], v[7]);
        *(u32x4*)(MT + (size_t)row * 384 + 256 + oct * 8) = o; }
    for (int idx = F.tid; idx < 128 * 32; idx += NTHR) { const int oct = idx & 31, row = idx >> 5, part = row >> 6, p = row & 63, j = oct >> 1, c20 = (oct & 1) * 8;
        const f32x2 w = *(const LAS f32x2*)(pw2 + ((15 - j) * 64 + p) * 2); float v[8];
#pragma unroll
        for (int h = 0; h < 2; ++h) { const f32x4 br = *(const LAS f32x4*)(bbr + p * 16 + c20 + 4 * h), bi = *(const LAS f32x4*)(bbi + p * 16 + c20 + 4 * h);
#pragma unroll
            for (int q = 0; q < 4; ++q) v[4 * h + q] = part == 0 ? (w[0] * br[q] - w[1] * bi[q]) : (w[0] * bi[q] + w[1] * br[q]); }
        u32x4 o; o.x = pk2(v[0], v[1]); o.y = pk2(v[2], v[3]); o.z = pk2(v[4], v[5]); o.w = pk2(v[6], v[7]);
        *(u32x4*)(WT + (size_t)row * 256 + oct * 8) = o; }
    __syncthreads();
}

template <int NU> __device__ __forceinline__ void mod_batch(const GAS float* wp, const LAS float* sp0, f32x4 (&acc)[8]) {
    f32x4 w[NU];
#pragma unroll
    for (int u = 0; u < NU; ++u) w[u] = *(const GAS f32x4*)(wp + (size_t)(4 * u) * NMOD);
#pragma unroll
    for (int u = 0; u < NU; ++u) { const LAS f32x4* sp = (const LAS f32x4*)(sp0 + 4 * u * 8); const f32x4 s0 = sp[0], s1 = sp[1];
#pragma unroll
        for (int b = 0; b < 4; ++b) { acc[b] += w[u] * s0[b]; acc[4 + b] += w[u] * s1[b]; } }
}
__device__ __forceinline__ void p0_prologue(const Frame& F0) {
    PHASE_VIEW();
    const float* c = F.in[1]; const float* ada_w = F.in[2]; const float* ada_b = F.in[3];
    float* mod = (float*)(F.ws + WS_MOD);
    LAS float* scT = (LAS float*)F.lds;
    LAS float* red = (LAS float*)(F.lds + 65536);
    for (int i = F.tid; i < NB * DM; i += NTHR) { const float v = c[i]; scT[(i & (DM - 1)) * 8 + (i >> 11)] = v / (1.f + __expf(-v)); }
    __syncthreads();
    for (int item = F.vcu; item < NMOD / 64; item += F.G) {
        const int rs = F.lane >> 4, c4 = F.lane & 15, ks = F.wave;
        const GAS float* wp = (const GAS float*)ada_w + (size_t)(ks * 256 + rs) * NMOD + item * 64 + 4 * c4;
        f32x4 acc[8];
#pragma unroll
        for (int b = 0; b < 8; ++b) acc[b] = (f32x4){0.f, 0.f, 0.f, 0.f};
#pragma unroll 1
        for (int q = 0; q < 60; q += 12) mod_batch<12>(wp + (size_t)(4 * q) * NMOD, scT + (ks * 256 + 4 * q + rs) * 8, acc);
        mod_batch<4>(wp + (size_t)240 * NMOD, scT + (ks * 256 + 240 + rs) * 8, acc);
#pragma unroll
        for (int b = 0; b < 8; ++b) *(LAS f32x4*)(red + ((F.wave * 4 + rs) * 8 + b) * 64 + 4 * c4) = acc[b];
        __syncthreads();
        { const int b = F.wave; float s = 0.f;
#pragma unroll
          for (int q = 0; q < 32; ++q) s += red[(q * 8 + b) * 64 + F.lane];
          mod[b * NMOD + item * 64 + F.lane] = s + ada_b[item * 64 + F.lane]; }
        __syncthreads();
    }
    __syncthreads();
    for (int g = F.G - 1 - F.vcu; g < NG; g += F.G) s5_build(F, g);
    LAS float* scr = (LAS float*)(F.lds + F.wave * 16384);
    const int gw = F.vcu * NWAVES + F.wave, NGW = F.G * NWAVES;
    bf16* WinT = (bf16*)(F.ws + WS_WIN_T); bf16* WoutT = (bf16*)(F.ws + WS_WOUT_T); bf16* GluT = (bf16*)(F.ws + WS_GLU_T); bf16* LoraT = (bf16*)(F.ws + WS_LORA_T);
    constexpr int I_IN = (DM / 64) * (DIN / 32), I_OUT = (DM / 64) * (DM / 32), I_GLU = (DSSM / 64) * (DSSM / 32), I_W = 32, I_A = 32, I_G = 64;
    constexpr int NITEMS = I_IN + I_OUT + I_GLU + I_W + I_A + I_G;
    for (int it = gw; it < NITEMS; it += NGW) {
        int r = it;
        if (r < I_IN) { const int nb = DIN / 32, kb = r / nb, n0 = (r % nb) * 32; transpose_item(F.in[8], DIN, WinT, DM, n0, kb * 64, n0, kb * 64, scr, F.lane); continue; } r -= I_IN;
        if (r < I_OUT) { const int nb = DM / 32, kb = r / nb, n0 = (r % nb) * 32; transpose_item(F.in[9], DM, WoutT, DM, n0, kb * 64, n0, kb * 64, scr, F.lane); continue; } r -= I_OUT;
        if (r < I_GLU) { const int nb = DSSM / 32, kb = r / nb, n0 = (r % nb) * 32; transpose_item(F.in[18], DSSM, GluT, DSSM, n0, kb * 64, n0, kb * 64, scr, F.lane); continue; } r -= I_GLU;
        if (r < I_W) { transpose_item(F.in[22], DRW, LoraT, 256, r * 32, 0, r * 32, 0, scr, F.lane); continue; } r -= I_W;
        if (r < I_A) { transpose_item(F.in[24], DRW, LoraT, 256, 1024 + r * 32, 0, r * 32, 64, scr, F.lane); continue; } r -= I_A;
        { const int kb = r / 32, n0 = (r % 32) * 32; transpose_item(F.in[25], DRW, LoraT, 256, 2048 + n0, kb * 64, n0, 128 + kb * 64, scr, F.lane); }
    }
    for (int p = blockIdx.x * NTHR + F.tid; p < 3072 * 32; p += F.G * NTHR) { const int row = p >> 5, c8 = (p & 31) * 8; const int kind = row >> 10;
        const bool data = kind == 0 ? (c8 < 64) : (kind == 1 ? (c8 >= 64 && c8 < 128) : (c8 >= 128));
        if (!data) *(u32x4*)(LoraT + (size_t)row * 256 + c8) = (u32x4){0u, 0u, 0u, 0u}; }
    bf16* rwt = (bf16*)(F.ws + WS_RWT);
    for (int p = blockIdx.x * NTHR + F.tid; p < 64 * 5 * 64 * 8; p += F.G * NTHR) { const int e = p & 7, ln = (p >> 3) & 63, jt = (p >> 9) % 5, ks = (p >> 9) / 5;
        const int j = 16 * jt + (ln & 15), k = 32 * ks + 8 * (ln >> 4) + e;
        const float w = j < 8 ? F.in[31][k * 8 + j] : (j < 72 ? F.in[33][k * 64 + (j - 8)] : 0.f);
        const unsigned hi = pk2(w, 0.f) & 0xffffu; const float wl = w - __uint_as_float(hi << 16);
        const size_t o = ((size_t)((ks * 5 + jt) * 2) * 64 + ln) * 8 + e;
        rwt[o] = (bf16)hi; rwt[o + 512] = (bf16)(pk2(wl, 0.f) & 0xffffu); }
}

__device__ __forceinline__ void p1_h1(const Frame& F0) {
    PHASE_VIEW();
    const GAS float* x = (const GAS float*)F.in[0]; const GAS float* g = (const GAS float*)F.in[4]; const GAS float* mod = (const GAS float*)(F.ws + WS_MOD); GAS bf16* H = (GAS bf16*)(F.ws + WS_H);
    const int gw = F.vcu * NWAVES + F.wave, NGW = F.G * NWAVES;
    f32x4 gv[8];
#pragma unroll
    for (int j = 0; j < 8; ++j) gv[j] = *(const GAS f32x4*)(g + 4 * (F.lane + 64 * j));
    for (int row = gw; row < NT; row += NGW) {
        const int b = row >> 11; const GAS f32x4* xr = (const GAS f32x4*)(x + (size_t)row * DM) + F.lane;
        f32x4 v[8], sh[8], scv[8]; float ss = 0.f;
#pragma unroll
        for (int j = 0; j < 8; ++j) { v[j] = xr[64 * j]; sh[j] = *(const GAS f32x4*)(mod + b * NMOD + 4 * (F.lane + 64 * j)); scv[j] = *(const GAS f32x4*)(mod + b * NMOD + DM + 4 * (F.lane + 64 * j)); }
#pragma unroll
        for (int j = 0; j < 8; ++j) ss += (v[j].x * v[j].x + v[j].y * v[j].y) + (v[j].z * v[j].z + v[j].w * v[j].w);
        const float rs = rsqrtf(wave_sum(ss) * (1.f / DM) + RMS_EPS);
        u32x2 w[8];
#pragma unroll
        for (int j = 0; j < 8; ++j) { const f32x4 h = v[j] * rs * gv[j] * (scv[j] + 1.0f) + sh[j]; w[j].x = pk2(h.x, h.y); w[j].y = pk2(h.z, h.w); }
        GAS u32x2* o = (GAS u32x2*)(H + (size_t)row * DM) + F.lane;
#pragma unroll
        for (int j = 0; j < 8; ++j) o[64 * j] = w[j];
    }
}

typedef short bf16x8_t __attribute__((ext_vector_type(8)));
#define MFMA16(a, b, c) __builtin_amdgcn_mfma_f32_16x16x32_bf16((a), (b), (c), 0, 0, 0)
__device__ __forceinline__ bf16x8_t lfrag(const LAS bf16* m, int pitch, int row, int k0) { return *(const LAS bf16x8_t*)(m + row * pitch + k0); }
__device__ __forceinline__ void st4(LAS bf16* p, const f32x4& v) { u32x2 w; w.x = pk2(v[0], v[1]); w.y = pk2(v[2], v[3]); *(LAS u32x2*)p = w; }
constexpr int CH_T = 32, CHP_K = 72, CHP_T = 40;
constexpr int CH_GRP_BYTES = 66560;
constexpr size_t GHQ_CHUNK = 12288;
__device__ __forceinline__ float wave_sum_dpp(float x) {
    x = row16_sum(x);
    x += __builtin_bit_cast(float, __builtin_amdgcn_update_dpp(0, __builtin_bit_cast(int, x), 0x142, 0xa, 0xf, false));
    x += __builtin_bit_cast(float, __builtin_amdgcn_update_dpp(0, __builtin_bit_cast(int, x), 0x143, 0xc, 0xf, false));
    return __builtin_bit_cast(float, __builtin_amdgcn_readlane(__builtin_bit_cast(int, x), 63));
}
__device__ __forceinline__ void wave_sum8_dpp(float (&x)[8]) {
#define WS8_STAGE(ctrl, rmask) _Pragma("unroll") for (int i_ = 0; i_ < 8; ++i_) x[i_] += __builtin_bit_cast(float, __builtin_amdgcn_update_dpp(0, __builtin_bit_cast(int, x[i_]), ctrl, rmask, 0xf, false));
    WS8_STAGE(0xB1, 0xf) WS8_STAGE(0x4E, 0xf) WS8_STAGE(0x141, 0xf) WS8_STAGE(0x140, 0xf) WS8_STAGE(0x142, 0xa) WS8_STAGE(0x143, 0xc)
#undef WS8_STAGE
#pragma unroll
    for (int i = 0; i < 8; ++i) x[i] = __builtin_bit_cast(float, __builtin_amdgcn_readlane(__builtin_bit_cast(int, x[i]), 63));
}
__device__ __forceinline__ float tanh_fast(float x) { const float e = __builtin_amdgcn_exp2f(2.8853900817779268f * x); return 1.f - 2.f * __builtin_amdgcn_rcpf(e + 1.f); }
#define INV_P8(acc, A0, L0, M0, A1, L1, M1, A2, L2, M2, A3, L3, M3, A4, L4, M4, A5, L5, M5, A6, L6, M6, A7, L7, M7) do { float tmp_; asm volatile("v_readlane_b32 %1, %2, %10\n\tv_fmac_f32 %0, %1, %18\n\tv_readlane_b32 %1, %3, %11\n\tv_fmac_f32 %0, %1, %19\n\tv_readlane_b32 %1, %4, %12\n\tv_fmac_f32 %0, %1, %20\n\tv_readlane_b32 %1, %5, %13\n\tv_fmac_f32 %0, %1, %21\n\tv_readlane_b32 %1, %6, %14\n\tv_fmac_f32 %0, %1, %22\n\tv_readlane_b32 %1, %7, %15\n\tv_fmac_f32 %0, %1, %23\n\tv_readlane_b32 %1, %8, %16\n\tv_fmac_f32 %0, %1, %24\n\tv_readlane_b32 %1, %9, %17\n\tv_fmac_f32 %0, %1, %25" : "+v"(acc), "=&s"(tmp_) : "v"(A0), "v"(A1), "v"(A2), "v"(A3), "v"(A4), "v"(A5), "v"(A6), "v"(A7), "i"(L0), "i"(L1), "i"(L2), "i"(L3), "i"(L4), "i"(L5), "i"(L6), "i"(L7), "v"(M0), "v"(M1), "v"(M2), "v"(M3), "v"(M4), "v"(M5), "v"(M6), "v"(M7)); } while (0)
#define INV_P4(acc, A0, L0, M0, A1, L1, M1, A2, L2, M2, A3, L3, M3) do { float tmp_; asm volatile("v_readlane_b32 %1, %2, %6\n\tv_fmac_f32 %0, %1, %10\n\tv_readlane_b32 %1, %3, %7\n\tv_fmac_f32 %0, %1, %11\n\tv_readlane_b32 %1, %4, %8\n\tv_fmac_f32 %0, %1, %12\n\tv_readlane_b32 %1, %5, %9\n\tv_fmac_f32 %0, %1, %13" : "+v"(acc), "=&s"(tmp_) : "v"(A0), "v"(A1), "v"(A2), "v"(A3), "i"(L0), "i"(L1), "i"(L2), "i"(L3), "v"(M0), "v"(M1), "v"(M2), "v"(M3)); } while (0)
#define INV_P2(acc, A0, L0, M0, A1, L1, M1) do { float tmp_; asm volatile("v_readlane_b32 %1, %2, %4\n\tv_fmac_f32 %0, %1, %6\n\tv_readlane_b32 %1, %3, %5\n\tv_fmac_f32 %0, %1, %7" : "+v"(acc), "=&s"(tmp_) : "v"(A0), "v"(A1), "i"(L0), "i"(L1), "v"(M0), "v"(M1)); } while (0)
#define INV_P1(acc, A0, L0, M0) do { float tmp_; asm volatile("v_readlane_b32 %1, %2, %3\n\tv_fmac_f32 %0, %1, %4" : "+v"(acc), "=&s"(tmp_) : "v"(A0), "i"(L0), "v"(M0)); } while (0)
__device__ __forceinline__ void p9a_rwkv_chunks(const Frame& F0) {
    PHASE_VIEW();
    const GAS bf16* PROJ = (const GAS bf16*)(F.ws + WS_PROJ); const GAS bf16* LoraT = (const GAS bf16*)(F.ws + WS_LORA_T);
    GAS bf16* VB = (GAS bf16*)(F.ws + WS_VB); GAS bf16* GB = (GAS bf16*)(F.ws + WS_GB); GAS float* BON = (GAS float*)(F.ws + WS_BON);
    const float* mu = F.in[20]; const float* w0 = F.in[21]; const float* a0 = F.in[23]; const float* k_k = F.in[26]; const float* k_a = F.in[27]; const float* r_k = F.in[28];
    GAS bf16* GHQ = (GAS bf16*)(F.ws + WS_GHQ); GAS float* GT = (GAS float*)(F.ws + WS_GT);
    const int grp = F.tid >> 8, gt = F.tid & 255, gw = (F.tid >> 6) & 3, lo = F.lane & 15, hi = F.lane >> 4;
    LAS unsigned char* gb = F.lds + grp * CH_GRP_BYTES;
    LAS bf16* At = (LAS bf16*)gb; LAS bf16* Bt = At + 32 * CHP_K; LAS bf16* Kt = Bt + 32 * CHP_K; LAS bf16* Rt = Kt + 32 * CHP_K;
    LAS bf16* X1T = At; LAS bf16* P1T = X1T + 64 * CHP_T; LAS bf16* Minv = P1T + 64 * CHP_T; LAS bf16* XG = At;
    LAS bf16* AtT = Rt + 32 * CHP_K; LAS bf16* BhT = AtT + 64 * CHP_T; LAS bf16* KhT = BhT + 64 * CHP_T; LAS bf16* VmT = KhT + 64 * CHP_T;
    LAS float* AabF = (LAS float*)(VmT + 64 * CHP_T);
    LAS bf16* Aak = (LAS bf16*)(AabF + 32 * 36); LAS bf16* Arb = Aak + 32 * CHP_T; LAS bf16* Ark = Arb + 32 * CHP_T; LAS bf16* P2T = Ark + 32 * CHP_T;
    LAS float* LWs = AabF; LAS float* AAs = LWs + 32 * 68; LAS bf16* W1 = (LAS bf16*)AabF;
    LAS float* part = (LAS float*)(P2T + 64 * CHP_T);
    LAS bf16* XW = (LAS bf16*)(part + 256); LAS bf16* XA = XW + 32 * CHP_K;
    const f32x4 z4 = (f32x4){0.f, 0.f, 0.f, 0.f};
    LAS unsigned* gbw = (LAS unsigned*)(F.lds + MISC_OFF) + 40 + grp; unsigned gb_target = 0u;
    __syncthreads(); if (gt == 0) *(volatile LAS unsigned*)gbw = 0u; __syncthreads();
#define GROUP_BARRIER() do { gb_target += 4u; asm volatile("s_waitcnt lgkmcnt(0)" ::: "memory"); \
        if (F.lane == 0) (void)__hip_atomic_fetch_add(gbw, 1u, __ATOMIC_RELAXED, __HIP_MEMORY_SCOPE_WORKGROUP); \
        while (*(volatile LAS unsigned*)gbw < gb_target) __builtin_amdgcn_s_sleep(1); \
        asm volatile("" ::: "memory"); } while (0)
    for (int it0 = F.vcu * 2; it0 < NB * (SEQ / CH_T); it0 += F.G * 2) {
        const int item = it0 + grp; const int c = item & 63, b = item >> 6;
        const size_t tok0 = (size_t)b * SEQ + c * CH_T;
        GROUP_BARRIER();
#pragma unroll 4
        for (int i = 0; i < 16; ++i) { const int pidx = gt + 256 * i, t = pidx >> 7, cp = (pidx & 127) * 2;
            const unsigned zw = *(const GAS unsigned*)(PROJ + (tok0 + t) * DIN + 4096 + cp);
            const unsigned pw = (c == 0 && t == 0) ? 0u : *(const GAS unsigned*)(PROJ + (tok0 + t - 1) * DIN + 4096 + cp);
            const f32x2 m = *(const f32x2*)(mu + 3072 + cp);
            const float z0 = bf_lo(zw), z1 = bf_hi(zw); const float v0 = z0 + m.x * (bf_lo(pw) - z0), v1 = z1 + m.y * (bf_hi(pw) - z1);
            if (cp < 64) *(LAS unsigned*)(XW + t * CHP_K + cp) = pk2(tanh_fast(v0), tanh_fast(v1));
            else if (cp < 128) *(LAS unsigned*)(XA + t * CHP_K + cp - 64) = pk2(v0, v1);
            else *(LAS unsigned*)(XG + t * 136 + cp - 128) = pk2(sigmoidf_(v0), sigmoidf_(v1)); }
        GROUP_BARRIER();
        { bf16x8_t xg[2][4];
#pragma unroll
          for (int mt = 0; mt < 2; ++mt)
#pragma unroll
              for (int ks = 0; ks < 4; ++ks) xg[mt][ks] = lfrag(XG, 136, 16 * mt + lo, 32 * ks + 8 * hi);
          bf16x8_t ygc[4], ygn[4];
#pragma unroll
          for (int ks = 0; ks < 4; ++ks) ygc[ks] = *(const GAS bf16x8_t*)(LoraT + (size_t)(2048 + 16 * gw + lo) * 256 + 128 + 32 * ks + 8 * hi);
#pragma unroll 1
          for (int hh = 0; hh < NH; ++hh) { const int n0 = hh * 64 + 16 * gw, n1 = (hh + 1 < NH ? hh + 1 : hh) * 64 + 16 * gw; f32x4 dg[2] = {z4, z4};
#pragma unroll
              for (int ks = 0; ks < 4; ++ks) ygn[ks] = *(const GAS bf16x8_t*)(LoraT + (size_t)(2048 + n1 + lo) * 256 + 128 + 32 * ks + 8 * hi);
#pragma unroll
              for (int ks = 0; ks < 4; ++ks) { dg[0] = MFMA16(ygc[ks], xg[0][ks], dg[0]); dg[1] = MFMA16(ygc[ks], xg[1][ks], dg[1]); }
#pragma unroll
              for (int mt = 0; mt < 2; ++mt) { u32x2 w; w.x = pk2(dg[mt][0], dg[mt][1]); w.y = pk2(dg[mt][2], dg[mt][3]); *(GAS u32x2*)(GB + (tok0 + 16 * mt + lo) * 1024 + n0 + 4 * hi) = w; }
#pragma unroll
              for (int ks = 0; ks < 4; ++ks) ygc[ks] = ygn[ks]; }
        }
        const int k = gt & 63, tq = gw; const bool first = (c == 0 && tq == 0);
        const GAS bf16* pp = PROJ + (tok0 + tq * 8) * DIN + 1024 + k;
        bf16 nr[9], nk[9], nv[9];
#pragma unroll
        for (int i = 0; i < 9; ++i) { const GAS bf16* q = pp + (ptrdiff_t)(i - 1) * DIN; const bool z = first && i == 0;
            nr[i] = z ? (bf16)0 : q[0]; nk[i] = z ? (bf16)0 : q[1024]; nv[i] = z ? (bf16)0 : q[2048]; }
        bf16x8_t lyw[2], lya[2]; f32x4 lw0, la0; float cmur, cmuk, cmuv, ckk, cka, crk;
#define HEAD_LOADS(hn_) do { const int n1_ = (hn_) * 64 + 16 * gw, ch1_ = (hn_) * 64 + k; \
            _Pragma("unroll") for (int ks = 0; ks < 2; ++ks) { lyw[ks] = *(const GAS bf16x8_t*)(LoraT + (size_t)(n1_ + lo) * 256 + 32 * ks + 8 * hi); lya[ks] = *(const GAS bf16x8_t*)(LoraT + (size_t)(1024 + n1_ + lo) * 256 + 64 + 32 * ks + 8 * hi); } \
            lw0 = *(const GAS f32x4*)((const GAS float*)w0 + n1_ + 4 * hi); la0 = *(const GAS f32x4*)((const GAS float*)a0 + n1_ + 4 * hi); \
            cmur = ((const GAS float*)mu)[ch1_]; cmuk = ((const GAS float*)mu)[1024 + ch1_]; cmuv = ((const GAS float*)mu)[2048 + ch1_]; \
            ckk = ((const GAS float*)k_k)[ch1_]; cka = ((const GAS float*)k_a)[ch1_]; crk = ((const GAS float*)r_k)[ch1_]; } while (0)
        HEAD_LOADS(0);
#pragma unroll 1
        for (int h = 0; h < NH; ++h) {
            const int ci = (b * NH + h) * 64 + c; const int ch = h * 64 + k;
            GROUP_BARRIER();
            { const int n0 = h * 64 + 16 * gw; f32x4 dw[2] = {z4, z4}, da[2] = {z4, z4};
#pragma unroll
              for (int ks = 0; ks < 2; ++ks) { const bf16x8_t yw = lyw[ks], ya = lya[ks];
#pragma unroll
                  for (int mt = 0; mt < 2; ++mt) { dw[mt] = MFMA16(yw, lfrag(XW, CHP_K, 16 * mt + lo, 32 * ks + 8 * hi), dw[mt]); da[mt] = MFMA16(ya, lfrag(XA, CHP_K, 16 * mt + lo, 32 * ks + 8 * hi), da[mt]); } }
              const f32x4 w0v = lw0, a0v = la0;
#pragma unroll
              for (int mt = 0; mt < 2; ++mt) { const int t = 16 * mt + lo; f32x4 lwv, aav;
#pragma unroll
                  for (int r = 0; r < 4; ++r) { lwv[r] = (-0.6065306597126334f * 1.4426950408889634f) * sigmoidf_(dw[mt][r] + w0v[r]);     aav[r] = sigmoidf_(da[mt][r] + a0v[r]); }
                  *(LAS f32x4*)(LWs + t * 68 + 16 * gw + 4 * hi) = lwv; *(LAS f32x4*)(AAs + t * 68 + 16 * gw + 4 * hi) = aav; }
            }
            GROUP_BARRIER();
            { const float mur = cmur, muk = cmuk, muv = cmuv, kkc = ckk, kac = cka, rkc = crk;
              float lw[8], ls[8], rv[8], kv[8], vv[8], av[8], bv[8]; float run = 0.f;
              float kraw[8], x8[8];
#pragma unroll
              for (int i = 0; i < 8; ++i) { const int t = tq * 8 + i;
                  const float zr = bf2f(nr[i + 1]), zk = bf2f(nk[i + 1]), zv = bf2f(nv[i + 1]), pr = bf2f(nr[i]), pk_ = bf2f(nk[i]), pv = bf2f(nv[i]);
                  rv[i] = zr + mur * (pr - zr); kraw[i] = zk + muk * (pk_ - zk); vv[i] = zv + muv * (pv - zv);
                  av[i] = AAs[t * 68 + k]; lw[i] = LWs[t * 68 + k];
                  const float kk = kraw[i] * kkc; x8[i] = kk * kk; }
              wave_sum8_dpp(x8);
#pragma unroll
              for (int i = 0; i < 8; ++i) { const float a = av[i]; const float kk = kraw[i] * kkc * __builtin_amdgcn_rsqf(fmaxf(x8[i], 1e-24f));
                  const float km = kraw[i] * (1.f + (a - 1.f) * kac);
                  x8[i] = rv[i] * km * rkc; kv[i] = km; av[i] = -kk; bv[i] = kk * a; run += lw[i]; ls[i] = run; }
              wave_sum8_dpp(x8);
              { float bsel = x8[0];
#pragma unroll
                for (int i = 1; i < 8; ++i) bsel = (F.lane == i) ? x8[i] : bsel;
                if (F.lane < 8) BON[(tok0 + tq * 8 + F.lane) * 16 + h] = bsel; }
              if (h + 1 < NH) {
#pragma unroll
                  for (int i = 0; i < 9; ++i) { const GAS bf16* q = pp + (ptrdiff_t)(i - 1) * DIN + (h + 1) * 64; const bool z = first && i == 0;
                      nr[i] = z ? (bf16)0 : q[0]; nk[i] = z ? (bf16)0 : q[1024]; nv[i] = z ? (bf16)0 : q[2048]; } }
              { u32x4 w; w.x = pk2(vv[0], vv[1]); w.y = pk2(vv[2], vv[3]); w.z = pk2(vv[4], vv[5]); w.w = pk2(vv[6], vv[7]);
                GAS bf16* vb = VB + (tok0 + tq * 8) * 1024 + ch;
                vb[0] = (bf16)(w.x & 0xffffu); vb[1024] = (bf16)(w.x >> 16); vb[2048] = (bf16)(w.y & 0xffffu); vb[3072] = (bf16)(w.y >> 16);
                vb[4096] = (bf16)(w.z & 0xffffu); vb[5120] = (bf16)(w.z >> 16); vb[6144] = (bf16)(w.w & 0xffffu); vb[7168] = (bf16)(w.w >> 16); }
              part[tq * 64 + k] = run;
              GROUP_BARRIER();
              float off = 0.f, tot = 0.f;
#pragma unroll
              for (int q = 0; q < 4; ++q) { const float pq = part[q * 64 + k]; tot += pq; if (q < tq) off += pq; }
              if (tq == 0) GT[(size_t)ci * 64 + k] = __builtin_amdgcn_exp2f(tot);
              float aT[8], bT[8], kT[8];
#pragma unroll
              for (int i = 0; i < 8; ++i) { const int t = tq * 8 + i; const float lg = off + ls[i], lgm = lg - lw[i];
                  const float eneg = __builtin_amdgcn_exp2f(-lg), eh = __builtin_amdgcn_exp2f(tot - lg);
                  const float at = av[i] * __builtin_amdgcn_exp2f(lgm);
                  const unsigned wa = pk2(at, bv[i] * eneg), wk = pk2(kv[i] * eneg, rv[i] * __builtin_amdgcn_exp2f(lg));
                  At[t * CHP_K + k] = (bf16)(wa & 0xffffu); Bt[t * CHP_K + k] = (bf16)(wa >> 16); Kt[t * CHP_K + k] = (bf16)(wk & 0xffffu); Rt[t * CHP_K + k] = (bf16)(wk >> 16);
                  aT[i] = at; bT[i] = bv[i] * eh; kT[i] = kv[i] * eh; }
              u32x4 w;
              w.x = pk2(aT[0], aT[1]); w.y = pk2(aT[2], aT[3]); w.z = pk2(aT[4], aT[5]); w.w = pk2(aT[6], aT[7]); *(LAS u32x4*)(AtT + k * CHP_T + tq * 8) = w;
              w.x = pk2(bT[0], bT[1]); w.y = pk2(bT[2], bT[3]); w.z = pk2(bT[4], bT[5]); w.w = pk2(bT[6], bT[7]); *(LAS u32x4*)(BhT + k * CHP_T + tq * 8) = w;
              w.x = pk2(kT[0], kT[1]); w.y = pk2(kT[2], kT[3]); w.z = pk2(kT[4], kT[5]); w.w = pk2(kT[6], kT[7]); *(LAS u32x4*)(KhT + k * CHP_T + tq * 8) = w;
              w.x = pk2(vv[0], vv[1]); w.y = pk2(vv[2], vv[3]); w.z = pk2(vv[4], vv[5]); w.w = pk2(vv[6], vv[7]); *(LAS u32x4*)(VmT + k * CHP_T + tq * 8) = w;
            }
            GROUP_BARRIER();
            f32x4 dt = z4, a10 = z4;
            const int mi = gw ^ grp;
            { const LAS bf16* X = (mi < 2) ? At : Rt; const LAS bf16* Y = (mi & 1) ? Kt : Bt;
              f32x4 acc[2][2] = {{z4, z4}, {z4, z4}};
#pragma unroll
              for (int ks = 0; ks < 2; ++ks) { bf16x8_t xf[2], yf[2];
#pragma unroll
                  for (int m = 0; m < 2; ++m) { xf[m] = lfrag(X, CHP_K, 16 * m + lo, 32 * ks + 8 * hi); yf[m] = lfrag(Y, CHP_K, 16 * m + lo, 32 * ks + 8 * hi); }
#pragma unroll
                  for (int m = 0; m < 2; ++m)
#pragma unroll
                      for (int n = 0; n < 2; ++n) acc[m][n] = MFMA16(yf[n], xf[m], acc[m][n]);
                  if (mi == 1) dt = MFMA16(lfrag(Bt, CHP_K, 16 + lo, 32 * ks + 8 * hi), xf[1], dt); }
              LAS bf16* dstb = (mi == 1) ? Aak : ((mi == 2) ? Arb : Ark);
#pragma unroll
              for (int m = 0; m < 2; ++m)
#pragma unroll
                  for (int n = 0; n < 2; ++n) { const int t = 16 * m + lo, j0 = 16 * n + 4 * hi; f32x4 v = acc[m][n];
#pragma unroll
                      for (int r = 0; r < 4; ++r) { const int j = j0 + r; const bool keep = (mi < 2) ? (j < t) : (j <= t); v[r] = keep ? v[r] : 0.f; }
                      if (mi != 0) st4(dstb + t * CHP_T + j0, v); else { if (m == 0 && n == 0) dt = v; if (m == 1 && n == 0) a10 = v; } }
              if (mi == 1) {
#pragma unroll
                  for (int r = 0; r < 4; ++r) dt[r] = (4 * hi + r < lo) ? dt[r] : 0.f; }
            }
            GROUP_BARRIER();
            if (mi < 2) {
                int cc = F.lane & 15; asm volatile("" : "+v"(cc));
                float mcol[16];
                { float acc = (0 == cc) ? 1.f : 0.f;
                  mcol[0] = acc; }
                { float acc = (1 == cc) ? 1.f : 0.f;
                  INV_P1(acc, dt[0], 1, mcol[0]);
                  mcol[1] = acc; }
                { float acc = (2 == cc) ? 1.f : 0.f;
                  INV_P2(acc, dt[0], 2, mcol[0], dt[1], 2, mcol[1]);
                  mcol[2] = acc; }
                { float acc = (3 == cc) ? 1.f : 0.f;
                  INV_P2(acc, dt[0], 3, mcol[0], dt[1], 3, mcol[1]);
                  INV_P1(acc, dt[2], 3, mcol[2]);
                  mcol[3] = acc; }
                { float acc = (4 == cc) ? 1.f : 0.f;
                  INV_P4(acc, dt[0], 4, mcol[0], dt[1], 4, mcol[1], dt[2], 4, mcol[2], dt[3], 4, mcol[3]);
                  mcol[4] = acc; }
                { float acc = (5 == cc) ? 1.f : 0.f;
                  INV_P4(acc, dt[0], 5, mcol[0], dt[1], 5, mcol[1], dt[2], 5, mcol[2], dt[3], 5, mcol[3]);
                  INV_P1(acc, dt[0], 21, mcol[4]);
                  mcol[5] = acc; }
                { float acc = (6 == cc) ? 1.f : 0.f;
                  INV_P4(acc, dt[0], 6, mcol[0], dt[1], 6, mcol[1], dt[2], 6, mcol[2], dt[3], 6, mcol[3]);
                  INV_P2(acc, dt[0], 22, mcol[4], dt[1], 22, mcol[5]);
                  mcol[6] = acc; }
                { float acc = (7 == cc) ? 1.f : 0.f;
                  INV_P4(acc, dt[0], 7, mcol[0], dt[1], 7, mcol[1], dt[2], 7, mcol[2], dt[3], 7, mcol[3]);
                  INV_P2(acc, dt[0], 23, mcol[4], dt[1], 23, mcol[5]);
                  INV_P1(acc, dt[2], 23, mcol[6]);
                  mcol[7] = acc; }
                { float acc = (8 == cc) ? 1.f : 0.f;
                  INV_P8(acc, dt[0], 8, mcol[0], dt[1], 8, mcol[1], dt[2], 8, mcol[2], dt[3], 8, mcol[3], dt[0], 24, mcol[4], dt[1], 24, mcol[5], dt[2], 24, mcol[6], dt[3], 24, mcol[7]);
                  mcol[8] = acc; }
                { float acc = (9 == cc) ? 1.f : 0.f;
                  INV_P8(acc, dt[0], 9, mcol[0], dt[1], 9, mcol[1], dt[2], 9, mcol[2], dt[3], 9, mcol[3], dt[0], 25, mcol[4], dt[1], 25, mcol[5], dt[2], 25, mcol[6], dt[3], 25, mcol[7]);
                  INV_P1(acc, dt[0], 41, mcol[8]);
                  mcol[9] = acc; }
                { float acc = (10 == cc) ? 1.f : 0.f;
                  INV_P8(acc, dt[0], 10, mcol[0], dt[1], 10, mcol[1], dt[2], 10, mcol[2], dt[3], 10, mcol[3], dt[0], 26, mcol[4], dt[1], 26, mcol[5], dt[2], 26, mcol[6], dt[3], 26, mcol[7]);
                  INV_P2(acc, dt[0], 42, mcol[8], dt[1], 42, mcol[9]);
                  mcol[10] = acc; }
                { float acc = (11 == cc) ? 1.f : 0.f;
                  INV_P8(acc, dt[0], 11, mcol[0], dt[1], 11, mcol[1], dt[2], 11, mcol[2], dt[3], 11, mcol[3], dt[0], 27, mcol[4], dt[1], 27, mcol[5], dt[2], 27, mcol[6], dt[3], 27, mcol[7]);
                  INV_P2(acc, dt[0], 43, mcol[8], dt[1], 43, mcol[9]);
                  INV_P1(acc, dt[2], 43, mcol[10]);
                  mcol[11] = acc; }
                { float acc = (12 == cc) ? 1.f : 0.f;
                  INV_P8(acc, dt[0], 12, mcol[0], dt[1], 12, mcol[1], dt[2], 12, mcol[2], dt[3], 12, mcol[3], dt[0], 28, mcol[4], dt[1], 28, mcol[5], dt[2], 28, mcol[6], dt[3], 28, mcol[7]);
                  INV_P4(acc, dt[0], 44, mcol[8], dt[1], 44, mcol[9], dt[2], 44, mcol[10], dt[3], 44, mcol[11]);
                  mcol[12] = acc; }
                { float acc = (13 == cc) ? 1.f : 0.f;
                  INV_P8(acc, dt[0], 13, mcol[0], dt[1], 13, mcol[1], dt[2], 13, mcol[2], dt[3], 13, mcol[3], dt[0], 29, mcol[4], dt[1], 29, mcol[5], dt[2], 29, mcol[6], dt[3], 29, mcol[7]);
                  INV_P4(acc, dt[0], 45, mcol[8], dt[1], 45, mcol[9], dt[2], 45, mcol[10], dt[3], 45, mcol[11]);
                  INV_P1(acc, dt[0], 61, mcol[12]);
                  mcol[13] = acc; }
                { float acc = (14 == cc) ? 1.f : 0.f;
                  INV_P8(acc, dt[0], 14, mcol[0], dt[1], 14, mcol[1], dt[2], 14, mcol[2], dt[3], 14, mcol[3], dt[0], 30, mcol[4], dt[1], 30, mcol[5], dt[2], 30, mcol[6], dt[3], 30, mcol[7]);
                  INV_P4(acc, dt[0], 46, mcol[8], dt[1], 46, mcol[9], dt[2], 46, mcol[10], dt[3], 46, mcol[11]);
                  INV_P2(acc, dt[0], 62, mcol[12], dt[1], 62, mcol[13]);
                  mcol[14] = acc; }
                { float acc = (15 == cc) ? 1.f : 0.f;
                  INV_P8(acc, dt[0], 15, mcol[0], dt[1], 15, mcol[1], dt[2], 15, mcol[2], dt[3], 15, mcol[3], dt[0], 31, mcol[4], dt[1], 31, mcol[5], dt[2], 31, mcol[6], dt[3], 31, mcol[7]);
                  INV_P4(acc, dt[0], 47, mcol[8], dt[1], 47, mcol[9], dt[2], 47, mcol[10], dt[3], 47, mcol[11]);
                  INV_P2(acc, dt[0], 63, mcol[12], dt[1], 63, mcol[13]);
                  INV_P1(acc, dt[2], 63, mcol[14]);
                  mcol[15] = acc; }
                if (F.lane < 32) { const int col = F.lane; const bool mine = (mi == 0) ? (col < 16) : (col >= 16);
#pragma unroll
                    for (int t = 0; t < 16; ++t) Minv[(16 * mi + t) * CHP_T + col] = (bf16)(pk2(mine ? mcol[t] : 0.f, 0.f) & 0xffffu); }
                if (mi == 0) { st4(W1 + lo * CHP_T + 4 * hi, a10);
                    f32x4 id;
#pragma unroll
                    for (int r = 0; r < 4; ++r) id[r] = (4 * hi + r == lo) ? 1.f : 0.f;
                    st4(W1 + lo * CHP_T + 16 + 4 * hi, id); }
            } else {
                const int wk = mi - 2;
                for (int tile = wk * 4; tile < wk * 4 + 4; ++tile) { const int mt = tile >> 2, nt = tile & 3;
                    const bf16x8_t xf = lfrag(Aak, CHP_T, 16 * mt + lo, 8 * hi), yf = lfrag(VmT, CHP_T, 16 * nt + lo, 8 * hi);
                    const f32x4 d = MFMA16(xf, yf, z4);
                    st4(X1T + (16 * nt + lo) * CHP_T + 16 * mt + 4 * hi, d); }
            }
            GROUP_BARRIER();
            { const bf16x8_t ya = lfrag(AtT, CHP_T, 16 * gw + lo, 8 * hi), yx = lfrag(X1T, CHP_T, 16 * gw + lo, 8 * hi);
              const bf16x8_t m0 = lfrag(Minv, CHP_T, lo, 8 * hi), m1 = lfrag(Minv, CHP_T, 16 + lo, 8 * hi), w1 = lfrag(W1, CHP_T, lo, 8 * hi);
              LAS bf16* p1r = P1T + (16 * gw + lo) * CHP_T; LAS bf16* p2r = P2T + (16 * gw + lo) * CHP_T;
              const f32x4 a = MFMA16(m0, ya, z4), b = MFMA16(m0, yx, z4);
              st4(p1r + 4 * hi, a); st4(p2r + 4 * hi, b);
              asm volatile("" ::: "memory");
              const bf16x8_t pa = *(const LAS bf16x8_t*)(p1r + 8 * (hi & 1)), pb = *(const LAS bf16x8_t*)(p2r + 8 * (hi & 1));
              const bf16x8_t za = (hi < 2) ? pa : ya, zx = (hi < 2) ? pb : yx;
              const f32x4 ta = MFMA16(w1, za, z4), tb = MFMA16(w1, zx, z4);
              st4(p1r + 16 + 4 * hi, ta); st4(p2r + 16 + 4 * hi, tb);
              asm volatile("" ::: "memory");
              const bf16x8_t qa = *(const LAS bf16x8_t*)(p1r + 8 * hi), qx = *(const LAS bf16x8_t*)(p2r + 8 * hi);
              const f32x4 ca = MFMA16(m1, qa, z4), cb = MFMA16(m1, qx, z4);
              asm volatile("" ::: "memory");
              st4(p1r + 16 + 4 * hi, ca); st4(p2r + 16 + 4 * hi, cb);
            }
            GROUP_BARRIER();
            HEAD_LOADS((h + 1 < NH) ? h + 1 : h);
            { GAS bf16* outp = GHQ + (size_t)ci * GHQ_CHUNK;
              const bf16x8_t p1 = lfrag(P1T, CHP_T, 16 * gw + lo, 8 * hi), p2 = lfrag(P2T, CHP_T, 16 * gw + lo, 8 * hi), vm = lfrag(VmT, CHP_T, 16 * gw + lo, 8 * hi);
#pragma unroll
              for (int mt = 0; mt < 2; ++mt) { const bf16x8_t arb = lfrag(Arb, CHP_T, 16 * mt + lo, 8 * hi), ark = lfrag(Ark, CHP_T, 16 * mt + lo, 8 * hi);
                  f32x4 q1 = MFMA16(p1, arb, z4);
                  { const int t = 16 * mt + lo, k0 = 16 * gw + 4 * hi; const u32x2 rw = *(const LAS u32x2*)(Rt + t * CHP_K + k0);
                    q1[0] += bf_lo(rw.x); q1[1] += bf_hi(rw.x); q1[2] += bf_lo(rw.y); q1[3] += bf_hi(rw.y);
                    u32x2 w; w.x = pk2(q1[0], q1[1]); w.y = pk2(q1[2], q1[3]); *(GAS u32x2*)(outp + 8192 + t * 64 + k0) = w; }
                  f32x4 q2 = MFMA16(arb, p2, z4); q2 = MFMA16(ark, vm, q2);
                  { u32x2 w; w.x = pk2(q2[0], q2[1]); w.y = pk2(q2[2], q2[3]); *(GAS u32x2*)(outp + 10240 + (16 * gw + lo) * 32 + 16 * mt + 4 * hi) = w; } }
#pragma unroll
              for (int mt = 0; mt < 4; ++mt) { const bf16x8_t bh = lfrag(BhT, CHP_T, 16 * mt + lo, 8 * hi), kh = lfrag(KhT, CHP_T, 16 * mt + lo, 8 * hi);
                  const f32x4 g = MFMA16(p1, bh, z4);
                  { u32x2 w; w.x = pk2(g[0], g[1]); w.y = pk2(g[2], g[3]); *(GAS u32x2*)(outp + (16 * mt + lo) * 64 + 16 * gw + 4 * hi) = w; }
                  f32x4 hh = MFMA16(bh, p2, z4); hh = MFMA16(kh, vm, hh);
                  { u32x2 w; w.x = pk2(hh[0], hh[1]); w.y = pk2(hh[2], hh[3]); *(GAS u32x2*)(outp + 4096 + (16 * gw + lo) * 64 + 16 * mt + 4 * hi) = w; } }
            }
        }
    }
    __syncthreads();
#undef GROUP_BARRIER
#undef HEAD_LOADS
}
__device__ __forceinline__ void p9b_rwkv_seq(const Frame& F0) {
    PHASE_VIEW();
    const GAS bf16* GHQ = (const GAS bf16*)(F.ws + WS_GHQ); const GAS float* GT = (const GAS float*)(F.ws + WS_GT); GAS bf16* Yy = (GAS bf16*)(F.ws + WS_Y);
    LAS bf16* Sb = (LAS bf16*)F.lds;
    LAS bf16* Yb = Sb + 2 * 32 * CHP_K;
    const int lo = F.lane & 15, hi = F.lane >> 4, vt = F.wave & 1;
    const bool ywave = F.wave < 4, twave = (F.wave == 4 || F.wave == 5), writer = F.wave >= 6;
    const int kt = ywave ? (F.wave >> 1) : 2, mt = (F.wave >> 1) & 1;
    const f32x4 z4 = (f32x4){0.f, 0.f, 0.f, 0.f};
    for (int item = F.vcu; item < NB * NH * 2; item += F.G) {
        const int b = item >> 5, h = (item >> 1) & 15, vh = item & 1;
        __syncthreads();
        for (int i = F.tid; i < 2 * 32 * CHP_K / 2; i += NTHR) ((LAS unsigned*)Sb)[i] = 0u;
        __syncthreads();
        f32x4 Sf = z4, Sf2 = z4;
        const size_t cbase = (size_t)(b * NH + h) * 64;
        const int vrow = vh * 32 + 16 * vt + lo;
        const int offX = ywave ? 8192 + (16 * mt + lo) * 64 + 8 * hi : (48 + lo) * 64 + 8 * hi;
        const int offX2 = ywave ? 10240 + vrow * 32 + 16 * mt + 4 * hi : 4096 + vrow * 64 + 48 + 4 * hi;
        const int offT2 = ywave ? 16 * kt + 4 * hi : 48 + 4 * hi;
#define SEQ_LOAD(G_, X_, H_, X2_, GT_, GT2_, cc_) do { if (!writer) { const int cn_ = (cc_) < 64 ? (cc_) : 63; const GAS bf16* cp_ = GHQ + (cbase + cn_) * GHQ_CHUNK; \
            G_[0] = *(const GAS bf16x8_t*)(cp_ + (16 * kt + lo) * 64 + 8 * hi); G_[1] = *(const GAS bf16x8_t*)(cp_ + (16 * kt + lo) * 64 + 32 + 8 * hi); \
            H_ = *(const GAS u32x2*)(cp_ + 4096 + vrow * 64 + 16 * kt + 4 * hi); GT_ = *(const GAS f32x4*)(GT + (cbase + cn_) * 64 + 16 * kt + 4 * hi); \
            X_[0] = *(const GAS bf16x8_t*)(cp_ + offX); X_[1] = *(const GAS bf16x8_t*)(cp_ + offX + 32); \
            X2_ = *(const GAS u32x2*)(cp_ + offX2); GT2_ = *(const GAS f32x4*)(GT + (cbase + cn_) * 64 + offT2); } } while (0)
#define SEQ_FLUSH(cc_) do { const int r_ = (F.wave - 6) * 16 + (F.lane >> 2), q_ = F.lane & 3; \
            const u32x4 yv_ = *(const LAS u32x4*)(Yb + ((cc_) & 1) * 1024 + r_ * 32 + 8 * q_); \
            *(GAS u32x4*)(Yy + (size_t)(b * SEQ + (cc_) * CH_T + r_) * 1024 + h * 64 + vh * 32 + 8 * q_) = yv_; } while (0)
#define SEQ_STEP(G_, X_, H_, X2_, GT_, GT2_, cc_) do { \
            const LAS bf16* Sc = Sb + ((cc_) & 1) * 32 * CHP_K; LAS bf16* Sn = Sb + (((cc_) + 1) & 1) * 32 * CHP_K; \
            if (!writer) { \
                const bf16x8_t s0 = lfrag(Sc, CHP_K, 16 * vt + lo, 8 * hi), s1 = lfrag(Sc, CHP_K, 16 * vt + lo, 32 + 8 * hi); \
                f32x4 acc2 = (f32x4){bf_lo(X2_.x), bf_hi(X2_.x), bf_lo(X2_.y), bf_hi(X2_.y)}; \
                if (twave) acc2 = acc2 + GT2_ * Sf2; \
                acc2 = MFMA16(X_[0], s0, acc2); acc2 = MFMA16(X_[1], s1, acc2); \
                f32x4 acc = (f32x4){bf_lo(H_.x), bf_hi(H_.x), bf_lo(H_.y), bf_hi(H_.y)} + GT_ * Sf; \
                acc = MFMA16(G_[0], s0, acc); acc = MFMA16(G_[1], s1, acc); \
                Sf = acc; st4(Sn + (16 * vt + lo) * CHP_K + 16 * kt + 4 * hi, acc); \
                if (twave) { Sf2 = acc2; st4(Sn + (16 * vt + lo) * CHP_K + 48 + 4 * hi, acc2); } \
                else { LAS bf16* yo_ = Yb + ((cc_) & 1) * 1024 + (16 * mt + 4 * hi) * 32 + 16 * vt + lo; const unsigned w01 = pk2(acc2[0], acc2[1]), w23 = pk2(acc2[2], acc2[3]);     \
                    yo_[0] = (bf16)(w01 & 0xffffu); yo_[32] = (bf16)(w01 >> 16); yo_[64] = (bf16)(w23 & 0xffffu); yo_[96] = (bf16)(w23 >> 16); } \
                SEQ_LOAD(G_, X_, H_, X2_, GT_, GT2_, (cc_) + 4); \
            } else if ((cc_) > 0) SEQ_FLUSH((cc_) - 1); \
            asm volatile("s_waitcnt lgkmcnt(0)" ::: "memory"); __builtin_amdgcn_s_barrier(); asm volatile("" ::: "memory"); } while (0)
        bf16x8_t gA[2], xA[2], gB[2], xB[2], gC[2], xC[2], gD[2], xD[2]; u32x2 hA, x2A, hB, x2B, hC, x2C, hD, x2D; f32x4 gtA, gtB, gtC, gtD, gsA, gsB, gsC, gsD;
        SEQ_LOAD(gA, xA, hA, x2A, gtA, gsA, 0); SEQ_LOAD(gB, xB, hB, x2B, gtB, gsB, 1); SEQ_LOAD(gC, xC, hC, x2C, gtC, gsC, 2); SEQ_LOAD(gD, xD, hD, x2D, gtD, gsD, 3);
#pragma unroll
        for (int c = 0; c < 64; c += 4) {
            SEQ_STEP(gA, xA, hA, x2A, gtA, gsA, c); SEQ_STEP(gB, xB, hB, x2B, gtB, gsB, c + 1); SEQ_STEP(gC, xC, hC, x2C, gtC, gsC, c + 2); SEQ_STEP(gD, xD, hD, x2D, gtD, gsD, c + 3);
        }
        if (writer) SEQ_FLUSH(63);
#undef SEQ_LOAD
#undef SEQ_FLUSH
#undef SEQ_STEP
    }
}
__device__ __forceinline__ void p9_rwkv_post(const Frame& F0) {
    PHASE_VIEW();
    const GAS bf16* VB = (const GAS bf16*)(F.ws + WS_VB); const GAS bf16* GB = (const GAS bf16*)(F.ws + WS_GB); const GAS float* BON = (const GAS float*)(F.ws + WS_BON);
    const GAS bf16* Yy = (const GAS bf16*)(F.ws + WS_Y);
    const GAS float* ln_w = (const GAS float*)F.in[29]; const GAS float* ln_b = (const GAS float*)F.in[30]; GAS bf16* MIX = (GAS bf16*)(F.ws + WS_MIX);
    const int gw = F.vcu * NWAVES + F.wave, NGW = F.G * NWAVES;
    u32x2 ywn, vwn, gwn; float bonn;
#define POST_LOAD(it_) do { const int it2 = (it_) < NT * 4 ? (it_) : gw; const int row_ = it2 >> 2, c_ = (it2 & 3) * 256 + F.lane * 4; const size_t idx_ = (size_t)row_ * 1024 + c_; \
        ywn = *(const GAS u32x2*)(Yy + idx_); vwn = *(const GAS u32x2*)(VB + idx_); gwn = *(const GAS u32x2*)(GB + idx_); bonn = BON[row_ * 16 + (c_ >> 6)]; } while (0)
    POST_LOAD(gw);
    for (int it = gw; it < NT * 4; it += NGW) {
        const int row = it >> 2, c = (it & 3) * 256 + F.lane * 4;
        const u32x2 yw = ywn, vw = vwn, gwv = gwn; const float bon = bonn;
        const f32x4 lw = *(const GAS f32x4*)(ln_w + c), lb = *(const GAS f32x4*)(ln_b + c);
        POST_LOAD(it + NGW);
        const f32x4 y = (f32x4){bf_lo(yw.x), bf_hi(yw.x), bf_lo(yw.y), bf_hi(yw.y)};
        const float mean = row16_sum((y.x + y.y) + (y.z + y.w)) * (1.f / 64.f); const f32x4 d = y - mean;
        const float var = row16_sum((d.x * d.x + d.y * d.y) + (d.z * d.z + d.w * d.w)) * (1.f / 64.f); const float rstd = rsqrtf(var + GN_EPS);
        const f32x4 vv = (f32x4){bf_lo(vw.x), bf_hi(vw.x), bf_lo(vw.y), bf_hi(vw.y)}, gg = (f32x4){bf_lo(gwv.x), bf_hi(gwv.x), bf_lo(gwv.y), bf_hi(gwv.y)};
        const f32x4 o = (d * rstd * lw + lb + vv * bon) * gg;
        u32x2 w; w.x = pk2(o.x, o.y); w.y = pk2(o.z, o.w); *(GAS u32x2*)(MIX + (size_t)row * DM + DSSM + c) = w;
    }
#undef POST_LOAD
}

__device__ __forceinline__ void p11_x1_router(const Frame& F0) {
    PHASE_VIEW();
    const GAS float* x = (const GAS float*)F.in[0]; const GAS float* gpost = (const GAS float*)F.in[5]; const GAS float* gpre2 = (const GAS float*)F.in[6]; const GAS float* mod = (const GAS float*)(F.ws + WS_MOD);
    const GAS bf16* MIXED = (const GAS bf16*)(F.ws + WS_MIXED); GAS bf16* X1 = (GAS bf16*)(F.ws + WS_X1); GAS bf16* H = (GAS bf16*)(F.ws + WS_H);
    const GAS bf16x8_t* rwt = (const GAS bf16x8_t*)(F.ws + WS_RWT); const float* b_grp = F.in[32]; const float* b_exp = F.in[34];
    unsigned* tokinfo = (unsigned*)(F.ws + WS_TOKINFO); int* list = (int*)(F.ws + WS_LIST);
    LAS float* slab = (LAS float*)(F.lds + F.wave * 16384) + F.lane * 8;
    LAS float* Lp = (LAS float*)F.lds;
    LAS float* red1 = (LAS float*)(F.lds + 131072); LAS float* red2 = red1 + 128; LAS float* Lf = red2 + 128;
    const int lo = F.lane & 15, hi = F.lane >> 4, k0 = 256 * F.wave + 8 * hi;
    const f32x4 z4 = (f32x4){0.f, 0.f, 0.f, 0.f};
    for (int tile = F.vcu; tile < NT / 16; tile += F.G) {
        const int row = tile * 16 + lo, b = tile >> 7;
        const size_t ro = (size_t)row * DM + k0;
        f32x4 xr[8][2];
#pragma unroll
        for (int s_ = 0; s_ < 8; ++s_) { xr[s_][0] = *(const GAS f32x4*)(x + ro + 32 * s_); xr[s_][1] = *(const GAS f32x4*)(x + ro + 32 * s_ + 4); }
        float ss = 0.f;
#pragma unroll
        for (int s_ = 0; s_ < 8; ++s_) { const u32x4 mw = *(const GAS u32x4*)(MIXED + ro + 32 * s_); const f32x4 a0 = (f32x4){bf_lo(mw.x), bf_hi(mw.x), bf_lo(mw.y), bf_hi(mw.y)}, a1 = (f32x4){bf_lo(mw.z), bf_hi(mw.z), bf_lo(mw.w), bf_hi(mw.w)};
            *(LAS f32x4*)(slab + s_ * 512) = a0; *(LAS f32x4*)(slab + s_ * 512 + 4) = a1;
            ss += (a0.x * a0.x + a0.y * a0.y) + (a0.z * a0.z + a0.w * a0.w) + (a1.x * a1.x + a1.y * a1.y) + (a1.z * a1.z + a1.w * a1.w); }
        ss += __shfl_xor(ss, 16); ss += __shfl_xor(ss, 32);
        if (hi == 0) red1[F.wave * 16 + lo] = ss;
        LDS_BARRIER();
        float tot = 0.f;
#pragma unroll
        for (int w = 0; w < 8; ++w) tot += red1[w * 16 + lo];
        const float rs = rsqrtf(tot * (1.f / DM) + RMS_EPS);
        float ss2 = 0.f;
        const GAS float* modb = mod + b * NMOD + k0;
#pragma unroll
        for (int s_ = 0; s_ < 8; ++s_) { f32x4 xo[2];
#pragma unroll
            for (int q = 0; q < 2; ++q) { const f32x4 xv = xr[s_][q], gv = *(const GAS f32x4*)(gpost + k0 + 32 * s_ + 4 * q), gt = *(const GAS f32x4*)(modb + 2 * DM + 32 * s_ + 4 * q);
                const f32x4 mm = *(const LAS f32x4*)(slab + s_ * 512 + 4 * q);
                const f32x4 v = xv + gt * (mm * rs * gv); *(LAS f32x4*)(slab + s_ * 512 + 4 * q) = v; xo[q] = v;
                ss2 += (v.x * v.x + v.y * v.y) + (v.z * v.z + v.w * v.w); }
            (void)xo; }
        ss2 += __shfl_xor(ss2, 16); ss2 += __shfl_xor(ss2, 32);
        if (hi == 0) red2[F.wave * 16 + lo] = ss2;
        LDS_BARRIER();
        float tot2 = 0.f;
#pragma unroll
        for (int w = 0; w < 8; ++w) tot2 += red2[w * 16 + lo];
        const float rs2 = rsqrtf(tot2 * (1.f / DM) + RMS_EPS);
        f32x4 acc[5] = {z4, z4, z4, z4, z4};
        bf16x8_t wA[10], wB[10]; f32x4 cA[6], cB[6];
#define RT_LOAD(W_, C_, st_) do { const GAS bf16x8_t* wb_ = rwt + (size_t)((F.wave * 8 + (st_)) * 10) * 64; \
            _Pragma("unroll") for (int j_ = 0; j_ < 10; ++j_) W_[j_] = wb_[j_ * 64 + F.lane]; \
            _Pragma("unroll") for (int q_ = 0; q_ < 2; ++q_) { C_[3 * q_] = *(const GAS f32x4*)(gpre2 + k0 + 32 * (st_) + 4 * q_); C_[3 * q_ + 1] = *(const GAS f32x4*)(modb + 3 * DM + 32 * (st_) + 4 * q_); C_[3 * q_ + 2] = *(const GAS f32x4*)(modb + 4 * DM + 32 * (st_) + 4 * q_); } } while (0)
#define RT_STEP(W_, C_, st_) do { f32x4 hv[2]; \
            u32x4 xb_; \
            _Pragma("unroll") for (int q_ = 0; q_ < 2; ++q_) { const f32x4 mm = *(const LAS f32x4*)(slab + (st_) * 512 + 4 * q_); hv[q_] = mm * rs2 * C_[3 * q_] * (C_[3 * q_ + 2] + 1.0f) + C_[3 * q_ + 1]; \
                if (q_ == 0) { xb_.x = pk2(mm.x, mm.y); xb_.y = pk2(mm.z, mm.w); } else { xb_.z = pk2(mm.x, mm.y); xb_.w = pk2(mm.z, mm.w); } } \
            *(LAS u32x4*)(slab + (st_) * 512 + 4) = xb_;     \
            u32x4 hh, hl; \
            hh.x = pk2(hv[0].x, hv[0].y); hh.y = pk2(hv[0].z, hv[0].w); hh.z = pk2(hv[1].x, hv[1].y); hh.w = pk2(hv[1].z, hv[1].w); \
            *(LAS u32x4*)(slab + (st_) * 512) = hh;        \
            hl.x = pk2(hv[0].x - bf_lo(hh.x), hv[0].y - bf_hi(hh.x)); hl.y = pk2(hv[0].z - bf_lo(hh.y), hv[0].w - bf_hi(hh.y)); \
            hl.z = pk2(hv[1].x - bf_lo(hh.z), hv[1].y - bf_hi(hh.z)); hl.w = pk2(hv[1].z - bf_lo(hh.w), hv[1].w - bf_hi(hh.w)); \
            const bf16x8_t fh = __builtin_bit_cast(bf16x8_t, hh), fl = __builtin_bit_cast(bf16x8_t, hl); \
            _Pragma("unroll") for (int jt = 0; jt < 5; ++jt) { acc[jt] = MFMA16(W_[2 * jt], fh, acc[jt]); acc[jt] = MFMA16(W_[2 * jt], fl, acc[jt]); acc[jt] = MFMA16(W_[2 * jt + 1], fh, acc[jt]); } } while (0)
        RT_LOAD(wA, cA, 0);
#pragma unroll 1
        for (int s2 = 0; s2 < 8; s2 += 2) { RT_LOAD(wB, cB, s2 + 1); RT_STEP(wA, cA, s2); RT_LOAD(wA, cA, (s2 + 2 < 8 ? s2 + 2 : 7)); RT_STEP(wB, cB, s2 + 1); }
#undef RT_LOAD
#undef RT_STEP
#pragma unroll
        for (int s_ = 0; s_ < 8; ++s_) { *(GAS u32x4*)(H + ro + 32 * s_) = *(const LAS u32x4*)(slab + s_ * 512); *(GAS u32x4*)(X1 + ro + 32 * s_) = *(const LAS u32x4*)(slab + s_ * 512 + 4); }
        LDS_WAIT(); asm volatile("" ::: "memory");
#pragma unroll
        for (int jt = 0; jt < 5; ++jt) *(LAS f32x4*)(Lp + F.wave * 4096 + lo * 80 + 16 * jt + 4 * hi) = acc[jt];
        LDS_BARRIER();
        for (int i = F.tid; i < 16 * 80; i += NTHR) { float sacc = 0.f;
#pragma unroll
            for (int w = 0; w < 8; ++w) sacc += Lp[w * 4096 + i];
            const int j = i % 80; Lf[i] = sacc + (j < 8 ? b_grp[j] : (j < 72 ? b_exp[j - 8] : 0.f)); }
        LDS_BARRIER();
        if (F.tid < 16) { const LAS float* lg = Lf + F.tid * 80; const int tok = tile * 16 + F.tid;
            int gi = 0; float gmax = lg[0];
#pragma unroll
            for (int j = 1; j < 8; ++j) if (lg[j] > gmax) { gmax = lg[j]; gi = j; }
            float gsum = 0.f;
#pragma unroll
            for (int j = 0; j < 8; ++j) gsum += __expf(lg[j] - gmax);
            const float pg = 1.f / gsum;
            const LAS float* le = lg + 8 + gi * 8; int i1 = 0; float m1 = le[0];
#pragma unroll
            for (int j = 1; j < 8; ++j) if (le[j] > m1) { m1 = le[j]; i1 = j; }
            int i2 = -1; float m2 = -INFINITY;
#pragma unroll
            for (int j = 0; j < 8; ++j) if (j != i1 && le[j] > m2) { m2 = le[j]; i2 = j; }
            const float e2 = __expf(m2 - m1); const float g1 = pg / (1.f + e2), g2 = pg * e2 / (1.f + e2);
            const int x1i = gi * 8 + i1, x2i = gi * 8 + i2;
            const unsigned p1 = atomicAdd(F.ctl + CW_CNT + 64 * x1i, 1u), p2 = atomicAdd(F.ctl + CW_CNT + 64 * x2i, 1u);
            list[x1i * NT + p1] = tok; list[x2i * NT + p2] = tok;
            u32x4 a; a.x = (unsigned)x1i; a.y = p1; a.z = (unsigned)x2i; a.w = p2; *(u32x4*)(tokinfo + (size_t)tok * 8) = a;
            u32x2 g; g.x = __float_as_uint(g1); g.y = __float_as_uint(g2); *(u32x2*)(tokinfo + (size_t)tok * 8 + 4) = g;
        }
    }
    __syncthreads();
}

__device__ __forceinline__ void conv_item_src(const Frame& F, int it, const float*& W, int& N, bf16*& WT, int& ldk, int& drow, int& k0, int& n0) {
    if (it < NEXP * 1024) { const int e = it >> 10, r = it & 1023, which = r >> 9, rr = r & 511; k0 = (rr >> 4) * 64; n0 = (rr & 15) * 32;
        W = F.in[which ? 36 : 35] + (size_t)e * DM * DEXP; N = DEXP; WT = (bf16*)(F.ws + WS_EW1) + (size_t)e * 1024 * DM; ldk = DM; drow = (n0 >> 7) * 256 + which * 128 + (n0 & 127); }
    else { const int j = it - NEXP * 1024, e = j >> 9, r = j & 511; k0 = (r >> 6) * 64; n0 = (r & 63) * 32;
        W = F.in[37] + (size_t)e * DEXP * DM; N = DM; WT = (bf16*)(F.ws + WS_EW2) + (size_t)e * DM * DEXP; ldk = DEXP; drow = n0; }
}
struct ConvItem { const GAS float* src; GAS bf16* dst; int ldk; };
__device__ __forceinline__ void conv_decode(const Frame& F, int it, int lane, ConvItem& ci, int& N) {
    const float* W; int ldk, drow, k0, n0; bf16* WT; conv_item_src(F, it, W, N, WT, ldk, drow, k0, n0);
    ci.src = (const GAS float*)W + (size_t)(k0 + (lane >> 3)) * N + n0 + 4 * (lane & 7); ci.dst = (GAS bf16*)WT + (size_t)(drow + (lane >> 3)) * ldk + k0 + 8 * (lane & 7); ci.ldk = ldk;
}
__device__ __forceinline__ int conv_stream(const Frame& F, int first, int step, int total, const unsigned* stopw) {
    LAS float* scr = (LAS float*)(F.lds + F.wave * 16384);
    const int lane = F.lane;
    f32x4 bA[8], bB[8], bC[8]; ConvItem iA, iB, iC; int done = 0;
#define CV_LOAD(buf, ci, idx) do { int N_; conv_decode(F, (idx) < total ? (idx) : total - 1, lane, ci, N_); _Pragma("unroll") for (int i_ = 0; i_ < 8; ++i_) buf[i_] = *(const GAS f32x4*)(ci.src + (size_t)(8 * i_) * N_); } while (0)
#define CV_PROC(buf, ci) do { _Pragma("unroll") for (int i_ = 0; i_ < 8; ++i_) *(LAS f32x4*)(scr + (8 * i_ + (lane >> 3)) * 36 + 4 * (lane & 7)) = buf[i_]; \
        LDS_WAIT(); asm volatile("" ::: "memory"); \
        { const int c_ = lane & 7; _Pragma("unroll") for (int j_ = 0; j_ < 4; ++j_) { const LAS float* sp = scr + (8 * c_) * 36 + (lane >> 3) + 8 * j_; \
              u32x4 o; o.x = pk2(sp[0 * 36], sp[1 * 36]); o.y = pk2(sp[2 * 36], sp[3 * 36]); o.z = pk2(sp[4 * 36], sp[5 * 36]); o.w = pk2(sp[6 * 36], sp[7 * 36]); \
              *(GAS u32x4*)(ci.dst + (size_t)(8 * j_) * ci.ldk) = o; } } \
        LDS_WAIT(); asm volatile("" ::: "memory"); ++done; } while (0)
#define CV_STOPLD() __hip_atomic_load((const GAS unsigned*)stopw, RLX_AGENT)
#define CV_STOP(v) (__builtin_amdgcn_readfirstlane((int)(v)) != 0)
    int it = first;
    CV_LOAD(bA, iA, it); CV_LOAD(bB, iB, it + step);
    while (it < total) {
        unsigned sv = CV_STOPLD();
        CV_LOAD(bC, iC, it + 2 * step);
        CV_PROC(bA, iA); if (CV_STOP(sv)) break;
        if (it + step >= total) break;
        sv = CV_STOPLD();
        CV_LOAD(bA, iA, it + 3 * step);
        CV_PROC(bB, iB); if (CV_STOP(sv)) break;
        if (it + 2 * step >= total) break;
        sv = CV_STOPLD();
        CV_LOAD(bB, iB, it + 4 * step);
        CV_PROC(bC, iC); if (CV_STOP(sv)) break;
        it += 3 * step;
    }
#undef CV_STOPLD
#undef CV_LOAD
#undef CV_PROC
#undef CV_STOP
    return done;
}
__device__ __forceinline__ void p12_expert_convert(const Frame& F0) {
    PHASE_VIEW();
    volatile LAS int* red = (volatile LAS int*)(F.lds + 131072);
    const int ncw = (F.G >= 256) ? (F.G - CONV_GEMM_BLOCKS) * NWAVES : 0;
    __syncthreads();
    if (F.tid == 0) red[0] = 0x7fffffff;
    __syncthreads();
    for (int i = F.tid; i < ncw; i += NTHR) atomicMin((int*)red, (int)__hip_atomic_load(F.ctl + CW_PROG + i, RLX_AGENT));
    __syncthreads();
    const int start = ncw ? red[0] * ncw : 0;
    __syncthreads();
    const int gw = F.vcu * NWAVES + F.wave, NGW = F.G * NWAVES;
    (void)conv_stream(F, start + gw, NGW, CONV_ITEMS, F.ctl + CW_TMO + 2);
}

__device__ __forceinline__ void moe_build_tp(const Frame& F0) {
    PHASE_VIEW();
    volatile LAS int* tp = (volatile LAS int*)(F.lds + TP_OFF);
    __syncthreads();
    if (F.tid < NEXP) { const unsigned c = __hip_atomic_load(F.ctl + CW_CNT + 64 * F.tid, RLX_AGENT); tp[80 + F.tid] = (int)((c + 255u) >> 8); tp[160 + F.tid] = (int)c; }
    __syncthreads();
    if (F.tid == 0) { int s = 0; for (int e = 0; e < NEXP; ++e) { tp[e] = s; s += tp[80 + e]; } tp[NEXP] = s; }
    __syncthreads();
}
template <bool G1> struct MoeOrder {
    static constexpr bool GATHER = G1; static constexpr int A2 = 0;
    static constexpr int NNT = G1 ? 4 : 8, KK = G1 ? DM : DEXP;
    __device__ __forceinline__ size_t kstepA() const { return 128; }
    __device__ __forceinline__ size_t hstepA() const { return (size_t)128 * KK * 2; }
    __device__ __forceinline__ size_t a2off() const { return 0; }
    const LAS int* tp; const unsigned* cntw; const int* list; const char* A; const char* EW; int G, c;
    __device__ bool next(int i, pg8::Unit& u) const {
        const int x = c & 7, r = c >> 3, W = G >> 3;
        const int L = i * W + r, tl = L / NNT; u.pn = L % NNT;
        int cum = 0, e = -1, mt = 0;
#pragma unroll
        for (int j = 0; j < 8; ++j) { const int nj = tp[80 + x + 8 * j]; if (e < 0 && tl < cum + nj) { e = x + 8 * j; mt = tl - cum; } cum += nj; }
        if (e < 0) return false;
        e = __builtin_amdgcn_readfirstlane(e); mt = __builtin_amdgcn_readfirstlane(mt);
        const int tile = tp[e] + mt;
        u.e = e; u.pm = tile; u.cnt = tp[160 + e] - mt * 256;
        u.Bb = EW + ((size_t)e * (G1 ? 1024 : DM) + (size_t)u.pn * 256) * KK * 2;
        u.Ab = G1 ? A : A + (size_t)tile * 256 * KK * 2;
        return true;
    }
    template <int NV> __device__ __forceinline__ void a_voff(const pg8::Unit& u, unsigned (&v)[NV][2], const int (&R)[2], const int (&C)[2]) const {
        if constexpr (G1) {
            const int mt = u.pm - tp[u.e];
#pragma unroll
            for (int h = 0; h < 2; ++h)
#pragma unroll
                for (int i = 0; i < 2; ++i) { const int rr = h * 128 + R[i]; const int tok = list[u.e * NT + mt * 256 + (rr < u.cnt ? rr : 0)]; v[h][i] = (unsigned)(tok * KK + C[i]) * 2u; }
        } else {
#pragma unroll
            for (int i = 0; i < 2; ++i) v[0][i] = (unsigned)(R[i] * KK + C[i]) * 2u;
        }
    }
};

__device__ __forceinline__ void p15_final(const Frame& F0) {
    PHASE_VIEW();
    const GAS bf16* X1 = (const GAS bf16*)(F.ws + WS_X1); const GAS bf16* YS = (const GAS bf16*)(F.ws + WS_YSLOT); const GAS unsigned* tokinfo = (const GAS unsigned*)(F.ws + WS_TOKINFO);
    const GAS float* gpost2 = (const GAS float*)F.in[7]; const GAS float* mod = (const GAS float*)(F.ws + WS_MOD); GAS float* out = (GAS float*)F.out;
    const LAS int* tp = (const LAS int*)(F.lds + TP_OFF);
    const int gw = F.vcu * NWAVES + F.wave, NGW = F.G * NWAVES;
    f32x4 gv[8];
#pragma unroll
    for (int j = 0; j < 8; ++j) gv[j] = *(const GAS f32x4*)(gpost2 + 4 * (F.lane + 64 * j));
    u32x4 tin = *(const GAS u32x4*)(tokinfo + (size_t)gw * 8); u32x2 tgn = *(const GAS u32x2*)(tokinfo + (size_t)gw * 8 + 4);
    for (int row = gw; row < NT; row += NGW) {
        const int b = row >> 11;
        const u32x4 ti = tin; const u32x2 tg = tgn;
        const size_t r1 = (size_t)tp[ti.x] * 256 + ti.y, r2 = (size_t)tp[ti.z] * 256 + ti.w; const float g1 = __uint_as_float(tg.x), g2 = __uint_as_float(tg.y);
        const GAS u32x2* y1 = (const GAS u32x2*)(YS + r1 * DM) + F.lane; const GAS u32x2* y2 = (const GAS u32x2*)(YS + r2 * DM) + F.lane; const GAS u32x2* xp = (const GAS u32x2*)(X1 + (size_t)row * DM) + F.lane;
        u32x2 ya[8], yb[8], xw[8]; f32x4 gt[8];
#pragma unroll
        for (int j = 0; j < 8; ++j) { ya[j] = y1[64 * j]; yb[j] = y2[64 * j]; xw[j] = xp[64 * j]; gt[j] = *(const GAS f32x4*)(mod + b * NMOD + 5 * DM + 4 * (F.lane + 64 * j)); }
        { const int rn = (row + NGW < NT) ? row + NGW : row; tin = *(const GAS u32x4*)(tokinfo + (size_t)rn * 8); tgn = *(const GAS u32x2*)(tokinfo + (size_t)rn * 8 + 4); }
        f32x4 v[8]; float ss = 0.f;
#pragma unroll
        for (int j = 0; j < 8; ++j) { const u32x2 a = ya[j], c = yb[j];
            v[j] = (f32x4){bf_lo(a.x), bf_hi(a.x), bf_lo(a.y), bf_hi(a.y)} * g1 + (f32x4){bf_lo(c.x), bf_hi(c.x), bf_lo(c.y), bf_hi(c.y)} * g2;
            ss += (v[j].x * v[j].x + v[j].y * v[j].y) + (v[j].z * v[j].z + v[j].w * v[j].w); }
        const float rs = rsqrtf(wave_sum_dpp(ss) * (1.f / DM) + RMS_EPS);
#pragma unroll
        for (int j = 0; j < 8; ++j) { const f32x4 xv = (f32x4){bf_lo(xw[j].x), bf_hi(xw[j].x), bf_lo(xw[j].y), bf_hi(xw[j].y)}; v[j] = xv + gt[j] * (v[j] * rs * gv[j]); }
#pragma unroll
        for (int j = 0; j < 8; ++j) ((GAS f32x4*)(out + (size_t)row * DM))[F.lane + 64 * j] = v[j];
    }
}

constexpr int NPH = 15;
__global__ void __launch_bounds__(NTHR, 2) mk_fwd(Args args) {
    extern __shared__ __attribute__((aligned(16))) unsigned char lds[];
    Frame F0;
    F0.lds = (LAS unsigned char*)lds; F0.MISC = (volatile LAS unsigned*)(F0.lds + MISC_OFF);
    F0.tid = threadIdx.x; F0.lane = F0.tid & 63; F0.wave = __builtin_amdgcn_readfirstlane(F0.tid >> 6);
    F0.G = gridDim.x; { const int bx = blockIdx.x; F0.vcu = (F0.G % 8 == 0) ? (bx % 8) * (F0.G / 8) + bx / 8 : bx; }
    F0.in.kp = (kargp_t)__builtin_amdgcn_kernarg_segment_ptr(); F0.out = args.out; F0.ws = args.ws; F0.ctl = (unsigned*)(args.ws + WS_CTL);
    if (F0.tid < 64) F0.MISC[F0.tid] = 0u;
    __syncthreads();
    const int lo = args.ph_lo, hi = args.ph_hi;
    XcdBarrier bar; bar.bar = F0.ctl + CW_BAR; bar.x = 0; bar.st = nullptr;
    if (hi - lo > 1) bar = xcd_barrier_post(F0.ctl + CW_BAR, F0.MISC + 8);
#ifndef PROBE_MASK
#define PROBE_MASK 0
#endif
#define REPS(k) ((((PROBE_MASK) >> (k)) & 1) + 1)
#define IN(k) (lo <= (k) && (k) < hi)
#define SEAM(k) do { if (IN(k) && IN((k) + 1)) xcd_barrier(bar); } while (0)
    LAS unsigned char* ring = F0.lds;

    if (IN(0)) for (int rep_ = 0; rep_ < REPS(0); ++rep_) { p0_prologue(F0); } SEAM(0);
    if (IN(1)) for (int rep_ = 0; rep_ < REPS(1); ++rep_) { p1_h1(F0); } SEAM(1);
    if (IN(2)) for (int rep_ = 0; rep_ < REPS(2); ++rep_) {
        PHASE_VIEW();
        const int G_GEMM = (F.G >= 256) ? CONV_GEMM_BLOCKS : F.G;
        if ((int)blockIdx.x < G_GEMM) {
            pg8::Gemm g{(const bf16*)(F.ws + WS_H), (const bf16*)(F.ws + WS_WIN_T), NT, DIN, DM}; pg8::StaticOrder S; S.init(g, G_GEMM, (int)blockIdx.x);
            pg8::EpiBf16 E{(bf16*)(F.ws + WS_PROJ), DIN};
            pg8::gemm_phase(ring, DM, S, E);
            __syncthreads();
            if (F.tid == 0 && rep_ == 0) { const unsigned d = atomicAdd(F.ctl + CW_GDONE, 1u); if (d == (unsigned)G_GEMM - 1u) __hip_atomic_store(F.ctl + CW_STOP, 1u, RLX_AGENT); }
        } else if (rep_ == 0) {
            const int jw = ((int)blockIdx.x - G_GEMM) * NWAVES + F.wave, ncw = (F.G - G_GEMM) * NWAVES;
            const int done = conv_stream(F, jw, ncw, CONV_ITEMS, F.ctl + CW_STOP);
            if (F.lane == 0) __hip_atomic_store(F.ctl + CW_PROG + jw, (unsigned)done, RLX_AGENT);
        }
    } SEAM(2);
    if (IN(3)) for (int rep_ = 0; rep_ < REPS(3); ++rep_) {
        PHASE_VIEW();
        S5Order<1> S{(const char*)(F.ws + WS_PROJ), (const char*)(F.ws + WS_SIN), (const char*)(F.ws + WS_S5WT), F.G, F.vcu};
        pg8::EpiS5Scan E{(bf16*)(F.ws + WS_SIN), F.in[10], F.in[11], F.in[12]};
        if (F.G >= NG * 4) pg8::gemm_phase(ring, 256, S, E);
    }
    if (IN(3) && IN(4)) { asm volatile("s_waitcnt vmcnt(0)" ::: "memory"); __syncthreads(); __builtin_amdgcn_fence(__ATOMIC_ACQUIRE, "agent"); asm volatile("s_waitcnt vmcnt(0)" ::: "memory"); __syncthreads(); }
    if (IN(4)) for (int rep_ = 0; rep_ < REPS(4); ++rep_) {
        PHASE_VIEW();
        S5Order<2> S{(const char*)(F.ws + WS_PROJ), (const char*)(F.ws + WS_SIN), (const char*)(F.ws + WS_S5MT), F.G, F.vcu};
        pg8::EpiS5Y E{(bf16*)(F.ws + WS_YSG)};
        int kk = 384; LAUNDER(kk);
        pg8::gemm_phase(ring, kk, S, E);
    } SEAM(4);
    if (IN(5)) for (int rep_ = 0; rep_ < REPS(5); ++rep_) {
        PHASE_VIEW();
        pg8::Gemm g{(const bf16*)(F.ws + WS_YSG), (const bf16*)(F.ws + WS_GLU_T), NT, DSSM, DSSM}; pg8::StaticOrder S; S.init(g, F.G, (int)blockIdx.x);
        pg8::EpiGlu E{(const bf16*)(F.ws + WS_YSG), (bf16*)(F.ws + WS_MIX), DM, F.in[19]};
        pg8::gemm_phase(ring, DSSM, S, E);
    } SEAM(5);
    if (IN(6)) for (int rep_ = 0; rep_ < REPS(6); ++rep_) { p9a_rwkv_chunks(F0); } SEAM(6);
    if (IN(7)) for (int rep_ = 0; rep_ < REPS(7); ++rep_) { p9b_rwkv_seq(F0); } SEAM(7);
    if (IN(8)) for (int rep_ = 0; rep_ < REPS(8); ++rep_) { p9_rwkv_post(F0); } SEAM(8);
    if (IN(9)) for (int rep_ = 0; rep_ < REPS(9); ++rep_) {
        PHASE_VIEW();
        pg8::Gemm g{(const bf16*)(F.ws + WS_MIX), (const bf16*)(F.ws + WS_WOUT_T), NT, DM, DM}; pg8::StaticOrder S; S.init(g, F.G, (int)blockIdx.x);
        pg8::EpiBf16 E{(bf16*)(F.ws + WS_MIXED), DM};
        pg8::gemm_phase(ring, DM, S, E);
    } SEAM(9);
    if (IN(10)) for (int rep_ = 0; rep_ < REPS(10); ++rep_) { p11_x1_router(F0); }
    if (IN(11)) for (int rep_ = 0; rep_ < REPS(11); ++rep_) { p12_expert_convert(F0); } SEAM(11);
    if (IN(12)) for (int rep_ = 0; rep_ < REPS(12); ++rep_) {
        PHASE_VIEW();
        moe_build_tp(F);
        MoeOrder<true> S{(const LAS int*)(F.lds + TP_OFF), F.ctl + CW_CNT, (const int*)(F.ws + WS_LIST), (const char*)(F.ws + WS_H), (const char*)(F.ws + WS_EW1), F.G, (int)blockIdx.x};
        pg8::EpiSwiglu E{(bf16*)(F.ws + WS_HID)};
        pg8::gemm_phase(ring, DM, S, E);
    } SEAM(12);
    if (IN(13)) for (int rep_ = 0; rep_ < REPS(13); ++rep_) {
        PHASE_VIEW();
        moe_build_tp(F);
        MoeOrder<false> S{(const LAS int*)(F.lds + TP_OFF), F.ctl + CW_CNT, (const int*)(F.ws + WS_LIST), (const char*)(F.ws + WS_HID), (const char*)(F.ws + WS_EW2), F.G, (int)blockIdx.x};
        pg8::EpiBf16 E{(bf16*)(F.ws + WS_YSLOT), DM};
        pg8::gemm_phase(ring, DEXP, S, E);
    } SEAM(13);
    if (IN(14)) for (int rep_ = 0; rep_ < REPS(14); ++rep_) { moe_build_tp(F0); p15_final(F0); }
#undef IN
#undef SEAM
}

extern "C" void kernel_launch(void* const* d_in, const int* in_sizes, int n_in, void* d_out, int out_size, void* d_ws, size_t ws_size, hipStream_t stream) {
    static int grid = 0;
    if (grid == 0) {
        if (n_in != 38 || out_size != NT * DM || ws_size < WS_END) { fprintf(stderr, "kernel_launch: unexpected problem (n_in %d, out %d, ws %zu < %zu)\n", n_in, out_size, ws_size, (size_t)WS_END); grid = -1; return; }
        int dev = 0, cus = 0, per_cu = 0;
        if (hipGetDevice(&dev) != hipSuccess || hipDeviceGetAttribute(&cus, hipDeviceAttributeMultiprocessorCount, dev) != hipSuccess) { grid = -1; return; }
        if (hipFuncSetAttribute((const void*)mk_fwd, hipFuncAttributeMaxDynamicSharedMemorySize, LDS_BYTES) != hipSuccess) { fprintf(stderr, "kernel_launch: hipFuncSetAttribute failed\n"); grid = -1; return; }
        if (hipOccupancyMaxActiveBlocksPerMultiprocessor(&per_cu, (const void*)mk_fwd, NTHR, LDS_BYTES) != hipSuccess || per_cu < 1) fprintf(stderr, "kernel_launch: occupancy query says %d\n", per_cu);
        (void)hipGetLastError();
        grid = cus;
    }
    if (grid < 0) return;
    if (hipMemsetAsync((char*)d_ws + WS_CTL, 0, CTL_ZERO_BYTES, stream) != hipSuccess) return;
    Args a{};
    for (int i = 0; i < 38; ++i) a.in[i] = (const float*)d_in[i];
    a.out = (float*)d_out; a.ws = (unsigned char*)d_ws;
#if MK_N_LAUNCHES == 1
    a.ph_lo = 0; a.ph_hi = NPH;
    hipLaunchKernelGGL(mk_fwd, dim3(grid), dim3(NTHR), LDS_BYTES, stream, a);
#else
    for (int p = 0; p < NPH; ++p) { a.ph_lo = p; a.ph_hi = p + 1; hipLaunchKernelGGL(mk_fwd, dim3(grid), dim3(NTHR), LDS_BYTES, stream, a); }
#endif
}
```

```cpp
#include <hip/hip_runtime.h>
#include <cstdio>
#include <cstdint>

#ifndef MK_N_LAUNCHES
#define MK_N_LAUNCHES 1
#endif

#ifndef CONV_GEMM_BLOCKS
#define CONV_GEMM_BLOCKS 184
#endif

#define GAS __attribute__((address_space(1)))
namespace pg8 {
#define PG8_LAS __attribute__((address_space(3)))
typedef unsigned short bf16_t;
typedef short bf16x8 __attribute__((ext_vector_type(8)));
typedef float f32x4 __attribute__((ext_vector_type(4)));
typedef float f32x2 __attribute__((ext_vector_type(2)));
typedef unsigned u32x4 __attribute__((ext_vector_type(4)));
typedef unsigned u32x2 __attribute__((ext_vector_type(2)));
constexpr int BM = 256, BK = 64, HALF = 128, HTB = HALF * BK * 2, STAGE_BYTES = 8 * HTB, NXCD = 8, WGM = 8;

__host__ __device__ __forceinline__ int lds_byte(int r, int c) { const int st = (r >> 4) * 2 + (c >> 5), rr = r & 15, cc = c & 31, ob = rr * 64 + cc * 2; return st * 1024 + (ob ^ (((ob >> 9) & 1) << 5)); }
__host__ __device__ __forceinline__ void stage_rc(int b, int& R, int& C) { const int st = b / 1024, sb = b % 1024, swz = sb ^ (((sb >> 9) & 1) << 5); R = (st >> 1) * 16 + swz / 64; C = (st & 1) * 32 + (swz % 64) / 2; }
__host__ __device__ __forceinline__ int perm32(int rho) { const int n = rho >> 4, i = rho & 15; return 8 * (i >> 2) + 4 * n + (i & 3); }

struct Unit { int pm, pn, e, cnt; const char* Ab; const char* Bb; };
struct Gemm { const bf16_t* A; const bf16_t* Bt; int M, N, K; };

struct StaticOrder {
    static constexpr bool GATHER = false; static constexpr int A2 = 0;
    __device__ __forceinline__ size_t kstepA() const { return (size_t)BK * 2; }
    __device__ __forceinline__ size_t hstepA() const { return (size_t)HALF * K * 2; }
    __device__ __forceinline__ size_t a2off() const { return 0; }
    int nM, nN, nwg, G, c, K; const char* A; const char* Bt;
    __device__ void init(const Gemm& g, int G_, int c_) { nM = g.M / BM; nN = g.N / BM; nwg = nM * nN; G = G_; c = c_; K = g.K; A = (const char*)g.A; Bt = (const char*)g.Bt; }
    __device__ bool next(int i, Unit& u) const {
        const long L = (long)i * G + c; if (L >= nwg) return false;
        int wgid = (int)L; { const int q = nwg / NXCD, r = nwg % NXCD, xcd = wgid % NXCD, off = wgid / NXCD; wgid = (xcd < r ? xcd * (q + 1) : r * (q + 1) + (xcd - r) * q) + off; }
        const int nig = WGM * nN, gid = wgid / nig, fm = gid * WGM, gsz = (nM - fm) < WGM ? (nM - fm) : WGM;
        u.pm = fm + ((wgid % nig) % gsz); u.pn = (wgid % nig) / gsz; u.e = 0; u.cnt = BM;
        u.Ab = A + (size_t)u.pm * BM * K * 2; u.Bb = Bt + (size_t)u.pn * BM * K * 2; return true;
    }
    template <int NV> __device__ __forceinline__ void a_voff(const Unit&, unsigned (&v)[NV][2], const int (&R)[2], const int (&C)[2]) const {
#pragma unroll
        for (int i = 0; i < 2; ++i) v[0][i] = (unsigned)(R[i] * K + C[i]) * 2u;
    }
};

typedef __bf16 bf16x2_v __attribute__((ext_vector_type(2)));
__device__ __forceinline__ unsigned cvt_pk_bf16(float lo, float hi) { const f32x2 v = {lo, hi}; const bf16x2_v b = __builtin_convertvector(v, bf16x2_v); return __builtin_bit_cast(unsigned, b); }
__device__ __forceinline__ float bf_lo(unsigned w) { return __uint_as_float(w << 16); }
__device__ __forceinline__ float bf_hi(unsigned w) { return __uint_as_float(w & 0xffff0000u); }
__device__ __forceinline__ float sigmoidf_(float x) { return __builtin_amdgcn_rcpf(1.0f + __builtin_amdgcn_exp2f(-1.4426950408889634f * x)); }

struct EpiF32 {
    static constexpr bool AFTER_DRAIN = false; static constexpr bool PERM = false;
    float* C; int ldc;
    __device__ __forceinline__ void operator()(const f32x4 (&acc)[2][2][4][2], const Unit& u, int wr, int wc, int fr, int fq) const {
        const int row0 = u.pm * BM + wr * 64 + fr, col0 = u.pn * BM + wc * 32 + 4 * fq;
#pragma unroll
        for (int ai = 0; ai < 2; ++ai)
#pragma unroll
            for (int m = 0; m < 4; ++m) { float* rowp = C + (size_t)(row0 + ai * HALF + m * 16) * ldc + col0;
#pragma unroll
                for (int bj = 0; bj < 2; ++bj)
#pragma unroll
                    for (int n = 0; n < 2; ++n) *(f32x4*)(rowp + bj * HALF + n * 16) = acc[ai][bj][m][n]; }
    }
};
struct EpiBf16 {
    static constexpr bool AFTER_DRAIN = false; static constexpr bool PERM = true;
    bf16_t* O; int ldc;
    __device__ __forceinline__ void operator()(const f32x4 (&acc)[2][2][4][2], const Unit& u, int wr, int wc, int fr, int fq) const {
        const int row0 = u.pm * BM + wr * 64 + fr, col0 = u.pn * BM + wc * 32 + 8 * fq;
#pragma unroll
        for (int ai = 0; ai < 2; ++ai)
#pragma unroll
            for (int m = 0; m < 4; ++m) { GAS bf16_t* rowp = (GAS bf16_t*)O + (size_t)(row0 + ai * HALF + m * 16) * ldc + col0;
#pragma unroll
                for (int bj = 0; bj < 2; ++bj) { const f32x4 v0 = acc[ai][bj][m][0], v1 = acc[ai][bj][m][1];
                    u32x4 w; w.x = cvt_pk_bf16(v0[0], v0[1]); w.y = cvt_pk_bf16(v0[2], v0[3]); w.z = cvt_pk_bf16(v1[0], v1[1]); w.w = cvt_pk_bf16(v1[2], v1[3]);
                    *(GAS u32x4*)(rowp + bj * HALF) = w; } }
    }
};
struct EpiLora {
    static constexpr bool AFTER_DRAIN = false; static constexpr bool PERM = false;
    float* base; size_t stride; const float* w0; const float* a0;
    __device__ __forceinline__ void operator()(const f32x4 (&acc)[2][2][4][2], const Unit& u, int wr, int wc, int fr, int fq) const {
        const int row0 = u.pm * BM + wr * 64 + fr; const int kind = u.pn >> 2; const int col0 = (u.pn & 3) * BM + wc * 32 + 4 * fq;
        float* dst = base + (size_t)kind * stride;
        const float* bp = (kind == 0) ? w0 : a0; const float bs = (kind == 2) ? 0.f : 1.f;
        f32x4 bv[2][2];
#pragma unroll
        for (int bj = 0; bj < 2; ++bj)
#pragma unroll
            for (int n = 0; n < 2; ++n) bv[bj][n] = *(const f32x4*)(bp + col0 + bj * HALF + n * 16) * bs;
#pragma unroll
        for (int ai = 0; ai < 2; ++ai)
#pragma unroll
            for (int m = 0; m < 4; ++m) { float* rowp = dst + (size_t)(row0 + ai * HALF + m * 16) * 1024 + col0;
#pragma unroll
                for (int bj = 0; bj < 2; ++bj)
#pragma unroll
                    for (int n = 0; n < 2; ++n) { f32x4 v = acc[ai][bj][m][n] + bv[bj][n];
                        if (kind == 0) {
#pragma unroll
                            for (int j = 0; j < 4; ++j) v[j] = __expf(-0.6065306597126334f * sigmoidf_(v[j])); }
                        else if (kind == 1) {
#pragma unroll
                            for (int j = 0; j < 4; ++j) v[j] = sigmoidf_(v[j]); }
                        *(f32x4*)(rowp + bj * HALF + n * 16) = v; } }
    }
};
struct EpiGlu {
    static constexpr bool AFTER_DRAIN = false; static constexpr bool PERM = true;
    const bf16_t* Y; bf16_t* O; int ldo; const float* bias;
    __device__ __forceinline__ void operator()(const f32x4 (&acc)[2][2][4][2], const Unit& u, int wr, int wc, int fr, int fq) const {
        const int row0 = u.pm * BM + wr * 64 + fr, col0 = u.pn * BM + wc * 32 + 8 * fq;
        f32x4 bv[2][2];
#pragma unroll
        for (int bj = 0; bj < 2; ++bj)
#pragma unroll
            for (int n = 0; n < 2; ++n) bv[bj][n] = *(const GAS f32x4*)((const GAS float*)bias + col0 + bj * HALF + 4 * n);
#pragma unroll
        for (int ai = 0; ai < 2; ++ai)
#pragma unroll
            for (int m = 0; m < 4; ++m) { const size_t r = (size_t)(row0 + ai * HALF + m * 16);
#pragma unroll
                for (int bj = 0; bj < 2; ++bj) { const u32x4 yv = *(const GAS u32x4*)((const GAS bf16_t*)Y + r * 1024 + col0 + bj * HALF);
                    const f32x4 v0 = acc[ai][bj][m][0] + bv[bj][0], v1 = acc[ai][bj][m][1] + bv[bj][1];
                    u32x4 w;
                    w.x = cvt_pk_bf16(bf_lo(yv.x) * sigmoidf_(v0[0]), bf_hi(yv.x) * sigmoidf_(v0[1]));
                    w.y = cvt_pk_bf16(bf_lo(yv.y) * sigmoidf_(v0[2]), bf_hi(yv.y) * sigmoidf_(v0[3]));
                    w.z = cvt_pk_bf16(bf_lo(yv.z) * sigmoidf_(v1[0]), bf_hi(yv.z) * sigmoidf_(v1[1]));
                    w.w = cvt_pk_bf16(bf_lo(yv.w) * sigmoidf_(v1[2]), bf_hi(yv.w) * sigmoidf_(v1[3]));
                    *(GAS u32x4*)((GAS bf16_t*)O + r * ldo + col0 + bj * HALF) = w; } }
    }
};
struct EpiSwiglu {
    static constexpr bool AFTER_DRAIN = false; static constexpr bool PERM = true;
    bf16_t* Hd;
    __device__ __forceinline__ void operator()(const f32x4 (&acc)[2][2][4][2], const Unit& u, int wr, int wc, int fr, int fq) const {
        const int row0 = u.pm * BM + wr * 64 + fr, col0 = u.pn * HALF + wc * 32 + 8 * fq;
#pragma unroll
        for (int ai = 0; ai < 2; ++ai)
#pragma unroll
            for (int m = 0; m < 4; ++m) { GAS bf16_t* rowp = (GAS bf16_t*)Hd + (size_t)(row0 + ai * HALF + m * 16) * 512 + col0;
                float o[8];
#pragma unroll
                for (int n = 0; n < 2; ++n)
#pragma unroll
                    for (int j = 0; j < 4; ++j) { const float a = acc[ai][0][m][n][j], b = acc[ai][1][m][n][j]; o[n * 4 + j] = a * sigmoidf_(a) * b; }
                u32x4 w; w.x = cvt_pk_bf16(o[0], o[1]); w.y = cvt_pk_bf16(o[2], o[3]); w.z = cvt_pk_bf16(o[4], o[5]); w.w = cvt_pk_bf16(o[6], o[7]);
                *(GAS u32x4*)rowp = w; }
    }
};

struct EpiS5Scan {
    static constexpr bool AFTER_DRAIN = true; static constexpr bool PERM = false;
    bf16_t* SIN; const float* lam_re; const float* lam_im; const float* log_dt;
    __device__ __forceinline__ void operator()(const f32x4 (&)[2][2][4][2], const Unit&, int, int, int, int) const {}
    __device__ __forceinline__ void fused(const f32x4 (&acc)[2][2][4][2], const Unit& u, int wr, int wc, int fr, int fq, PG8_LAS unsigned char* lds) const {
        PG8_LAS float* T = (PG8_LAS float*)lds;
#pragma unroll
        for (int ai = 0; ai < 2; ++ai)
#pragma unroll
            for (int m = 0; m < 4; ++m)
#pragma unroll
                for (int n = 0; n < 2; ++n) *(PG8_LAS f32x4*)(T + (ai * HALF + wr * 64 + m * 16 + fr) * 128 + wc * 32 + n * 16 + 4 * fq) = acc[ai][0][m][n];
        __syncthreads();
        const int tid = threadIdx.x;
        if (tid < 128) {
            const int b2 = tid >> 6, p = tid & 63, g = u.e;
            const float lr = fminf(lam_re[g * 64 + p], -1e-4f), li = lam_im[g * 64 + p], dt = __expf(log_dt[g]);
            const float mag = __expf(lr * dt * 16.f), ang = li * dt * 16.f; const float ar = mag * cosf(ang), ai_ = mag * sinf(ang);
            float sr = 0.f, si = 0.f;
            GAS bf16_t* dst = (GAS bf16_t*)SIN + ((size_t)(u.pm * 256 + b2 * 128) * 16 + (p >> 4)) * 4352 + g * 16 + (p & 15);
            const PG8_LAS float* src = T + (b2 * 128) * 128 + p;
#pragma unroll 8
            for (int ch = 0; ch < 128; ++ch) {
                const unsigned w = cvt_pk_bf16(sr, si);
                dst[(size_t)ch * 16 * 4352] = (bf16_t)(w & 0xffffu); dst[(size_t)ch * 16 * 4352 + 4 * 4352] = (bf16_t)(w >> 16);
                const float lr_ = src[ch * 128], li_ = src[ch * 128 + 64];
                const float nr = ar * sr - ai_ * si + lr_, ni = ar * si + ai_ * sr + li_; sr = nr; si = ni;
            }
        }
    }
};
__device__ __forceinline__ float gelu_tanh_(float y) { const float u = 0.7978845608028654f * (y + 0.044715f * y * y * y); const float e = __builtin_amdgcn_exp2f(2.8853900817779268f * u); return y * (1.f - __builtin_amdgcn_rcpf(e + 1.f)); }
struct EpiS5Y {
    static constexpr bool AFTER_DRAIN = false; static constexpr bool PERM = true;
    bf16_t* Y;
    __device__ __forceinline__ void operator()(const f32x4 (&acc)[2][2][4][2], const Unit& u, int wr, int wc, int fr, int fq) const {
        const int row0 = u.pm * BM + wr * 64 + fr;
#pragma unroll
        for (int ai = 0; ai < 2; ++ai)
#pragma unroll
            for (int m = 0; m < 4; ++m) { const size_t r = (size_t)(row0 + ai * HALF + m * 16);
#pragma unroll
                for (int bj = 0; bj < 2; ++bj) { const int col = bj * HALF + wc * 32 + 8 * fq; const int t = col >> 4, c = col & 15;
                    const f32x4 v0 = acc[ai][bj][m][0], v1 = acc[ai][bj][m][1];
                    u32x4 w; w.x = cvt_pk_bf16(gelu_tanh_(v0[0]), gelu_tanh_(v0[1])); w.y = cvt_pk_bf16(gelu_tanh_(v0[2]), gelu_tanh_(v0[3]));
                    w.z = cvt_pk_bf16(gelu_tanh_(v1[0]), gelu_tanh_(v1[1])); w.w = cvt_pk_bf16(gelu_tanh_(v1[2]), gelu_tanh_(v1[3]));
                    *(GAS u32x4*)((GAS bf16_t*)Y + (r * 16 + t) * 1024 + u.e * 16 + c) = w; } }
    }
};

template <class Epi, class Sched>
__device__ __forceinline__ void gemm_phase(PG8_LAS unsigned char* lds, const int K, const Sched& S, const Epi& E) {
    const int tid = threadIdx.x, wid = __builtin_amdgcn_readfirstlane(tid >> 6), lane = tid & 63, wr = wid >> 2, wc = wid & 3, fr = lane & 15, fq = lane >> 4;
    const int nt = K / BK;
    int RR[2], CC[2]; unsigned voffB[2];
#pragma unroll
    for (int i = 0; i < 2; ++i) { stage_rc(tid * 16 + i * 8192, RR[i], CC[i]); const int Rb = Epi::PERM ? ((RR[i] & ~31) + perm32(RR[i] & 31)) : RR[i];
        voffB[i] = (unsigned)(Rb * K + CC[i]) * 2u; }
    const size_t kstep = (size_t)(BK * 2);
    const size_t hstep = (size_t)HALF * K * 2;
    const unsigned ldsw = (unsigned)wid * 1024u;
    const int aoff = lds_byte(wr * 64 + fr, fq * 8), boff = lds_byte(wc * 32 + fr, fq * 8);
#define PG8_SA(b, h) (((b) * 2 + (h)) * HTB)
#define PG8_SB(b, h) ((4 + (b) * 2 + (h)) * HTB)
#define PG8_STAGE(bufoff, gbase, voff) do { _Pragma("unroll") for (int _i = 0; _i < 2; ++_i) \
        __builtin_amdgcn_global_load_lds((const unsigned*)((const char*)(gbase) + (voff)[_i]), (PG8_LAS unsigned*)(lds + (bufoff) + ldsw + _i * 8192), 16, 0, 0); } while (0)
#define PG8_LDA(dst, b, h) do { _Pragma("unroll") for (int m = 0; m < 4; ++m) _Pragma("unroll") for (int k = 0; k < 2; ++k) dst[m][k] = *(const PG8_LAS bf16x8*)(lds + PG8_SA(b, h) + aoff + m * 2048 + k * 1024); } while (0)
#define PG8_LDB(dst, b, h) do { _Pragma("unroll") for (int n = 0; n < 2; ++n) _Pragma("unroll") for (int k = 0; k < 2; ++k) dst[n][k] = *(const PG8_LAS bf16x8*)(lds + PG8_SB(b, h) + boff + n * 2048 + k * 1024); } while (0)
#define PG8_MMA(ai, bj, At, Bt) do { __builtin_amdgcn_s_setprio(1); _Pragma("unroll") for (int m = 0; m < 4; ++m) _Pragma("unroll") for (int n = 0; n < 2; ++n) _Pragma("unroll") for (int k = 0; k < 2; ++k) \
        acc[ai][bj][m][n] = __builtin_amdgcn_mfma_f32_16x16x32_bf16(Bt[n][k], At[m][k], acc[ai][bj][m][n], 0, 0, 0); __builtin_amdgcn_s_setprio(0); } while (0)
#define PG8_WAIT_V(n) asm volatile("s_waitcnt vmcnt(" #n ")" ::: "memory")
#define PG8_WAIT_L(n) asm volatile("s_waitcnt lgkmcnt(" #n ")" ::: "memory")
#define PG8_BAR __builtin_amdgcn_s_barrier()
#define PG8_SCHED __builtin_amdgcn_sched_barrier(0)
    Unit cur, nxt; int ui = 0;
    if (!S.next(0, cur)) return;
    f32x4 acc[2][2][4][2];
#pragma unroll
    for (int a = 0; a < 2; ++a)
#pragma unroll
        for (int b = 0; b < 2; ++b)
#pragma unroll
            for (int m = 0; m < 4; ++m)
#pragma unroll
                for (int n = 0; n < 2; ++n) acc[a][b][m][n] = (f32x4){0.f, 0.f, 0.f, 0.f};
    bf16x8 At[4][2], B0[2][2], B1[2][2];
    constexpr bool GA = Sched::GATHER;
    constexpr int A2 = Sched::A2;
    constexpr int NV = GA ? 2 : 1;
    unsigned vA[NV][2], vN[NV][2];
    const size_t kstepA = S.kstepA(), hstepA = GA ? 0 : S.hstepA();
    const size_t a2off = (A2 > 0) ? S.a2off() : 0;
    S.template a_voff<NV>(cur, vA, RR, CC);
    const char* cA = cur.Ab; const char* cB = cur.Bb;
    PG8_STAGE(PG8_SB(0, 0), cB, voffB); PG8_STAGE(PG8_SB(0, 1), cB + hstep, voffB); PG8_STAGE(PG8_SA(0, 0), cA, vA[0]); PG8_STAGE(PG8_SA(0, 1), cA + hstepA, vA[NV - 1]);
    if (wr == 1) PG8_BAR;
    PG8_WAIT_V(2); PG8_BAR;
    PG8_STAGE(PG8_SB(1, 0), cB + kstep, voffB); PG8_STAGE(PG8_SA(1, 0), cA + kstepA, vA[0]); PG8_STAGE(PG8_SB(1, 1), cB + hstep + kstep, voffB);
    PG8_WAIT_V(6); PG8_BAR;
    for (;;) {
        const bool has_next = S.next(ui + 1, nxt);
        const char* nA = has_next ? nxt.Ab : cA; const char* nB = has_next ? nxt.Bb : cB;
        if constexpr (GA) {
            if (has_next) S.template a_voff<NV>(nxt, vN, RR, CC);
            else {
#pragma unroll
                for (int h = 0; h < NV; ++h)
#pragma unroll
                    for (int i = 0; i < 2; ++i) vN[h][i] = vA[h][i]; }
        }
#pragma clang loop unroll(disable)
        for (int t = 0; t < nt; t += 2) {
            const bool last = (t == nt - 2);
            const bool s1 = (A2 > 0) && (t + 1 >= A2), s2 = (A2 > 0) && !last && (t + 2 >= A2);
            const char* a1 = cA + (size_t)(t + 1) * kstepA + (s1 ? a2off : 0);
            const char* a2 = last ? nA : cA + (size_t)(t + 2) * kstepA + (s2 ? a2off : 0);
            const char* a3 = a2 + kstepA;
            const char* b2 = last ? nB : cB + (size_t)(t + 2) * kstep; const char* b3 = b2 + kstep;
            unsigned v2[NV][2];
#pragma unroll
            for (int h = 0; h < NV; ++h)
#pragma unroll
                for (int i = 0; i < 2; ++i) v2[h][i] = (GA && last) ? vN[h][i] : vA[h][i];
            PG8_LDB(B0, 0, 0); PG8_LDB(B1, 0, 1); PG8_SCHED; PG8_LDA(At, 0, 0); PG8_STAGE(PG8_SA(1, 1), a1 + hstepA, vA[NV - 1]);
            PG8_WAIT_V(8); PG8_WAIT_L(0); PG8_BAR; PG8_MMA(0, 0, At, B0); PG8_MMA(0, 1, At, B1); PG8_BAR; PG8_SCHED;
            PG8_LDA(At, 0, 1); PG8_STAGE(PG8_SB(0, 0), b2, voffB); PG8_STAGE(PG8_SB(0, 1), b2 + hstep, voffB); PG8_STAGE(PG8_SA(0, 0), a2, v2[0]);
            PG8_WAIT_V(8); PG8_WAIT_L(0); PG8_BAR; PG8_MMA(1, 0, At, B0); PG8_MMA(1, 1, At, B1); PG8_BAR; PG8_SCHED;
            PG8_LDB(B0, 1, 0); PG8_LDB(B1, 1, 1); PG8_SCHED; PG8_LDA(At, 1, 0); PG8_STAGE(PG8_SA(0, 1), a2 + hstepA, v2[NV - 1]);
            PG8_WAIT_V(8); PG8_WAIT_L(0); PG8_BAR; PG8_MMA(0, 0, At, B0); PG8_MMA(0, 1, At, B1); PG8_BAR; PG8_SCHED;
            PG8_LDA(At, 1, 1); PG8_STAGE(PG8_SB(1, 0), b3, voffB); PG8_STAGE(PG8_SB(1, 1), b3 + hstep, voffB); PG8_STAGE(PG8_SA(1, 0), a3, v2[0]);
            PG8_WAIT_V(8); PG8_WAIT_L(0); PG8_BAR; PG8_MMA(1, 0, At, B0); PG8_MMA(1, 1, At, B1); PG8_BAR; PG8_SCHED;
        }
        if (wr == 0) PG8_BAR;
        if constexpr (!Epi::AFTER_DRAIN) E(acc, cur, wr, wc, fr, fq);
        if (!has_next) break;
#pragma unroll
        for (int a = 0; a < 2; ++a)
#pragma unroll
            for (int b = 0; b < 2; ++b)
#pragma unroll
                for (int m = 0; m < 4; ++m)
#pragma unroll
                    for (int n = 0; n < 2; ++n) acc[a][b][m][n] = (f32x4){0.f, 0.f, 0.f, 0.f};
        cur = nxt; cA = nA; cB = nB; ++ui;
        if constexpr (GA) {
#pragma unroll
            for (int h = 0; h < NV; ++h)
#pragma unroll
                for (int i = 0; i < 2; ++i) vA[h][i] = vN[h][i]; }
        if (wr == 1) PG8_BAR;
    }
    PG8_WAIT_V(0);
    PG8_BAR;
    if constexpr (Epi::AFTER_DRAIN) E.fused(acc, cur, wr, wc, fr, fq, lds);
#undef PG8_SA
#undef PG8_SB
#undef PG8_STAGE
#undef PG8_LDA
#undef PG8_LDB
#undef PG8_MMA
#undef PG8_WAIT_V
#undef PG8_WAIT_L
#undef PG8_BAR
#undef PG8_SCHED
}
}
using pg8::f32x4; using pg8::f32x2; using pg8::u32x4; using pg8::u32x2; using pg8::cvt_pk_bf16; using pg8::bf_lo; using pg8::bf_hi; using pg8::sigmoidf_;

constexpr int NWAVES = 8, NTHR = 512;
constexpr int DM = 2048, NB = 8, SEQ = 2048, NT = NB * SEQ;
constexpr int DSSM = 1024, NG = 64, GC = 16, NP = 64;
constexpr int DRW = 1024, NH = 16, HD = 64;
constexpr int DIN = 4352, ZW = 3328;
constexpr int NEXP = 64, DEXP = 512, NMOD = 6 * DM;
constexpr float RMS_EPS = 1e-6f, GN_EPS = 64e-5f;
constexpr int CAP_ROWS = 49152;

constexpr size_t MiB = 1u << 20;
constexpr size_t WS_CTL = 0, CTL_ZERO_BYTES = 1 * MiB;
constexpr size_t WS_MOD = 1 * MiB;
constexpr size_t WS_RWT = 1 * MiB + 512 * 1024;
constexpr size_t WS_LORA_T = 2 * MiB + 512 * 1024;
constexpr size_t WS_GLU_T = 4 * MiB;
constexpr size_t WS_WOUT_T = 6 * MiB;
constexpr size_t WS_WIN_T = 14 * MiB;
constexpr size_t WS_TOKINFO = 31 * MiB;
constexpr size_t WS_LIST = 32 * MiB;
constexpr size_t WS_LIN = 36 * MiB;
constexpr size_t WS_H = 44 * MiB;
constexpr size_t WS_PROJ = 108 * MiB;
constexpr size_t WS_MIX = 244 * MiB;
constexpr size_t WS_EW1 = 308 * MiB;
constexpr size_t WS_EW2 = 564 * MiB;
constexpr size_t WS_SIN = 692 * MiB;
constexpr size_t WS_YSG = 828 * MiB;
constexpr size_t WS_S5MT = 860 * MiB;
constexpr size_t WS_S5WT = 872 * MiB;
constexpr size_t WS_VB = 692 * MiB;
constexpr size_t WS_GB = 724 * MiB;
constexpr size_t WS_GHQ = 756 * MiB;
constexpr size_t WS_GT = 948 * MiB;
constexpr size_t WS_BON = 950 * MiB;
constexpr size_t WS_Y = 952 * MiB;
constexpr size_t WS_X1 = 692 * MiB;
constexpr size_t WS_HID = 756 * MiB;
constexpr size_t WS_END = 984 * MiB;
constexpr size_t WS_MIXED = 108 * MiB;
constexpr size_t WS_YSLOT = 108 * MiB;
static_assert(WS_YSLOT + (size_t)CAP_ROWS * 2048 * 2 <= WS_EW1, "yslot overlay");
static_assert(WS_HID + (size_t)CAP_ROWS * 512 * 2 <= WS_END && WS_GHQ + (size_t)8192 * 12288 * 2 <= WS_GT && WS_SIN + (size_t)NT * DIN * 2 <= WS_YSG, "pool");
constexpr int CW_TMO = 0;
constexpr int CW_BAR = 4096;
constexpr int CW_CNT = 16384;
constexpr int CW_GDONE = 8192, CW_STOP = 8192 + 64, CW_PROG = 8192 + 128;
constexpr int CONV_ITEMS = NEXP * 1536;
constexpr int CONV_POOL = 32768, CONV_MAIN = CONV_ITEMS - CONV_POOL, CONV_CLAIM = 12;
constexpr int CW_POOL = 12288;


constexpr int RING_BYTES = 131072;
constexpr int LDSCTL_OFF = 147456 - 2048;
constexpr int MISC_OFF = LDSCTL_OFF;
constexpr int TP_OFF = LDSCTL_OFF + 256;
constexpr int LDS_BYTES = 147456;

#define LAS __attribute__((address_space(3)))
typedef unsigned short bf16;
typedef GAS unsigned gu32;
#define RLX_AGENT __ATOMIC_RELAXED, __HIP_MEMORY_SCOPE_AGENT

#define XB_TMO      128
#define XB_XCNT(j)  (256  + 64 * (j))
#define XB_XSUB(j)  (1280 + 64 * (j))
#define XB_XGEN(j)  (2304 + 64 * (j))
#define XB_TOP      3328
#define XB_TOPGEN   3392
#define XCD_BAR_WORDS 3456
#define XB_SPIN_CAP (1u << 18)
__device__ __forceinline__ unsigned xb_ld(unsigned* p)              { return __hip_atomic_load(p, __ATOMIC_RELAXED, __HIP_MEMORY_SCOPE_AGENT); }
__device__ __forceinline__ unsigned xb_add(unsigned* p, unsigned v) { return __hip_atomic_fetch_add(p, v, __ATOMIC_RELAXED, __HIP_MEMORY_SCOPE_AGENT); }
__device__ __forceinline__ unsigned xb_xcc_id() { return (unsigned)__builtin_amdgcn_s_getreg((3 << 11) | 20) & 0xFu; }
#define XB_SPIN(cond, bar) do { unsigned _sp = 0; while (cond) { __builtin_amdgcn_s_sleep(1); \
    if ((++_sp & 255u) == 0u) { if (xb_ld(&(bar)[XB_TMO])) break; if (_sp > XB_SPIN_CAP) { atomicAdd(&(bar)[XB_TMO], 1u); break; } } } } while (0)
struct XcdBarrier { unsigned* bar; unsigned x; volatile LAS unsigned* st; };
__device__ __forceinline__ XcdBarrier xcd_barrier_post(unsigned* bar, volatile LAS unsigned* st) {
    XcdBarrier b; b.bar = bar; b.x = xb_xcc_id(); b.st = st;
    if (threadIdx.x == 0) (void)xb_add(&bar[XB_XCNT(b.x)], 1u);
    return b;
}
__device__ __forceinline__ void xcd_barrier_complete(unsigned* bar, unsigned x, unsigned& nloc, unsigned& nx) {
    const unsigned G = gridDim.x * gridDim.y * gridDim.z;
    unsigned sum, cnt, mine, sp = 0u;
    for (;;) {
        sum = 0u; cnt = 0u; mine = 0u;
#pragma unroll
        for (unsigned j = 0; j < 16; ++j) { const unsigned c = xb_ld(&bar[XB_XCNT(j)]); sum += c; cnt += (c > 0u) ? 1u : 0u; mine = (j == x) ? c : mine; }
        if (sum == G) break;
        __builtin_amdgcn_s_sleep(1);
        if ((++sp & 255u) == 0u) { if (xb_ld(&bar[XB_TMO])) break; if (sp > XB_SPIN_CAP) { atomicAdd(&bar[XB_TMO], 1u); break; } }
    }
    nloc = mine > 0u ? mine : 1u; nx = cnt > 0u ? cnt : 1u;
}
__device__ __forceinline__ void xcd_barrier(const XcdBarrier& b) {
    asm volatile("s_waitcnt vmcnt(0)" ::: "memory");
    __syncthreads();
    if (threadIdx.x == 0) {
        unsigned* bar = b.bar;
        __builtin_amdgcn_s_waitcnt(0);
        unsigned nloc = b.st[0], nx = b.st[1];
        if (nloc == 0u) { xcd_barrier_complete(bar, b.x, nloc, nx); b.st[0] = nloc; b.st[1] = nx; }
        const unsigned old = xb_add(&bar[XB_XSUB(b.x)], 1u);
        const unsigned gen = old / nloc;
        if (old + 1u == (gen + 1u) * nloc) {
            __builtin_amdgcn_fence(__ATOMIC_RELEASE, "agent");
            asm volatile("s_waitcnt vmcnt(0)" ::: "memory");
            const unsigned og = xb_add(&bar[XB_TOP], 1u);
            const unsigned tg = og / nx;
            if (og + 1u == (tg + 1u) * nx) xb_add(&bar[XB_TOPGEN], 1u);
            else XB_SPIN(xb_ld(&bar[XB_TOPGEN]) == tg, bar);
            __builtin_amdgcn_fence(__ATOMIC_ACQUIRE, "agent");
            xb_add(&bar[XB_XGEN(b.x)], 1u);
            asm volatile("s_waitcnt vmcnt(0)" ::: "memory");
        } else {
            XB_SPIN(xb_ld(&bar[XB_XGEN(b.x)]) == gen, bar);
            __builtin_amdgcn_fence(__ATOMIC_ACQUIRE, "agent");
            asm volatile("s_waitcnt vmcnt(0)" ::: "memory");
        }
    }
    __syncthreads();
}

struct Args { const float* in[38]; float* out; unsigned char* ws; int ph_lo, ph_hi; };
typedef const float* cfp_t;
typedef __attribute__((address_space(4))) const unsigned char* kargp_t;
struct InTab { kargp_t kp;
    __device__ __forceinline__ const float* operator[](int i) const { return *(const __attribute__((address_space(4))) cfp_t*)(kp + 8 * i); } };
struct Frame {
    LAS unsigned char* lds; volatile LAS unsigned* MISC; unsigned* ctl;
    int tid, lane, wave, vcu, G;
    InTab in; float* out; unsigned char* ws;
};
#define LDS_WAIT() asm volatile("s_waitcnt lgkmcnt(0)" ::: "memory")
#define LAUNDER(p) asm volatile("" : "+s"(p))
#define LDS_BARRIER() do { asm volatile("s_waitcnt lgkmcnt(0)" ::: "memory"); __builtin_amdgcn_s_barrier(); asm volatile("" ::: "memory"); } while (0)
#define PHASE_VIEW() Frame F = F0; LAUNDER(F.ws); LAUNDER(F.in.kp); LAUNDER(F.ctl)
__device__ __forceinline__ float wave_sum(float v) {
#pragma unroll
    for (int o = 1; o < 64; o <<= 1) v += __shfl_xor(v, o);
    return v;
}
__device__ __forceinline__ float wave_max(float v) {
#pragma unroll
    for (int o = 1; o < 64; o <<= 1) v = fmaxf(v, __shfl_xor(v, o));
    return v;
}
__device__ __forceinline__ float row16_sum(float x) {
    x += __builtin_bit_cast(float, __builtin_amdgcn_update_dpp(0, __builtin_bit_cast(int, x), 0xB1, 0xf, 0xf, false));
    x += __builtin_bit_cast(float, __builtin_amdgcn_update_dpp(0, __builtin_bit_cast(int, x), 0x4E, 0xf, 0xf, false));
    x += __builtin_bit_cast(float, __builtin_amdgcn_update_dpp(0, __builtin_bit_cast(int, x), 0x141, 0xf, 0xf, false));
    x += __builtin_bit_cast(float, __builtin_amdgcn_update_dpp(0, __builtin_bit_cast(int, x), 0x140, 0xf, 0xf, false));
    return x;
}
__device__ __forceinline__ unsigned pk2(float lo, float hi) { return cvt_pk_bf16(lo, hi); }
__device__ __forceinline__ float bf2f(bf16 b) { return __uint_as_float(((unsigned)b) << 16); }
__device__ __forceinline__ float gelu_tanh(float y) { const float u = 0.7978845608028654f * (y + 0.044715f * y * y * y); const float e = __expf(2.f * u); const float th = 1.f - 2.f / (e + 1.f); return 0.5f * y * (1.f + th); }

__device__ __forceinline__ void transpose_item(const float* W, int N, bf16* WT, int ldk, int dst_row0, int k0, int n0, int kdst0, LAS float* scr, int lane) {
    float tv[32];
#pragma unroll
    for (int i = 0; i < 32; ++i) tv[i] = W[(size_t)(k0 + 2 * i + (lane >> 5)) * N + n0 + (lane & 31)];
#pragma unroll
    for (int i = 0; i < 32; ++i) scr[(2 * i + (lane >> 5)) * 33 + (lane & 31)] = tv[i];
    LDS_WAIT(); asm volatile("" ::: "memory");
    const int c = lane & 7;
#pragma unroll
    for (int j = 0; j < 4; ++j) { const int n = (lane >> 3) + 8 * j; const LAS float* s = scr + (8 * c) * 33 + n;
        u32x4 o; o.x = pk2(s[0 * 33], s[1 * 33]); o.y = pk2(s[2 * 33], s[3 * 33]); o.z = pk2(s[4 * 33], s[5 * 33]); o.w = pk2(s[6 * 33], s[7 * 33]);
        *(u32x4*)(WT + (size_t)(dst_row0 + n) * ldk + kdst0 + 8 * c) = o; }
    LDS_WAIT(); asm volatile("" ::: "memory");
}

constexpr int PROJ_PITCH = DIN * 2;
template <int PASS> struct S5Order {
    static constexpr bool GATHER = false; static constexpr int A2 = PASS == 2 ? 4 : 0;
    static constexpr int KB = PASS == 2 ? 384 : 256;
    const char* U; const char* SIN; const char* BT; int G, c;
    __device__ __forceinline__ size_t kstepA() const { return (size_t)4 * PROJ_PITCH; }
    __device__ __forceinline__ size_t hstepA() const { return (size_t)128 * 16 * PROJ_PITCH; }
    __device__ __forceinline__ size_t a2off() const { return (size_t)(SIN - U) - (size_t)A2 * kstepA(); }
    __device__ bool next(int i, pg8::Unit& u) const {
        const int L = i * G + c; if (L >= NG * 4) return false;
        const int g = L >> 2, pm = L & 3; u.e = g; u.pm = pm; u.pn = 0; u.cnt = 256;
        u.Ab = U + (size_t)g * 32 + (size_t)pm * 256 * 16 * PROJ_PITCH; u.Bb = BT + (size_t)g * 256 * KB * 2;
        return true;
    }
    template <int NV> __device__ __forceinline__ void a_voff(const pg8::Unit&, unsigned (&v)[NV][2], const int (&R)[2], const int (&C)[2]) const {
#pragma unroll
        for (int i = 0; i < 2; ++i) v[0][i] = (unsigned)(R[i] * 16 * PROJ_PITCH + (C[i] >> 4) * PROJ_PITCH + (C[i] & 15) * 2);
    }
};
__device__ __forceinline__ void s5_build(const Frame& F, int g) {
    const float* lam_re = F.in[10]; const float* lam_im = F.in[11]; const float* log_dt = F.in[12];
    const float* b_re = F.in[13]; const float* b_im = F.in[14]; const float* c_re = F.in[15]; const float* c_im = F.in[16]; const float* dsk = F.in[17];
    constexpr int PC = 68;
    LAS float* pw2 = (LAS float*)F.lds;
    LAS float* bbr = pw2 + 17 * 64 * 2; LAS float* bbi = bbr + 1024;
    LAS float* cre = bbi + 1024; LAS float* cim = cre + 16 * PC; LAS float* dsl = cim + 16 * PC; LAS float* Kt = dsl + 16;
    bf16* MT = (bf16*)(F.ws + WS_S5MT) + (size_t)g * 256 * 384; bf16* WT = (bf16*)(F.ws + WS_S5WT) + (size_t)g * 256 * 256;
    const float dt = __expf(log_dt[g]);
    __syncthreads();
    for (int i = F.tid; i < 17 * 64; i += NTHR) { const int tau = i >> 6, p = i & 63; const float lr = fminf(lam_re[g * NP + p], -1e-4f), li = lam_im[g * NP + p];
        const float mag = __expf(lr * dt * (float)tau), ang = li * dt * (float)tau; pw2[2 * i] = mag * cosf(ang); pw2[2 * i + 1] = mag * sinf(ang); }
    for (int i = F.tid; i < 1024; i += NTHR) { const int p = i >> 4; const float lr = fminf(lam_re[g * NP + p], -1e-4f), li = lam_im[g * NP + p];
        const float mag = __expf(lr * dt), ang = li * dt; const float ar = mag * cosf(ang), ai = mag * sinf(ang), den = lr * lr + li * li;
        const float qr = ((ar - 1.f) * lr + ai * li) / den, qi = (ai * lr - (ar - 1.f) * li) / den;
        const float br = b_re[(size_t)g * 1024 + i], bi = b_im[(size_t)g * 1024 + i]; bbr[i] = qr * br - qi * bi; bbi[i] = qr * bi + qi * br;
        cre[(i >> 6) * PC + (i & 63)] = c_re[(size_t)g * 1024 + i]; cim[(i >> 6) * PC + (i & 63)] = c_im[(size_t)g * 1024 + i]; }
    if (F.tid < 16) dsl[F.tid] = dsk[g * GC + F.tid];
    __syncthreads();
    { const int half = F.tid >> 8, c = (F.tid >> 4) & 15, c2 = F.tid & 15; float acc[8] = {0.f, 0.f, 0.f, 0.f, 0.f, 0.f, 0.f, 0.f};
      for (int p0 = 0; p0 < 64; p0 += 4) { const f32x4 cr4 = *(const LAS f32x4*)(cre + c * PC + p0), ci4 = *(const LAS f32x4*)(cim + c * PC + p0);
#pragma unroll
          for (int u = 0; u < 4; ++u) { const int p = p0 + u; const float br = bbr[p * 16 + c2], bi = bbi[p * 16 + c2];
              const float cbr = cr4[u] * br - ci4[u] * bi, cbi = cr4[u] * bi + ci4[u] * br;
#pragma unroll
              for (int k = 0; k < 8; ++k) { const f32x2 w = *(const LAS f32x2*)(pw2 + ((half * 8 + k) * 64 + p) * 2); acc[k] += w[0] * cbr - w[1] * cbi; } } }
#pragma unroll
      for (int k = 0; k < 8; ++k) Kt[(half * 8 + k) * 256 + c * 16 + c2] = acc[k]; }
    __syncthreads();
    for (int idx = F.tid; idx < 256 * 32; idx += NTHR) { const int oct = idx & 31, row = idx >> 5, t = row >> 4, c = row & 15, j = oct >> 1, c20 = (oct & 1) * 8;
        f32x4 x0 = (f32x4){0.f, 0.f, 0.f, 0.f}, x1 = x0;
        if (j <= t) { x0 = *(const LAS f32x4*)(Kt + (t - j) * 256 + c * 16 + c20); x1 = *(const LAS f32x4*)(Kt + (t - j) * 256 + c * 16 + c20 + 4); }
        if (j == t && (c >> 3) == (oct & 1)) { const float d = dsl[c];
#pragma unroll
            for (int q = 0; q < 4; ++q) { x0[q] += (q == (c & 7)) ? d : 0.f; x1[q] += (q + 4 == (c & 7)) ? d : 0.f; } }
        u32x4 o; o.x = pk2(x0[0], x0[1]); o.y = pk2(x0[2], x0[3]); o.z = pk2(x1[0], x1[1]); o.w = pk2(x1[2], x1[3]);
        *(u32x4*)(MT + (size_t)row * 384 + oct * 8) = o; }
    for (int idx = F.tid; idx < 256 * 16; idx += NTHR) { const int oct = idx & 15, row = idx >> 4, t = row >> 4, c = row & 15, p0 = (oct & 7) * 8; float v[8];
#pragma unroll
        for (int h = 0; h < 2; ++h) { const f32x4 cr = *(const LAS f32x4*)(cre + c * PC + p0 + 4 * h), ci = *(const LAS f32x4*)(cim + c * PC + p0 + 4 * h);
            const f32x4 wa = *(const LAS f32x4*)(pw2 + ((t + 1) * 64 + p0 + 4 * h) * 2), wb = *(const LAS f32x4*)(pw2 + ((t + 1) * 64 + p0 + 4 * h) * 2 + 4);
            const float pr[4] = {wa[0], wa[2], wb[0], wb[2]}, pi[4] = {wa[1], wa[3], wb[1], wb[3]};
#pragma unroll
            for (int q = 0; q < 4; ++q) v[4 * h + q] = (oct < 8) ? (cr[q] * pr[q] - ci[q] * pi[q]) : -(cr[q] * pi[q] + ci[q] * pr[q]); }
        u32x4 o; o.x = pk2(v[0], v[1]); o.y = pk2(v[2], v[3]); o.z = pk2(v[4], v[5]); o.w = pk2(v[6], v[7]);
        *(u32x4*)(MT + (size_t)row * 384 + 256 + oct * 8) = o; }
    for (int idx = F.tid; idx < 128 * 32; idx += NTHR) { const int oct = idx & 31, row = idx >> 5, part = row >> 6, p = row & 63, j = oct >> 1, c20 = (oct & 1) * 8;
        const f32x2 w = *(const LAS f32x2*)(pw2 + ((15 - j) * 64 + p) * 2); float v[8];
#pragma unroll
        for (int h = 0; h < 2; ++h) { const f32x4 br = *(const LAS f32x4*)(bbr + p * 16 + c20 + 4 * h), bi = *(const LAS f32x4*)(bbi + p * 16 + c20 + 4 * h);
#pragma unroll
            for (int q = 0; q < 4; ++q) v[4 * h + q] = part == 0 ? (w[0] * br[q] - w[1] * bi[q]) : (w[0] * bi[q] + w[1] * br[q]); }
        u32x4 o; o.x = pk2(v[0], v[1]); o.y = pk2(v[2], v[3]); o.z = pk2(v[4], v[5]); o.w = pk2(v[6], v[7]);
        *(u32x4*)(WT + (size_t)row * 256 + oct * 8) = o; }
    __syncthreads();
}

template <int NU> __device__ __forceinline__ void mod_batch(const GAS float* wp, const LAS float* sp0, f32x4 (&acc)[8]) {
    f32x4 w[NU];
#pragma unroll
    for (int u = 0; u < NU; ++u) w[u] = *(const GAS f32x4*)(wp + (size_t)(4 * u) * NMOD);
#pragma unroll
    for (int u = 0; u < NU; ++u) { const LAS f32x4* sp = (const LAS f32x4*)(sp0 + 4 * u * 8); const f32x4 s0 = sp[0], s1 = sp[1];
#pragma unroll
        for (int b = 0; b < 4; ++b) { acc[b] += w[u] * s0[b]; acc[4 + b] += w[u] * s1[b]; } }
}
__device__ __forceinline__ void p0_prologue(const Frame& F0) {
    PHASE_VIEW();
    const float* c = F.in[1]; const float* ada_w = F.in[2]; const float* ada_b = F.in[3];
    float* mod = (float*)(F.ws + WS_MOD);
    LAS float* scT = (LAS float*)F.lds;
    LAS float* red = (LAS float*)(F.lds + 65536);
    for (int i = F.tid; i < NB * DM; i += NTHR) { const float v = c[i]; scT[(i & (DM - 1)) * 8 + (i >> 11)] = v / (1.f + __expf(-v)); }
    __syncthreads();
    for (int item = F.vcu; item < NMOD / 64; item += F.G) {
        const int rs = F.lane >> 4, c4 = F.lane & 15, ks = F.wave;
        const GAS float* wp = (const GAS float*)ada_w + (size_t)(ks * 256 + rs) * NMOD + item * 64 + 4 * c4;
        f32x4 acc[8];
#pragma unroll
        for (int b = 0; b < 8; ++b) acc[b] = (f32x4){0.f, 0.f, 0.f, 0.f};
#pragma unroll 1
        for (int q = 0; q < 60; q += 12) mod_batch<12>(wp + (size_t)(4 * q) * NMOD, scT + (ks * 256 + 4 * q + rs) * 8, acc);
        mod_batch<4>(wp + (size_t)240 * NMOD, scT + (ks * 256 + 240 + rs) * 8, acc);
#pragma unroll
        for (int b = 0; b < 8; ++b) *(LAS f32x4*)(red + ((F.wave * 4 + rs) * 8 + b) * 64 + 4 * c4) = acc[b];
        __syncthreads();
        { const int b = F.wave; float s = 0.f;
#pragma unroll
          for (int q = 0; q < 32; ++q) s += red[(q * 8 + b) * 64 + F.lane];
          mod[b * NMOD + item * 64 + F.lane] = s + ada_b[item * 64 + F.lane]; }
        __syncthreads();
    }
    __syncthreads();
    for (int g = F.G - 1 - F.vcu; g < NG; g += F.G) s5_build(F, g);
    LAS float* scr = (LAS float*)(F.lds + F.wave * 16384);
    const int gw = F.vcu * NWAVES + F.wave, NGW = F.G * NWAVES;
    bf16* WinT = (bf16*)(F.ws + WS_WIN_T); bf16* WoutT = (bf16*)(F.ws + WS_WOUT_T); bf16* GluT = (bf16*)(F.ws + WS_GLU_T); bf16* LoraT = (bf16*)(F.ws + WS_LORA_T);
    constexpr int I_IN = (DM / 64) * (DIN / 32), I_OUT = (DM / 64) * (DM / 32), I_GLU = (DSSM / 64) * (DSSM / 32), I_W = 32, I_A = 32, I_G = 64;
    constexpr int NITEMS = I_IN + I_OUT + I_GLU + I_W + I_A + I_G;
    for (int it = gw; it < NITEMS; it += NGW) {
        int r = it;
        if (r < I_IN) { const int nb = DIN / 32, kb = r / nb, n0 = (r % nb) * 32; transpose_item(F.in[8], DIN, WinT, DM, n0, kb * 64, n0, kb * 64, scr, F.lane); continue; } r -= I_IN;
        if (r < I_OUT) { const int nb = DM / 32, kb = r / nb, n0 = (r % nb) * 32; transpose_item(F.in[9], DM, WoutT, DM, n0, kb * 64, n0, kb * 64, scr, F.lane); continue; } r -= I_OUT;
        if (r < I_GLU) { const int nb = DSSM / 32, kb = r / nb, n0 = (r % nb) * 32; transpose_item(F.in[18], DSSM, GluT, DSSM, n0, kb * 64, n0, kb * 64, scr, F.lane); continue; } r -= I_GLU;
        if (r < I_W) { transpose_item(F.in[22], DRW, LoraT, 256, r * 32, 0, r * 32, 0, scr, F.lane); continue; } r -= I_W;
        if (r < I_A) { transpose_item(F.in[24], DRW, LoraT, 256, 1024 + r * 32, 0, r * 32, 64, scr, F.lane); continue; } r -= I_A;
        { const int kb = r / 32, n0 = (r % 32) * 32; transpose_item(F.in[25], DRW, LoraT, 256, 2048 + n0, kb * 64, n0, 128 + kb * 64, scr, F.lane); }
    }
    for (int p = blockIdx.x * NTHR + F.tid; p < 3072 * 32; p += F.G * NTHR) { const int row = p >> 5, c8 = (p & 31) * 8; const int kind = row >> 10;
        const bool data = kind == 0 ? (c8 < 64) : (kind == 1 ? (c8 >= 64 && c8 < 128) : (c8 >= 128));
        if (!data) *(u32x4*)(LoraT + (size_t)row * 256 + c8) = (u32x4){0u, 0u, 0u, 0u}; }
    bf16* rwt = (bf16*)(F.ws + WS_RWT);
    for (int p = blockIdx.x * NTHR + F.tid; p < 64 * 5 * 64 * 8; p += F.G * NTHR) { const int e = p & 7, ln = (p >> 3) & 63, jt = (p >> 9) % 5, ks = (p >> 9) / 5;
        const int j = 16 * jt + (ln & 15), k = 32 * ks + 8 * (ln >> 4) + e;
        const float w = j < 8 ? F.in[31][k * 8 + j] : (j < 72 ? F.in[33][k * 64 + (j - 8)] : 0.f);
        const unsigned hi = pk2(w, 0.f) & 0xffffu; const float wl = w - __uint_as_float(hi << 16);
        const size_t o = ((size_t)((ks * 5 + jt) * 2) * 64 + ln) * 8 + e;
        rwt[o] = (bf16)hi; rwt[o + 512] = (bf16)(pk2(wl, 0.f) & 0xffffu); }
}

__device__ __forceinline__ void p1_h1(const Frame& F0) {
    PHASE_VIEW();
    const GAS float* x = (const GAS float*)F.in[0]; const GAS float* g = (const GAS float*)F.in[4]; const GAS float* mod = (const GAS float*)(F.ws + WS_MOD); GAS bf16* H = (GAS bf16*)(F.ws + WS_H);
    const int gw = F.vcu * NWAVES + F.wave, NGW = F.G * NWAVES;
    f32x4 gv[8];
#pragma unroll
    for (int j = 0; j < 8; ++j) gv[j] = *(const GAS f32x4*)(g + 4 * (F.lane + 64 * j));
    for (int row = gw; row < NT; row += NGW) {
        const int b = row >> 11; const GAS f32x4* xr = (const GAS f32x4*)(x + (size_t)row * DM) + F.lane;
        f32x4 v[8], sh[8], scv[8]; float ss = 0.f;
#pragma unroll
        for (int j = 0; j < 8; ++j) { v[j] = xr[64 * j]; sh[j] = *(const GAS f32x4*)(mod + b * NMOD + 4 * (F.lane + 64 * j)); scv[j] = *(const GAS f32x4*)(mod + b * NMOD + DM + 4 * (F.lane + 64 * j)); }
#pragma unroll
        for (int j = 0; j < 8; ++j) ss += (v[j].x * v[j].x + v[j].y * v[j].y) + (v[j].z * v[j].z + v[j].w * v[j].w);
        const float rs = rsqrtf(wave_sum(ss) * (1.f / DM) + RMS_EPS);
        u32x2 w[8];
#pragma unroll
        for (int j = 0; j < 8; ++j) { const f32x4 h = v[j] * rs * gv[j] * (scv[j] + 1.0f) + sh[j]; w[j].x = pk2(h.x, h.y); w[j].y = pk2(h.z, h.w); }
        GAS u32x2* o = (GAS u32x2*)(H + (size_t)row * DM) + F.lane;
#pragma unroll
        for (int j = 0; j < 8; ++j) o[64 * j] = w[j];
    }
}

typedef short bf16x8_t __attribute__((ext_vector_type(8)));
#define MFMA16(a, b, c) __builtin_amdgcn_mfma_f32_16x16x32_bf16((a), (b), (c), 0, 0, 0)
__device__ __forceinline__ bf16x8_t lfrag(const LAS bf16* m, int pitch, int row, int k0) { return *(const LAS bf16x8_t*)(m + row * pitch + k0); }
__device__ __forceinline__ void st4(LAS bf16* p, const f32x4& v) { u32x2 w; w.x = pk2(v[0], v[1]); w.y = pk2(v[2], v[3]); *(LAS u32x2*)p = w; }
constexpr int CH_T = 32, CHP_K = 72, CHP_T = 40;
constexpr int CH_GRP_BYTES = 66560;
constexpr size_t GHQ_CHUNK = 12288;
__device__ __forceinline__ float wave_sum_dpp(float x) {
    x = row16_sum(x);
    x += __builtin_bit_cast(float, __builtin_amdgcn_update_dpp(0, __builtin_bit_cast(int, x), 0x142, 0xa, 0xf, false));
    x += __builtin_bit_cast(float, __builtin_amdgcn_update_dpp(0, __builtin_bit_cast(int, x), 0x143, 0xc, 0xf, false));
    return __builtin_bit_cast(float, __builtin_amdgcn_readlane(__builtin_bit_cast(int, x), 63));
}
__device__ __forceinline__ void wave_sum8_dpp(float (&x)[8]) {
#define WS8_STAGE(ctrl, rmask) _Pragma("unroll") for (int i_ = 0; i_ < 8; ++i_) x[i_] += __builtin_bit_cast(float, __builtin_amdgcn_update_dpp(0, __builtin_bit_cast(int, x[i_]), ctrl, rmask, 0xf, false));
    WS8_STAGE(0xB1, 0xf) WS8_STAGE(0x4E, 0xf) WS8_STAGE(0x141, 0xf) WS8_STAGE(0x140, 0xf) WS8_STAGE(0x142, 0xa) WS8_STAGE(0x143, 0xc)
#undef WS8_STAGE
#pragma unroll
    for (int i = 0; i < 8; ++i) x[i] = __builtin_bit_cast(float, __builtin_amdgcn_readlane(__builtin_bit_cast(int, x[i]), 63));
}
__device__ __forceinline__ float tanh_fast(float x) { const float e = __builtin_amdgcn_exp2f(2.8853900817779268f * x); return 1.f - 2.f * __builtin_amdgcn_rcpf(e + 1.f); }
#define INV_P8(acc, A0, L0, M0, A1, L1, M1, A2, L2, M2, A3, L3, M3, A4, L4, M4, A5, L5, M5, A6, L6, M6, A7, L7, M7) do { float tmp_; asm volatile("v_readlane_b32 %1, %2, %10\n\tv_fmac_f32 %0, %1, %18\n\tv_readlane_b32 %1, %3, %11\n\tv_fmac_f32 %0, %1, %19\n\tv_readlane_b32 %1, %4, %12\n\tv_fmac_f32 %0, %1, %20\n\tv_readlane_b32 %1, %5, %13\n\tv_fmac_f32 %0, %1, %21\n\tv_readlane_b32 %1, %6, %14\n\tv_fmac_f32 %0, %1, %22\n\tv_readlane_b32 %1, %7, %15\n\tv_fmac_f32 %0, %1, %23\n\tv_readlane_b32 %1, %8, %16\n\tv_fmac_f32 %0, %1, %24\n\tv_readlane_b32 %1, %9, %17\n\tv_fmac_f32 %0, %1, %25" : "+v"(acc), "=&s"(tmp_) : "v"(A0), "v"(A1), "v"(A2), "v"(A3), "v"(A4), "v"(A5), "v"(A6), "v"(A7), "i"(L0), "i"(L1), "i"(L2), "i"(L3), "i"(L4), "i"(L5), "i"(L6), "i"(L7), "v"(M0), "v"(M1), "v"(M2), "v"(M3), "v"(M4), "v"(M5), "v"(M6), "v"(M7)); } while (0)
#define INV_P4(acc, A0, L0, M0, A1, L1, M1, A2, L2, M2, A3, L3, M3) do { float tmp_; asm volatile("v_readlane_b32 %1, %2, %6\n\tv_fmac_f32 %0, %1, %10\n\tv_readlane_b32 %1, %3, %7\n\tv_fmac_f32 %0, %1, %11\n\tv_readlane_b32 %1, %4, %8\n\tv_fmac_f32 %0, %1, %12\n\tv_readlane_b32 %1, %5, %9\n\tv_fmac_f32 %0, %1, %13" : "+v"(acc), "=&s"(tmp_) : "v"(A0), "v"(A1), "v"(A2), "v"(A3), "i"(L0), "i"(L1), "i"(L2), "i"(L3), "v"(M0), "v"(M1), "v"(M2), "v"(M3)); } while (0)
#define INV_P2(acc, A0, L0, M0, A1, L1, M1) do { float tmp_; asm volatile("v_readlane_b32 %1, %2, %4\n\tv_fmac_f32 %0, %1, %6\n\tv_readlane_b32 %1, %3, %5\n\tv_fmac_f32 %0, %1, %7" : "+v"(acc), "=&s"(tmp_) : "v"(A0), "v"(A1), "i"(L0), "i"(L1), "v"(M0), "v"(M1)); } while (0)
#define INV_P1(acc, A0, L0, M0) do { float tmp_; asm volatile("v_readlane_b32 %1, %2, %3\n\tv_fmac_f32 %0, %1, %4" : "+v"(acc), "=&s"(tmp_) : "v"(A0), "i"(L0), "v"(M0)); } while (0)
__device__ __forceinline__ void p9a_rwkv_chunks(const Frame& F0) {
    PHASE_VIEW();
    const GAS bf16* PROJ = (const GAS bf16*)(F.ws + WS_PROJ); const GAS bf16* LoraT = (const GAS bf16*)(F.ws + WS_LORA_T);
    GAS bf16* VB = (GAS bf16*)(F.ws + WS_VB); GAS bf16* GB = (GAS bf16*)(F.ws + WS_GB); GAS float* BON = (GAS float*)(F.ws + WS_BON);
    const float* mu = F.in[20]; const float* w0 = F.in[21]; const float* a0 = F.in[23]; const float* k_k = F.in[26]; const float* k_a = F.in[27]; const float* r_k = F.in[28];
    GAS bf16* GHQ = (GAS bf16*)(F.ws + WS_GHQ); GAS float* GT = (GAS float*)(F.ws + WS_GT);
    const int grp = F.tid >> 8, gt = F.tid & 255, gw = (F.tid >> 6) & 3, lo = F.lane & 15, hi = F.lane >> 4;
    LAS unsigned char* gb = F.lds + grp * CH_GRP_BYTES;
    LAS bf16* At = (LAS bf16*)gb; LAS bf16* Bt = At + 32 * CHP_K; LAS bf16* Kt = Bt + 32 * CHP_K; LAS bf16* Rt = Kt + 32 * CHP_K;
    LAS bf16* X1T = At; LAS bf16* P1T = X1T + 64 * CHP_T; LAS bf16* Minv = P1T + 64 * CHP_T; LAS bf16* XG = At;
    LAS bf16* AtT = Rt + 32 * CHP_K; LAS bf16* BhT = AtT + 64 * CHP_T; LAS bf16* KhT = BhT + 64 * CHP_T; LAS bf16* VmT = KhT + 64 * CHP_T;
    LAS float* AabF = (LAS float*)(VmT + 64 * CHP_T);
    LAS bf16* Aak = (LAS bf16*)(AabF + 32 * 36); LAS bf16* Arb = Aak + 32 * CHP_T; LAS bf16* Ark = Arb + 32 * CHP_T; LAS bf16* P2T = Ark + 32 * CHP_T;
    LAS float* LWs = AabF; LAS float* AAs = LWs + 32 * 68; LAS bf16* W1 = (LAS bf16*)AabF;
    LAS float* part = (LAS float*)(P2T + 64 * CHP_T);
    LAS bf16* XW = (LAS bf16*)(part + 256); LAS bf16* XA = XW + 32 * CHP_K;
    const f32x4 z4 = (f32x4){0.f, 0.f, 0.f, 0.f};
    LAS unsigned* gbw = (LAS unsigned*)(F.lds + MISC_OFF) + 40 + grp; unsigned gb_target = 0u;
    __syncthreads(); if (gt == 0) *(volatile LAS unsigned*)gbw = 0u; __syncthreads();
#define GROUP_BARRIER() do { gb_target += 4u; asm volatile("s_waitcnt lgkmcnt(0)" ::: "memory"); \
        if (F.lane == 0) (void)__hip_atomic_fetch_add(gbw, 1u, __ATOMIC_RELAXED, __HIP_MEMORY_SCOPE_WORKGROUP); \
        while (*(volatile LAS unsigned*)gbw < gb_target) __builtin_amdgcn_s_sleep(1); \
        asm volatile("" ::: "memory"); } while (0)
    for (int it0 = F.vcu * 2; it0 < NB * (SEQ / CH_T); it0 += F.G * 2) {
        const int item = it0 + grp; const int c = item & 63, b = item >> 6;
        const size_t tok0 = (size_t)b * SEQ + c * CH_T;
        GROUP_BARRIER();
#pragma unroll 4
        for (int i = 0; i < 16; ++i) { const int pidx = gt + 256 * i, t = pidx >> 7, cp = (pidx & 127) * 2;
            const unsigned zw = *(const GAS unsigned*)(PROJ + (tok0 + t) * DIN + 4096 + cp);
            const unsigned pw = (c == 0 && t == 0) ? 0u : *(const GAS unsigned*)(PROJ + (tok0 + t - 1) * DIN + 4096 + cp);
            const f32x2 m = *(const f32x2*)(mu + 3072 + cp);
            const float z0 = bf_lo(zw), z1 = bf_hi(zw); const float v0 = z0 + m.x * (bf_lo(pw) - z0), v1 = z1 + m.y * (bf_hi(pw) - z1);
            if (cp < 64) *(LAS unsigned*)(XW + t * CHP_K + cp) = pk2(tanh_fast(v0), tanh_fast(v1));
            else if (cp < 128) *(LAS unsigned*)(XA + t * CHP_K + cp - 64) = pk2(v0, v1);
            else *(LAS unsigned*)(XG + t * 136 + cp - 128) = pk2(sigmoidf_(v0), sigmoidf_(v1)); }
        GROUP_BARRIER();
        { bf16x8_t xg[2][4];
#pragma unroll
          for (int mt = 0; mt < 2; ++mt)
#pragma unroll
              for (int ks = 0; ks < 4; ++ks) xg[mt][ks] = lfrag(XG, 136, 16 * mt + lo, 32 * ks + 8 * hi);
          bf16x8_t ygc[4], ygn[4];
#pragma unroll
          for (int ks = 0; ks < 4; ++ks) ygc[ks] = *(const GAS bf16x8_t*)(LoraT + (size_t)(2048 + 16 * gw + lo) * 256 + 128 + 32 * ks + 8 * hi);
#pragma unroll 1
          for (int hh = 0; hh < NH; ++hh) { const int n0 = hh * 64 + 16 * gw, n1 = (hh + 1 < NH ? hh + 1 : hh) * 64 + 16 * gw; f32x4 dg[2] = {z4, z4};
#pragma unroll
              for (int ks = 0; ks < 4; ++ks) ygn[ks] = *(const GAS bf16x8_t*)(LoraT + (size_t)(2048 + n1 + lo) * 256 + 128 + 32 * ks + 8 * hi);
#pragma unroll
              for (int ks = 0; ks < 4; ++ks) { dg[0] = MFMA16(ygc[ks], xg[0][ks], dg[0]); dg[1] = MFMA16(ygc[ks], xg[1][ks], dg[1]); }
#pragma unroll
              for (int mt = 0; mt < 2; ++mt) { u32x2 w; w.x = pk2(dg[mt][0], dg[mt][1]); w.y = pk2(dg[mt][2], dg[mt][3]); *(GAS u32x2*)(GB + (tok0 + 16 * mt + lo) * 1024 + n0 + 4 * hi) = w; }
#pragma unroll
              for (int ks = 0; ks < 4; ++ks) ygc[ks] = ygn[ks]; }
        }
        const int k = gt & 63, tq = gw; const bool first = (c == 0 && tq == 0);
        const GAS bf16* pp = PROJ + (tok0 + tq * 8) * DIN + 1024 + k;
        bf16 nr[9], nk[9], nv[9];
#pragma unroll
        for (int i = 0; i < 9; ++i) { const GAS bf16* q = pp + (ptrdiff_t)(i - 1) * DIN; const bool z = first && i == 0;
            nr[i] = z ? (bf16)0 : q[0]; nk[i] = z ? (bf16)0 : q[1024]; nv[i] = z ? (bf16)0 : q[2048]; }
        bf16x8_t lyw[2], lya[2]; f32x4 lw0, la0; float cmur, cmuk, cmuv, ckk, cka, crk;
#define HEAD_LOADS(hn_) do { const int n1_ = (hn_) * 64 + 16 * gw, ch1_ = (hn_) * 64 + k; \
            _Pragma("unroll") for (int ks = 0; ks < 2; ++ks) { lyw[ks] = *(const GAS bf16x8_t*)(LoraT + (size_t)(n1_ + lo) * 256 + 32 * ks + 8 * hi); lya[ks] = *(const GAS bf16x8_t*)(LoraT + (size_t)(1024 + n1_ + lo) * 256 + 64 + 32 * ks + 8 * hi); } \
            lw0 = *(const GAS f32x4*)((const GAS float*)w0 + n1_ + 4 * hi); la0 = *(const GAS f32x4*)((const GAS float*)a0 + n1_ + 4 * hi); \
            cmur = ((const GAS float*)mu)[ch1_]; cmuk = ((const GAS float*)mu)[1024 + ch1_]; cmuv = ((const GAS float*)mu)[2048 + ch1_]; \
            ckk = ((const GAS float*)k_k)[ch1_]; cka = ((const GAS float*)k_a)[ch1_]; crk = ((const GAS float*)r_k)[ch1_]; } while (0)
        HEAD_LOADS(0);
#pragma unroll 1
        for (int h = 0; h < NH; ++h) {
            const int ci = (b * NH + h) * 64 + c; const int ch = h * 64 + k;
            GROUP_BARRIER();
            { const int n0 = h * 64 + 16 * gw; f32x4 dw[2] = {z4, z4}, da[2] = {z4, z4};
#pragma unroll
              for (int ks = 0; ks < 2; ++ks) { const bf16x8_t yw = lyw[ks], ya = lya[ks];
#pragma unroll
                  for (int mt = 0; mt < 2; ++mt) { dw[mt] = MFMA16(yw, lfrag(XW, CHP_K, 16 * mt + lo, 32 * ks + 8 * hi), dw[mt]); da[mt] = MFMA16(ya, lfrag(XA, CHP_K, 16 * mt + lo, 32 * ks + 8 * hi), da[mt]); } }
              const f32x4 w0v = lw0, a0v = la0;
#pragma unroll
              for (int mt = 0; mt < 2; ++mt) { const int t = 16 * mt + lo; f32x4 lwv, aav;
#pragma unroll
                  for (int r = 0; r < 4; ++r) { lwv[r] = (-0.6065306597126334f * 1.4426950408889634f) * sigmoidf_(dw[mt][r] + w0v[r]);     aav[r] = sigmoidf_(da[mt][r] + a0v[r]); }
                  *(LAS f32x4*)(LWs + t * 68 + 16 * gw + 4 * hi) = lwv; *(LAS f32x4*)(AAs + t * 68 + 16 * gw + 4 * hi) = aav; }
            }
            GROUP_BARRIER();
            { const float mur = cmur, muk = cmuk, muv = cmuv, kkc = ckk, kac = cka, rkc = crk;
              float lw[8], ls[8], rv[8], kv[8], vv[8], av[8], bv[8]; float run = 0.f;
              float kraw[8], x8[8];
#pragma unroll
              for (int i = 0; i < 8; ++i) { const int t = tq * 8 + i;
                  const float zr = bf2f(nr[i + 1]), zk = bf2f(nk[i + 1]), zv = bf2f(nv[i + 1]), pr = bf2f(nr[i]), pk_ = bf2f(nk[i]), pv = bf2f(nv[i]);
                  rv[i] = zr + mur * (pr - zr); kraw[i] = zk + muk * (pk_ - zk); vv[i] = zv + muv * (pv - zv);
                  av[i] = AAs[t * 68 + k]; lw[i] = LWs[t * 68 + k];
                  const float kk = kraw[i] * kkc; x8[i] = kk * kk; }
              wave_sum8_dpp(x8);
#pragma unroll
              for (int i = 0; i < 8; ++i) { const float a = av[i]; const float kk = kraw[i] * kkc * __builtin_amdgcn_rsqf(fmaxf(x8[i], 1e-24f));
                  const float km = kraw[i] * (1.f + (a - 1.f) * kac);
                  x8[i] = rv[i] * km * rkc; kv[i] = km; av[i] = -kk; bv[i] = kk * a; run += lw[i]; ls[i] = run; }
              wave_sum8_dpp(x8);
              { float bsel = x8[0];
#pragma unroll
                for (int i = 1; i < 8; ++i) bsel = (F.lane == i) ? x8[i] : bsel;
                if (F.lane < 8) BON[(tok0 + tq * 8 + F.lane) * 16 + h] = bsel; }
              if (h + 1 < NH) {
#pragma unroll
                  for (int i = 0; i < 9; ++i) { const GAS bf16* q = pp + (ptrdiff_t)(i - 1) * DIN + (h + 1) * 64; const bool z = first && i == 0;
                      nr[i] = z ? (bf16)0 : q[0]; nk[i] = z ? (bf16)0 : q[1024]; nv[i] = z ? (bf16)0 : q[2048]; } }
              { u32x4 w; w.x = pk2(vv[0], vv[1]); w.y = pk2(vv[2], vv[3]); w.z = pk2(vv[4], vv[5]); w.w = pk2(vv[6], vv[7]);
                GAS bf16* vb = VB + (tok0 + tq * 8) * 1024 + ch;
                vb[0] = (bf16)(w.x & 0xffffu); vb[1024] = (bf16)(w.x >> 16); vb[2048] = (bf16)(w.y & 0xffffu); vb[3072] = (bf16)(w.y >> 16);
                vb[4096] = (bf16)(w.z & 0xffffu); vb[5120] = (bf16)(w.z >> 16); vb[6144] = (bf16)(w.w & 0xffffu); vb[7168] = (bf16)(w.w >> 16); }
              part[tq * 64 + k] = run;
              GROUP_BARRIER();
              float off = 0.f, tot = 0.f;
#pragma unroll
              for (int q = 0; q < 4; ++q) { const float pq = part[q * 64 + k]; tot += pq; if (q < tq) off += pq; }
              if (tq == 0) GT[(size_t)ci * 64 + k] = __builtin_amdgcn_exp2f(tot);
              float aT[8], bT[8], kT[8];
#pragma unroll
              for (int i = 0; i < 8; ++i) { const int t = tq * 8 + i; const float lg = off + ls[i], lgm = lg - lw[i];
                  const float eneg = __builtin_amdgcn_exp2f(-lg), eh = __builtin_amdgcn_exp2f(tot - lg);
                  const float at = av[i] * __builtin_amdgcn_exp2f(lgm);
                  const unsigned wa = pk2(at, bv[i] * eneg), wk = pk2(kv[i] * eneg, rv[i] * __builtin_amdgcn_exp2f(lg));
                  At[t * CHP_K + k] = (bf16)(wa & 0xffffu); Bt[t * CHP_K + k] = (bf16)(wa >> 16); Kt[t * CHP_K + k] = (bf16)(wk & 0xffffu); Rt[t * CHP_K + k] = (bf16)(wk >> 16);
                  aT[i] = at; bT[i] = bv[i] * eh; kT[i] = kv[i] * eh; }
              u32x4 w;
              w.x = pk2(aT[0], aT[1]); w.y = pk2(aT[2], aT[3]); w.z = pk2(aT[4], aT[5]); w.w = pk2(aT[6], aT[7]); *(LAS u32x4*)(AtT + k * CHP_T + tq * 8) = w;
              w.x = pk2(bT[0], bT[1]); w.y = pk2(bT[2], bT[3]); w.z = pk2(bT[4], bT[5]); w.w = pk2(bT[6], bT[7]); *(LAS u32x4*)(BhT + k * CHP_T + tq * 8) = w;
              w.x = pk2(kT[0], kT[1]); w.y = pk2(kT[2], kT[3]); w.z = pk2(kT[4], kT[5]); w.w = pk2(kT[6], kT[7]); *(LAS u32x4*)(KhT + k * CHP_T + tq * 8) = w;
              w.x = pk2(vv[0], vv[1]); w.y = pk2(vv[2], vv[3]); w.z = pk2(vv[4], vv[5]); w.w = pk2(vv[6], vv[7]); *(LAS u32x4*)(VmT + k * CHP_T + tq * 8) = w;
            }
            GROUP_BARRIER();
            f32x4 dt = z4, a10 = z4;
            const int mi = gw ^ grp;
            { const LAS bf16* X = (mi < 2) ? At : Rt; const LAS bf16* Y = (mi & 1) ? Kt : Bt;
              f32x4 acc[2][2] = {{z4, z4}, {z4, z4}};
#pragma unroll
              for (int ks = 0; ks < 2; ++ks) { bf16x8_t xf[2], yf[2];
#pragma unroll
                  for (int m = 0; m < 2; ++m) { xf[m] = lfrag(X, CHP_K, 16 * m + lo, 32 * ks + 8 * hi); yf[m] = lfrag(Y, CHP_K, 16 * m + lo, 32 * ks + 8 * hi); }
#pragma unroll
                  for (int m = 0; m < 2; ++m)
#pragma unroll
                      for (int n = 0; n < 2; ++n) acc[m][n] = MFMA16(yf[n], xf[m], acc[m][n]);
                  if (mi == 1) dt = MFMA16(lfrag(Bt, CHP_K, 16 + lo, 32 * ks + 8 * hi), xf[1], dt); }
              LAS bf16* dstb = (mi == 1) ? Aak : ((mi == 2) ? Arb : Ark);
#pragma unroll
              for (int m = 0; m < 2; ++m)
#pragma unroll
                  for (int n = 0; n < 2; ++n) { const int t = 16 * m + lo, j0 = 16 * n + 4 * hi; f32x4 v = acc[m][n];
#pragma unroll
                      for (int r = 0; r < 4; ++r) { const int j = j0 + r; const bool keep = (mi < 2) ? (j < t) : (j <= t); v[r] = keep ? v[r] : 0.f; }
                      if (mi != 0) st4(dstb + t * CHP_T + j0, v); else { if (m == 0 && n == 0) dt = v; if (m == 1 && n == 0) a10 = v; } }
              if (mi == 1) {
#pragma unroll
                  for (int r = 0; r < 4; ++r) dt[r] = (4 * hi + r < lo) ? dt[r] : 0.f; }
            }
            GROUP_BARRIER();
            if (mi < 2) {
                int cc = F.lane & 15; asm volatile("" : "+v"(cc));
                float mcol[16];
                { float acc = (0 == cc) ? 1.f : 0.f;
                  mcol[0] = acc; }
                { float acc = (1 == cc) ? 1.f : 0.f;
                  INV_P1(acc, dt[0], 1, mcol[0]);
                  mcol[1] = acc; }
                { float acc = (2 == cc) ? 1.f : 0.f;
                  INV_P2(acc, dt[0], 2, mcol[0], dt[1], 2, mcol[1]);
                  mcol[2] = acc; }
                { float acc = (3 == cc) ? 1.f : 0.f;
                  INV_P2(acc, dt[0], 3, mcol[0], dt[1], 3, mcol[1]);
                  INV_P1(acc, dt[2], 3, mcol[2]);
                  mcol[3] = acc; }
                { float acc = (4 == cc) ? 1.f : 0.f;
                  INV_P4(acc, dt[0], 4, mcol[0], dt[1], 4, mcol[1], dt[2], 4, mcol[2], dt[3], 4, mcol[3]);
                  mcol[4] = acc; }
                { float acc = (5 == cc) ? 1.f : 0.f;
                  INV_P4(acc, dt[0], 5, mcol[0], dt[1], 5, mcol[1], dt[2], 5, mcol[2], dt[3], 5, mcol[3]);
                  INV_P1(acc, dt[0], 21, mcol[4]);
                  mcol[5] = acc; }
                { float acc = (6 == cc) ? 1.f : 0.f;
                  INV_P4(acc, dt[0], 6, mcol[0], dt[1], 6, mcol[1], dt[2], 6, mcol[2], dt[3], 6, mcol[3]);
                  INV_P2(acc, dt[0], 22, mcol[4], dt[1], 22, mcol[5]);
                  mcol[6] = acc; }
                { float acc = (7 == cc) ? 1.f : 0.f;
                  INV_P4(acc, dt[0], 7, mcol[0], dt[1], 7, mcol[1], dt[2], 7, mcol[2], dt[3], 7, mcol[3]);
                  INV_P2(acc, dt[0], 23, mcol[4], dt[1], 23, mcol[5]);
                  INV_P1(acc, dt[2], 23, mcol[6]);
                  mcol[7] = acc; }
                { float acc = (8 == cc) ? 1.f : 0.f;
                  INV_P8(acc, dt[0], 8, mcol[0], dt[1], 8, mcol[1], dt[2], 8, mcol[2], dt[3], 8, mcol[3], dt[0], 24, mcol[4], dt[1], 24, mcol[5], dt[2], 24, mcol[6], dt[3], 24, mcol[7]);
                  mcol[8] = acc; }
                { float acc = (9 == cc) ? 1.f : 0.f;
                  INV_P8(acc, dt[0], 9, mcol[0], dt[1], 9, mcol[1], dt[2], 9, mcol[2], dt[3], 9, mcol[3], dt[0], 25, mcol[4], dt[1], 25, mcol[5], dt[2], 25, mcol[6], dt[3], 25, mcol[7]);
                  INV_P1(acc, dt[0], 41, mcol[8]);
                  mcol[9] = acc; }
                { float acc = (10 == cc) ? 1.f : 0.f;
                  INV_P8(acc, dt[0], 10, mcol[0], dt[1], 10, mcol[1], dt[2], 10, mcol[2], dt[3], 10, mcol[3], dt[0], 26, mcol[4], dt[1], 26, mcol[5], dt[2], 26, mcol[6], dt[3], 26, mcol[7]);
                  INV_P2(acc, dt[0], 42, mcol[8], dt[1], 42, mcol[9]);
                  mcol[10] = acc; }
                { float acc = (11 == cc) ? 1.f : 0.f;
                  INV_P8(acc, dt[0], 11, mcol[0], dt[1], 11, mcol[1], dt[2], 11, mcol[2], dt[3], 11, mcol[3], dt[0], 27, mcol[4], dt[1], 27, mcol[5], dt[2], 27, mcol[6], dt[3], 27, mcol[7]);
                  INV_P2(acc, dt[0], 43, mcol[8], dt[1], 43, mcol[9]);
                  INV_P1(acc, dt[2], 43, mcol[10]);
                  mcol[11] = acc; }
                { float acc = (12 == cc) ? 1.f : 0.f;
                  INV_P8(acc, dt[0], 12, mcol[0], dt[1], 12, mcol[1], dt[2], 12, mcol[2], dt[3], 12, mcol[3], dt[0], 28, mcol[4], dt[1], 28, mcol[5], dt[2], 28, mcol[6], dt[3], 28, mcol[7]);
                  INV_P4(acc, dt[0], 44, mcol[8], dt[1], 44, mcol[9], dt[2], 44, mcol[10], dt[3], 44, mcol[11]);
                  mcol[12] = acc; }
                { float acc = (13 == cc) ? 1.f : 0.f;
                  INV_P8(acc, dt[0], 13, mcol[0], dt[1], 13, mcol[1], dt[2], 13, mcol[2], dt[3], 13, mcol[3], dt[0], 29, mcol[4], dt[1], 29, mcol[5], dt[2], 29, mcol[6], dt[3], 29, mcol[7]);
                  INV_P4(acc, dt[0], 45, mcol[8], dt[1], 45, mcol[9], dt[2], 45, mcol[10], dt[3], 45, mcol[11]);
                  INV_P1(acc, dt[0], 61, mcol[12]);
                  mcol[13] = acc; }
                { float acc = (14 == cc) ? 1.f : 0.f;
                  INV_P8(acc, dt[0], 14, mcol[0], dt[1], 14, mcol[1], dt[2], 14, mcol[2], dt[3], 14, mcol[3], dt[0], 30, mcol[4], dt[1], 30, mcol[5], dt[2], 30, mcol[6], dt[3], 30, mcol[7]);
                  INV_P4(acc, dt[0], 46, mcol[8], dt[1], 46, mcol[9], dt[2], 46, mcol[10], dt[3], 46, mcol[11]);
                  INV_P2(acc, dt[0], 62, mcol[12], dt[1], 62, mcol[13]);
                  mcol[14] = acc; }
                { float acc = (15 == cc) ? 1.f : 0.f;
                  INV_P8(acc, dt[0], 15, mcol[0], dt[1], 15, mcol[1], dt[2], 15, mcol[2], dt[3], 15, mcol[3], dt[0], 31, mcol[4], dt[1], 31, mcol[5], dt[2], 31, mcol[6], dt[3], 31, mcol[7]);
                  INV_P4(acc, dt[0], 47, mcol[8], dt[1], 47, mcol[9], dt[2], 47, mcol[10], dt[3], 47, mcol[11]);
                  INV_P2(acc, dt[0], 63, mcol[12], dt[1], 63, mcol[13]);
                  INV_P1(acc, dt[2], 63, mcol[14]);
                  mcol[15] = acc; }
                if (F.lane < 32) { const int col = F.lane; const bool mine = (mi == 0) ? (col < 16) : (col >= 16);
#pragma unroll
                    for (int t = 0; t < 16; ++t) Minv[(16 * mi + t) * CHP_T + col] = (bf16)(pk2(mine ? mcol[t] : 0.f, 0.f) & 0xffffu); }
                if (mi == 0) { st4(W1 + lo * CHP_T + 4 * hi, a10);
                    f32x4 id;
#pragma unroll
                    for (int r = 0; r < 4; ++r) id[r] = (4 * hi + r == lo) ? 1.f : 0.f;
                    st4(W1 + lo * CHP_T + 16 + 4 * hi, id); }
            } else {
                const int wk = mi - 2;
                for (int tile = wk * 4; tile < wk * 4 + 4; ++tile) { const int mt = tile >> 2, nt = tile & 3;
                    const bf16x8_t xf = lfrag(Aak, CHP_T, 16 * mt + lo, 8 * hi), yf = lfrag(VmT, CHP_T, 16 * nt + lo, 8 * hi);
                    const f32x4 d = MFMA16(xf, yf, z4);
                    st4(X1T + (16 * nt + lo) * CHP_T + 16 * mt + 4 * hi, d); }
            }
            GROUP_BARRIER();
            { const bf16x8_t ya = lfrag(AtT, CHP_T, 16 * gw + lo, 8 * hi), yx = lfrag(X1T, CHP_T, 16 * gw + lo, 8 * hi);
              const bf16x8_t m0 = lfrag(Minv, CHP_T, lo, 8 * hi), m1 = lfrag(Minv, CHP_T, 16 + lo, 8 * hi), w1 = lfrag(W1, CHP_T, lo, 8 * hi);
              LAS bf16* p1r = P1T + (16 * gw + lo) * CHP_T; LAS bf16* p2r = P2T + (16 * gw + lo) * CHP_T;
              const f32x4 a = MFMA16(m0, ya, z4), b = MFMA16(m0, yx, z4);
              st4(p1r + 4 * hi, a); st4(p2r + 4 * hi, b);
              asm volatile("" ::: "memory");
              const bf16x8_t pa = *(const LAS bf16x8_t*)(p1r + 8 * (hi & 1)), pb = *(const LAS bf16x8_t*)(p2r + 8 * (hi & 1));
              const bf16x8_t za = (hi < 2) ? pa : ya, zx = (hi < 2) ? pb : yx;
              const f32x4 ta = MFMA16(w1, za, z4), tb = MFMA16(w1, zx, z4);
              st4(p1r + 16 + 4 * hi, ta); st4(p2r + 16 + 4 * hi, tb);
              asm volatile("" ::: "memory");
              const bf16x8_t qa = *(const LAS bf16x8_t*)(p1r + 8 * hi), qx = *(const LAS bf16x8_t*)(p2r + 8 * hi);
              const f32x4 ca = MFMA16(m1, qa, z4), cb = MFMA16(m1, qx, z4);
              asm volatile("" ::: "memory");
              st4(p1r + 16 + 4 * hi, ca); st4(p2r + 16 + 4 * hi, cb);
            }
            GROUP_BARRIER();
            HEAD_LOADS((h + 1 < NH) ? h + 1 : h);
            { GAS bf16* outp = GHQ + (size_t)ci * GHQ_CHUNK;
              const bf16x8_t p1 = lfrag(P1T, CHP_T, 16 * gw + lo, 8 * hi), p2 = lfrag(P2T, CHP_T, 16 * gw + lo, 8 * hi), vm = lfrag(VmT, CHP_T, 16 * gw + lo, 8 * hi);
#pragma unroll
              for (int mt = 0; mt < 2; ++mt) { const bf16x8_t arb = lfrag(Arb, CHP_T, 16 * mt + lo, 8 * hi), ark = lfrag(Ark, CHP_T, 16 * mt + lo, 8 * hi);
                  f32x4 q1 = MFMA16(p1, arb, z4);
                  { const int t = 16 * mt + lo, k0 = 16 * gw + 4 * hi; const u32x2 rw = *(const LAS u32x2*)(Rt + t * CHP_K + k0);
                    q1[0] += bf_lo(rw.x); q1[1] += bf_hi(rw.x); q1[2] += bf_lo(rw.y); q1[3] += bf_hi(rw.y);
                    u32x2 w; w.x = pk2(q1[0], q1[1]); w.y = pk2(q1[2], q1[3]); *(GAS u32x2*)(outp + 8192 + t * 64 + k0) = w; }
                  f32x4 q2 = MFMA16(arb, p2, z4); q2 = MFMA16(ark, vm, q2);
                  { u32x2 w; w.x = pk2(q2[0], q2[1]); w.y = pk2(q2[2], q2[3]); *(GAS u32x2*)(outp + 10240 + (16 * gw + lo) * 32 + 16 * mt + 4 * hi) = w; } }
#pragma unroll
              for (int mt = 0; mt < 4; ++mt) { const bf16x8_t bh = lfrag(BhT, CHP_T, 16 * mt + lo, 8 * hi), kh = lfrag(KhT, CHP_T, 16 * mt + lo, 8 * hi);
                  const f32x4 g = MFMA16(p1, bh, z4);
                  { u32x2 w; w.x = pk2(g[0], g[1]); w.y = pk2(g[2], g[3]); *(GAS u32x2*)(outp + (16 * mt + lo) * 64 + 16 * gw + 4 * hi) = w; }
                  f32x4 hh = MFMA16(bh, p2, z4); hh = MFMA16(kh, vm, hh);
                  { u32x2 w; w.x = pk2(hh[0], hh[1]); w.y = pk2(hh[2], hh[3]); *(GAS u32x2*)(outp + 4096 + (16 * gw + lo) * 64 + 16 * mt + 4 * hi) = w; } }
            }
        }
    }
    __syncthreads();
#undef GROUP_BARRIER
#undef HEAD_LOADS
}
__device__ __forceinline__ void p9b_rwkv_seq(const Frame& F0) {
    PHASE_VIEW();
    const GAS bf16* GHQ = (const GAS bf16*)(F.ws + WS_GHQ); const GAS float* GT = (const GAS float*)(F.ws + WS_GT); GAS bf16* Yy = (GAS bf16*)(F.ws + WS_Y);
    LAS bf16* Sb = (LAS bf16*)F.lds;
    LAS bf16* Yb = Sb + 2 * 32 * CHP_K;
    const int lo = F.lane & 15, hi = F.lane >> 4, vt = F.wave & 1;
    const bool ywave = F.wave < 4, twave = (F.wave == 4 || F.wave == 5), writer = F.wave >= 6;
    const int kt = ywave ? (F.wave >> 1) : 2, mt = (F.wave >> 1) & 1;
    const f32x4 z4 = (f32x4){0.f, 0.f, 0.f, 0.f};
    for (int item = F.vcu; item < NB * NH * 2; item += F.G) {
        const int b = item >> 5, h = (item >> 1) & 15, vh = item & 1;
        __syncthreads();
        for (int i = F.tid; i < 2 * 32 * CHP_K / 2; i += NTHR) ((LAS unsigned*)Sb)[i] = 0u;
        __syncthreads();
        f32x4 Sf = z4, Sf2 = z4;
        const size_t cbase = (size_t)(b * NH + h) * 64;
        const int vrow = vh * 32 + 16 * vt + lo;
        const int offX = ywave ? 8192 + (16 * mt + lo) * 64 + 8 * hi : (48 + lo) * 64 + 8 * hi;
        const int offX2 = ywave ? 10240 + vrow * 32 + 16 * mt + 4 * hi : 4096 + vrow * 64 + 48 + 4 * hi;
        const int offT2 = ywave ? 16 * kt + 4 * hi : 48 + 4 * hi;
#define SEQ_LOAD(G_, X_, H_, X2_, GT_, GT2_, cc_) do { if (!writer) { const int cn_ = (cc_) < 64 ? (cc_) : 63; const GAS bf16* cp_ = GHQ + (cbase + cn_) * GHQ_CHUNK; \
            G_[0] = *(const GAS bf16x8_t*)(cp_ + (16 * kt + lo) * 64 + 8 * hi); G_[1] = *(const GAS bf16x8_t*)(cp_ + (16 * kt + lo) * 64 + 32 + 8 * hi); \
            H_ = *(const GAS u32x2*)(cp_ + 4096 + vrow * 64 + 16 * kt + 4 * hi); GT_ = *(const GAS f32x4*)(GT + (cbase + cn_) * 64 + 16 * kt + 4 * hi); \
            X_[0] = *(const GAS bf16x8_t*)(cp_ + offX); X_[1] = *(const GAS bf16x8_t*)(cp_ + offX + 32); \
            X2_ = *(const GAS u32x2*)(cp_ + offX2); GT2_ = *(const GAS f32x4*)(GT + (cbase + cn_) * 64 + offT2); } } while (0)
#define SEQ_FLUSH(cc_) do { const int r_ = (F.wave - 6) * 16 + (F.lane >> 2), q_ = F.lane & 3; \
            const u32x4 yv_ = *(const LAS u32x4*)(Yb + ((cc_) & 1) * 1024 + r_ * 32 + 8 * q_); \
            *(GAS u32x4*)(Yy + (size_t)(b * SEQ + (cc_) * CH_T + r_) * 1024 + h * 64 + vh * 32 + 8 * q_) = yv_; } while (0)
#define SEQ_STEP(G_, X_, H_, X2_, GT_, GT2_, cc_) do { \
            const LAS bf16* Sc = Sb + ((cc_) & 1) * 32 * CHP_K; LAS bf16* Sn = Sb + (((cc_) + 1) & 1) * 32 * CHP_K; \
            if (!writer) { \
                const bf16x8_t s0 = lfrag(Sc, CHP_K, 16 * vt + lo, 8 * hi), s1 = lfrag(Sc, CHP_K, 16 * vt + lo, 32 + 8 * hi); \
                f32x4 acc2 = (f32x4){bf_lo(X2_.x), bf_hi(X2_.x), bf_lo(X2_.y), bf_hi(X2_.y)}; \
                if (twave) acc2 = acc2 + GT2_ * Sf2; \
                acc2 = MFMA16(X_[0], s0, acc2); acc2 = MFMA16(X_[1], s1, acc2); \
                f32x4 acc = (f32x4){bf_lo(H_.x), bf_hi(H_.x), bf_lo(H_.y), bf_hi(H_.y)} + GT_ * Sf; \
                acc = MFMA16(G_[0], s0, acc); acc = MFMA16(G_[1], s1, acc); \
                Sf = acc; st4(Sn + (16 * vt + lo) * CHP_K + 16 * kt + 4 * hi, acc); \
                if (twave) { Sf2 = acc2; st4(Sn + (16 * vt + lo) * CHP_K + 48 + 4 * hi, acc2); } \
                else { LAS bf16* yo_ = Yb + ((cc_) & 1) * 1024 + (16 * mt + 4 * hi) * 32 + 16 * vt + lo; const unsigned w01 = pk2(acc2[0], acc2[1]), w23 = pk2(acc2[2], acc2[3]);     \
                    yo_[0] = (bf16)(w01 & 0xffffu); yo_[32] = (bf16)(w01 >> 16); yo_[64] = (bf16)(w23 & 0xffffu); yo_[96] = (bf16)(w23 >> 16); } \
                SEQ_LOAD(G_, X_, H_, X2_, GT_, GT2_, (cc_) + 4); \
            } else if ((cc_) > 0) SEQ_FLUSH((cc_) - 1); \
            asm volatile("s_waitcnt lgkmcnt(0)" ::: "memory"); __builtin_amdgcn_s_barrier(); asm volatile("" ::: "memory"); } while (0)
        bf16x8_t gA[2], xA[2], gB[2], xB[2], gC[2], xC[2], gD[2], xD[2]; u32x2 hA, x2A, hB, x2B, hC, x2C, hD, x2D; f32x4 gtA, gtB, gtC, gtD, gsA, gsB, gsC, gsD;
        SEQ_LOAD(gA, xA, hA, x2A, gtA, gsA, 0); SEQ_LOAD(gB, xB, hB, x2B, gtB, gsB, 1); SEQ_LOAD(gC, xC, hC, x2C, gtC, gsC, 2); SEQ_LOAD(gD, xD, hD, x2D, gtD, gsD, 3);
#pragma unroll
        for (int c = 0; c < 64; c += 4) {
            SEQ_STEP(gA, xA, hA, x2A, gtA, gsA, c); SEQ_STEP(gB, xB, hB, x2B, gtB, gsB, c + 1); SEQ_STEP(gC, xC, hC, x2C, gtC, gsC, c + 2); SEQ_STEP(gD, xD, hD, x2D, gtD, gsD, c + 3);
        }
        if (writer) SEQ_FLUSH(63);
#undef SEQ_LOAD
#undef SEQ_FLUSH
#undef SEQ_STEP
    }
}
__device__ __forceinline__ void p9_rwkv_post(const Frame& F0) {
    PHASE_VIEW();
    const GAS bf16* VB = (const GAS bf16*)(F.ws + WS_VB); const GAS bf16* GB = (const GAS bf16*)(F.ws + WS_GB); const GAS float* BON = (const GAS float*)(F.ws + WS_BON);
    const GAS bf16* Yy = (const GAS bf16*)(F.ws + WS_Y);
    const GAS float* ln_w = (const GAS float*)F.in[29]; const GAS float* ln_b = (const GAS float*)F.in[30]; GAS bf16* MIX = (GAS bf16*)(F.ws + WS_MIX);
    const int gw = F.vcu * NWAVES + F.wave, NGW = F.G * NWAVES;
    u32x2 ywn, vwn, gwn; float bonn;
#define POST_LOAD(it_) do { const int it2 = (it_) < NT * 4 ? (it_) : gw; const int row_ = it2 >> 2, c_ = (it2 & 3) * 256 + F.lane * 4; const size_t idx_ = (size_t)row_ * 1024 + c_; \
        ywn = *(const GAS u32x2*)(Yy + idx_); vwn = *(const GAS u32x2*)(VB + idx_); gwn = *(const GAS u32x2*)(GB + idx_); bonn = BON[row_ * 16 + (c_ >> 6)]; } while (0)
    POST_LOAD(gw);
    for (int it = gw; it < NT * 4; it += NGW) {
        const int row = it >> 2, c = (it & 3) * 256 + F.lane * 4;
        const u32x2 yw = ywn, vw = vwn, gwv = gwn; const float bon = bonn;
        const f32x4 lw = *(const GAS f32x4*)(ln_w + c), lb = *(const GAS f32x4*)(ln_b + c);
        POST_LOAD(it + NGW);
        const f32x4 y = (f32x4){bf_lo(yw.x), bf_hi(yw.x), bf_lo(yw.y), bf_hi(yw.y)};
        const float mean = row16_sum((y.x + y.y) + (y.z + y.w)) * (1.f / 64.f); const f32x4 d = y - mean;
        const float var = row16_sum((d.x * d.x + d.y * d.y) + (d.z * d.z + d.w * d.w)) * (1.f / 64.f); const float rstd = rsqrtf(var + GN_EPS);
        const f32x4 vv = (f32x4){bf_lo(vw.x), bf_hi(vw.x), bf_lo(vw.y), bf_hi(vw.y)}, gg = (f32x4){bf_lo(gwv.x), bf_hi(gwv.x), bf_lo(gwv.y), bf_hi(gwv.y)};
        const f32x4 o = (d * rstd * lw + lb + vv * bon) * gg;
        u32x2 w; w.x = pk2(o.x, o.y); w.y = pk2(o.z, o.w); *(GAS u32x2*)(MIX + (size_t)row * DM + DSSM + c) = w;
    }
#undef POST_LOAD
}

__device__ __forceinline__ void p11_x1_router(const Frame& F0) {
    PHASE_VIEW();
    const GAS float* x = (const GAS float*)F.in[0]; const GAS float* gpost = (const GAS float*)F.in[5]; const GAS float* gpre2 = (const GAS float*)F.in[6]; const GAS float* mod = (const GAS float*)(F.ws + WS_MOD);
    const GAS bf16* MIXED = (const GAS bf16*)(F.ws + WS_MIXED); GAS bf16* X1 = (GAS bf16*)(F.ws + WS_X1); GAS bf16* H = (GAS bf16*)(F.ws + WS_H);
    const GAS bf16x8_t* rwt = (const GAS bf16x8_t*)(F.ws + WS_RWT); const float* b_grp = F.in[32]; const float* b_exp = F.in[34];
    unsigned* tokinfo = (unsigned*)(F.ws + WS_TOKINFO); int* list = (int*)(F.ws + WS_LIST);
    LAS float* slab = (LAS float*)(F.lds + F.wave * 16384) + F.lane * 8;
    LAS float* Lp = (LAS float*)F.lds;
    LAS float* red1 = (LAS float*)(F.lds + 131072); LAS float* red2 = red1 + 128; LAS float* Lf = red2 + 128;
    const int lo = F.lane & 15, hi = F.lane >> 4, k0 = 256 * F.wave + 8 * hi;
    const f32x4 z4 = (f32x4){0.f, 0.f, 0.f, 0.f};
    for (int tile = F.vcu; tile < NT / 16; tile += F.G) {
        const int row = tile * 16 + lo, b = tile >> 7;
        const size_t ro = (size_t)row * DM + k0;
        f32x4 xr[8][2];
#pragma unroll
        for (int s_ = 0; s_ < 8; ++s_) { xr[s_][0] = *(const GAS f32x4*)(x + ro + 32 * s_); xr[s_][1] = *(const GAS f32x4*)(x + ro + 32 * s_ + 4); }
        float ss = 0.f;
#pragma unroll
        for (int s_ = 0; s_ < 8; ++s_) { const u32x4 mw = *(const GAS u32x4*)(MIXED + ro + 32 * s_); const f32x4 a0 = (f32x4){bf_lo(mw.x), bf_hi(mw.x), bf_lo(mw.y), bf_hi(mw.y)}, a1 = (f32x4){bf_lo(mw.z), bf_hi(mw.z), bf_lo(mw.w), bf_hi(mw.w)};
            *(LAS f32x4*)(slab + s_ * 512) = a0; *(LAS f32x4*)(slab + s_ * 512 + 4) = a1;
            ss += (a0.x * a0.x + a0.y * a0.y) + (a0.z * a0.z + a0.w * a0.w) + (a1.x * a1.x + a1.y * a1.y) + (a1.z * a1.z + a1.w * a1.w); }
        ss += __shfl_xor(ss, 16); ss += __shfl_xor(ss, 32);
        if (hi == 0) red1[F.wave * 16 + lo] = ss;
        LDS_BARRIER();
        float tot = 0.f;
#pragma unroll
        for (int w = 0; w < 8; ++w) tot += red1[w * 16 + lo];
        const float rs = rsqrtf(tot * (1.f / DM) + RMS_EPS);
        float ss2 = 0.f;
        const GAS float* modb = mod + b * NMOD + k0;
#pragma unroll
        for (int s_ = 0; s_ < 8; ++s_) { f32x4 xo[2];
#pragma unroll
            for (int q = 0; q < 2; ++q) { const f32x4 xv = xr[s_][q], gv = *(const GAS f32x4*)(gpost + k0 + 32 * s_ + 4 * q), gt = *(const GAS f32x4*)(modb + 2 * DM + 32 * s_ + 4 * q);
                const f32x4 mm = *(const LAS f32x4*)(slab + s_ * 512 + 4 * q);
                const f32x4 v = xv + gt * (mm * rs * gv); *(LAS f32x4*)(slab + s_ * 512 + 4 * q) = v; xo[q] = v;
                ss2 += (v.x * v.x + v.y * v.y) + (v.z * v.z + v.w * v.w); }
            (void)xo; }
        ss2 += __shfl_xor(ss2, 16); ss2 += __shfl_xor(ss2, 32);
        if (hi == 0) red2[F.wave * 16 + lo] = ss2;
        LDS_BARRIER();
        float tot2 = 0.f;
#pragma unroll
        for (int w = 0; w < 8; ++w) tot2 += red2[w * 16 + lo];
        const float rs2 = rsqrtf(tot2 * (1.f / DM) + RMS_EPS);
        f32x4 acc[5] = {z4, z4, z4, z4, z4};
        bf16x8_t wA[10], wB[10]; f32x4 cA[6], cB[6];
#define RT_LOAD(W_, C_, st_) do { const GAS bf16x8_t* wb_ = rwt + (size_t)((F.wave * 8 + (st_)) * 10) * 64; \
            _Pragma("unroll") for (int j_ = 0; j_ < 10; ++j_) W_[j_] = wb_[j_ * 64 + F.lane]; \
            _Pragma("unroll") for (int q_ = 0; q_ < 2; ++q_) { C_[3 * q_] = *(const GAS f32x4*)(gpre2 + k0 + 32 * (st_) + 4 * q_); C_[3 * q_ + 1] = *(const GAS f32x4*)(modb + 3 * DM + 32 * (st_) + 4 * q_); C_[3 * q_ + 2] = *(const GAS f32x4*)(modb + 4 * DM + 32 * (st_) + 4 * q_); } } while (0)
#define RT_STEP(W_, C_, st_) do { f32x4 hv[2]; \
            u32x4 xb_; \
            _Pragma("unroll") for (int q_ = 0; q_ < 2; ++q_) { const f32x4 mm = *(const LAS f32x4*)(slab + (st_) * 512 + 4 * q_); hv[q_] = mm * rs2 * C_[3 * q_] * (C_[3 * q_ + 2] + 1.0f) + C_[3 * q_ + 1]; \
                if (q_ == 0) { xb_.x = pk2(mm.x, mm.y); xb_.y = pk2(mm.z, mm.w); } else { xb_.z = pk2(mm.x, mm.y); xb_.w = pk2(mm.z, mm.w); } } \
            *(LAS u32x4*)(slab + (st_) * 512 + 4) = xb_;     \
            u32x4 hh, hl; \
            hh.x = pk2(hv[0].x, hv[0].y); hh.y = pk2(hv[0].z, hv[0].w); hh.z = pk2(hv[1].x, hv[1].y); hh.w = pk2(hv[1].z, hv[1].w); \
            *(LAS u32x4*)(slab + (st_) * 512) = hh;        \
            hl.x = pk2(hv[0].x - bf_lo(hh.x), hv[0].y - bf_hi(hh.x)); hl.y = pk2(hv[0].z - bf_lo(hh.y), hv[0].w - bf_hi(hh.y)); \
            hl.z = pk2(hv[1].x - bf_lo(hh.z), hv[1].y - bf_hi(hh.z)); hl.w = pk2(hv[1].z - bf_lo(hh.w), hv[1].w - bf_hi(hh.w)); \
            const bf16x8_t fh = __builtin_bit_cast(bf16x8_t, hh), fl = __builtin_bit_cast(bf16x8_t, hl); \
            _Pragma("unroll") for (int jt = 0; jt < 5; ++jt) { acc[jt] = MFMA16(W_[2 * jt], fh, acc[jt]); acc[jt] = MFMA16(W_[2 * jt], fl, acc[jt]); acc[jt] = MFMA16(W_[2 * jt + 1], fh, acc[jt]); } } while (0)
        RT_LOAD(wA, cA, 0);
#pragma unroll 1
        for (int s2 = 0; s2 < 8; s2 += 2) { RT_LOAD(wB, cB, s2 + 1); RT_STEP(wA, cA, s2); RT_LOAD(wA, cA, (s2 + 2 < 8 ? s2 + 2 : 7)); RT_STEP(wB, cB, s2 + 1); }
#undef RT_LOAD
#undef RT_STEP
#pragma unroll
        for (int s_ = 0; s_ < 8; ++s_) { *(GAS u32x4*)(H + ro + 32 * s_) = *(const LAS u32x4*)(slab + s_ * 512); *(GAS u32x4*)(X1 + ro + 32 * s_) = *(const LAS u32x4*)(slab + s_ * 512 + 4); }
        LDS_WAIT(); asm volatile("" ::: "memory");
#pragma unroll
        for (int jt = 0; jt < 5; ++jt) *(LAS f32x4*)(Lp + F.wave * 4096 + lo * 80 + 16 * jt + 4 * hi) = acc[jt];
        LDS_BARRIER();
        for (int i = F.tid; i < 16 * 80; i += NTHR) { float sacc = 0.f;
#pragma unroll
            for (int w = 0; w < 8; ++w) sacc += Lp[w * 4096 + i];
            const int j = i % 80; Lf[i] = sacc + (j < 8 ? b_grp[j] : (j < 72 ? b_exp[j - 8] : 0.f)); }
        LDS_BARRIER();
        if (F.tid < 16) { const LAS float* lg = Lf + F.tid * 80; const int tok = tile * 16 + F.tid;
            int gi = 0; float gmax = lg[0];
#pragma unroll
            for (int j = 1; j < 8; ++j) if (lg[j] > gmax) { gmax = lg[j]; gi = j; }
            float gsum = 0.f;
#pragma unroll
            for (int j = 0; j < 8; ++j) gsum += __expf(lg[j] - gmax);
            const float pg = 1.f / gsum;
            const LAS float* le = lg + 8 + gi * 8; int i1 = 0; float m1 = le[0];
#pragma unroll
            for (int j = 1; j < 8; ++j) if (le[j] > m1) { m1 = le[j]; i1 = j; }
            int i2 = -1; float m2 = -INFINITY;
#pragma unroll
            for (int j = 0; j < 8; ++j) if (j != i1 && le[j] > m2) { m2 = le[j]; i2 = j; }
            const float e2 = __expf(m2 - m1); const float g1 = pg / (1.f + e2), g2 = pg * e2 / (1.f + e2);
            const int x1i = gi * 8 + i1, x2i = gi * 8 + i2;
            const unsigned p1 = atomicAdd(F.ctl + CW_CNT + 64 * x1i, 1u), p2 = atomicAdd(F.ctl + CW_CNT + 64 * x2i, 1u);
            list[x1i * NT + p1] = tok; list[x2i * NT + p2] = tok;
            u32x4 a; a.x = (unsigned)x1i; a.y = p1; a.z = (unsigned)x2i; a.w = p2; *(u32x4*)(tokinfo + (size_t)tok * 8) = a;
            u32x2 g; g.x = __float_as_uint(g1); g.y = __float_as_uint(g2); *(u32x2*)(tokinfo + (size_t)tok * 8 + 4) = g;
        }
    }
    __syncthreads();
}

__device__ __forceinline__ void conv_item_src(const Frame& F, int it, const float*& W, int& N, bf16*& WT, int& ldk, int& drow, int& k0, int& n0) {
    if (it < NEXP * 1024) { const int e = it >> 10, r = it & 1023, which = r >> 9, rr = r & 511; k0 = (rr >> 4) * 64; n0 = (rr & 15) * 32;
        W = F.in[which ? 36 : 35] + (size_t)e * DM * DEXP; N = DEXP; WT = (bf16*)(F.ws + WS_EW1) + (size_t)e * 1024 * DM; ldk = DM; drow = (n0 >> 7) * 256 + which * 128 + (n0 & 127); }
    else { const int j = it - NEXP * 1024, e = j >> 9, r = j & 511; k0 = (r >> 6) * 64; n0 = (r & 63) * 32;
        W = F.in[37] + (size_t)e * DEXP * DM; N = DM; WT = (bf16*)(F.ws + WS_EW2) + (size_t)e * DM * DEXP; ldk = DEXP; drow = n0; }
}
struct ConvItem { const GAS float* src; GAS bf16* dst; int ldk; };
__device__ __forceinline__ void conv_decode(const Frame& F, int it, int lane, ConvItem& ci, int& N) {
    const float* W; int ldk, drow, k0, n0; bf16* WT; conv_item_src(F, it, W, N, WT, ldk, drow, k0, n0);
    ci.src = (const GAS float*)W + (size_t)(k0 + (lane >> 3)) * N + n0 + 4 * (lane & 7); ci.dst = (GAS bf16*)WT + (size_t)(drow + (lane >> 3)) * ldk + k0 + 8 * (lane & 7); ci.ldk = ldk;
}
__device__ __forceinline__ int conv_stream(const Frame& F, int first, int step, int total, const unsigned* stopw) {
    LAS float* scr = (LAS float*)(F.lds + F.wave * 16384);
    const int lane = F.lane;
    f32x4 bA[8], bB[8], bC[8]; ConvItem iA, iB, iC; int done = 0;
#define CV_LOAD(buf, ci, idx) do { int N_; conv_decode(F, (idx) < total ? (idx) : total - 1, lane, ci, N_); _Pragma("unroll") for (int i_ = 0; i_ < 8; ++i_) buf[i_] = *(const GAS f32x4*)(ci.src + (size_t)(8 * i_) * N_); } while (0)
#define CV_PROC(buf, ci) do { _Pragma("unroll") for (int i_ = 0; i_ < 8; ++i_) *(LAS f32x4*)(scr + (8 * i_ + (lane >> 3)) * 36 + 4 * (lane & 7)) = buf[i_]; \
        LDS_WAIT(); asm volatile("" ::: "memory"); \
        { const int c_ = lane & 7; _Pragma("unroll") for (int j_ = 0; j_ < 4; ++j_) { const LAS float* sp = scr + (8 * c_) * 36 + (lane >> 3) + 8 * j_; \
              u32x4 o; o.x = pk2(sp[0 * 36], sp[1 * 36]); o.y = pk2(sp[2 * 36], sp[3 * 36]); o.z = pk2(sp[4 * 36], sp[5 * 36]); o.w = pk2(sp[6 * 36], sp[7 * 36]); \
              *(GAS u32x4*)(ci.dst + (size_t)(8 * j_) * ci.ldk) = o; } } \
        LDS_WAIT(); asm volatile("" ::: "memory"); ++done; } while (0)
#define CV_STOPLD() __hip_atomic_load((const GAS unsigned*)stopw, RLX_AGENT)
#define CV_STOP(v) (__builtin_amdgcn_readfirstlane((int)(v)) != 0)
    int it = first;
    CV_LOAD(bA, iA, it); CV_LOAD(bB, iB, it + step);
    while (it < total) {
        unsigned sv = CV_STOPLD();
        CV_LOAD(bC, iC, it + 2 * step);
        CV_PROC(bA, iA); if (CV_STOP(sv)) break;
        if (it + step >= total) break;
        sv = CV_STOPLD();
        CV_LOAD(bA, iA, it + 3 * step);
        CV_PROC(bB, iB); if (CV_STOP(sv)) break;
        if (it + 2 * step >= total) break;
        sv = CV_STOPLD();
        CV_LOAD(bB, iB, it + 4 * step);
        CV_PROC(bC, iC); if (CV_STOP(sv)) break;
        it += 3 * step;
    }
#undef CV_STOPLD
#undef CV_LOAD
#undef CV_PROC
#undef CV_STOP
    return done;
}
__device__ __forceinline__ void p12_expert_convert(const Frame& F0) {
    PHASE_VIEW();
    volatile LAS int* red = (volatile LAS int*)(F.lds + 131072);
    const int ncw = (F.G >= 256) ? (F.G - CONV_GEMM_BLOCKS) * NWAVES : 0;
    __syncthreads();
    if (F.tid == 0) red[0] = 0x7fffffff;
    __syncthreads();
    for (int i = F.tid; i < ncw; i += NTHR) atomicMin((int*)red, (int)__hip_atomic_load(F.ctl + CW_PROG + i, RLX_AGENT));
    __syncthreads();
    const int start = ncw ? red[0] * ncw : 0;
    __syncthreads();
    const int gw = F.vcu * NWAVES + F.wave, NGW = F.G * NWAVES;
    (void)conv_stream(F, start + gw, NGW, CONV_MAIN, F.ctl + CW_TMO + 2);
}

__device__ __forceinline__ void moe_build_tp(const Frame& F0) {
    PHASE_VIEW();
    volatile LAS int* tp = (volatile LAS int*)(F.lds + TP_OFF);
    __syncthreads();
    if (F.tid < NEXP) { const unsigned c = __hip_atomic_load(F.ctl + CW_CNT + 64 * F.tid, RLX_AGENT); tp[80 + F.tid] = (int)((c + 255u) >> 8); tp[160 + F.tid] = (int)c; }
    __syncthreads();
    if (F.tid == 0) { int s = 0; for (int e = 0; e < NEXP; ++e) { tp[e] = s; s += tp[80 + e]; } tp[NEXP] = s; }
    __syncthreads();
}
template <bool G1> struct MoeOrder {
    static constexpr bool GATHER = G1; static constexpr int A2 = 0;
    static constexpr int NNT = G1 ? 4 : 8, KK = G1 ? DM : DEXP;
    __device__ __forceinline__ size_t kstepA() const { return 128; }
    __device__ __forceinline__ size_t hstepA() const { return (size_t)128 * KK * 2; }
    __device__ __forceinline__ size_t a2off() const { return 0; }
    const LAS int* tp; const unsigned* cntw; const int* list; const char* A; const char* EW; int G, c;
    __device__ bool next(int i, pg8::Unit& u) const {
        const int x = c & 7, r = c >> 3, W = G >> 3;
        const int L = i * W + r, tl = L / NNT; u.pn = L % NNT;
        int cum = 0, e = -1, mt = 0;
#pragma unroll
        for (int j = 0; j < 8; ++j) { const int nj = tp[80 + x + 8 * j]; if (e < 0 && tl < cum + nj) { e = x + 8 * j; mt = tl - cum; } cum += nj; }
        if (e < 0) return false;
        e = __builtin_amdgcn_readfirstlane(e); mt = __builtin_amdgcn_readfirstlane(mt);
        const int tile = tp[e] + mt;
        u.e = e; u.pm = tile; u.cnt = tp[160 + e] - mt * 256;
        u.Bb = EW + ((size_t)e * (G1 ? 1024 : DM) + (size_t)u.pn * 256) * KK * 2;
        u.Ab = G1 ? A : A + (size_t)tile * 256 * KK * 2;
        return true;
    }
    template <int NV> __device__ __forceinline__ void a_voff(const pg8::Unit& u, unsigned (&v)[NV][2], const int (&R)[2], const int (&C)[2]) const {
        if constexpr (G1) {
            const int mt = u.pm - tp[u.e];
#pragma unroll
            for (int h = 0; h < 2; ++h)
#pragma unroll
                for (int i = 0; i < 2; ++i) { const int rr = h * 128 + R[i]; const int tok = list[u.e * NT + mt * 256 + (rr < u.cnt ? rr : 0)]; v[h][i] = (unsigned)(tok * KK + C[i]) * 2u; }
        } else {
#pragma unroll
            for (int i = 0; i < 2; ++i) v[0][i] = (unsigned)(R[i] * KK + C[i]) * 2u;
        }
    }
};

__device__ __forceinline__ void p15_final(const Frame& F0) {
    PHASE_VIEW();
    const GAS bf16* X1 = (const GAS bf16*)(F.ws + WS_X1); const GAS bf16* YS = (const GAS bf16*)(F.ws + WS_YSLOT); const GAS unsigned* tokinfo = (const GAS unsigned*)(F.ws + WS_TOKINFO);
    const GAS float* gpost2 = (const GAS float*)F.in[7]; const GAS float* mod = (const GAS float*)(F.ws + WS_MOD); GAS float* out = (GAS float*)F.out;
    const LAS int* tp = (const LAS int*)(F.lds + TP_OFF);
    const int gw = F.vcu * NWAVES + F.wave, NGW = F.G * NWAVES;
    f32x4 gv[8];
#pragma unroll
    for (int j = 0; j < 8; ++j) gv[j] = *(const GAS f32x4*)(gpost2 + 4 * (F.lane + 64 * j));
    u32x4 tin = *(const GAS u32x4*)(tokinfo + (size_t)gw * 8); u32x2 tgn = *(const GAS u32x2*)(tokinfo + (size_t)gw * 8 + 4);
    for (int row = gw; row < NT; row += NGW) {
        const int b = row >> 11;
        const u32x4 ti = tin; const u32x2 tg = tgn;
        const size_t r1 = (size_t)tp[ti.x] * 256 + ti.y, r2 = (size_t)tp[ti.z] * 256 + ti.w; const float g1 = __uint_as_float(tg.x), g2 = __uint_as_float(tg.y);
        const GAS u32x2* y1 = (const GAS u32x2*)(YS + r1 * DM) + F.lane; const GAS u32x2* y2 = (const GAS u32x2*)(YS + r2 * DM) + F.lane; const GAS u32x2* xp = (const GAS u32x2*)(X1 + (size_t)row * DM) + F.lane;
        u32x2 ya[8], yb[8], xw[8]; f32x4 gt[8];
#pragma unroll
        for (int j = 0; j < 8; ++j) { ya[j] = y1[64 * j]; yb[j] = y2[64 * j]; xw[j] = xp[64 * j]; gt[j] = *(const GAS f32x4*)(mod + b * NMOD + 5 * DM + 4 * (F.lane + 64 * j)); }
        { const int rn = (row + NGW < NT) ? row + NGW : row; tin = *(const GAS u32x4*)(tokinfo + (size_t)rn * 8); tgn = *(const GAS u32x2*)(tokinfo + (size_t)rn * 8 + 4); }
        f32x4 v[8]; float ss = 0.f;
#pragma unroll
        for (int j = 0; j < 8; ++j) { const u32x2 a = ya[j], c = yb[j];
            v[j] = (f32x4){bf_lo(a.x), bf_hi(a.x), bf_lo(a.y), bf_hi(a.y)} * g1 + (f32x4){bf_lo(c.x), bf_hi(c.x), bf_lo(c.y), bf_hi(c.y)} * g2;
            ss += (v[j].x * v[j].x + v[j].y * v[j].y) + (v[j].z * v[j].z + v[j].w * v[j].w); }
        const float rs = rsqrtf(wave_sum_dpp(ss) * (1.f / DM) + RMS_EPS);
#pragma unroll
        for (int j = 0; j < 8; ++j) { const f32x4 xv = (f32x4){bf_lo(xw[j].x), bf_hi(xw[j].x), bf_lo(xw[j].y), bf_hi(xw[j].y)}; v[j] = xv + gt[j] * (v[j] * rs * gv[j]); }
#pragma unroll
        for (int j = 0; j < 8; ++j) ((GAS f32x4*)(out + (size_t)row * DM))[F.lane + 64 * j] = v[j];
    }
}

constexpr int NPH = 15;
__global__ void __launch_bounds__(NTHR, 2) mk_fwd(Args args) {
    extern __shared__ __attribute__((aligned(16))) unsigned char lds[];
    Frame F0;
    F0.lds = (LAS unsigned char*)lds; F0.MISC = (volatile LAS unsigned*)(F0.lds + MISC_OFF);
    F0.tid = threadIdx.x; F0.lane = F0.tid & 63; F0.wave = __builtin_amdgcn_readfirstlane(F0.tid >> 6);
    F0.G = gridDim.x; { const int bx = blockIdx.x; F0.vcu = (F0.G % 8 == 0) ? (bx % 8) * (F0.G / 8) + bx / 8 : bx; }
    F0.in.kp = (kargp_t)__builtin_amdgcn_kernarg_segment_ptr(); F0.out = args.out; F0.ws = args.ws; F0.ctl = (unsigned*)(args.ws + WS_CTL);
    if (F0.tid < 64) F0.MISC[F0.tid] = 0u;
    __syncthreads();
    const int lo = args.ph_lo, hi = args.ph_hi;
    XcdBarrier bar; bar.bar = F0.ctl + CW_BAR; bar.x = 0; bar.st = nullptr;
    if (hi - lo > 1) bar = xcd_barrier_post(F0.ctl + CW_BAR, F0.MISC + 8);
#ifndef PROBE_MASK
#define PROBE_MASK 0
#endif
#define REPS(k) ((((PROBE_MASK) >> (k)) & 1) + 1)
#define IN(k) (lo <= (k) && (k) < hi)
#define SEAM(k) do { if (IN(k) && IN((k) + 1)) xcd_barrier(bar); } while (0)
    LAS unsigned char* ring = F0.lds;

    if (IN(0)) for (int rep_ = 0; rep_ < REPS(0); ++rep_) { p0_prologue(F0); } SEAM(0);
    if (IN(1)) for (int rep_ = 0; rep_ < REPS(1); ++rep_) { p1_h1(F0); } SEAM(1);
    if (IN(2)) for (int rep_ = 0; rep_ < REPS(2); ++rep_) {
        PHASE_VIEW();
        const int G_GEMM = (F.G >= 256) ? CONV_GEMM_BLOCKS : F.G;
        if ((int)blockIdx.x < G_GEMM) {
            pg8::Gemm g{(const bf16*)(F.ws + WS_H), (const bf16*)(F.ws + WS_WIN_T), NT, DIN, DM}; pg8::StaticOrder S; S.init(g, G_GEMM, (int)blockIdx.x);
            pg8::EpiBf16 E{(bf16*)(F.ws + WS_PROJ), DIN};
            pg8::gemm_phase(ring, DM, S, E);
            __syncthreads();
            if (F.tid == 0 && rep_ == 0) { const unsigned d = atomicAdd(F.ctl + CW_GDONE, 1u); if (d == (unsigned)G_GEMM - 1u) __hip_atomic_store(F.ctl + CW_STOP, 1u, RLX_AGENT); }
        } else if (rep_ == 0) {
            const int jw = ((int)blockIdx.x - G_GEMM) * NWAVES + F.wave, ncw = (F.G - G_GEMM) * NWAVES;
            const int done = conv_stream(F, jw, ncw, CONV_MAIN, F.ctl + CW_STOP);
            if (F.lane == 0) __hip_atomic_store(F.ctl + CW_PROG + jw, (unsigned)done, RLX_AGENT);
        }
    } SEAM(2);
    if (IN(3)) for (int rep_ = 0; rep_ < REPS(3); ++rep_) {
        PHASE_VIEW();
        S5Order<1> S{(const char*)(F.ws + WS_PROJ), (const char*)(F.ws + WS_SIN), (const char*)(F.ws + WS_S5WT), F.G, F.vcu};
        pg8::EpiS5Scan E{(bf16*)(F.ws + WS_SIN), F.in[10], F.in[11], F.in[12]};
        if (F.G >= NG * 4) pg8::gemm_phase(ring, 256, S, E);
    }
    if (IN(3) && IN(4)) { asm volatile("s_waitcnt vmcnt(0)" ::: "memory"); __syncthreads(); __builtin_amdgcn_fence(__ATOMIC_ACQUIRE, "agent"); asm volatile("s_waitcnt vmcnt(0)" ::: "memory"); __syncthreads(); }
    if (IN(4)) for (int rep_ = 0; rep_ < REPS(4); ++rep_) {
        PHASE_VIEW();
        S5Order<2> S{(const char*)(F.ws + WS_PROJ), (const char*)(F.ws + WS_SIN), (const char*)(F.ws + WS_S5MT), F.G, F.vcu};
        pg8::EpiS5Y E{(bf16*)(F.ws + WS_YSG)};
        int kk = 384; LAUNDER(kk);
        pg8::gemm_phase(ring, kk, S, E);
    } SEAM(4);
    if (IN(5)) for (int rep_ = 0; rep_ < REPS(5); ++rep_) {
        PHASE_VIEW();
        pg8::Gemm g{(const bf16*)(F.ws + WS_YSG), (const bf16*)(F.ws + WS_GLU_T), NT, DSSM, DSSM}; pg8::StaticOrder S; S.init(g, F.G, (int)blockIdx.x);
        pg8::EpiGlu E{(const bf16*)(F.ws + WS_YSG), (bf16*)(F.ws + WS_MIX), DM, F.in[19]};
        pg8::gemm_phase(ring, DSSM, S, E);
    } SEAM(5);
    if (IN(6)) for (int rep_ = 0; rep_ < REPS(6); ++rep_) { p9a_rwkv_chunks(F0); } SEAM(6);
    if (IN(7)) for (int rep_ = 0; rep_ < REPS(7); ++rep_) { p9b_rwkv_seq(F0); } SEAM(7);
    if (IN(8)) for (int rep_ = 0; rep_ < REPS(8); ++rep_) { p9_rwkv_post(F0); } SEAM(8);
    if (IN(9)) for (int rep_ = 0; rep_ < REPS(9); ++rep_) {
        PHASE_VIEW();
        pg8::Gemm g{(const bf16*)(F.ws + WS_MIX), (const bf16*)(F.ws + WS_WOUT_T), NT, DM, DM}; pg8::StaticOrder S; S.init(g, F.G, (int)blockIdx.x);
        pg8::EpiBf16 E{(bf16*)(F.ws + WS_MIXED), DM};
        pg8::gemm_phase(ring, DM, S, E);
    } SEAM(9);
    if (IN(10)) for (int rep_ = 0; rep_ < REPS(10); ++rep_) { p11_x1_router(F0); }
    if (IN(11)) for (int rep_ = 0; rep_ < REPS(11); ++rep_) { p12_expert_convert(F0); } SEAM(11);
    if (IN(12)) for (int rep_ = 0; rep_ < REPS(12); ++rep_) {
        PHASE_VIEW();
        moe_build_tp(F);
        MoeOrder<true> S{(const LAS int*)(F.lds + TP_OFF), F.ctl + CW_CNT, (const int*)(F.ws + WS_LIST), (const char*)(F.ws + WS_H), (const char*)(F.ws + WS_EW1), F.G, (int)blockIdx.x};
        pg8::EpiSwiglu E{(bf16*)(F.ws + WS_HID)};
        pg8::gemm_phase(ring, DM, S, E);
        __syncthreads();
        for (;;) { int base = 0; if (F.lane == 0) base = (int)atomicAdd(F.ctl + CW_POOL, (unsigned)CONV_CLAIM); base = __builtin_amdgcn_readfirstlane(base);
            if (base >= CONV_POOL) break;
            (void)conv_stream(F, CONV_MAIN + base, 1, CONV_MAIN + (base + CONV_CLAIM < CONV_POOL ? base + CONV_CLAIM : CONV_POOL), F.ctl + CW_TMO + 2); }
    } SEAM(12);
    if (IN(13)) for (int rep_ = 0; rep_ < REPS(13); ++rep_) {
        PHASE_VIEW();
        moe_build_tp(F);
        MoeOrder<false> S{(const LAS int*)(F.lds + TP_OFF), F.ctl + CW_CNT, (const int*)(F.ws + WS_LIST), (const char*)(F.ws + WS_HID), (const char*)(F.ws + WS_EW2), F.G, (int)blockIdx.x};
        pg8::EpiBf16 E{(bf16*)(F.ws + WS_YSLOT), DM};
        pg8::gemm_phase(ring, DEXP, S, E);
    } SEAM(13);
    if (IN(14)) for (int rep_ = 0; rep_ < REPS(14); ++rep_) { moe_build_tp(F0); p15_final(F0); }
#undef IN
#undef SEAM
}

extern "C" void kernel_launch(void* const* d_in, const int* in_sizes, int n_in, void* d_out, int out_size, void* d_ws, size_t ws_size, hipStream_t stream) {
    static int grid = 0;
    if (grid == 0) {
        if (n_in != 38 || out_size != NT * DM || ws_size < WS_END) { fprintf(stderr, "kernel_launch: unexpected problem (n_in %d, out %d, ws %zu < %zu)\n", n_in, out_size, ws_size, (size_t)WS_END); grid = -1; return; }
        int dev = 0, cus = 0, per_cu = 0;
        if (hipGetDevice(&dev) != hipSuccess || hipDeviceGetAttribute(&cus, hipDeviceAttributeMultiprocessorCount, dev) != hipSuccess) { grid = -1; return; }
        if (hipFuncSetAttribute((const void*)mk_fwd, hipFuncAttributeMaxDynamicSharedMemorySize, LDS_BYTES) != hipSuccess) { fprintf(stderr, "kernel_launch: hipFuncSetAttribute failed\n"); grid = -1; return; }
        if (hipOccupancyMaxActiveBlocksPerMultiprocessor(&per_cu, (const void*)mk_fwd, NTHR, LDS_BYTES) != hipSuccess || per_cu < 1) fprintf(stderr, "kernel_launch: occupancy query says %d\n", per_cu);
        (void)hipGetLastError();
        grid = cus;
    }
    if (grid < 0) return;
    if (hipMemsetAsync((char*)d_ws + WS_CTL, 0, CTL_ZERO_BYTES, stream) != hipSuccess) return;
    Args a{};
    for (int i = 0; i < 38; ++i) a.in[i] = (const float*)d_in[i];
    a.out = (float*)d_out; a.ws = (unsigned char*)d_ws;
#if MK_N_LAUNCHES == 1
    a.ph_lo = 0; a.ph_hi = NPH;
    hipLaunchKernelGGL(mk_fwd, dim3(grid), dim3(NTHR), LDS_BYTES, stream, a);
#else
    for (int p = 0; p < NPH; ++p) { a.ph_lo = p; a.ph_hi = p + 1; hipLaunchKernelGGL(mk_fwd, dim3(grid), dim3(NTHR), LDS_BYTES, stream, a); }
#endif
}
```

```cpp
#include <hip/hip_runtime.h>
#include <cstdio>
#include <cstdint>

#ifndef MK_N_LAUNCHES
#define MK_N_LAUNCHES 1
#endif

#ifndef CONV_GEMM_BLOCKS
#define CONV_GEMM_BLOCKS 184
#endif

#define GAS __attribute__((address_space(1)))
namespace pg8 {
#define PG8_LAS __attribute__((address_space(3)))
typedef unsigned short bf16_t;
typedef short bf16x8 __attribute__((ext_vector_type(8)));
typedef float f32x4 __attribute__((ext_vector_type(4)));
typedef float f32x2 __attribute__((ext_vector_type(2)));
typedef unsigned u32x4 __attribute__((ext_vector_type(4)));
typedef unsigned u32x2 __attribute__((ext_vector_type(2)));
constexpr int BM = 256, BK = 64, HALF = 128, HTB = HALF * BK * 2, STAGE_BYTES = 8 * HTB, NXCD = 8, WGM = 8;

__host__ __device__ __forceinline__ int lds_byte(int r, int c) { const int st = (r >> 4) * 2 + (c >> 5), rr = r & 15, cc = c & 31, ob = rr * 64 + cc * 2; return st * 1024 + (ob ^ (((ob >> 9) & 1) << 5)); }
__host__ __device__ __forceinline__ void stage_rc(int b, int& R, int& C) { const int st = b / 1024, sb = b % 1024, swz = sb ^ (((sb >> 9) & 1) << 5); R = (st >> 1) * 16 + swz / 64; C = (st & 1) * 32 + (swz % 64) / 2; }
__host__ __device__ __forceinline__ int perm32(int rho) { const int n = rho >> 4, i = rho & 15; return 8 * (i >> 2) + 4 * n + (i & 3); }

struct Unit { int pm, pn, e, cnt; const char* Ab; const char* Bb; };
struct Gemm { const bf16_t* A; const bf16_t* Bt; int M, N, K; };

struct StaticOrder {
    static constexpr bool GATHER = false; static constexpr int A2 = 0;
    __device__ __forceinline__ size_t kstepA() const { return (size_t)BK * 2; }
    __device__ __forceinline__ size_t hstepA() const { return (size_t)HALF * K * 2; }
    __device__ __forceinline__ size_t a2off() const { return 0; }
    int nM, nN, nwg, G, c, K; const char* A; const char* Bt;
    __device__ void init(const Gemm& g, int G_, int c_) { nM = g.M / BM; nN = g.N / BM; nwg = nM * nN; G = G_; c = c_; K = g.K; A = (const char*)g.A; Bt = (const char*)g.Bt; }
    __device__ bool next(int i, Unit& u) const {
        const long L = (long)i * G + c; if (L >= nwg) return false;
        int wgid = (int)L; { const int q = nwg / NXCD, r = nwg % NXCD, xcd = wgid % NXCD, off = wgid / NXCD; wgid = (xcd < r ? xcd * (q + 1) : r * (q + 1) + (xcd - r) * q) + off; }
        const int nig = WGM * nN, gid = wgid / nig, fm = gid * WGM, gsz = (nM - fm) < WGM ? (nM - fm) : WGM;
        u.pm = fm + ((wgid % nig) % gsz); u.pn = (wgid % nig) / gsz; u.e = 0; u.cnt = BM;
        u.Ab = A + (size_t)u.pm * BM * K * 2; u.Bb = Bt + (size_t)u.pn * BM * K * 2; return true;
    }
    template <int NV> __device__ __forceinline__ void a_voff(const Unit&, unsigned (&v)[NV][2], const int (&R)[2], const int (&C)[2]) const {
#pragma unroll
        for (int i = 0; i < 2; ++i) v[0][i] = (unsigned)(R[i] * K + C[i]) * 2u;
    }
};

typedef __bf16 bf16x2_v __attribute__((ext_vector_type(2)));
__device__ __forceinline__ unsigned cvt_pk_bf16(float lo, float hi) { const f32x2 v = {lo, hi}; const bf16x2_v b = __builtin_convertvector(v, bf16x2_v); return __builtin_bit_cast(unsigned, b); }
__device__ __forceinline__ float bf_lo(unsigned w) { return __uint_as_float(w << 16); }
__device__ __forceinline__ float bf_hi(unsigned w) { return __uint_as_float(w & 0xffff0000u); }
__device__ __forceinline__ float sigmoidf_(float x) { return __builtin_amdgcn_rcpf(1.0f + __builtin_amdgcn_exp2f(-1.4426950408889634f * x)); }

struct EpiF32 {
    static constexpr bool AFTER_DRAIN = false; static constexpr bool PERM = false;
    float* C; int ldc;
    __device__ __forceinline__ void operator()(const f32x4 (&acc)[2][2][4][2], const Unit& u, int wr, int wc, int fr, int fq) const {
        const int row0 = u.pm * BM + wr * 64 + fr, col0 = u.pn * BM + wc * 32 + 4 * fq;
#pragma unroll
        for (int ai = 0; ai < 2; ++ai)
#pragma unroll
            for (int m = 0; m < 4; ++m) { float* rowp = C + (size_t)(row0 + ai * HALF + m * 16) * ldc + col0;
#pragma unroll
                for (int bj = 0; bj < 2; ++bj)
#pragma unroll
                    for (int n = 0; n < 2; ++n) *(f32x4*)(rowp + bj * HALF + n * 16) = acc[ai][bj][m][n]; }
    }
};
struct EpiBf16 {
    static constexpr bool AFTER_DRAIN = false; static constexpr bool PERM = true;
    bf16_t* O; int ldc;
    __device__ __forceinline__ void operator()(const f32x4 (&acc)[2][2][4][2], const Unit& u, int wr, int wc, int fr, int fq) const {
        const int row0 = u.pm * BM + wr * 64 + fr, col0 = u.pn * BM + wc * 32 + 8 * fq;
#pragma unroll
        for (int ai = 0; ai < 2; ++ai)
#pragma unroll
            for (int m = 0; m < 4; ++m) { GAS bf16_t* rowp = (GAS bf16_t*)O + (size_t)(row0 + ai * HALF + m * 16) * ldc + col0;
#pragma unroll
                for (int bj = 0; bj < 2; ++bj) { const f32x4 v0 = acc[ai][bj][m][0], v1 = acc[ai][bj][m][1];
                    u32x4 w; w.x = cvt_pk_bf16(v0[0], v0[1]); w.y = cvt_pk_bf16(v0[2], v0[3]); w.z = cvt_pk_bf16(v1[0], v1[1]); w.w = cvt_pk_bf16(v1[2], v1[3]);
                    *(GAS u32x4*)(rowp + bj * HALF) = w; } }
    }
};
struct EpiLora {
    static constexpr bool AFTER_DRAIN = false; static constexpr bool PERM = false;
    float* base; size_t stride; const float* w0; const float* a0;
    __device__ __forceinline__ void operator()(const f32x4 (&acc)[2][2][4][2], const Unit& u, int wr, int wc, int fr, int fq) const {
        const int row0 = u.pm * BM + wr * 64 + fr; const int kind = u.pn >> 2; const int col0 = (u.pn & 3) * BM + wc * 32 + 4 * fq;
        float* dst = base + (size_t)kind * stride;
        const float* bp = (kind == 0) ? w0 : a0; const float bs = (kind == 2) ? 0.f : 1.f;
        f32x4 bv[2][2];
#pragma unroll
        for (int bj = 0; bj < 2; ++bj)
#pragma unroll
            for (int n = 0; n < 2; ++n) bv[bj][n] = *(const f32x4*)(bp + col0 + bj * HALF + n * 16) * bs;
#pragma unroll
        for (int ai = 0; ai < 2; ++ai)
#pragma unroll
            for (int m = 0; m < 4; ++m) { float* rowp = dst + (size_t)(row0 + ai * HALF + m * 16) * 1024 + col0;
#pragma unroll
                for (int bj = 0; bj < 2; ++bj)
#pragma unroll
                    for (int n = 0; n < 2; ++n) { f32x4 v = acc[ai][bj][m][n] + bv[bj][n];
                        if (kind == 0) {
#pragma unroll
                            for (int j = 0; j < 4; ++j) v[j] = __expf(-0.6065306597126334f * sigmoidf_(v[j])); }
                        else if (kind == 1) {
#pragma unroll
                            for (int j = 0; j < 4; ++j) v[j] = sigmoidf_(v[j]); }
                        *(f32x4*)(rowp + bj * HALF + n * 16) = v; } }
    }
};
struct EpiGlu {
    static constexpr bool AFTER_DRAIN = false; static constexpr bool PERM = true;
    const bf16_t* Y; bf16_t* O; int ldo; const float* bias;
    __device__ __forceinline__ void operator()(const f32x4 (&acc)[2][2][4][2], const Unit& u, int wr, int wc, int fr, int fq) const {
        const int row0 = u.pm * BM + wr * 64 + fr, col0 = u.pn * BM + wc * 32 + 8 * fq;
        f32x4 bv[2][2];
#pragma unroll
        for (int bj = 0; bj < 2; ++bj)
#pragma unroll
            for (int n = 0; n < 2; ++n) bv[bj][n] = *(const GAS f32x4*)((const GAS float*)bias + col0 + bj * HALF + 4 * n);
#pragma unroll
        for (int ai = 0; ai < 2; ++ai)
#pragma unroll
            for (int m = 0; m < 4; ++m) { const size_t r = (size_t)(row0 + ai * HALF + m * 16);
#pragma unroll
                for (int bj = 0; bj < 2; ++bj) { const u32x4 yv = *(const GAS u32x4*)((const GAS bf16_t*)Y + r * 1024 + col0 + bj * HALF);
                    const f32x4 v0 = acc[ai][bj][m][0] + bv[bj][0], v1 = acc[ai][bj][m][1] + bv[bj][1];
                    u32x4 w;
                    w.x = cvt_pk_bf16(bf_lo(yv.x) * sigmoidf_(v0[0]), bf_hi(yv.x) * sigmoidf_(v0[1]));
                    w.y = cvt_pk_bf16(bf_lo(yv.y) * sigmoidf_(v0[2]), bf_hi(yv.y) * sigmoidf_(v0[3]));
                    w.z = cvt_pk_bf16(bf_lo(yv.z) * sigmoidf_(v1[0]), bf_hi(yv.z) * sigmoidf_(v1[1]));
                    w.w = cvt_pk_bf16(bf_lo(yv.w) * sigmoidf_(v1[2]), bf_hi(yv.w) * sigmoidf_(v1[3]));
                    *(GAS u32x4*)((GAS bf16_t*)O + r * ldo + col0 + bj * HALF) = w; } }
    }
};
struct EpiSwiglu {
    static constexpr bool AFTER_DRAIN = false; static constexpr bool PERM = true;
    bf16_t* Hd;
    __device__ __forceinline__ void operator()(const f32x4 (&acc)[2][2][4][2], const Unit& u, int wr, int wc, int fr, int fq) const {
        const int row0 = u.pm * BM + wr * 64 + fr, col0 = u.pn * HALF + wc * 32 + 8 * fq;
#pragma unroll
        for (int ai = 0; ai < 2; ++ai)
#pragma unroll
            for (int m = 0; m < 4; ++m) { GAS bf16_t* rowp = (GAS bf16_t*)Hd + (size_t)(row0 + ai * HALF + m * 16) * 512 + col0;
                float o[8];
#pragma unroll
                for (int n = 0; n < 2; ++n)
#pragma unroll
                    for (int j = 0; j < 4; ++j) { const float a = acc[ai][0][m][n][j], b = acc[ai][1][m][n][j]; o[n * 4 + j] = a * sigmoidf_(a) * b; }
                u32x4 w; w.x = cvt_pk_bf16(o[0], o[1]); w.y = cvt_pk_bf16(o[2], o[3]); w.z = cvt_pk_bf16(o[4], o[5]); w.w = cvt_pk_bf16(o[6], o[7]);
                *(GAS u32x4*)rowp = w; }
    }
};

struct EpiS5Scan {
    static constexpr bool AFTER_DRAIN = true; static constexpr bool PERM = false;
    bf16_t* SIN; const float* lam_re; const float* lam_im; const float* log_dt;
    __device__ __forceinline__ void operator()(const f32x4 (&)[2][2][4][2], const Unit&, int, int, int, int) const {}
    __device__ __forceinline__ void fused(const f32x4 (&acc)[2][2][4][2], const Unit& u, int wr, int wc, int fr, int fq, PG8_LAS unsigned char* lds) const {
        PG8_LAS float* T = (PG8_LAS float*)lds;
#pragma unroll
        for (int ai = 0; ai < 2; ++ai)
#pragma unroll
            for (int m = 0; m < 4; ++m)
#pragma unroll
                for (int n = 0; n < 2; ++n) *(PG8_LAS f32x4*)(T + (ai * HALF + wr * 64 + m * 16 + fr) * 128 + wc * 32 + n * 16 + 4 * fq) = acc[ai][0][m][n];
        __syncthreads();
        const int tid = threadIdx.x;
        if (tid < 128) {
            const int b2 = tid >> 6, p = tid & 63, g = u.e;
            const float lr = fminf(lam_re[g * 64 + p], -1e-4f), li = lam_im[g * 64 + p], dt = __expf(log_dt[g]);
            const float mag = __expf(lr * dt * 16.f), ang = li * dt * 16.f; const float ar = mag * cosf(ang), ai_ = mag * sinf(ang);
            float sr = 0.f, si = 0.f;
            GAS bf16_t* dst = (GAS bf16_t*)SIN + ((size_t)(u.pm * 256 + b2 * 128) * 16 + (p >> 4)) * 4352 + g * 16 + (p & 15);
            const PG8_LAS float* src = T + (b2 * 128) * 128 + p;
#pragma unroll 8
            for (int ch = 0; ch < 128; ++ch) {
                const unsigned w = cvt_pk_bf16(sr, si);
                dst[(size_t)ch * 16 * 4352] = (bf16_t)(w & 0xffffu); dst[(size_t)ch * 16 * 4352 + 4 * 4352] = (bf16_t)(w >> 16);
                const float lr_ = src[ch * 128], li_ = src[ch * 128 + 64];
                const float nr = ar * sr - ai_ * si + lr_, ni = ar * si + ai_ * sr + li_; sr = nr; si = ni;
            }
        }
    }
};
__device__ __forceinline__ float gelu_tanh_(float y) { const float u = 0.7978845608028654f * (y + 0.044715f * y * y * y); const float e = __builtin_amdgcn_exp2f(2.8853900817779268f * u); return y * (1.f - __builtin_amdgcn_rcpf(e + 1.f)); }
struct EpiS5Y {
    static constexpr bool AFTER_DRAIN = false; static constexpr bool PERM = true;
    bf16_t* Y;
    __device__ __forceinline__ void operator()(const f32x4 (&acc)[2][2][4][2], const Unit& u, int wr, int wc, int fr, int fq) const {
        const int row0 = u.pm * BM + wr * 64 + fr;
#pragma unroll
        for (int ai = 0; ai < 2; ++ai)
#pragma unroll
            for (int m = 0; m < 4; ++m) { const size_t r = (size_t)(row0 + ai * HALF + m * 16);
#pragma unroll
                for (int bj = 0; bj < 2; ++bj) { const int col = bj * HALF + wc * 32 + 8 * fq; const int t = col >> 4, c = col & 15;
                    const f32x4 v0 = acc[ai][bj][m][0], v1 = acc[ai][bj][m][1];
                    u32x4 w; w.x = cvt_pk_bf16(gelu_tanh_(v0[0]), gelu_tanh_(v0[1])); w.y = cvt_pk_bf16(gelu_tanh_(v0[2]), gelu_tanh_(v0[3]));
                    w.z = cvt_pk_bf16(gelu_tanh_(v1[0]), gelu_tanh_(v1[1])); w.w = cvt_pk_bf16(gelu_tanh_(v1[2]), gelu_tanh_(v1[3]));
                    *(GAS u32x4*)((GAS bf16_t*)Y + (r * 16 + t) * 1024 + u.e * 16 + c) = w; } }
    }
};

template <class Epi, class Sched>
__device__ __forceinline__ void gemm_phase(PG8_LAS unsigned char* lds, const int K, const Sched& S, const Epi& E) {
    const int tid = threadIdx.x, wid = __builtin_amdgcn_readfirstlane(tid >> 6), lane = tid & 63, wr = wid >> 2, wc = wid & 3, fr = lane & 15, fq = lane >> 4;
    const int nt = K / BK;
    int RR[2], CC[2]; unsigned voffB[2];
#pragma unroll
    for (int i = 0; i < 2; ++i) { stage_rc(tid * 16 + i * 8192, RR[i], CC[i]); const int Rb = Epi::PERM ? ((RR[i] & ~31) + perm32(RR[i] & 31)) : RR[i];
        voffB[i] = (unsigned)(Rb * K + CC[i]) * 2u; }
    const size_t kstep = (size_t)(BK * 2);
    const size_t hstep = (size_t)HALF * K * 2;
    const unsigned ldsw = (unsigned)wid * 1024u;
    const int aoff = lds_byte(wr * 64 + fr, fq * 8), boff = lds_byte(wc * 32 + fr, fq * 8);
#define PG8_SA(b, h) (((b) * 2 + (h)) * HTB)
#define PG8_SB(b, h) ((4 + (b) * 2 + (h)) * HTB)
#define PG8_STAGE(bufoff, gbase, voff) do { _Pragma("unroll") for (int _i = 0; _i < 2; ++_i) \
        __builtin_amdgcn_global_load_lds((const unsigned*)((const char*)(gbase) + (voff)[_i]), (PG8_LAS unsigned*)(lds + (bufoff) + ldsw + _i * 8192), 16, 0, 0); } while (0)
#define PG8_LDA(dst, b, h) do { _Pragma("unroll") for (int m = 0; m < 4; ++m) _Pragma("unroll") for (int k = 0; k < 2; ++k) dst[m][k] = *(const PG8_LAS bf16x8*)(lds + PG8_SA(b, h) + aoff + m * 2048 + k * 1024); } while (0)
#define PG8_LDB(dst, b, h) do { _Pragma("unroll") for (int n = 0; n < 2; ++n) _Pragma("unroll") for (int k = 0; k < 2; ++k) dst[n][k] = *(const PG8_LAS bf16x8*)(lds + PG8_SB(b, h) + boff + n * 2048 + k * 1024); } while (0)
#define PG8_MMA(ai, bj, At, Bt) do { __builtin_amdgcn_s_setprio(1); _Pragma("unroll") for (int m = 0; m < 4; ++m) _Pragma("unroll") for (int n = 0; n < 2; ++n) _Pragma("unroll") for (int k = 0; k < 2; ++k) \
        acc[ai][bj][m][n] = __builtin_amdgcn_mfma_f32_16x16x32_bf16(Bt[n][k], At[m][k], acc[ai][bj][m][n], 0, 0, 0); __builtin_amdgcn_s_setprio(0); } while (0)
#define PG8_WAIT_V(n) asm volatile("s_waitcnt vmcnt(" #n ")" ::: "memory")
#define PG8_WAIT_L(n) asm volatile("s_waitcnt lgkmcnt(" #n ")" ::: "memory")
#define PG8_BAR __builtin_amdgcn_s_barrier()
#define PG8_SCHED __builtin_amdgcn_sched_barrier(0)
    Unit cur, nxt; int ui = 0;
    if (!S.next(0, cur)) return;
    f32x4 acc[2][2][4][2];
#pragma unroll
    for (int a = 0; a < 2; ++a)
#pragma unroll
        for (int b = 0; b < 2; ++b)
#pragma unroll
            for (int m = 0; m < 4; ++m)
#pragma unroll
                for (int n = 0; n < 2; ++n) acc[a][b][m][n] = (f32x4){0.f, 0.f, 0.f, 0.f};
    bf16x8 At[4][2], B0[2][2], B1[2][2];
    constexpr bool GA = Sched::GATHER;
    constexpr int A2 = Sched::A2;
    constexpr int NV = GA ? 2 : 1;
    unsigned vA[NV][2], vN[NV][2];
    const size_t kstepA = S.kstepA(), hstepA = GA ? 0 : S.hstepA();
    const size_t a2off = (A2 > 0) ? S.a2off() : 0;
    S.template a_voff<NV>(cur, vA, RR, CC);
    const char* cA = cur.Ab; const char* cB = cur.Bb;
    PG8_STAGE(PG8_SB(0, 0), cB, voffB); PG8_STAGE(PG8_SB(0, 1), cB + hstep, voffB); PG8_STAGE(PG8_SA(0, 0), cA, vA[0]); PG8_STAGE(PG8_SA(0, 1), cA + hstepA, vA[NV - 1]);
    if (wr == 1) PG8_BAR;
    PG8_WAIT_V(2); PG8_BAR;
    PG8_STAGE(PG8_SB(1, 0), cB + kstep, voffB); PG8_STAGE(PG8_SA(1, 0), cA + kstepA, vA[0]); PG8_STAGE(PG8_SB(1, 1), cB + hstep + kstep, voffB);
    PG8_WAIT_V(6); PG8_BAR;
    for (;;) {
        const bool has_next = S.next(ui + 1, nxt);
        const char* nA = has_next ? nxt.Ab : cA; const char* nB = has_next ? nxt.Bb : cB;
        if constexpr (GA) {
            if (has_next) S.template a_voff<NV>(nxt, vN, RR, CC);
            else {
#pragma unroll
                for (int h = 0; h < NV; ++h)
#pragma unroll
                    for (int i = 0; i < 2; ++i) vN[h][i] = vA[h][i]; }
        }
#pragma clang loop unroll(disable)
        for (int t = 0; t < nt; t += 2) {
            const bool last = (t == nt - 2);
            const bool s1 = (A2 > 0) && (t + 1 >= A2), s2 = (A2 > 0) && !last && (t + 2 >= A2);
            const char* a1 = cA + (size_t)(t + 1) * kstepA + (s1 ? a2off : 0);
            const char* a2 = last ? nA : cA + (size_t)(t + 2) * kstepA + (s2 ? a2off : 0);
            const char* a3 = a2 + kstepA;
            const char* b2 = last ? nB : cB + (size_t)(t + 2) * kstep; const char* b3 = b2 + kstep;
            unsigned v2[NV][2];
#pragma unroll
            for (int h = 0; h < NV; ++h)
#pragma unroll
                for (int i = 0; i < 2; ++i) v2[h][i] = (GA && last) ? vN[h][i] : vA[h][i];
            PG8_LDB(B0, 0, 0); PG8_LDB(B1, 0, 1); PG8_SCHED; PG8_LDA(At, 0, 0); PG8_STAGE(PG8_SA(1, 1), a1 + hstepA, vA[NV - 1]);
            PG8_WAIT_V(8); PG8_WAIT_L(0); PG8_BAR; PG8_MMA(0, 0, At, B0); PG8_MMA(0, 1, At, B1); PG8_BAR; PG8_SCHED;
            PG8_LDA(At, 0, 1); PG8_STAGE(PG8_SB(0, 0), b2, voffB); PG8_STAGE(PG8_SB(0, 1), b2 + hstep, voffB); PG8_STAGE(PG8_SA(0, 0), a2, v2[0]);
            PG8_WAIT_V(8); PG8_WAIT_L(0); PG8_BAR; PG8_MMA(1, 0, At, B0); PG8_MMA(1, 1, At, B1); PG8_BAR; PG8_SCHED;
            PG8_LDB(B0, 1, 0); PG8_LDB(B1, 1, 1); PG8_SCHED; PG8_LDA(At, 1, 0); PG8_STAGE(PG8_SA(0, 1), a2 + hstepA, v2[NV - 1]);
            PG8_WAIT_V(8); PG8_WAIT_L(0); PG8_BAR; PG8_MMA(0, 0, At, B0); PG8_MMA(0, 1, At, B1); PG8_BAR; PG8_SCHED;
            PG8_LDA(At, 1, 1); PG8_STAGE(PG8_SB(1, 0), b3, voffB); PG8_STAGE(PG8_SB(1, 1), b3 + hstep, voffB); PG8_STAGE(PG8_SA(1, 0), a3, v2[0]);
            PG8_WAIT_V(8); PG8_WAIT_L(0); PG8_BAR; PG8_MMA(1, 0, At, B0); PG8_MMA(1, 1, At, B1); PG8_BAR; PG8_SCHED;
        }
        if (wr == 0) PG8_BAR;
        if constexpr (!Epi::AFTER_DRAIN) E(acc, cur, wr, wc, fr, fq);
        if (!has_next) break;
#pragma unroll
        for (int a = 0; a < 2; ++a)
#pragma unroll
            for (int b = 0; b < 2; ++b)
#pragma unroll
                for (int m = 0; m < 4; ++m)
#pragma unroll
                    for (int n = 0; n < 2; ++n) acc[a][b][m][n] = (f32x4){0.f, 0.f, 0.f, 0.f};
        cur = nxt; cA = nA; cB = nB; ++ui;
        if constexpr (GA) {
#pragma unroll
            for (int h = 0; h < NV; ++h)
#pragma unroll
                for (int i = 0; i < 2; ++i) vA[h][i] = vN[h][i]; }
        if (wr == 1) PG8_BAR;
    }
    PG8_WAIT_V(0);
    PG8_BAR;
    if constexpr (Epi::AFTER_DRAIN) E.fused(acc, cur, wr, wc, fr, fq, lds);
#undef PG8_SA
#undef PG8_SB
#undef PG8_STAGE
#undef PG8_LDA
#undef PG8_LDB
#undef PG8_MMA
#undef PG8_WAIT_V
#undef PG8_WAIT_L
#undef PG8_BAR
#undef PG8_SCHED
}
}
using pg8::f32x4; using pg8::f32x2; using pg8::u32x4; using pg8::u32x2; using pg8::cvt_pk_bf16; using pg8::bf_lo; using pg8::bf_hi; using pg8::sigmoidf_;

constexpr int NWAVES = 8, NTHR = 512;
constexpr int DM = 2048, NB = 8, SEQ = 2048, NT = NB * SEQ;
constexpr int DSSM = 1024, NG = 64, GC = 16, NP = 64;
constexpr int DRW = 1024, NH = 16, HD = 64;
constexpr int DIN = 4352, ZW = 3328;
constexpr int NEXP = 64, DEXP = 512, NMOD = 6 * DM;
constexpr float RMS_EPS = 1e-6f, GN_EPS = 64e-5f;
constexpr int CAP_ROWS = 49152;

constexpr size_t MiB = 1u << 20;
constexpr size_t WS_CTL = 0, CTL_ZERO_BYTES = 1 * MiB;
constexpr size_t WS_MOD = 1 * MiB;
constexpr size_t WS_RWT = 1 * MiB + 512 * 1024;
constexpr size_t WS_LORA_T = 2 * MiB + 512 * 1024;
constexpr size_t WS_GLU_T = 4 * MiB;
constexpr size_t WS_WOUT_T = 6 * MiB;
constexpr size_t WS_WIN_T = 14 * MiB;
constexpr size_t WS_TOKINFO = 31 * MiB;
constexpr size_t WS_LIST = 32 * MiB;
constexpr size_t WS_LIN = 36 * MiB;
constexpr size_t WS_H = 44 * MiB;
constexpr size_t WS_PROJ = 108 * MiB;
constexpr size_t WS_MIX = 244 * MiB;
constexpr size_t WS_EW1 = 308 * MiB;
constexpr size_t WS_EW2 = 564 * MiB;
constexpr size_t WS_SIN = 692 * MiB;
constexpr size_t WS_YSG = 44 * MiB;
constexpr size_t WS_S5MT = 860 * MiB;
constexpr size_t WS_S5WT = 872 * MiB;
constexpr size_t WS_VB = 692 * MiB;
constexpr size_t WS_GB = 724 * MiB;
constexpr size_t WS_GHQ = 756 * MiB;
constexpr size_t WS_GT = 948 * MiB;
constexpr size_t WS_BON = 950 * MiB;
constexpr size_t WS_Y = 952 * MiB;
constexpr size_t WS_X1 = 692 * MiB;
constexpr size_t WS_HID = 756 * MiB;
constexpr size_t WS_END = 984 * MiB;
constexpr size_t WS_MIXED = 108 * MiB;
constexpr size_t WS_YSLOT = 108 * MiB;
static_assert(WS_YSLOT + (size_t)CAP_ROWS * 2048 * 2 <= WS_EW1, "yslot overlay");
static_assert(WS_HID + (size_t)CAP_ROWS * 512 * 2 <= WS_END && WS_GHQ + (size_t)8192 * 12288 * 2 <= WS_GT && WS_SIN + (size_t)NT * DIN * 2 <= WS_S5MT, "pool");
constexpr int CW_TMO = 0;
constexpr int CW_BAR = 4096;
constexpr int CW_CNT = 16384;
constexpr int CW_GDONE = 8192, CW_STOP = 8192 + 64, CW_PROG = 8192 + 128;
constexpr int CONV_ITEMS = NEXP * 1536;
constexpr int CONV_POOL = 32768, CONV_MAIN = CONV_ITEMS - CONV_POOL, CONV_CLAIM = 12;
constexpr int CW_POOL = 12288;


constexpr int RING_BYTES = 131072;
constexpr int LDSCTL_OFF = 147456 - 2048;
constexpr int MISC_OFF = LDSCTL_OFF;
constexpr int TP_OFF = LDSCTL_OFF + 256;
constexpr int LDS_BYTES = 147456;

#define LAS __attribute__((address_space(3)))
typedef unsigned short bf16;
typedef GAS unsigned gu32;
#define RLX_AGENT __ATOMIC_RELAXED, __HIP_MEMORY_SCOPE_AGENT

#define XB_TMO      128
#define XB_XCNT(j)  (256  + 64 * (j))
#define XB_XSUB(j)  (1280 + 64 * (j))
#define XB_XGEN(j)  (2304 + 64 * (j))
#define XB_TOP      3328
#define XB_TOPGEN   3392
#define XCD_BAR_WORDS 3456
#define XB_SPIN_CAP (1u << 18)
__device__ __forceinline__ unsigned xb_ld(unsigned* p)              { return __hip_atomic_load(p, __ATOMIC_RELAXED, __HIP_MEMORY_SCOPE_AGENT); }
__device__ __forceinline__ unsigned xb_add(unsigned* p, unsigned v) { return __hip_atomic_fetch_add(p, v, __ATOMIC_RELAXED, __HIP_MEMORY_SCOPE_AGENT); }
__device__ __forceinline__ unsigned xb_xcc_id() { return (unsigned)__builtin_amdgcn_s_getreg((3 << 11) | 20) & 0xFu; }
#define XB_SPIN(cond, bar) do { unsigned _sp = 0; while (cond) { __builtin_amdgcn_s_sleep(1); \
    if ((++_sp & 255u) == 0u) { if (xb_ld(&(bar)[XB_TMO])) break; if (_sp > XB_SPIN_CAP) { atomicAdd(&(bar)[XB_TMO], 1u); break; } } } } while (0)
struct XcdBarrier { unsigned* bar; unsigned x; volatile LAS unsigned* st; };
__device__ __forceinline__ XcdBarrier xcd_barrier_post(unsigned* bar, volatile LAS unsigned* st) {
    XcdBarrier b; b.bar = bar; b.x = xb_xcc_id(); b.st = st;
    if (threadIdx.x == 0) (void)xb_add(&bar[XB_XCNT(b.x)], 1u);
    return b;
}
__device__ __forceinline__ void xcd_barrier_complete(unsigned* bar, unsigned x, unsigned& nloc, unsigned& nx) {
    const unsigned G = gridDim.x * gridDim.y * gridDim.z;
    unsigned sum, cnt, mine, sp = 0u;
    for (;;) {
        sum = 0u; cnt = 0u; mine = 0u;
#pragma unroll
        for (unsigned j = 0; j < 16; ++j) { const unsigned c = xb_ld(&bar[XB_XCNT(j)]); sum += c; cnt += (c > 0u) ? 1u : 0u; mine = (j == x) ? c : mine; }
        if (sum == G) break;
        __builtin_amdgcn_s_sleep(1);
        if ((++sp & 255u) == 0u) { if (xb_ld(&bar[XB_TMO])) break; if (sp > XB_SPIN_CAP) { atomicAdd(&bar[XB_TMO], 1u); break; } }
    }
    nloc = mine > 0u ? mine : 1u; nx = cnt > 0u ? cnt : 1u;
}
__device__ __forceinline__ void xcd_barrier(const XcdBarrier& b) {
    asm volatile("s_waitcnt vmcnt(0)" ::: "memory");
    __syncthreads();
    if (threadIdx.x == 0) {
        unsigned* bar = b.bar;
        __builtin_amdgcn_s_waitcnt(0);
        unsigned nloc = b.st[0], nx = b.st[1];
        if (nloc == 0u) { xcd_barrier_complete(bar, b.x, nloc, nx); b.st[0] = nloc; b.st[1] = nx; }
        const unsigned old = xb_add(&bar[XB_XSUB(b.x)], 1u);
        const unsigned gen = old / nloc;
        if (old + 1u == (gen + 1u) * nloc) {
            __builtin_amdgcn_fence(__ATOMIC_RELEASE, "agent");
            asm volatile("s_waitcnt vmcnt(0)" ::: "memory");
            const unsigned og = xb_add(&bar[XB_TOP], 1u);
            const unsigned tg = og / nx;
            if (og + 1u == (tg + 1u) * nx) xb_add(&bar[XB_TOPGEN], 1u);
            else XB_SPIN(xb_ld(&bar[XB_TOPGEN]) == tg, bar);
            __builtin_amdgcn_fence(__ATOMIC_ACQUIRE, "agent");
            xb_add(&bar[XB_XGEN(b.x)], 1u);
            asm volatile("s_waitcnt vmcnt(0)" ::: "memory");
        } else {
            XB_SPIN(xb_ld(&bar[XB_XGEN(b.x)]) == gen, bar);
            __builtin_amdgcn_fence(__ATOMIC_ACQUIRE, "agent");
            asm volatile("s_waitcnt vmcnt(0)" ::: "memory");
        }
    }
    __syncthreads();
}

struct Args { const float* in[38]; float* out; unsigned char* ws; int ph_lo, ph_hi; };
typedef const float* cfp_t;
typedef __attribute__((address_space(4))) const unsigned char* kargp_t;
struct InTab { kargp_t kp;
    __device__ __forceinline__ const float* operator[](int i) const { return *(const __attribute__((address_space(4))) cfp_t*)(kp + 8 * i); } };
struct Frame {
    LAS unsigned char* lds; volatile LAS unsigned* MISC; unsigned* ctl;
    int tid, lane, wave, vcu, G;
    InTab in; float* out; unsigned char* ws;
};
#define LDS_WAIT() asm volatile("s_waitcnt lgkmcnt(0)" ::: "memory")
#define LAUNDER(p) asm volatile("" : "+s"(p))
#define LDS_BARRIER() do { asm volatile("s_waitcnt lgkmcnt(0)" ::: "memory"); __builtin_amdgcn_s_barrier(); asm volatile("" ::: "memory"); } while (0)
#define PHASE_VIEW() Frame F = F0; LAUNDER(F.ws); LAUNDER(F.in.kp); LAUNDER(F.ctl)
__device__ __forceinline__ float wave_sum(float v) {
#pragma unroll
    for (int o = 1; o < 64; o <<= 1) v += __shfl_xor(v, o);
    return v;
}
__device__ __forceinline__ float wave_max(float v) {
#pragma unroll
    for (int o = 1; o < 64; o <<= 1) v = fmaxf(v, __shfl_xor(v, o));
    return v;
}
__device__ __forceinline__ float row16_sum(float x) {
    x += __builtin_bit_cast(float, __builtin_amdgcn_update_dpp(0, __builtin_bit_cast(int, x), 0xB1, 0xf, 0xf, false));
    x += __builtin_bit_cast(float, __builtin_amdgcn_update_dpp(0, __builtin_bit_cast(int, x), 0x4E, 0xf, 0xf, false));
    x += __builtin_bit_cast(float, __builtin_amdgcn_update_dpp(0, __builtin_bit_cast(int, x), 0x141, 0xf, 0xf, false));
    x += __builtin_bit_cast(float, __builtin_amdgcn_update_dpp(0, __builtin_bit_cast(int, x), 0x140, 0xf, 0xf, false));
    return x;
}
__device__ __forceinline__ unsigned pk2(float lo, float hi) { return cvt_pk_bf16(lo, hi); }
__device__ __forceinline__ float bf2f(bf16 b) { return __uint_as_float(((unsigned)b) << 16); }
__device__ __forceinline__ float gelu_tanh(float y) { const float u = 0.7978845608028654f * (y + 0.044715f * y * y * y); const float e = __expf(2.f * u); const float th = 1.f - 2.f / (e + 1.f); return 0.5f * y * (1.f + th); }

__device__ __forceinline__ void transpose_item(const float* W, int N, bf16* WT, int ldk, int dst_row0, int k0, int n0, int kdst0, LAS float* scr, int lane) {
    float tv[32];
#pragma unroll
    for (int i = 0; i < 32; ++i) tv[i] = W[(size_t)(k0 + 2 * i + (lane >> 5)) * N + n0 + (lane & 31)];
#pragma unroll
    for (int i = 0; i < 32; ++i) scr[(2 * i + (lane >> 5)) * 33 + (lane & 31)] = tv[i];
    LDS_WAIT(); asm volatile("" ::: "memory");
    const int c = lane & 7;
#pragma unroll
    for (int j = 0; j < 4; ++j) { const int n = (lane >> 3) + 8 * j; const LAS float* s = scr + (8 * c) * 33 + n;
        u32x4 o; o.x = pk2(s[0 * 33], s[1 * 33]); o.y = pk2(s[2 * 33], s[3 * 33]); o.z = pk2(s[4 * 33], s[5 * 33]); o.w = pk2(s[6 * 33], s[7 * 33]);
        *(u32x4*)(WT + (size_t)(dst_row0 + n) * ldk + kdst0 + 8 * c) = o; }
    LDS_WAIT(); asm volatile("" ::: "memory");
}

constexpr int PROJ_PITCH = DIN * 2;
template <int PASS> struct S5Order {
    static constexpr bool GATHER = false; static constexpr int A2 = PASS == 2 ? 4 : 0;
    static constexpr int KB = PASS == 2 ? 384 : 256;
    const char* U; const char* SIN; const char* BT; int G, c;
    __device__ __forceinline__ size_t kstepA() const { return (size_t)4 * PROJ_PITCH; }
    __device__ __forceinline__ size_t hstepA() const { return (size_t)128 * 16 * PROJ_PITCH; }
    __device__ __forceinline__ size_t a2off() const { return (size_t)(SIN - U) - (size_t)A2 * kstepA(); }
    __device__ bool next(int i, pg8::Unit& u) const {
        const int L = i * G + c; if (L >= NG * 4) return false;
        const int g = L >> 2, pm = L & 3; u.e = g; u.pm = pm; u.pn = 0; u.cnt = 256;
        u.Ab = U + (size_t)g * 32 + (size_t)pm * 256 * 16 * PROJ_PITCH; u.Bb = BT + (size_t)g * 256 * KB * 2;
        return true;
    }
    template <int NV> __device__ __forceinline__ void a_voff(const pg8::Unit&, unsigned (&v)[NV][2], const int (&R)[2], const int (&C)[2]) const {
#pragma unroll
        for (int i = 0; i < 2; ++i) v[0][i] = (unsigned)(R[i] * 16 * PROJ_PITCH + (C[i] >> 4) * PROJ_PITCH + (C[i] & 15) * 2);
    }
};
__device__ __forceinline__ void s5_build(const Frame& F, int g) {
    const float* lam_re = F.in[10]; const float* lam_im = F.in[11]; const float* log_dt = F.in[12];
    const float* b_re = F.in[13]; const float* b_im = F.in[14]; const float* c_re = F.in[15]; const float* c_im = F.in[16]; const float* dsk = F.in[17];
    constexpr int PC = 68;
    LAS float* pw2 = (LAS float*)F.lds;
    LAS float* bbr = pw2 + 17 * 64 * 2; LAS float* bbi = bbr + 1024;
    LAS float* cre = bbi + 1024; LAS float* cim = cre + 16 * PC; LAS float* dsl = cim + 16 * PC; LAS float* Kt = dsl + 16;
    bf16* MT = (bf16*)(F.ws + WS_S5MT) + (size_t)g * 256 * 384; bf16* WT = (bf16*)(F.ws + WS_S5WT) + (size_t)g * 256 * 256;
    const float dt = __expf(log_dt[g]);
    __syncthreads();
    for (int i = F.tid; i < 17 * 64; i += NTHR) { const int tau = i >> 6, p = i & 63; const float lr = fminf(lam_re[g * NP + p], -1e-4f), li = lam_im[g * NP + p];
        const float mag = __expf(lr * dt * (float)tau), ang = li * dt * (float)tau; pw2[2 * i] = mag * cosf(ang); pw2[2 * i + 1] = mag * sinf(ang); }
    for (int i = F.tid; i < 1024; i += NTHR) { const int p = i >> 4; const float lr = fminf(lam_re[g * NP + p], -1e-4f), li = lam_im[g * NP + p];
        const float mag = __expf(lr * dt), ang = li * dt; const float ar = mag * cosf(ang), ai = mag * sinf(ang), den = lr * lr + li * li;
        const float qr = ((ar - 1.f) * lr + ai * li) / den, qi = (ai * lr - (ar - 1.f) * li) / den;
        const float br = b_re[(size_t)g * 1024 + i], bi = b_im[(size_t)g * 1024 + i]; bbr[i] = qr * br - qi * bi; bbi[i] = qr * bi + qi * br;
        cre[(i >> 6) * PC + (i & 63)] = c_re[(size_t)g * 1024 + i]; cim[(i >> 6) * PC + (i & 63)] = c_im[(size_t)g * 1024 + i]; }
    if (F.tid < 16) dsl[F.tid] = dsk[g * GC + F.tid];
    __syncthreads();
    { const int half = F.tid >> 8, c = (F.tid >> 4) & 15, c2 = F.tid & 15; float acc[8] = {0.f, 0.f, 0.f, 0.f, 0.f, 0.f, 0.f, 0.f};
      for (int p0 = 0; p0 < 64; p0 += 4) { const f32x4 cr4 = *(const LAS f32x4*)(cre + c * PC + p0), ci4 = *(const LAS f32x4*)(cim + c * PC + p0);
#pragma unroll
          for (int u = 0; u < 4; ++u) { const int p = p0 + u; const float br = bbr[p * 16 + c2], bi = bbi[p * 16 + c2];
              const float cbr = cr4[u] * br - ci4[u] * bi, cbi = cr4[u] * bi + ci4[u] * br;
#pragma unroll
              for (int k = 0; k < 8; ++k) { const f32x2 w = *(const LAS f32x2*)(pw2 + ((half * 8 + k) * 64 + p) * 2); acc[k] += w[0] * cbr - w[1] * cbi; } } }
#pragma unroll
      for (int k = 0; k < 8; ++k) Kt[(half * 8 + k) * 256 + c * 16 + c2] = acc[k]; }
    __syncthreads();
    for (int idx = F.tid; idx < 256 * 32; idx += NTHR) { const int oct = idx & 31, row = idx >> 5, t = row >> 4, c = row & 15, j = oct >> 1, c20 = (oct & 1) * 8;
        f32x4 x0 = (f32x4){0.f, 0.f, 0.f, 0.f}, x1 = x0;
        if (j <= t) { x0 = *(const LAS f32x4*)(Kt + (t - j) * 256 + c * 16 + c20); x1 = *(const LAS f32x4*)(Kt + (t - j) * 256 + c * 16 + c20 + 4); }
        if (j == t && (c >> 3) == (oct & 1)) { const float d = dsl[c];
#pragma unroll
            for (int q = 0; q < 4; ++q) { x0[q] += (q == (c & 7)) ? d : 0.f; x1[q] += (q + 4 == (c & 7)) ? d : 0.f; } }
        u32x4 o; o.x = pk2(x0[0], x0[1]); o.y = pk2(x0[2], x0[3]); o.z = pk2(x1[0], x1[1]); o.w = pk2(x1[2], x1[3]);
        *(u32x4*)(MT + (size_t)row * 384 + oct * 8) = o; }
    for (int idx = F.tid; idx < 256 * 16; idx += NTHR) { const int oct = idx & 15, row = idx >> 4, t = row >> 4, c = row & 15, p0 = (oct & 7) * 8; float v[8];
#pragma unroll
        for (int h = 0; h < 2; ++h) { const f32x4 cr = *(const LAS f32x4*)(cre + c * PC + p0 + 4 * h), ci = *(const LAS f32x4*)(cim + c * PC + p0 + 4 * h);
            const f32x4 wa = *(const LAS f32x4*)(pw2 + ((t + 1) * 64 + p0 + 4 * h) * 2), wb = *(const LAS f32x4*)(pw2 + ((t + 1) * 64 + p0 + 4 * h) * 2 + 4);
            const float pr[4] = {wa[0], wa[2], wb[0], wb[2]}, pi[4] = {wa[1], wa[3], wb[1], wb[3]};
#pragma unroll
            for (int q = 0; q < 4; ++q) v[4 * h + q] = (oct < 8) ? (cr[q] * pr[q] - ci[q] * pi[q]) : -(cr[q] * pi[q] + ci[q] * pr[q]); }
        u32x4 o; o.x = pk2(v[0], v[1]); o.y = pk2(v[2], v[3]); o.z = pk2(v[4], v[5]); o.w = pk2(v[6], v[7]);
        *(u32x4*)(MT + (size_t)row * 384 + 256 + oct * 8) = o; }
    for (int idx = F.tid; idx < 128 * 32; idx += NTHR) { const int oct = idx & 31, row = idx >> 5, part = row >> 6, p = row & 63, j = oct >> 1, c20 = (oct & 1) * 8;
        const f32x2 w = *(const LAS f32x2*)(pw2 + ((15 - j) * 64 + p) * 2); float v[8];
#pragma unroll
        for (int h = 0; h < 2; ++h) { const f32x4 br = *(const LAS f32x4*)(bbr + p * 16 + c20 + 4 * h), bi = *(const LAS f32x4*)(bbi + p * 16 + c20 + 4 * h);
#pragma unroll
            for (int q = 0; q < 4; ++q) v[4 * h + q] = part == 0 ? (w[0] * br[q] - w[1] * bi[q]) : (w[0] * bi[q] + w[1] * br[q]); }
        u32x4 o; o.x = pk2(v[0], v[1]); o.y = pk2(v[2], v[3]); o.z = pk2(v[4], v[5]); o.w = pk2(v[6], v[7]);
        *(u32x4*)(WT + (size_t)row * 256 + oct * 8) = o; }
    __syncthreads();
}

template <int NU> __device__ __forceinline__ void mod_batch(const GAS float* wp, const LAS float* sp0, f32x4 (&acc)[8]) {
    f32x4 w[NU];
#pragma unroll
    for (int u = 0; u < NU; ++u) w[u] = *(const GAS f32x4*)(wp + (size_t)(4 * u) * NMOD);
#pragma unroll
    for (int u = 0; u < NU; ++u) { const LAS f32x4* sp = (const LAS f32x4*)(sp0 + 4 * u * 8); const f32x4 s0 = sp[0], s1 = sp[1];
#pragma unroll
        for (int b = 0; b < 4; ++b) { acc[b] += w[u] * s0[b]; acc[4 + b] += w[u] * s1[b]; } }
}
__device__ __forceinline__ void p0_prologue(const Frame& F0) {
    PHASE_VIEW();
    const float* c = F.in[1]; const float* ada_w = F.in[2]; const float* ada_b = F.in[3];
    float* mod = (float*)(F.ws + WS_MOD);
    LAS float* scT = (LAS float*)F.lds;
    LAS float* red = (LAS float*)(F.lds + 65536);
    for (int i = F.tid; i < NB * DM; i += NTHR) { const float v = c[i]; scT[(i & (DM - 1)) * 8 + (i >> 11)] = v / (1.f + __expf(-v)); }
    __syncthreads();
    for (int item = F.vcu; item < NMOD / 64; item += F.G) {
        const int rs = F.lane >> 4, c4 = F.lane & 15, ks = F.wave;
        const GAS float* wp = (const GAS float*)ada_w + (size_t)(ks * 256 + rs) * NMOD + item * 64 + 4 * c4;
        f32x4 acc[8];
#pragma unroll
        for (int b = 0; b < 8; ++b) acc[b] = (f32x4){0.f, 0.f, 0.f, 0.f};
#pragma unroll 1
        for (int q = 0; q < 60; q += 12) mod_batch<12>(wp + (size_t)(4 * q) * NMOD, scT + (ks * 256 + 4 * q + rs) * 8, acc);
        mod_batch<4>(wp + (size_t)240 * NMOD, scT + (ks * 256 + 240 + rs) * 8, acc);
#pragma unroll
        for (int b = 0; b < 8; ++b) *(LAS f32x4*)(red + ((F.wave * 4 + rs) * 8 + b) * 64 + 4 * c4) = acc[b];
        __syncthreads();
        { const int b = F.wave; float s = 0.f;
#pragma unroll
          for (int q = 0; q < 32; ++q) s += red[(q * 8 + b) * 64 + F.lane];
          mod[b * NMOD + item * 64 + F.lane] = s + ada_b[item * 64 + F.lane]; }
        __syncthreads();
    }
    __syncthreads();
    for (int g = F.G - 1 - F.vcu; g < NG; g += F.G) s5_build(F, g);
    LAS float* scr = (LAS float*)(F.lds + F.wave * 16384);
    const int gw = F.vcu * NWAVES + F.wave, NGW = F.G * NWAVES;
    bf16* WinT = (bf16*)(F.ws + WS_WIN_T); bf16* WoutT = (bf16*)(F.ws + WS_WOUT_T); bf16* GluT = (bf16*)(F.ws + WS_GLU_T); bf16* LoraT = (bf16*)(F.ws + WS_LORA_T);
    constexpr int I_IN = (DM / 64) * (DIN / 32), I_OUT = (DM / 64) * (DM / 32), I_GLU = (DSSM / 64) * (DSSM / 32), I_W = 32, I_A = 32, I_G = 64;
    constexpr int NITEMS = I_IN + I_OUT + I_GLU + I_W + I_A + I_G;
    for (int it = gw; it < NITEMS; it += NGW) {
        int r = it;
        if (r < I_IN) { const int nb = DIN / 32, kb = r / nb, n0 = (r % nb) * 32; transpose_item(F.in[8], DIN, WinT, DM, n0, kb * 64, n0, kb * 64, scr, F.lane); continue; } r -= I_IN;
        if (r < I_OUT) { const int nb = DM / 32, kb = r / nb, n0 = (r % nb) * 32; transpose_item(F.in[9], DM, WoutT, DM, n0, kb * 64, n0, kb * 64, scr, F.lane); continue; } r -= I_OUT;
        if (r < I_GLU) { const int nb = DSSM / 32, kb = r / nb, n0 = (r % nb) * 32; transpose_item(F.in[18], DSSM, GluT, DSSM, n0, kb * 64, n0, kb * 64, scr, F.lane); continue; } r -= I_GLU;
        if (r < I_W) { transpose_item(F.in[22], DRW, LoraT, 256, r * 32, 0, r * 32, 0, scr, F.lane); continue; } r -= I_W;
        if (r < I_A) { transpose_item(F.in[24], DRW, LoraT, 256, 1024 + r * 32, 0, r * 32, 64, scr, F.lane); continue; } r -= I_A;
        { const int kb = r / 32, n0 = (r % 32) * 32; transpose_item(F.in[25], DRW, LoraT, 256, 2048 + n0, kb * 64, n0, 128 + kb * 64, scr, F.lane); }
    }
    for (int p = blockIdx.x * NTHR + F.tid; p < 3072 * 32; p += F.G * NTHR) { const int row = p >> 5, c8 = (p & 31) * 8; const int kind = row >> 10;
        const bool data = kind == 0 ? (c8 < 64) : (kind == 1 ? (c8 >= 64 && c8 < 128) : (c8 >= 128));
        if (!data) *(u32x4*)(LoraT + (size_t)row * 256 + c8) = (u32x4){0u, 0u, 0u, 0u}; }
    bf16* rwt = (bf16*)(F.ws + WS_RWT);
    for (int p = blockIdx.x * NTHR + F.tid; p < 64 * 5 * 64 * 8; p += F.G * NTHR) { const int e = p & 7, ln = (p >> 3) & 63, jt = (p >> 9) % 5, ks = (p >> 9) / 5;
        const int j = 16 * jt + (ln & 15), k = 32 * ks + 8 * (ln >> 4) + e;
        const float w = j < 8 ? F.in[31][k * 8 + j] : (j < 72 ? F.in[33][k * 64 + (j - 8)] : 0.f);
        const unsigned hi = pk2(w, 0.f) & 0xffffu; const float wl = w - __uint_as_float(hi << 16);
        const size_t o = ((size_t)((ks * 5 + jt) * 2) * 64 + ln) * 8 + e;
        rwt[o] = (bf16)hi; rwt[o + 512] = (bf16)(pk2(wl, 0.f) & 0xffffu); }
}

__device__ __forceinline__ void p1_h1(const Frame& F0) {
    PHASE_VIEW();
    const GAS float* x = (const GAS float*)F.in[0]; const GAS float* g = (const GAS float*)F.in[4]; const GAS float* mod = (const GAS float*)(F.ws + WS_MOD); GAS bf16* H = (GAS bf16*)(F.ws + WS_H);
    const int gw = F.vcu * NWAVES + F.wave, NGW = F.G * NWAVES;
    f32x4 gv[8];
#pragma unroll
    for (int j = 0; j < 8; ++j) gv[j] = *(const GAS f32x4*)(g + 4 * (F.lane + 64 * j));
    for (int row = gw; row < NT; row += NGW) {
        const int b = row >> 11; const GAS f32x4* xr = (const GAS f32x4*)(x + (size_t)row * DM) + F.lane;
        f32x4 v[8], sh[8], scv[8]; float ss = 0.f;
#pragma unroll
        for (int j = 0; j < 8; ++j) { v[j] = xr[64 * j]; sh[j] = *(const GAS f32x4*)(mod + b * NMOD + 4 * (F.lane + 64 * j)); scv[j] = *(const GAS f32x4*)(mod + b * NMOD + DM + 4 * (F.lane + 64 * j)); }
#pragma unroll
        for (int j = 0; j < 8; ++j) ss += (v[j].x * v[j].x + v[j].y * v[j].y) + (v[j].z * v[j].z + v[j].w * v[j].w);
        const float rs = rsqrtf(wave_sum(ss) * (1.f / DM) + RMS_EPS);
        u32x2 w[8];
#pragma unroll
        for (int j = 0; j < 8; ++j) { const f32x4 h = v[j] * rs * gv[j] * (scv[j] + 1.0f) + sh[j]; w[j].x = pk2(h.x, h.y); w[j].y = pk2(h.z, h.w); }
        GAS u32x2* o = (GAS u32x2*)(H + (size_t)row * DM) + F.lane;
#pragma unroll
        for (int j = 0; j < 8; ++j) o[64 * j] = w[j];
    }
}

typedef short bf16x8_t __attribute__((ext_vector_type(8)));
#define MFMA16(a, b, c) __builtin_amdgcn_mfma_f32_16x16x32_bf16((a), (b), (c), 0, 0, 0)
__device__ __forceinline__ bf16x8_t lfrag(const LAS bf16* m, int pitch, int row, int k0) { return *(const LAS bf16x8_t*)(m + row * pitch + k0); }
__device__ __forceinline__ void st4(LAS bf16* p, const f32x4& v) { u32x2 w; w.x = pk2(v[0], v[1]); w.y = pk2(v[2], v[3]); *(LAS u32x2*)p = w; }
constexpr int CH_T = 32, CHP_K = 72, CHP_T = 40;
constexpr int CH_GRP_BYTES = 66560;
constexpr size_t GHQ_CHUNK = 12288;
__device__ __forceinline__ float wave_sum_dpp(float x) {
    x = row16_sum(x);
    x += __builtin_bit_cast(float, __builtin_amdgcn_update_dpp(0, __builtin_bit_cast(int, x), 0x142, 0xa, 0xf, false));
    x += __builtin_bit_cast(float, __builtin_amdgcn_update_dpp(0, __builtin_bit_cast(int, x), 0x143, 0xc, 0xf, false));
    return __builtin_bit_cast(float, __builtin_amdgcn_readlane(__builtin_bit_cast(int, x), 63));
}
__device__ __forceinline__ void wave_sum8_dpp(float (&x)[8]) {
#define WS8_STAGE(ctrl, rmask) _Pragma("unroll") for (int i_ = 0; i_ < 8; ++i_) x[i_] += __builtin_bit_cast(float, __builtin_amdgcn_update_dpp(0, __builtin_bit_cast(int, x[i_]), ctrl, rmask, 0xf, false));
    WS8_STAGE(0xB1, 0xf) WS8_STAGE(0x4E, 0xf) WS8_STAGE(0x141, 0xf) WS8_STAGE(0x140, 0xf) WS8_STAGE(0x142, 0xa) WS8_STAGE(0x143, 0xc)
#undef WS8_STAGE
#pragma unroll
    for (int i = 0; i < 8; ++i) x[i] = __builtin_bit_cast(float, __builtin_amdgcn_readlane(__builtin_bit_cast(int, x[i]), 63));
}
__device__ __forceinline__ float tanh_fast(float x) { const float e = __builtin_amdgcn_exp2f(2.8853900817779268f * x); return 1.f - 2.f * __builtin_amdgcn_rcpf(e + 1.f); }
#define INV_P8(acc, A0, L0, M0, A1, L1, M1, A2, L2, M2, A3, L3, M3, A4, L4, M4, A5, L5, M5, A6, L6, M6, A7, L7, M7) do { float tmp_; asm volatile("v_readlane_b32 %1, %2, %10\n\tv_fmac_f32 %0, %1, %18\n\tv_readlane_b32 %1, %3, %11\n\tv_fmac_f32 %0, %1, %19\n\tv_readlane_b32 %1, %4, %12\n\tv_fmac_f32 %0, %1, %20\n\tv_readlane_b32 %1, %5, %13\n\tv_fmac_f32 %0, %1, %21\n\tv_readlane_b32 %1, %6, %14\n\tv_fmac_f32 %0, %1, %22\n\tv_readlane_b32 %1, %7, %15\n\tv_fmac_f32 %0, %1, %23\n\tv_readlane_b32 %1, %8, %16\n\tv_fmac_f32 %0, %1, %24\n\tv_readlane_b32 %1, %9, %17\n\tv_fmac_f32 %0, %1, %25" : "+v"(acc), "=&s"(tmp_) : "v"(A0), "v"(A1), "v"(A2), "v"(A3), "v"(A4), "v"(A5), "v"(A6), "v"(A7), "i"(L0), "i"(L1), "i"(L2), "i"(L3), "i"(L4), "i"(L5), "i"(L6), "i"(L7), "v"(M0), "v"(M1), "v"(M2), "v"(M3), "v"(M4), "v"(M5), "v"(M6), "v"(M7)); } while (0)
#define INV_P4(acc, A0, L0, M0, A1, L1, M1, A2, L2, M2, A3, L3, M3) do { float tmp_; asm volatile("v_readlane_b32 %1, %2, %6\n\tv_fmac_f32 %0, %1, %10\n\tv_readlane_b32 %1, %3, %7\n\tv_fmac_f32 %0, %1, %11\n\tv_readlane_b32 %1, %4, %8\n\tv_fmac_f32 %0, %1, %12\n\tv_readlane_b32 %1, %5, %9\n\tv_fmac_f32 %0, %1, %13" : "+v"(acc), "=&s"(tmp_) : "v"(A0), "v"(A1), "v"(A2), "v"(A3), "i"(L0), "i"(L1), "i"(L2), "i"(L3), "v"(M0), "v"(M1), "v"(M2), "v"(M3)); } while (0)
#define INV_P2(acc, A0, L0, M0, A1, L1, M1) do { float tmp_; asm volatile("v_readlane_b32 %1, %2, %4\n\tv_fmac_f32 %0, %1, %6\n\tv_readlane_b32 %1, %3, %5\n\tv_fmac_f32 %0, %1, %7" : "+v"(acc), "=&s"(tmp_) : "v"(A0), "v"(A1), "i"(L0), "i"(L1), "v"(M0), "v"(M1)); } while (0)
#define INV_P1(acc, A0, L0, M0) do { float tmp_; asm volatile("v_readlane_b32 %1, %2, %3\n\tv_fmac_f32 %0, %1, %4" : "+v"(acc), "=&s"(tmp_) : "v"(A0), "i"(L0), "v"(M0)); } while (0)
__device__ __forceinline__ void p9a_rwkv_chunks(const Frame& F0) {
    PHASE_VIEW();
    const GAS bf16* PROJ = (const GAS bf16*)(F.ws + WS_PROJ); const GAS bf16* LoraT = (const GAS bf16*)(F.ws + WS_LORA_T);
    GAS bf16* VB = (GAS bf16*)(F.ws + WS_VB); GAS bf16* GB = (GAS bf16*)(F.ws + WS_GB); GAS float* BON = (GAS float*)(F.ws + WS_BON);
    const float* mu = F.in[20]; const float* w0 = F.in[21]; const float* a0 = F.in[23]; const float* k_k = F.in[26]; const float* k_a = F.in[27]; const float* r_k = F.in[28];
    GAS bf16* GHQ = (GAS bf16*)(F.ws + WS_GHQ); GAS float* GT = (GAS float*)(F.ws + WS_GT);
    const int grp = F.tid >> 8, gt = F.tid & 255, gw = (F.tid >> 6) & 3, lo = F.lane & 15, hi = F.lane >> 4;
    LAS unsigned char* gb = F.lds + grp * CH_GRP_BYTES;
    LAS bf16* At = (LAS bf16*)gb; LAS bf16* Bt = At + 32 * CHP_K; LAS bf16* Kt = Bt + 32 * CHP_K; LAS bf16* Rt = Kt + 32 * CHP_K;
    LAS bf16* X1T = At; LAS bf16* P1T = X1T + 64 * CHP_T; LAS bf16* Minv = P1T + 64 * CHP_T; LAS bf16* XG = At;
    LAS bf16* AtT = Rt + 32 * CHP_K; LAS bf16* BhT = AtT + 64 * CHP_T; LAS bf16* KhT = BhT + 64 * CHP_T; LAS bf16* VmT = KhT + 64 * CHP_T;
    LAS float* AabF = (LAS float*)(VmT + 64 * CHP_T);
    LAS bf16* Aak = (LAS bf16*)(AabF + 32 * 36); LAS bf16* Arb = Aak + 32 * CHP_T; LAS bf16* Ark = Arb + 32 * CHP_T; LAS bf16* P2T = Ark + 32 * CHP_T;
    LAS float* LWs = AabF; LAS float* AAs = LWs + 32 * 68; LAS bf16* W1 = (LAS bf16*)AabF;
    LAS float* part = (LAS float*)(P2T + 64 * CHP_T);
    LAS bf16* XW = (LAS bf16*)(part + 256); LAS bf16* XA = XW + 32 * CHP_K;
    const f32x4 z4 = (f32x4){0.f, 0.f, 0.f, 0.f};
    LAS unsigned* gbw = (LAS unsigned*)(F.lds + MISC_OFF) + 40 + grp; unsigned gb_target = 0u;
    __syncthreads(); if (gt == 0) *(volatile LAS unsigned*)gbw = 0u; __syncthreads();
#define GROUP_BARRIER() do { gb_target += 4u; asm volatile("s_waitcnt lgkmcnt(0)" ::: "memory"); \
        if (F.lane == 0) (void)__hip_atomic_fetch_add(gbw, 1u, __ATOMIC_RELAXED, __HIP_MEMORY_SCOPE_WORKGROUP); \
        while (*(volatile LAS unsigned*)gbw < gb_target) __builtin_amdgcn_s_sleep(1); \
        asm volatile("" ::: "memory"); } while (0)
    for (int it0 = F.vcu * 2; it0 < NB * (SEQ / CH_T); it0 += F.G * 2) {
        const int item = it0 + grp; const int c = item & 63, b = item >> 6;
        const size_t tok0 = (size_t)b * SEQ + c * CH_T;
        GROUP_BARRIER();
#pragma unroll 4
        for (int i = 0; i < 16; ++i) { const int pidx = gt + 256 * i, t = pidx >> 7, cp = (pidx & 127) * 2;
            const unsigned zw = *(const GAS unsigned*)(PROJ + (tok0 + t) * DIN + 4096 + cp);
            const unsigned pw = (c == 0 && t == 0) ? 0u : *(const GAS unsigned*)(PROJ + (tok0 + t - 1) * DIN + 4096 + cp);
            const f32x2 m = *(const f32x2*)(mu + 3072 + cp);
            const float z0 = bf_lo(zw), z1 = bf_hi(zw); const float v0 = z0 + m.x * (bf_lo(pw) - z0), v1 = z1 + m.y * (bf_hi(pw) - z1);
            if (cp < 64) *(LAS unsigned*)(XW + t * CHP_K + cp) = pk2(tanh_fast(v0), tanh_fast(v1));
            else if (cp < 128) *(LAS unsigned*)(XA + t * CHP_K + cp - 64) = pk2(v0, v1);
            else *(LAS unsigned*)(XG + t * 136 + cp - 128) = pk2(sigmoidf_(v0), sigmoidf_(v1)); }
        GROUP_BARRIER();
        { bf16x8_t xg[2][4];
#pragma unroll
          for (int mt = 0; mt < 2; ++mt)
#pragma unroll
              for (int ks = 0; ks < 4; ++ks) xg[mt][ks] = lfrag(XG, 136, 16 * mt + lo, 32 * ks + 8 * hi);
          bf16x8_t ygc[4], ygn[4];
#pragma unroll
          for (int ks = 0; ks < 4; ++ks) ygc[ks] = *(const GAS bf16x8_t*)(LoraT + (size_t)(2048 + 16 * gw + lo) * 256 + 128 + 32 * ks + 8 * hi);
#pragma unroll 1
          for (int hh = 0; hh < NH; ++hh) { const int n0 = hh * 64 + 16 * gw, n1 = (hh + 1 < NH ? hh + 1 : hh) * 64 + 16 * gw; f32x4 dg[2] = {z4, z4};
#pragma unroll
              for (int ks = 0; ks < 4; ++ks) ygn[ks] = *(const GAS bf16x8_t*)(LoraT + (size_t)(2048 + n1 + lo) * 256 + 128 + 32 * ks + 8 * hi);
#pragma unroll
              for (int ks = 0; ks < 4; ++ks) { dg[0] = MFMA16(ygc[ks], xg[0][ks], dg[0]); dg[1] = MFMA16(ygc[ks], xg[1][ks], dg[1]); }
#pragma unroll
              for (int mt = 0; mt < 2; ++mt) { u32x2 w; w.x = pk2(dg[mt][0], dg[mt][1]); w.y = pk2(dg[mt][2], dg[mt][3]); *(GAS u32x2*)(GB + (tok0 + 16 * mt + lo) * 1024 + n0 + 4 * hi) = w; }
#pragma unroll
              for (int ks = 0; ks < 4; ++ks) ygc[ks] = ygn[ks]; }
        }
        const int k = gt & 63, tq = gw; const bool first = (c == 0 && tq == 0);
        const GAS bf16* pp = PROJ + (tok0 + tq * 8) * DIN + 1024 + k;
        bf16 nr[9], nk[9], nv[9];
#pragma unroll
        for (int i = 0; i < 9; ++i) { const GAS bf16* q = pp + (ptrdiff_t)(i - 1) * DIN; const bool z = first && i == 0;
            nr[i] = z ? (bf16)0 : q[0]; nk[i] = z ? (bf16)0 : q[1024]; nv[i] = z ? (bf16)0 : q[2048]; }
        bf16x8_t lyw[2], lya[2]; f32x4 lw0, la0; float cmur, cmuk, cmuv, ckk, cka, crk;
#define HEAD_LOADS(hn_) do { const int n1_ = (hn_) * 64 + 16 * gw, ch1_ = (hn_) * 64 + k; \
            _Pragma("unroll") for (int ks = 0; ks < 2; ++ks) { lyw[ks] = *(const GAS bf16x8_t*)(LoraT + (size_t)(n1_ + lo) * 256 + 32 * ks + 8 * hi); lya[ks] = *(const GAS bf16x8_t*)(LoraT + (size_t)(1024 + n1_ + lo) * 256 + 64 + 32 * ks + 8 * hi); } \
            lw0 = *(const GAS f32x4*)((const GAS float*)w0 + n1_ + 4 * hi); la0 = *(const GAS f32x4*)((const GAS float*)a0 + n1_ + 4 * hi); \
            cmur = ((const GAS float*)mu)[ch1_]; cmuk = ((const GAS float*)mu)[1024 + ch1_]; cmuv = ((const GAS float*)mu)[2048 + ch1_]; \
            ckk = ((const GAS float*)k_k)[ch1_]; cka = ((const GAS float*)k_a)[ch1_]; crk = ((const GAS float*)r_k)[ch1_]; } while (0)
        HEAD_LOADS(0);
#pragma unroll 1
        for (int h = 0; h < NH; ++h) {
            const int ci = (b * NH + h) * 64 + c; const int ch = h * 64 + k;
            GROUP_BARRIER();
            { const int n0 = h * 64 + 16 * gw; f32x4 dw[2] = {z4, z4}, da[2] = {z4, z4};
#pragma unroll
              for (int ks = 0; ks < 2; ++ks) { const bf16x8_t yw = lyw[ks], ya = lya[ks];
#pragma unroll
                  for (int mt = 0; mt < 2; ++mt) { dw[mt] = MFMA16(yw, lfrag(XW, CHP_K, 16 * mt + lo, 32 * ks + 8 * hi), dw[mt]); da[mt] = MFMA16(ya, lfrag(XA, CHP_K, 16 * mt + lo, 32 * ks + 8 * hi), da[mt]); } }
              const f32x4 w0v = lw0, a0v = la0;
#pragma unroll
              for (int mt = 0; mt < 2; ++mt) { const int t = 16 * mt + lo; f32x4 lwv, aav;
#pragma unroll
                  for (int r = 0; r < 4; ++r) { lwv[r] = (-0.6065306597126334f * 1.4426950408889634f) * sigmoidf_(dw[mt][r] + w0v[r]);     aav[r] = sigmoidf_(da[mt][r] + a0v[r]); }
                  *(LAS f32x4*)(LWs + t * 68 + 16 * gw + 4 * hi) = lwv; *(LAS f32x4*)(AAs + t * 68 + 16 * gw + 4 * hi) = aav; }
            }
            GROUP_BARRIER();
            { const float mur = cmur, muk = cmuk, muv = cmuv, kkc = ckk, kac = cka, rkc = crk;
              float lw[8], ls[8], rv[8], kv[8], vv[8], av[8], bv[8]; float run = 0.f;
              float kraw[8], x8[8];
#pragma unroll
              for (int i = 0; i < 8; ++i) { const int t = tq * 8 + i;
                  const float zr = bf2f(nr[i + 1]), zk = bf2f(nk[i + 1]), zv = bf2f(nv[i + 1]), pr = bf2f(nr[i]), pk_ = bf2f(nk[i]), pv = bf2f(nv[i]);
                  rv[i] = zr + mur * (pr - zr); kraw[i] = zk + muk * (pk_ - zk); vv[i] = zv + muv * (pv - zv);
                  av[i] = AAs[t * 68 + k]; lw[i] = LWs[t * 68 + k];
                  const float kk = kraw[i] * kkc; x8[i] = kk * kk; }
              wave_sum8_dpp(x8);
#pragma unroll
              for (int i = 0; i < 8; ++i) { const float a = av[i]; const float kk = kraw[i] * kkc * __builtin_amdgcn_rsqf(fmaxf(x8[i], 1e-24f));
                  const float km = kraw[i] * (1.f + (a - 1.f) * kac);
                  x8[i] = rv[i] * km * rkc; kv[i] = km; av[i] = -kk; bv[i] = kk * a; run += lw[i]; ls[i] = run; }
              wave_sum8_dpp(x8);
              { float bsel = x8[0];
#pragma unroll
                for (int i = 1; i < 8; ++i) bsel = (F.lane == i) ? x8[i] : bsel;
                if (F.lane < 8) BON[(tok0 + tq * 8 + F.lane) * 16 + h] = bsel; }
              if (h + 1 < NH) {
#pragma unroll
                  for (int i = 0; i < 9; ++i) { const GAS bf16* q = pp + (ptrdiff_t)(i - 1) * DIN + (h + 1) * 64; const bool z = first && i == 0;
                      nr[i] = z ? (bf16)0 : q[0]; nk[i] = z ? (bf16)0 : q[1024]; nv[i] = z ? (bf16)0 : q[2048]; } }
              { u32x4 w; w.x = pk2(vv[0], vv[1]); w.y = pk2(vv[2], vv[3]); w.z = pk2(vv[4], vv[5]); w.w = pk2(vv[6], vv[7]);
                GAS bf16* vb = VB + (tok0 + tq * 8) * 1024 + ch;
                vb[0] = (bf16)(w.x & 0xffffu); vb[1024] = (bf16)(w.x >> 16); vb[2048] = (bf16)(w.y & 0xffffu); vb[3072] = (bf16)(w.y >> 16);
                vb[4096] = (bf16)(w.z & 0xffffu); vb[5120] = (bf16)(w.z >> 16); vb[6144] = (bf16)(w.w & 0xffffu); vb[7168] = (bf16)(w.w >> 16); }
              part[tq * 64 + k] = run;
              GROUP_BARRIER();
              float off = 0.f, tot = 0.f;
#pragma unroll
              for (int q = 0; q < 4; ++q) { const float pq = part[q * 64 + k]; tot += pq; if (q < tq) off += pq; }
              if (tq == 0) GT[(size_t)ci * 64 + k] = __builtin_amdgcn_exp2f(tot);
              float aT[8], bT[8], kT[8];
#pragma unroll
              for (int i = 0; i < 8; ++i) { const int t = tq * 8 + i; const float lg = off + ls[i], lgm = lg - lw[i];
                  const float eneg = __builtin_amdgcn_exp2f(-lg), eh = __builtin_amdgcn_exp2f(tot - lg);
                  const float at = av[i] * __builtin_amdgcn_exp2f(lgm);
                  const unsigned wa = pk2(at, bv[i] * eneg), wk = pk2(kv[i] * eneg, rv[i] * __builtin_amdgcn_exp2f(lg));
                  At[t * CHP_K + k] = (bf16)(wa & 0xffffu); Bt[t * CHP_K + k] = (bf16)(wa >> 16); Kt[t * CHP_K + k] = (bf16)(wk & 0xffffu); Rt[t * CHP_K + k] = (bf16)(wk >> 16);
                  aT[i] = at; bT[i] = bv[i] * eh; kT[i] = kv[i] * eh; }
              u32x4 w;
              w.x = pk2(aT[0], aT[1]); w.y = pk2(aT[2], aT[3]); w.z = pk2(aT[4], aT[5]); w.w = pk2(aT[6], aT[7]); *(LAS u32x4*)(AtT + k * CHP_T + tq * 8) = w;
              w.x = pk2(bT[0], bT[1]); w.y = pk2(bT[2], bT[3]); w.z = pk2(bT[4], bT[5]); w.w = pk2(bT[6], bT[7]); *(LAS u32x4*)(BhT + k * CHP_T + tq * 8) = w;
              w.x = pk2(kT[0], kT[1]); w.y = pk2(kT[2], kT[3]); w.z = pk2(kT[4], kT[5]); w.w = pk2(kT[6], kT[7]); *(LAS u32x4*)(KhT + k * CHP_T + tq * 8) = w;
              w.x = pk2(vv[0], vv[1]); w.y = pk2(vv[2], vv[3]); w.z = pk2(vv[4], vv[5]); w.w = pk2(vv[6], vv[7]); *(LAS u32x4*)(VmT + k * CHP_T + tq * 8) = w;
            }
            GROUP_BARRIER();
            f32x4 dt = z4, a10 = z4;
            const int mi = gw ^ grp;
            { const LAS bf16* X = (mi < 2) ? At : Rt; const LAS bf16* Y = (mi & 1) ? Kt : Bt;
              f32x4 acc[2][2] = {{z4, z4}, {z4, z4}};
#pragma unroll
              for (int ks = 0; ks < 2; ++ks) { bf16x8_t xf[2], yf[2];
#pragma unroll
                  for (int m = 0; m < 2; ++m) { xf[m] = lfrag(X, CHP_K, 16 * m + lo, 32 * ks + 8 * hi); yf[m] = lfrag(Y, CHP_K, 16 * m + lo, 32 * ks + 8 * hi); }
#pragma unroll
                  for (int m = 0; m < 2; ++m)
#pragma unroll
                      for (int n = 0; n < 2; ++n) acc[m][n] = MFMA16(yf[n], xf[m], acc[m][n]);
                  if (mi == 1) dt = MFMA16(lfrag(Bt, CHP_K, 16 + lo, 32 * ks + 8 * hi), xf[1], dt); }
              LAS bf16* dstb = (mi == 1) ? Aak : ((mi == 2) ? Arb : Ark);
#pragma unroll
              for (int m = 0; m < 2; ++m)
#pragma unroll
                  for (int n = 0; n < 2; ++n) { const int t = 16 * m + lo, j0 = 16 * n + 4 * hi; f32x4 v = acc[m][n];
#pragma unroll
                      for (int r = 0; r < 4; ++r) { const int j = j0 + r; const bool keep = (mi < 2) ? (j < t) : (j <= t); v[r] = keep ? v[r] : 0.f; }
                      if (mi != 0) st4(dstb + t * CHP_T + j0, v); else { if (m == 0 && n == 0) dt = v; if (m == 1 && n == 0) a10 = v; } }
              if (mi == 1) {
#pragma unroll
                  for (int r = 0; r < 4; ++r) dt[r] = (4 * hi + r < lo) ? dt[r] : 0.f; }
            }
            GROUP_BARRIER();
            if (mi < 2) {
                int cc = F.lane & 15; asm volatile("" : "+v"(cc));
                float mcol[16];
                { float acc = (0 == cc) ? 1.f : 0.f;
                  mcol[0] = acc; }
                { float acc = (1 == cc) ? 1.f : 0.f;
                  INV_P1(acc, dt[0], 1, mcol[0]);
                  mcol[1] = acc; }
                { float acc = (2 == cc) ? 1.f : 0.f;
                  INV_P2(acc, dt[0], 2, mcol[0], dt[1], 2, mcol[1]);
                  mcol[2] = acc; }
                { float acc = (3 == cc) ? 1.f : 0.f;
                  INV_P2(acc, dt[0], 3, mcol[0], dt[1], 3, mcol[1]);
                  INV_P1(acc, dt[2], 3, mcol[2]);
                  mcol[3] = acc; }
                { float acc = (4 == cc) ? 1.f : 0.f;
                  INV_P4(acc, dt[0], 4, mcol[0], dt[1], 4, mcol[1], dt[2], 4, mcol[2], dt[3], 4, mcol[3]);
                  mcol[4] = acc; }
                { float acc = (5 == cc) ? 1.f : 0.f;
                  INV_P4(acc, dt[0], 5, mcol[0], dt[1], 5, mcol[1], dt[2], 5, mcol[2], dt[3], 5, mcol[3]);
                  INV_P1(acc, dt[0], 21, mcol[4]);
                  mcol[5] = acc; }
                { float acc = (6 == cc) ? 1.f : 0.f;
                  INV_P4(acc, dt[0], 6, mcol[0], dt[1], 6, mcol[1], dt[2], 6, mcol[2], dt[3], 6, mcol[3]);
                  INV_P2(acc, dt[0], 22, mcol[4], dt[1], 22, mcol[5]);
                  mcol[6] = acc; }
                { float acc = (7 == cc) ? 1.f : 0.f;
                  INV_P4(acc, dt[0], 7, mcol[0], dt[1], 7, mcol[1], dt[2], 7, mcol[2], dt[3], 7, mcol[3]);
                  INV_P2(acc, dt[0], 23, mcol[4], dt[1], 23, mcol[5]);
                  INV_P1(acc, dt[2], 23, mcol[6]);
                  mcol[7] = acc; }
                { float acc = (8 == cc) ? 1.f : 0.f;
                  INV_P8(acc, dt[0], 8, mcol[0], dt[1], 8, mcol[1], dt[2], 8, mcol[2], dt[3], 8, mcol[3], dt[0], 24, mcol[4], dt[1], 24, mcol[5], dt[2], 24, mcol[6], dt[3], 24, mcol[7]);
                  mcol[8] = acc; }
                { float acc = (9 == cc) ? 1.f : 0.f;
                  INV_P8(acc, dt[0], 9, mcol[0], dt[1], 9, mcol[1], dt[2], 9, mcol[2], dt[3], 9, mcol[3], dt[0], 25, mcol[4], dt[1], 25, mcol[5], dt[2], 25, mcol[6], dt[3], 25, mcol[7]);
                  INV_P1(acc, dt[0], 41, mcol[8]);
                  mcol[9] = acc; }
                { float acc = (10 == cc) ? 1.f : 0.f;
                  INV_P8(acc, dt[0], 10, mcol[0], dt[1], 10, mcol[1], dt[2], 10, mcol[2], dt[3], 10, mcol[3], dt[0], 26, mcol[4], dt[1], 26, mcol[5], dt[2], 26, mcol[6], dt[3], 26, mcol[7]);
                  INV_P2(acc, dt[0], 42, mcol[8], dt[1], 42, mcol[9]);
                  mcol[10] = acc; }
                { float acc = (11 == cc) ? 1.f : 0.f;
                  INV_P8(acc, dt[0], 11, mcol[0], dt[1], 11, mcol[1], dt[2], 11, mcol[2], dt[3], 11, mcol[3], dt[0], 27, mcol[4], dt[1], 27, mcol[5], dt[2], 27, mcol[6], dt[3], 27, mcol[7]);
                  INV_P2(acc, dt[0], 43, mcol[8], dt[1], 43, mcol[9]);
                  INV_P1(acc, dt[2], 43, mcol[10]);
                  mcol[11] = acc; }
                { float acc = (12 == cc) ? 1.f : 0.f;
                  INV_P8(acc, dt[0], 12, mcol[0], dt[1], 12, mcol[1], dt[2], 12, mcol[2], dt[3], 12, mcol[3], dt[0], 28, mcol[4], dt[1], 28, mcol[5], dt[2], 28, mcol[6], dt[3], 28, mcol[7]);
                  INV_P4(acc, dt[0], 44, mcol[8], dt[1], 44, mcol[9], dt[2], 44, mcol[10], dt[3], 44, mcol[11]);
                  mcol[12] = acc; }
                { float acc = (13 == cc) ? 1.f : 0.f;
                  INV_P8(acc, dt[0], 13, mcol[0], dt[1], 13, mcol[1], dt[2], 13, mcol[2], dt[3], 13, mcol[3], dt[0], 29, mcol[4], dt[1], 29, mcol[5], dt[2], 29, mcol[6], dt[3], 29, mcol[7]);
                  INV_P4(acc, dt[0], 45, mcol[8], dt[1], 45, mcol[9], dt[2], 45, mcol[10], dt[3], 45, mcol[11]);
                  INV_P1(acc, dt[0], 61, mcol[12]);
                  mcol[13] = acc; }
                { float acc = (14 == cc) ? 1.f : 0.f;
                  INV_P8(acc, dt[0], 14, mcol[0], dt[1], 14, mcol[1], dt[2], 14, mcol[2], dt[3], 14, mcol[3], dt[0], 30, mcol[4], dt[1], 30, mcol[5], dt[2], 30, mcol[6], dt[3], 30, mcol[7]);
                  INV_P4(acc, dt[0], 46, mcol[8], dt[1], 46, mcol[9], dt[2], 46, mcol[10], dt[3], 46, mcol[11]);
                  INV_P2(acc, dt[0], 62, mcol[12], dt[1], 62, mcol[13]);
                  mcol[14] = acc; }
                { float acc = (15 == cc) ? 1.f : 0.f;
                  INV_P8(acc, dt[0], 15, mcol[0], dt[1], 15, mcol[1], dt[2], 15, mcol[2], dt[3], 15, mcol[3], dt[0], 31, mcol[4], dt[1], 31, mcol[5], dt[2], 31, mcol[6], dt[3], 31, mcol[7]);
                  INV_P4(acc, dt[0], 47, mcol[8], dt[1], 47, mcol[9], dt[2], 47, mcol[10], dt[3], 47, mcol[11]);
                  INV_P2(acc, dt[0], 63, mcol[12], dt[1], 63, mcol[13]);
                  INV_P1(acc, dt[2], 63, mcol[14]);
                  mcol[15] = acc; }
                if (F.lane < 32) { const int col = F.lane; const bool mine = (mi == 0) ? (col < 16) : (col >= 16);
#pragma unroll
                    for (int t = 0; t < 16; ++t) Minv[(16 * mi + t) * CHP_T + col] = (bf16)(pk2(mine ? mcol[t] : 0.f, 0.f) & 0xffffu); }
                if (mi == 0) { st4(W1 + lo * CHP_T + 4 * hi, a10);
                    f32x4 id;
#pragma unroll
                    for (int r = 0; r < 4; ++r) id[r] = (4 * hi + r == lo) ? 1.f : 0.f;
                    st4(W1 + lo * CHP_T + 16 + 4 * hi, id); }
            } else {
                const int wk = mi - 2;
                for (int tile = wk * 4; tile < wk * 4 + 4; ++tile) { const int mt = tile >> 2, nt = tile & 3;
                    const bf16x8_t xf = lfrag(Aak, CHP_T, 16 * mt + lo, 8 * hi), yf = lfrag(VmT, CHP_T, 16 * nt + lo, 8 * hi);
                    const f32x4 d = MFMA16(xf, yf, z4);
                    st4(X1T + (16 * nt + lo) * CHP_T + 16 * mt + 4 * hi, d); }
            }
            GROUP_BARRIER();
            { const bf16x8_t ya = lfrag(AtT, CHP_T, 16 * gw + lo, 8 * hi), yx = lfrag(X1T, CHP_T, 16 * gw + lo, 8 * hi);
              const bf16x8_t m0 = lfrag(Minv, CHP_T, lo, 8 * hi), m1 = lfrag(Minv, CHP_T, 16 + lo, 8 * hi), w1 = lfrag(W1, CHP_T, lo, 8 * hi);
              LAS bf16* p1r = P1T + (16 * gw + lo) * CHP_T; LAS bf16* p2r = P2T + (16 * gw + lo) * CHP_T;
              const f32x4 a = MFMA16(m0, ya, z4), b = MFMA16(m0, yx, z4);
              st4(p1r + 4 * hi, a); st4(p2r + 4 * hi, b);
              asm volatile("" ::: "memory");
              const bf16x8_t pa = *(const LAS bf16x8_t*)(p1r + 8 * (hi & 1)), pb = *(const LAS bf16x8_t*)(p2r + 8 * (hi & 1));
              const bf16x8_t za = (hi < 2) ? pa : ya, zx = (hi < 2) ? pb : yx;
              const f32x4 ta = MFMA16(w1, za, z4), tb = MFMA16(w1, zx, z4);
              st4(p1r + 16 + 4 * hi, ta); st4(p2r + 16 + 4 * hi, tb);
              asm volatile("" ::: "memory");
              const bf16x8_t qa = *(const LAS bf16x8_t*)(p1r + 8 * hi), qx = *(const LAS bf16x8_t*)(p2r + 8 * hi);
              const f32x4 ca = MFMA16(m1, qa, z4), cb = MFMA16(m1, qx, z4);
              asm volatile("" ::: "memory");
              st4(p1r + 16 + 4 * hi, ca); st4(p2r + 16 + 4 * hi, cb);
            }
            GROUP_BARRIER();
            HEAD_LOADS((h + 1 < NH) ? h + 1 : h);
            { GAS bf16* outp = GHQ + (size_t)ci * GHQ_CHUNK;
              const bf16x8_t p1 = lfrag(P1T, CHP_T, 16 * gw + lo, 8 * hi), p2 = lfrag(P2T, CHP_T, 16 * gw + lo, 8 * hi), vm = lfrag(VmT, CHP_T, 16 * gw + lo, 8 * hi);
#pragma unroll
              for (int mt = 0; mt < 2; ++mt) { const bf16x8_t arb = lfrag(Arb, CHP_T, 16 * mt + lo, 8 * hi), ark = lfrag(Ark, CHP_T, 16 * mt + lo, 8 * hi);
                  f32x4 q1 = MFMA16(p1, arb, z4);
                  { const int t = 16 * mt + lo, k0 = 16 * gw + 4 * hi; const u32x2 rw = *(const LAS u32x2*)(Rt + t * CHP_K + k0);
                    q1[0] += bf_lo(rw.x); q1[1] += bf_hi(rw.x); q1[2] += bf_lo(rw.y); q1[3] += bf_hi(rw.y);
                    u32x2 w; w.x = pk2(q1[0], q1[1]); w.y = pk2(q1[2], q1[3]); *(GAS u32x2*)(outp + 8192 + t * 64 + k0) = w; }
                  f32x4 q2 = MFMA16(arb, p2, z4); q2 = MFMA16(ark, vm, q2);
                  { u32x2 w; w.x = pk2(q2[0], q2[1]); w.y = pk2(q2[2], q2[3]); *(GAS u32x2*)(outp + 10240 + (16 * gw + lo) * 32 + 16 * mt + 4 * hi) = w; } }
#pragma unroll
              for (int mt = 0; mt < 4; ++mt) { const bf16x8_t bh = lfrag(BhT, CHP_T, 16 * mt + lo, 8 * hi), kh = lfrag(KhT, CHP_T, 16 * mt + lo, 8 * hi);
                  const f32x4 g = MFMA16(p1, bh, z4);
                  { u32x2 w; w.x = pk2(g[0], g[1]); w.y = pk2(g[2], g[3]); *(GAS u32x2*)(outp + (16 * mt + lo) * 64 + 16 * gw + 4 * hi) = w; }
                  f32x4 hh = MFMA16(bh, p2, z4); hh = MFMA16(kh, vm, hh);
                  { u32x2 w; w.x = pk2(hh[0], hh[1]); w.y = pk2(hh[2], hh[3]); *(GAS u32x2*)(outp + 4096 + (16 * gw + lo) * 64 + 16 * mt + 4 * hi) = w; } }
            }
        }
    }
    __syncthreads();
#undef GROUP_BARRIER
#undef HEAD_LOADS
}
__device__ __forceinline__ void p9b_rwkv_seq(const Frame& F0) {
    PHASE_VIEW();
    const GAS bf16* GHQ = (const GAS bf16*)(F.ws + WS_GHQ); const GAS float* GT = (const GAS float*)(F.ws + WS_GT); GAS bf16* Yy = (GAS bf16*)(F.ws + WS_Y);
    LAS bf16* Sb = (LAS bf16*)F.lds;
    LAS bf16* Yb = Sb + 2 * 32 * CHP_K;
    const int lo = F.lane & 15, hi = F.lane >> 4, vt = F.wave & 1;
    const bool ywave = F.wave < 4, twave = (F.wave == 4 || F.wave == 5), writer = F.wave >= 6;
    const int kt = ywave ? (F.wave >> 1) : 2, mt = (F.wave >> 1) & 1;
    const f32x4 z4 = (f32x4){0.f, 0.f, 0.f, 0.f};
    for (int item = F.vcu; item < NB * NH * 2; item += F.G) {
        const int b = item >> 5, h = (item >> 1) & 15, vh = item & 1;
        __syncthreads();
        for (int i = F.tid; i < 2 * 32 * CHP_K / 2; i += NTHR) ((LAS unsigned*)Sb)[i] = 0u;
        __syncthreads();
        f32x4 Sf = z4, Sf2 = z4;
        const size_t cbase = (size_t)(b * NH + h) * 64;
        const int vrow = vh * 32 + 16 * vt + lo;
        const int offX = ywave ? 8192 + (16 * mt + lo) * 64 + 8 * hi : (48 + lo) * 64 + 8 * hi;
        const int offX2 = ywave ? 10240 + vrow * 32 + 16 * mt + 4 * hi : 4096 + vrow * 64 + 48 + 4 * hi;
        const int offT2 = ywave ? 16 * kt + 4 * hi : 48 + 4 * hi;
#define SEQ_LOAD(G_, X_, H_, X2_, GT_, GT2_, cc_) do { if (!writer) { const int cn_ = (cc_) < 64 ? (cc_) : 63; const GAS bf16* cp_ = GHQ + (cbase + cn_) * GHQ_CHUNK; \
            G_[0] = *(const GAS bf16x8_t*)(cp_ + (16 * kt + lo) * 64 + 8 * hi); G_[1] = *(const GAS bf16x8_t*)(cp_ + (16 * kt + lo) * 64 + 32 + 8 * hi); \
            H_ = *(const GAS u32x2*)(cp_ + 4096 + vrow * 64 + 16 * kt + 4 * hi); GT_ = *(const GAS f32x4*)(GT + (cbase + cn_) * 64 + 16 * kt + 4 * hi); \
            X_[0] = *(const GAS bf16x8_t*)(cp_ + offX); X_[1] = *(const GAS bf16x8_t*)(cp_ + offX + 32); \
            X2_ = *(const GAS u32x2*)(cp_ + offX2); GT2_ = *(const GAS f32x4*)(GT + (cbase + cn_) * 64 + offT2); } } while (0)
#define SEQ_FLUSH(cc_) do { const int r_ = (F.wave - 6) * 16 + (F.lane >> 2), q_ = F.lane & 3; \
            const u32x4 yv_ = *(const LAS u32x4*)(Yb + ((cc_) & 1) * 1024 + r_ * 32 + 8 * q_); \
            *(GAS u32x4*)(Yy + (size_t)(b * SEQ + (cc_) * CH_T + r_) * 1024 + h * 64 + vh * 32 + 8 * q_) = yv_; } while (0)
#define SEQ_STEP(G_, X_, H_, X2_, GT_, GT2_, cc_) do { \
            const LAS bf16* Sc = Sb + ((cc_) & 1) * 32 * CHP_K; LAS bf16* Sn = Sb + (((cc_) + 1) & 1) * 32 * CHP_K; \
            if (!writer) { \
                const bf16x8_t s0 = lfrag(Sc, CHP_K, 16 * vt + lo, 8 * hi), s1 = lfrag(Sc, CHP_K, 16 * vt + lo, 32 + 8 * hi); \
                f32x4 acc2 = (f32x4){bf_lo(X2_.x), bf_hi(X2_.x), bf_lo(X2_.y), bf_hi(X2_.y)}; \
                if (twave) acc2 = acc2 + GT2_ * Sf2; \
                acc2 = MFMA16(X_[0], s0, acc2); acc2 = MFMA16(X_[1], s1, acc2); \
                f32x4 acc = (f32x4){bf_lo(H_.x), bf_hi(H_.x), bf_lo(H_.y), bf_hi(H_.y)} + GT_ * Sf; \
                acc = MFMA16(G_[0], s0, acc); acc = MFMA16(G_[1], s1, acc); \
                Sf = acc; st4(Sn + (16 * vt + lo) * CHP_K + 16 * kt + 4 * hi, acc); \
                if (twave) { Sf2 = acc2; st4(Sn + (16 * vt + lo) * CHP_K + 48 + 4 * hi, acc2); } \
                else { LAS bf16* yo_ = Yb + ((cc_) & 1) * 1024 + (16 * mt + 4 * hi) * 32 + 16 * vt + lo; const unsigned w01 = pk2(acc2[0], acc2[1]), w23 = pk2(acc2[2], acc2[3]);     \
                    yo_[0] = (bf16)(w01 & 0xffffu); yo_[32] = (bf16)(w01 >> 16); yo_[64] = (bf16)(w23 & 0xffffu); yo_[96] = (bf16)(w23 >> 16); } \
                SEQ_LOAD(G_, X_, H_, X2_, GT_, GT2_, (cc_) + 4); \
            } else if ((cc_) > 0) SEQ_FLUSH((cc_) - 1); \
            asm volatile("s_waitcnt lgkmcnt(0)" ::: "memory"); __builtin_amdgcn_s_barrier(); asm volatile("" ::: "memory"); } while (0)
        bf16x8_t gA[2], xA[2], gB[2], xB[2], gC[2], xC[2], gD[2], xD[2]; u32x2 hA, x2A, hB, x2B, hC, x2C, hD, x2D; f32x4 gtA, gtB, gtC, gtD, gsA, gsB, gsC, gsD;
        SEQ_LOAD(gA, xA, hA, x2A, gtA, gsA, 0); SEQ_LOAD(gB, xB, hB, x2B, gtB, gsB, 1); SEQ_LOAD(gC, xC, hC, x2C, gtC, gsC, 2); SEQ_LOAD(gD, xD, hD, x2D, gtD, gsD, 3);
#pragma unroll
        for (int c = 0; c < 64; c += 4) {
            SEQ_STEP(gA, xA, hA, x2A, gtA, gsA, c); SEQ_STEP(gB, xB, hB, x2B, gtB, gsB, c + 1); SEQ_STEP(gC, xC, hC, x2C, gtC, gsC, c + 2); SEQ_STEP(gD, xD, hD, x2D, gtD, gsD, c + 3);
        }
        if (writer) SEQ_FLUSH(63);
#undef SEQ_LOAD
#undef SEQ_FLUSH
#undef SEQ_STEP
    }
}
__device__ __forceinline__ void p9_rwkv_post(const Frame& F0) {
    PHASE_VIEW();
    const GAS bf16* VB = (const GAS bf16*)(F.ws + WS_VB); const GAS bf16* GB = (const GAS bf16*)(F.ws + WS_GB); const GAS float* BON = (const GAS float*)(F.ws + WS_BON);
    const GAS bf16* Yy = (const GAS bf16*)(F.ws + WS_Y);
    const GAS float* ln_w = (const GAS float*)F.in[29]; const GAS float* ln_b = (const GAS float*)F.in[30]; GAS bf16* MIX = (GAS bf16*)(F.ws + WS_MIX);
    const int gw = F.vcu * NWAVES + F.wave, NGW = F.G * NWAVES;
    u32x2 ywn, vwn, gwn; float bonn;
#define POST_LOAD(it_) do { const int it2 = (it_) < NT * 4 ? (it_) : gw; const int row_ = it2 >> 2, c_ = (it2 & 3) * 256 + F.lane * 4; const size_t idx_ = (size_t)row_ * 1024 + c_; \
        ywn = *(const GAS u32x2*)(Yy + idx_); vwn = *(const GAS u32x2*)(VB + idx_); gwn = *(const GAS u32x2*)(GB + idx_); bonn = BON[row_ * 16 + (c_ >> 6)]; } while (0)
    POST_LOAD(gw);
    for (int it = gw; it < NT * 4; it += NGW) {
        const int row = it >> 2, c = (it & 3) * 256 + F.lane * 4;
        const u32x2 yw = ywn, vw = vwn, gwv = gwn; const float bon = bonn;
        const f32x4 lw = *(const GAS f32x4*)(ln_w + c), lb = *(const GAS f32x4*)(ln_b + c);
        POST_LOAD(it + NGW);
        const f32x4 y = (f32x4){bf_lo(yw.x), bf_hi(yw.x), bf_lo(yw.y), bf_hi(yw.y)};
        const float mean = row16_sum((y.x + y.y) + (y.z + y.w)) * (1.f / 64.f); const f32x4 d = y - mean;
        const float var = row16_sum((d.x * d.x + d.y * d.y) + (d.z * d.z + d.w * d.w)) * (1.f / 64.f); const float rstd = rsqrtf(var + GN_EPS);
        const f32x4 vv = (f32x4){bf_lo(vw.x), bf_hi(vw.x), bf_lo(vw.y), bf_hi(vw.y)}, gg = (f32x4){bf_lo(gwv.x), bf_hi(gwv.x), bf_lo(gwv.y), bf_hi(gwv.y)};
        const f32x4 o = (d * rstd * lw + lb + vv * bon) * gg;
        u32x2 w; w.x = pk2(o.x, o.y); w.y = pk2(o.z, o.w); *(GAS u32x2*)(MIX + (size_t)row * DM + DSSM + c) = w;
    }
#undef POST_LOAD
}

__device__ __forceinline__ void p11_x1_router(const Frame& F0) {
    PHASE_VIEW();
    const GAS float* x = (const GAS float*)F.in[0]; const GAS float* gpost = (const GAS float*)F.in[5]; const GAS float* gpre2 = (const GAS float*)F.in[6]; const GAS float* mod = (const GAS float*)(F.ws + WS_MOD);
    const GAS bf16* MIXED = (const GAS bf16*)(F.ws + WS_MIXED); GAS bf16* X1 = (GAS bf16*)(F.ws + WS_X1); GAS bf16* H = (GAS bf16*)(F.ws + WS_H);
    const GAS bf16x8_t* rwt = (const GAS bf16x8_t*)(F.ws + WS_RWT); const float* b_grp = F.in[32]; const float* b_exp = F.in[34];
    unsigned* tokinfo = (unsigned*)(F.ws + WS_TOKINFO); int* list = (int*)(F.ws + WS_LIST);
    LAS float* slab = (LAS float*)(F.lds + F.wave * 16384) + F.lane * 8;
    LAS float* Lp = (LAS float*)F.lds;
    LAS float* red1 = (LAS float*)(F.lds + 131072); LAS float* red2 = red1 + 128; LAS float* Lf = red2 + 128;
    const int lo = F.lane & 15, hi = F.lane >> 4, k0 = 256 * F.wave + 8 * hi;
    const f32x4 z4 = (f32x4){0.f, 0.f, 0.f, 0.f};
    for (int tile = F.vcu; tile < NT / 16; tile += F.G) {
        const int row = tile * 16 + lo, b = tile >> 7;
        const size_t ro = (size_t)row * DM + k0;
        f32x4 xr[8][2];
#pragma unroll
        for (int s_ = 0; s_ < 8; ++s_) { xr[s_][0] = *(const GAS f32x4*)(x + ro + 32 * s_); xr[s_][1] = *(const GAS f32x4*)(x + ro + 32 * s_ + 4); }
        float ss = 0.f;
#pragma unroll
        for (int s_ = 0; s_ < 8; ++s_) { const u32x4 mw = *(const GAS u32x4*)(MIXED + ro + 32 * s_); const f32x4 a0 = (f32x4){bf_lo(mw.x), bf_hi(mw.x), bf_lo(mw.y), bf_hi(mw.y)}, a1 = (f32x4){bf_lo(mw.z), bf_hi(mw.z), bf_lo(mw.w), bf_hi(mw.w)};
            *(LAS f32x4*)(slab + s_ * 512) = a0; *(LAS f32x4*)(slab + s_ * 512 + 4) = a1;
            ss += (a0.x * a0.x + a0.y * a0.y) + (a0.z * a0.z + a0.w * a0.w) + (a1.x * a1.x + a1.y * a1.y) + (a1.z * a1.z + a1.w * a1.w); }
        ss += __shfl_xor(ss, 16); ss += __shfl_xor(ss, 32);
        if (hi == 0) red1[F.wave * 16 + lo] = ss;
        LDS_BARRIER();
        float tot = 0.f;
#pragma unroll
        for (int w = 0; w < 8; ++w) tot += red1[w * 16 + lo];
        const float rs = rsqrtf(tot * (1.f / DM) + RMS_EPS);
        float ss2 = 0.f;
        const GAS float* modb = mod + b * NMOD + k0;
#pragma unroll
        for (int s_ = 0; s_ < 8; ++s_) { f32x4 xo[2];
#pragma unroll
            for (int q = 0; q < 2; ++q) { const f32x4 xv = xr[s_][q], gv = *(const GAS f32x4*)(gpost + k0 + 32 * s_ + 4 * q), gt = *(const GAS f32x4*)(modb + 2 * DM + 32 * s_ + 4 * q);
                const f32x4 mm = *(const LAS f32x4*)(slab + s_ * 512 + 4 * q);
                const f32x4 v = xv + gt * (mm * rs * gv); *(LAS f32x4*)(slab + s_ * 512 + 4 * q) = v; xo[q] = v;
                ss2 += (v.x * v.x + v.y * v.y) + (v.z * v.z + v.w * v.w); }
            (void)xo; }
        ss2 += __shfl_xor(ss2, 16); ss2 += __shfl_xor(ss2, 32);
        if (hi == 0) red2[F.wave * 16 + lo] = ss2;
        LDS_BARRIER();
        float tot2 = 0.f;
#pragma unroll
        for (int w = 0; w < 8; ++w) tot2 += red2[w * 16 + lo];
        const float rs2 = rsqrtf(tot2 * (1.f / DM) + RMS_EPS);
        f32x4 acc[5] = {z4, z4, z4, z4, z4};
        bf16x8_t wA[10], wB[10]; f32x4 cA[6], cB[6];
#define RT_LOAD(W_, C_, st_) do { const GAS bf16x8_t* wb_ = rwt + (size_t)((F.wave * 8 + (st_)) * 10) * 64; \
            _Pragma("unroll") for (int j_ = 0; j_ < 10; ++j_) W_[j_] = wb_[j_ * 64 + F.lane]; \
            _Pragma("unroll") for (int q_ = 0; q_ < 2; ++q_) { C_[3 * q_] = *(const GAS f32x4*)(gpre2 + k0 + 32 * (st_) + 4 * q_); C_[3 * q_ + 1] = *(const GAS f32x4*)(modb + 3 * DM + 32 * (st_) + 4 * q_); C_[3 * q_ + 2] = *(const GAS f32x4*)(modb + 4 * DM + 32 * (st_) + 4 * q_); } } while (0)
#define RT_STEP(W_, C_, st_) do { f32x4 hv[2]; \
            u32x4 xb_; \
            _Pragma("unroll") for (int q_ = 0; q_ < 2; ++q_) { const f32x4 mm = *(const LAS f32x4*)(slab + (st_) * 512 + 4 * q_); hv[q_] = mm * rs2 * C_[3 * q_] * (C_[3 * q_ + 2] + 1.0f) + C_[3 * q_ + 1]; \
                if (q_ == 0) { xb_.x = pk2(mm.x, mm.y); xb_.y = pk2(mm.z, mm.w); } else { xb_.z = pk2(mm.x, mm.y); xb_.w = pk2(mm.z, mm.w); } } \
            *(LAS u32x4*)(slab + (st_) * 512 + 4) = xb_;     \
            u32x4 hh, hl; \
            hh.x = pk2(hv[0].x, hv[0].y); hh.y = pk2(hv[0].z, hv[0].w); hh.z = pk2(hv[1].x, hv[1].y); hh.w = pk2(hv[1].z, hv[1].w); \
            *(LAS u32x4*)(slab + (st_) * 512) = hh;        \
            hl.x = pk2(hv[0].x - bf_lo(hh.x), hv[0].y - bf_hi(hh.x)); hl.y = pk2(hv[0].z - bf_lo(hh.y), hv[0].w - bf_hi(hh.y)); \
            hl.z = pk2(hv[1].x - bf_lo(hh.z), hv[1].y - bf_hi(hh.z)); hl.w = pk2(hv[1].z - bf_lo(hh.w), hv[1].w - bf_hi(hh.w)); \
            const bf16x8_t fh = __builtin_bit_cast(bf16x8_t, hh), fl = __builtin_bit_cast(bf16x8_t, hl); \
            _Pragma("unroll") for (int jt = 0; jt < 5; ++jt) { acc[jt] = MFMA16(W_[2 * jt], fh, acc[jt]); acc[jt] = MFMA16(W_[2 * jt], fl, acc[jt]); acc[jt] = MFMA16(W_[2 * jt + 1], fh, acc[jt]); } } while (0)
        RT_LOAD(wA, cA, 0);
#pragma unroll 1
        for (int s2 = 0; s2 < 8; s2 += 2) { RT_LOAD(wB, cB, s2 + 1); RT_STEP(wA, cA, s2); RT_LOAD(wA, cA, (s2 + 2 < 8 ? s2 + 2 : 7)); RT_STEP(wB, cB, s2 + 1); }
#undef RT_LOAD
#undef RT_STEP
#pragma unroll
        for (int s_ = 0; s_ < 8; ++s_) { *(GAS u32x4*)(H + ro + 32 * s_) = *(const LAS u32x4*)(slab + s_ * 512); *(GAS u32x4*)(X1 + ro + 32 * s_) = *(const LAS u32x4*)(slab + s_ * 512 + 4); }
        LDS_WAIT(); asm volatile("" ::: "memory");
#pragma unroll
        for (int jt = 0; jt < 5; ++jt) *(LAS f32x4*)(Lp + F.wave * 4096 + lo * 80 + 16 * jt + 4 * hi) = acc[jt];
        LDS_BARRIER();
        for (int i = F.tid; i < 16 * 80; i += NTHR) { float sacc = 0.f;
#pragma unroll
            for (int w = 0; w < 8; ++w) sacc += Lp[w * 4096 + i];
            const int j = i % 80; Lf[i] = sacc + (j < 8 ? b_grp[j] : (j < 72 ? b_exp[j - 8] : 0.f)); }
        LDS_BARRIER();
        if (F.tid < 16) { const LAS float* lg = Lf + F.tid * 80; const int tok = tile * 16 + F.tid;
            int gi = 0; float gmax = lg[0];
#pragma unroll
            for (int j = 1; j < 8; ++j) if (lg[j] > gmax) { gmax = lg[j]; gi = j; }
            float gsum = 0.f;
#pragma unroll
            for (int j = 0; j < 8; ++j) gsum += __expf(lg[j] - gmax);
            const float pg = 1.f / gsum;
            const LAS float* le = lg + 8 + gi * 8; int i1 = 0; float m1 = le[0];
#pragma unroll
            for (int j = 1; j < 8; ++j) if (le[j] > m1) { m1 = le[j]; i1 = j; }
            int i2 = -1; float m2 = -INFINITY;
#pragma unroll
            for (int j = 0; j < 8; ++j) if (j != i1 && le[j] > m2) { m2 = le[j]; i2 = j; }
            const float e2 = __expf(m2 - m1); const float g1 = pg / (1.f + e2), g2 = pg * e2 / (1.f + e2);
            const int x1i = gi * 8 + i1, x2i = gi * 8 + i2;
            const unsigned p1 = atomicAdd(F.ctl + CW_CNT + 64 * x1i, 1u), p2 = atomicAdd(F.ctl + CW_CNT + 64 * x2i, 1u);
            list[x1i * NT + p1] = tok; list[x2i * NT + p2] = tok;
            u32x4 a; a.x = (unsigned)x1i; a.y = p1; a.z = (unsigned)x2i; a.w = p2; *(u32x4*)(tokinfo + (size_t)tok * 8) = a;
            u32x2 g; g.x = __float_as_uint(g1); g.y = __float_as_uint(g2); *(u32x2*)(tokinfo + (size_t)tok * 8 + 4) = g;
        }
    }
    __syncthreads();
}

__device__ __forceinline__ void conv_item_src(const Frame& F, int it, const float*& W, int& N, bf16*& WT, int& ldk, int& drow, int& k0, int& n0) {
    if (it < NEXP * 1024) { const int e = it >> 10, r = it & 1023, which = r >> 9, rr = r & 511; k0 = (rr >> 4) * 64; n0 = (rr & 15) * 32;
        W = F.in[which ? 36 : 35] + (size_t)e * DM * DEXP; N = DEXP; WT = (bf16*)(F.ws + WS_EW1) + (size_t)e * 1024 * DM; ldk = DM; drow = (n0 >> 7) * 256 + which * 128 + (n0 & 127); }
    else { const int j = it - NEXP * 1024, e = j >> 9, r = j & 511; k0 = (r >> 6) * 64; n0 = (r & 63) * 32;
        W = F.in[37] + (size_t)e * DEXP * DM; N = DM; WT = (bf16*)(F.ws + WS_EW2) + (size_t)e * DM * DEXP; ldk = DEXP; drow = n0; }
}
struct ConvItem { const GAS float* src; GAS bf16* dst; int ldk; };
__device__ __forceinline__ void conv_decode(const Frame& F, int it, int lane, ConvItem& ci, int& N) {
    const float* W; int ldk, drow, k0, n0; bf16* WT; conv_item_src(F, it, W, N, WT, ldk, drow, k0, n0);
    ci.src = (const GAS float*)W + (size_t)(k0 + (lane >> 3)) * N + n0 + 4 * (lane & 7); ci.dst = (GAS bf16*)WT + (size_t)(drow + (lane >> 3)) * ldk + k0 + 8 * (lane & 7); ci.ldk = ldk;
}
__device__ __forceinline__ int conv_stream(const Frame& F, int first, int step, int total, const unsigned* stopw) {
    LAS float* scr = (LAS float*)(F.lds + F.wave * 16384);
    const int lane = F.lane;
    f32x4 bA[8], bB[8], bC[8]; ConvItem iA, iB, iC; int done = 0;
#define CV_LOAD(buf, ci, idx) do { int N_; conv_decode(F, (idx) < total ? (idx) : total - 1, lane, ci, N_); _Pragma("unroll") for (int i_ = 0; i_ < 8; ++i_) buf[i_] = *(const GAS f32x4*)(ci.src + (size_t)(8 * i_) * N_); } while (0)
#define CV_PROC(buf, ci) do { _Pragma("unroll") for (int i_ = 0; i_ < 8; ++i_) *(LAS f32x4*)(scr + (8 * i_ + (lane >> 3)) * 36 + 4 * (lane & 7)) = buf[i_]; \
        LDS_WAIT(); asm volatile("" ::: "memory"); \
        { const int c_ = lane & 7; _Pragma("unroll") for (int j_ = 0; j_ < 4; ++j_) { const LAS float* sp = scr + (8 * c_) * 36 + (lane >> 3) + 8 * j_; \
              u32x4 o; o.x = pk2(sp[0 * 36], sp[1 * 36]); o.y = pk2(sp[2 * 36], sp[3 * 36]); o.z = pk2(sp[4 * 36], sp[5 * 36]); o.w = pk2(sp[6 * 36], sp[7 * 36]); \
              *(GAS u32x4*)(ci.dst + (size_t)(8 * j_) * ci.ldk) = o; } } \
        LDS_WAIT(); asm volatile("" ::: "memory"); ++done; } while (0)
#define CV_STOPLD() __hip_atomic_load((const GAS unsigned*)stopw, RLX_AGENT)
#define CV_STOP(v) (__builtin_amdgcn_readfirstlane((int)(v)) != 0)
    int it = first;
    CV_LOAD(bA, iA, it); CV_LOAD(bB, iB, it + step);
    while (it < total) {
        unsigned sv = CV_STOPLD();
        CV_LOAD(bC, iC, it + 2 * step);
        CV_PROC(bA, iA); if (CV_STOP(sv)) break;
        if (it + step >= total) break;
        sv = CV_STOPLD();
        CV_LOAD(bA, iA, it + 3 * step);
        CV_PROC(bB, iB); if (CV_STOP(sv)) break;
        if (it + 2 * step >= total) break;
        sv = CV_STOPLD();
        CV_LOAD(bB, iB, it + 4 * step);
        CV_PROC(bC, iC); if (CV_STOP(sv)) break;
        it += 3 * step;
    }
#undef CV_STOPLD
#undef CV_LOAD
#undef CV_PROC
#undef CV_STOP
    return done;
}
__device__ __forceinline__ void p12_expert_convert(const Frame& F0) {
    PHASE_VIEW();
    volatile LAS int* red = (volatile LAS int*)(F.lds + 131072);
    const int ncw = (F.G >= 256) ? (F.G - CONV_GEMM_BLOCKS) * NWAVES : 0;
    __syncthreads();
    if (F.tid == 0) red[0] = 0x7fffffff;
    __syncthreads();
    for (int i = F.tid; i < ncw; i += NTHR) atomicMin((int*)red, (int)__hip_atomic_load(F.ctl + CW_PROG + i, RLX_AGENT));
    __syncthreads();
    const int start = ncw ? red[0] * ncw : 0;
    __syncthreads();
    const int gw = F.vcu * NWAVES + F.wave, NGW = F.G * NWAVES;
    (void)conv_stream(F, start + gw, NGW, CONV_MAIN, F.ctl + CW_TMO + 2);
}

__device__ __forceinline__ void moe_build_tp(const Frame& F0) {
    PHASE_VIEW();
    volatile LAS int* tp = (volatile LAS int*)(F.lds + TP_OFF);
    __syncthreads();
    if (F.tid < NEXP) { const unsigned c = __hip_atomic_load(F.ctl + CW_CNT + 64 * F.tid, RLX_AGENT); tp[80 + F.tid] = (int)((c + 255u) >> 8); tp[160 + F.tid] = (int)c; }
    __syncthreads();
    if (F.tid == 0) { int s = 0; for (int e = 0; e < NEXP; ++e) { tp[e] = s; s += tp[80 + e]; } tp[NEXP] = s; }
    __syncthreads();
}
template <bool G1> struct MoeOrder {
    static constexpr bool GATHER = G1; static constexpr int A2 = 0;
    static constexpr int NNT = G1 ? 4 : 8, KK = G1 ? DM : DEXP;
    __device__ __forceinline__ size_t kstepA() const { return 128; }
    __device__ __forceinline__ size_t hstepA() const { return (size_t)128 * KK * 2; }
    __device__ __forceinline__ size_t a2off() const { return 0; }
    const LAS int* tp; const unsigned* cntw; const int* list; const char* A; const char* EW; int G, c;
    __device__ bool next(int i, pg8::Unit& u) const {
        const int x = c & 7, r = c >> 3, W = G >> 3;
        const int L = i * W + r, tl = L / NNT; u.pn = L % NNT;
        int cum = 0, e = -1, mt = 0;
#pragma unroll
        for (int j = 0; j < 8; ++j) { const int nj = tp[80 + x + 8 * j]; if (e < 0 && tl < cum + nj) { e = x + 8 * j; mt = tl - cum; } cum += nj; }
        if (e < 0) return false;
        e = __builtin_amdgcn_readfirstlane(e); mt = __builtin_amdgcn_readfirstlane(mt);
        const int tile = tp[e] + mt;
        u.e = e; u.pm = tile; u.cnt = tp[160 + e] - mt * 256;
        u.Bb = EW + ((size_t)e * (G1 ? 1024 : DM) + (size_t)u.pn * 256) * KK * 2;
        u.Ab = G1 ? A : A + (size_t)tile * 256 * KK * 2;
        return true;
    }
    template <int NV> __device__ __forceinline__ void a_voff(const pg8::Unit& u, unsigned (&v)[NV][2], const int (&R)[2], const int (&C)[2]) const {
        if constexpr (G1) {
            const int mt = u.pm - tp[u.e];
#pragma unroll
            for (int h = 0; h < 2; ++h)
#pragma unroll
                for (int i = 0; i < 2; ++i) { const int rr = h * 128 + R[i]; const int tok = list[u.e * NT + mt * 256 + (rr < u.cnt ? rr : 0)]; v[h][i] = (unsigned)(tok * KK + C[i]) * 2u; }
        } else {
#pragma unroll
            for (int i = 0; i < 2; ++i) v[0][i] = (unsigned)(R[i] * KK + C[i]) * 2u;
        }
    }
};

__device__ __forceinline__ void p15_final(const Frame& F0) {
    PHASE_VIEW();
    const GAS bf16* X1 = (const GAS bf16*)(F.ws + WS_X1); const GAS bf16* YS = (const GAS bf16*)(F.ws + WS_YSLOT); const GAS unsigned* tokinfo = (const GAS unsigned*)(F.ws + WS_TOKINFO);
    const GAS float* gpost2 = (const GAS float*)F.in[7]; const GAS float* mod = (const GAS float*)(F.ws + WS_MOD); GAS float* out = (GAS float*)F.out;
    const LAS int* tp = (const LAS int*)(F.lds + TP_OFF);
    const int gw = F.vcu * NWAVES + F.wave, NGW = F.G * NWAVES;
    f32x4 gv[8];
#pragma unroll
    for (int j = 0; j < 8; ++j) gv[j] = *(const GAS f32x4*)(gpost2 + 4 * (F.lane + 64 * j));
    u32x4 tin = *(const GAS u32x4*)(tokinfo + (size_t)gw * 8); u32x2 tgn = *(const GAS u32x2*)(tokinfo + (size_t)gw * 8 + 4);
    for (int row = gw; row < NT; row += NGW) {
        const int b = row >> 11;
        const u32x4 ti = tin; const u32x2 tg = tgn;
        const size_t r1 = (size_t)tp[ti.x] * 256 + ti.y, r2 = (size_t)tp[ti.z] * 256 + ti.w; const float g1 = __uint_as_float(tg.x), g2 = __uint_as_float(tg.y);
        const GAS u32x2* y1 = (const GAS u32x2*)(YS + r1 * DM) + F.lane; const GAS u32x2* y2 = (const GAS u32x2*)(YS + r2 * DM) + F.lane; const GAS u32x2* xp = (const GAS u32x2*)(X1 + (size_t)row * DM) + F.lane;
        u32x2 ya[8], yb[8], xw[8]; f32x4 gt[8];
#pragma unroll
        for (int j = 0; j < 8; ++j) { ya[j] = y1[64 * j]; yb[j] = y2[64 * j]; xw[j] = xp[64 * j]; gt[j] = *(const GAS f32x4*)(mod + b * NMOD + 5 * DM + 4 * (F.lane + 64 * j)); }
        { const int rn = (row + NGW < NT) ? row + NGW : row; tin = *(const GAS u32x4*)(tokinfo + (size_t)rn * 8); tgn = *(const GAS u32x2*)(tokinfo + (size_t)rn * 8 + 4); }
        f32x4 v[8]; float ss = 0.f;
#pragma unroll
        for (int j = 0; j < 8; ++j) { const u32x2 a = ya[j], c = yb[j];
            v[j] = (f32x4){bf_lo(a.x), bf_hi(a.x), bf_lo(a.y), bf_hi(a.y)} * g1 + (f32x4){bf_lo(c.x), bf_hi(c.x), bf_lo(c.y), bf_hi(c.y)} * g2;
            ss += (v[j].x * v[j].x + v[j].y * v[j].y) + (v[j].z * v[j].z + v[j].w * v[j].w); }
        const float rs = rsqrtf(wave_sum_dpp(ss) * (1.f / DM) + RMS_EPS);
#pragma unroll
        for (int j = 0; j < 8; ++j) { const f32x4 xv = (f32x4){bf_lo(xw[j].x), bf_hi(xw[j].x), bf_lo(xw[j].y), bf_hi(xw[j].y)}; v[j] = xv + gt[j] * (v[j] * rs * gv[j]); }
#pragma unroll
        for (int j = 0; j < 8; ++j) ((GAS f32x4*)(out + (size_t)row * DM))[F.lane + 64 * j] = v[j];
    }
}

constexpr int NPH = 15;
__global__ void __launch_bounds__(NTHR, 2) mk_fwd(Args args) {
    extern __shared__ __attribute__((aligned(16))) unsigned char lds[];
    Frame F0;
    F0.lds = (LAS unsigned char*)lds; F0.MISC = (volatile LAS unsigned*)(F0.lds + MISC_OFF);
    F0.tid = threadIdx.x; F0.lane = F0.tid & 63; F0.wave = __builtin_amdgcn_readfirstlane(F0.tid >> 6);
    F0.G = gridDim.x; { const int bx = blockIdx.x; F0.vcu = (F0.G % 8 == 0) ? (bx % 8) * (F0.G / 8) + bx / 8 : bx; }
    F0.in.kp = (kargp_t)__builtin_amdgcn_kernarg_segment_ptr(); F0.out = args.out; F0.ws = args.ws; F0.ctl = (unsigned*)(args.ws + WS_CTL);
    if (F0.tid < 64) F0.MISC[F0.tid] = 0u;
    __syncthreads();
    const int lo = args.ph_lo, hi = args.ph_hi;
    XcdBarrier bar; bar.bar = F0.ctl + CW_BAR; bar.x = 0; bar.st = nullptr;
    if (hi - lo > 1) bar = xcd_barrier_post(F0.ctl + CW_BAR, F0.MISC + 8);
#ifndef PROBE_MASK
#define PROBE_MASK 0
#endif
#define REPS(k) ((((PROBE_MASK) >> (k)) & 1) + 1)
#define IN(k) (lo <= (k) && (k) < hi)
#define SEAM(k) do { if (IN(k) && IN((k) + 1)) xcd_barrier(bar); } while (0)
    LAS unsigned char* ring = F0.lds;

    if (IN(0)) for (int rep_ = 0; rep_ < REPS(0); ++rep_) { p0_prologue(F0); } SEAM(0);
    if (IN(1)) for (int rep_ = 0; rep_ < REPS(1); ++rep_) { p1_h1(F0); } SEAM(1);
    if (IN(2)) for (int rep_ = 0; rep_ < REPS(2); ++rep_) {
        PHASE_VIEW();
        const int G_GEMM = (F.G >= 256) ? CONV_GEMM_BLOCKS : F.G;
        if ((int)blockIdx.x < G_GEMM) {
            pg8::Gemm g{(const bf16*)(F.ws + WS_H), (const bf16*)(F.ws + WS_WIN_T), NT, DIN, DM}; pg8::StaticOrder S; S.init(g, G_GEMM, (int)blockIdx.x);
            pg8::EpiBf16 E{(bf16*)(F.ws + WS_PROJ), DIN};
            pg8::gemm_phase(ring, DM, S, E);
            __syncthreads();
            if (F.tid == 0 && rep_ == 0) { const unsigned d = atomicAdd(F.ctl + CW_GDONE, 1u); if (d == (unsigned)G_GEMM - 1u) __hip_atomic_store(F.ctl + CW_STOP, 1u, RLX_AGENT); }
        } else if (rep_ == 0) {
            const int jw = ((int)blockIdx.x - G_GEMM) * NWAVES + F.wave, ncw = (F.G - G_GEMM) * NWAVES;
            const int done = conv_stream(F, jw, ncw, CONV_MAIN, F.ctl + CW_STOP);
            if (F.lane == 0) __hip_atomic_store(F.ctl + CW_PROG + jw, (unsigned)done, RLX_AGENT);
        }
    } SEAM(2);
    if (IN(3)) for (int rep_ = 0; rep_ < REPS(3); ++rep_) {
        PHASE_VIEW();
        S5Order<1> S{(const char*)(F.ws + WS_PROJ), (const char*)(F.ws + WS_SIN), (const char*)(F.ws + WS_S5WT), F.G, F.vcu};
        pg8::EpiS5Scan E{(bf16*)(F.ws + WS_SIN), F.in[10], F.in[11], F.in[12]};
        if (F.G >= NG * 4) pg8::gemm_phase(ring, 256, S, E);
    }
    if (IN(3) && IN(4)) { asm volatile("s_waitcnt vmcnt(0)" ::: "memory"); __syncthreads(); __builtin_amdgcn_fence(__ATOMIC_ACQUIRE, "agent"); asm volatile("s_waitcnt vmcnt(0)" ::: "memory"); __syncthreads(); }
    if (IN(4)) for (int rep_ = 0; rep_ < REPS(4); ++rep_) {
        PHASE_VIEW();
        S5Order<2> S{(const char*)(F.ws + WS_PROJ), (const char*)(F.ws + WS_SIN), (const char*)(F.ws + WS_S5MT), F.G, F.vcu};
        pg8::EpiS5Y E{(bf16*)(F.ws + WS_YSG)};
        int kk = 384; LAUNDER(kk);
        pg8::gemm_phase(ring, kk, S, E);
    } SEAM(4);
    if (IN(5)) for (int rep_ = 0; rep_ < REPS(5); ++rep_) {
        PHASE_VIEW();
        pg8::Gemm g{(const bf16*)(F.ws + WS_YSG), (const bf16*)(F.ws + WS_GLU_T), NT, DSSM, DSSM}; pg8::StaticOrder S; S.init(g, F.G, (int)blockIdx.x);
        pg8::EpiGlu E{(const bf16*)(F.ws + WS_YSG), (bf16*)(F.ws + WS_MIX), DM, F.in[19]};
        pg8::gemm_phase(ring, DSSM, S, E);
    }
    if (IN(6)) for (int rep_ = 0; rep_ < REPS(6); ++rep_) { p9a_rwkv_chunks(F0); } SEAM(6);
    if (IN(7)) for (int rep_ = 0; rep_ < REPS(7); ++rep_) { p9b_rwkv_seq(F0); } SEAM(7);
    if (IN(8)) for (int rep_ = 0; rep_ < REPS(8); ++rep_) { p9_rwkv_post(F0); } SEAM(8);
    if (IN(9)) for (int rep_ = 0; rep_ < REPS(9); ++rep_) {
        PHASE_VIEW();
        pg8::Gemm g{(const bf16*)(F.ws + WS_MIX), (const bf16*)(F.ws + WS_WOUT_T), NT, DM, DM}; pg8::StaticOrder S; S.init(g, F.G, (int)blockIdx.x);
        pg8::EpiBf16 E{(bf16*)(F.ws + WS_MIXED), DM};
        pg8::gemm_phase(ring, DM, S, E);
    } SEAM(9);
    if (IN(10)) for (int rep_ = 0; rep_ < REPS(10); ++rep_) { p11_x1_router(F0); }
    if (IN(11)) for (int rep_ = 0; rep_ < REPS(11); ++rep_) { p12_expert_convert(F0); } SEAM(11);
    if (IN(12)) for (int rep_ = 0; rep_ < REPS(12); ++rep_) {
        PHASE_VIEW();
        moe_build_tp(F);
        MoeOrder<true> S{(const LAS int*)(F.lds + TP_OFF), F.ctl + CW_CNT, (const int*)(F.ws + WS_LIST), (const char*)(F.ws + WS_H), (const char*)(F.ws + WS_EW1), F.G, (int)blockIdx.x};
        pg8::EpiSwiglu E{(bf16*)(F.ws + WS_HID)};
        pg8::gemm_phase(ring, DM, S, E);
        __syncthreads();
        for (;;) { int base = 0; if (F.lane == 0) base = (int)atomicAdd(F.ctl + CW_POOL, (unsigned)CONV_CLAIM); base = __builtin_amdgcn_readfirstlane(base);
            if (base >= CONV_POOL) break;
            (void)conv_stream(F, CONV_MAIN + base, 1, CONV_MAIN + (base + CONV_CLAIM < CONV_POOL ? base + CONV_CLAIM : CONV_POOL), F.ctl + CW_TMO + 2); }
    } SEAM(12);
    if (IN(13)) for (int rep_ = 0; rep_ < REPS(13); ++rep_) {
        PHASE_VIEW();
        if (!IN(12)) moe_build_tp(F);
        MoeOrder<false> S{(const LAS int*)(F.lds + TP_OFF), F.ctl + CW_CNT, (const int*)(F.ws + WS_LIST), (const char*)(F.ws + WS_HID), (const char*)(F.ws + WS_EW2), F.G, (int)blockIdx.x};
        pg8::EpiBf16 E{(bf16*)(F.ws + WS_YSLOT), DM};
        pg8::gemm_phase(ring, DEXP, S, E);
    } SEAM(13);
    if (IN(14)) for (int rep_ = 0; rep_ < REPS(14); ++rep_) { if (!IN(13)) moe_build_tp(F0); p15_final(F0); }
#undef IN
#undef SEAM
}

extern "C" void kernel_launch(void* const* d_in, const int* in_sizes, int n_in, void* d_out, int out_size, void* d_ws, size_t ws_size, hipStream_t stream) {
    static int grid = 0;
    if (grid == 0) {
        if (n_in != 38 || out_size != NT * DM || ws_size < WS_END) { fprintf(stderr, "kernel_launch: unexpected problem (n_in %d, out %d, ws %zu < %zu)\n", n_in, out_size, ws_size, (size_t)WS_END); grid = -1; return; }
        int dev = 0, cus = 0, per_cu = 0;
        if (hipGetDevice(&dev) != hipSuccess || hipDeviceGetAttribute(&cus, hipDeviceAttributeMultiprocessorCount, dev) != hipSuccess) { grid = -1; return; }
        if (hipFuncSetAttribute((const void*)mk_fwd, hipFuncAttributeMaxDynamicSharedMemorySize, LDS_BYTES) != hipSuccess) { fprintf(stderr, "kernel_launch: hipFuncSetAttribute failed\n"); grid = -1; return; }
        if (hipOccupancyMaxActiveBlocksPerMultiprocessor(&per_cu, (const void*)mk_fwd, NTHR, LDS_BYTES) != hipSuccess || per_cu < 1) fprintf(stderr, "kernel_launch: occupancy query says %d\n", per_cu);
        (void)hipGetLastError();
        grid = cus;
    }
    if (grid < 0) return;
    if (hipMemsetAsync((char*)d_ws + WS_CTL, 0, CTL_ZERO_BYTES, stream) != hipSuccess) return;
    Args a{};
    for (int i = 0; i < 38; ++i) a.in[i] = (const float*)d_in[i];
    a.out = (float*)d_out; a.ws = (unsigned char*)d_ws;
#if MK_N_LAUNCHES == 1
    a.ph_lo = 0; a.ph_hi = NPH;
    hipLaunchKernelGGL(mk_fwd, dim3(grid), dim3(NTHR), LDS_BYTES, stream, a);
#else
    for (int p = 0; p < NPH; ++p) { a.ph_lo = p; a.ph_hi = p + 1; hipLaunchKernelGGL(mk_fwd, dim3(grid), dim3(NTHR), LDS_BYTES, stream, a); }
#endif
}
```

```cpp
#include <hip/hip_runtime.h>
#include <cstdio>
#include <cstdint>

#ifndef MK_N_LAUNCHES
#define MK_N_LAUNCHES 1
#endif

#ifndef CONV_GEMM_BLOCKS
#define CONV_GEMM_BLOCKS 184
#endif

#define GAS __attribute__((address_space(1)))
namespace pg8 {
#define PG8_LAS __attribute__((address_space(3)))
typedef unsigned short bf16_t;
typedef short bf16x8 __attribute__((ext_vector_type(8)));
typedef float f32x4 __attribute__((ext_vector_type(4)));
typedef float f32x2 __attribute__((ext_vector_type(2)));
typedef unsigned u32x4 __attribute__((ext_vector_type(4)));
typedef unsigned u32x2 __attribute__((ext_vector_type(2)));
constexpr int BM = 256, BK = 64, HALF = 128, HTB = HALF * BK * 2, STAGE_BYTES = 8 * HTB, NXCD = 8, WGM = 8;

__host__ __device__ __forceinline__ int lds_byte(int r, int c) { const int st = (r >> 4) * 2 + (c >> 5), rr = r & 15, cc = c & 31, ob = rr * 64 + cc * 2; return st * 1024 + (ob ^ (((ob >> 9) & 1) << 5)); }
__host__ __device__ __forceinline__ void stage_rc(int b, int& R, int& C) { const int st = b / 1024, sb = b % 1024, swz = sb ^ (((sb >> 9) & 1) << 5); R = (st >> 1) * 16 + swz / 64; C = (st & 1) * 32 + (swz % 64) / 2; }
__host__ __device__ __forceinline__ int perm32(int rho) { const int n = rho >> 4, i = rho & 15; return 8 * (i >> 2) + 4 * n + (i & 3); }

struct Unit { int pm, pn, e, cnt; const char* Ab; const char* Bb; };
struct Gemm { const bf16_t* A; const bf16_t* Bt; int M, N, K; };

struct StaticOrder {
    static constexpr bool GATHER = false; static constexpr int A2 = 0;
    __device__ __forceinline__ size_t kstepA() const { return (size_t)BK * 2; }
    __device__ __forceinline__ size_t hstepA() const { return (size_t)HALF * K * 2; }
    __device__ __forceinline__ size_t a2off() const { return 0; }
    int nM, nN, nwg, G, c, K; const char* A; const char* Bt;
    __device__ void init(const Gemm& g, int G_, int c_) { nM = g.M / BM; nN = g.N / BM; nwg = nM * nN; G = G_; c = c_; K = g.K; A = (const char*)g.A; Bt = (const char*)g.Bt; }
    __device__ bool next(int i, Unit& u) const {
        const long L = (long)i * G + c; if (L >= nwg) return false;
        int wgid = (int)L; { const int q = nwg / NXCD, r = nwg % NXCD, xcd = wgid % NXCD, off = wgid / NXCD; wgid = (xcd < r ? xcd * (q + 1) : r * (q + 1) + (xcd - r) * q) + off; }
        const int nig = WGM * nN, gid = wgid / nig, fm = gid * WGM, gsz = (nM - fm) < WGM ? (nM - fm) : WGM;
        u.pm = fm + ((wgid % nig) % gsz); u.pn = (wgid % nig) / gsz; u.e = 0; u.cnt = BM;
        u.Ab = A + (size_t)u.pm * BM * K * 2; u.Bb = Bt + (size_t)u.pn * BM * K * 2; return true;
    }
    template <int NV> __device__ __forceinline__ void a_voff(const Unit&, unsigned (&v)[NV][2], const int (&R)[2], const int (&C)[2]) const {
#pragma unroll
        for (int i = 0; i < 2; ++i) v[0][i] = (unsigned)(R[i] * K + C[i]) * 2u;
    }
};

typedef __bf16 bf16x2_v __attribute__((ext_vector_type(2)));
__device__ __forceinline__ unsigned cvt_pk_bf16(float lo, float hi) { const f32x2 v = {lo, hi}; const bf16x2_v b = __builtin_convertvector(v, bf16x2_v); return __builtin_bit_cast(unsigned, b); }
__device__ __forceinline__ float bf_lo(unsigned w) { return __uint_as_float(w << 16); }
__device__ __forceinline__ float bf_hi(unsigned w) { return __uint_as_float(w & 0xffff0000u); }
__device__ __forceinline__ float sigmoidf_(float x) { return __builtin_amdgcn_rcpf(1.0f + __builtin_amdgcn_exp2f(-1.4426950408889634f * x)); }

struct EpiF32 {
    static constexpr bool AFTER_DRAIN = false; static constexpr bool PERM = false;
    float* C; int ldc;
    __device__ __forceinline__ void operator()(const f32x4 (&acc)[2][2][4][2], const Unit& u, int wr, int wc, int fr, int fq) const {
        const int row0 = u.pm * BM + wr * 64 + fr, col0 = u.pn * BM + wc * 32 + 4 * fq;
#pragma unroll
        for (int ai = 0; ai < 2; ++ai)
#pragma unroll
            for (int m = 0; m < 4; ++m) { float* rowp = C + (size_t)(row0 + ai * HALF + m * 16) * ldc + col0;
#pragma unroll
                for (int bj = 0; bj < 2; ++bj)
#pragma unroll
                    for (int n = 0; n < 2; ++n) *(f32x4*)(rowp + bj * HALF + n * 16) = acc[ai][bj][m][n]; }
    }
};
struct EpiBf16 {
    static constexpr bool AFTER_DRAIN = false; static constexpr bool PERM = true;
    bf16_t* O; int ldc;
    __device__ __forceinline__ void operator()(const f32x4 (&acc)[2][2][4][2], const Unit& u, int wr, int wc, int fr, int fq) const {
        const int row0 = u.pm * BM + wr * 64 + fr, col0 = u.pn * BM + wc * 32 + 8 * fq;
#pragma unroll
        for (int ai = 0; ai < 2; ++ai)
#pragma unroll
            for (int m = 0; m < 4; ++m) { GAS bf16_t* rowp = (GAS bf16_t*)O + (size_t)(row0 + ai * HALF + m * 16) * ldc + col0;
#pragma unroll
                for (int bj = 0; bj < 2; ++bj) { const f32x4 v0 = acc[ai][bj][m][0], v1 = acc[ai][bj][m][1];
                    u32x4 w; w.x = cvt_pk_bf16(v0[0], v0[1]); w.y = cvt_pk_bf16(v0[2], v0[3]); w.z = cvt_pk_bf16(v1[0], v1[1]); w.w = cvt_pk_bf16(v1[2], v1[3]);
                    *(GAS u32x4*)(rowp + bj * HALF) = w; } }
    }
};
struct EpiLora {
    static constexpr bool AFTER_DRAIN = false; static constexpr bool PERM = false;
    float* base; size_t stride; const float* w0; const float* a0;
    __device__ __forceinline__ void operator()(const f32x4 (&acc)[2][2][4][2], const Unit& u, int wr, int wc, int fr, int fq) const {
        const int row0 = u.pm * BM + wr * 64 + fr; const int kind = u.pn >> 2; const int col0 = (u.pn & 3) * BM + wc * 32 + 4 * fq;
        float* dst = base + (size_t)kind * stride;
        const float* bp = (kind == 0) ? w0 : a0; const float bs = (kind == 2) ? 0.f : 1.f;
        f32x4 bv[2][2];
#pragma unroll
        for (int bj = 0; bj < 2; ++bj)
#pragma unroll
            for (int n = 0; n < 2; ++n) bv[bj][n] = *(const f32x4*)(bp + col0 + bj * HALF + n * 16) * bs;
#pragma unroll
        for (int ai = 0; ai < 2; ++ai)
#pragma unroll
            for (int m = 0; m < 4; ++m) { float* rowp = dst + (size_t)(row0 + ai * HALF + m * 16) * 1024 + col0;
#pragma unroll
                for (int bj = 0; bj < 2; ++bj)
#pragma unroll
                    for (int n = 0; n < 2; ++n) { f32x4 v = acc[ai][bj][m][n] + bv[bj][n];
                        if (kind == 0) {
#pragma unroll
                            for (int j = 0; j < 4; ++j) v[j] = __expf(-0.6065306597126334f * sigmoidf_(v[j])); }
                        else if (kind == 1) {
#pragma unroll
                            for (int j = 0; j < 4; ++j) v[j] = sigmoidf_(v[j]); }
                        *(f32x4*)(rowp + bj * HALF + n * 16) = v; } }
    }
};
struct EpiGlu {
    static constexpr bool AFTER_DRAIN = false; static constexpr bool PERM = true;
    const bf16_t* Y; bf16_t* O; int ldo; const float* bias;
    __device__ __forceinline__ void operator()(const f32x4 (&acc)[2][2][4][2], const Unit& u, int wr, int wc, int fr, int fq) const {
        const int row0 = u.pm * BM + wr * 64 + fr, col0 = u.pn * BM + wc * 32 + 8 * fq;
        f32x4 bv[2][2];
#pragma unroll
        for (int bj = 0; bj < 2; ++bj)
#pragma unroll
            for (int n = 0; n < 2; ++n) bv[bj][n] = *(const GAS f32x4*)((const GAS float*)bias + col0 + bj * HALF + 4 * n);
#pragma unroll
        for (int ai = 0; ai < 2; ++ai)
#pragma unroll
            for (int m = 0; m < 4; ++m) { const size_t r = (size_t)(row0 + ai * HALF + m * 16);
#pragma unroll
                for (int bj = 0; bj < 2; ++bj) { const u32x4 yv = *(const GAS u32x4*)((const GAS bf16_t*)Y + r * 1024 + col0 + bj * HALF);
                    const f32x4 v0 = acc[ai][bj][m][0] + bv[bj][0], v1 = acc[ai][bj][m][1] + bv[bj][1];
                    u32x4 w;
                    w.x = cvt_pk_bf16(bf_lo(yv.x) * sigmoidf_(v0[0]), bf_hi(yv.x) * sigmoidf_(v0[1]));
                    w.y = cvt_pk_bf16(bf_lo(yv.y) * sigmoidf_(v0[2]), bf_hi(yv.y) * sigmoidf_(v0[3]));
                    w.z = cvt_pk_bf16(bf_lo(yv.z) * sigmoidf_(v1[0]), bf_hi(yv.z) * sigmoidf_(v1[1]));
                    w.w = cvt_pk_bf16(bf_lo(yv.w) * sigmoidf_(v1[2]), bf_hi(yv.w) * sigmoidf_(v1[3]));
                    *(GAS u32x4*)((GAS bf16_t*)O + r * ldo + col0 + bj * HALF) = w; } }
    }
};
struct EpiSwiglu {
    static constexpr bool AFTER_DRAIN = false; static constexpr bool PERM = true;
    bf16_t* Hd;
    __device__ __forceinline__ void operator()(const f32x4 (&acc)[2][2][4][2], const Unit& u, int wr, int wc, int fr, int fq) const {
        const int row0 = u.pm * BM + wr * 64 + fr, col0 = u.pn * HALF + wc * 32 + 8 * fq;
#pragma unroll
        for (int ai = 0; ai < 2; ++ai)
#pragma unroll
            for (int m = 0; m < 4; ++m) { GAS bf16_t* rowp = (GAS bf16_t*)Hd + (size_t)(row0 + ai * HALF + m * 16) * 512 + col0;
                float o[8];
#pragma unroll
                for (int n = 0; n < 2; ++n)
#pragma unroll
                    for (int j = 0; j < 4; ++j) { const float a = acc[ai][0][m][n][j], b = acc[ai][1][m][n][j]; o[n * 4 + j] = a * sigmoidf_(a) * b; }
                u32x4 w; w.x = cvt_pk_bf16(o[0], o[1]); w.y = cvt_pk_bf16(o[2], o[3]); w.z = cvt_pk_bf16(o[4], o[5]); w.w = cvt_pk_bf16(o[6], o[7]);
                *(GAS u32x4*)rowp = w; }
    }
};

struct EpiS5Scan {
    static constexpr bool AFTER_DRAIN = true; static constexpr bool PERM = false;
    bf16_t* SIN; const float* lam_re; const float* lam_im; const float* log_dt;
    __device__ __forceinline__ void operator()(const f32x4 (&)[2][2][4][2], const Unit&, int, int, int, int) const {}
    __device__ __forceinline__ void fused(const f32x4 (&acc)[2][2][4][2], const Unit& u, int wr, int wc, int fr, int fq, PG8_LAS unsigned char* lds) const {
        PG8_LAS float* T = (PG8_LAS float*)lds;
#pragma unroll
        for (int ai = 0; ai < 2; ++ai)
#pragma unroll
            for (int m = 0; m < 4; ++m)
#pragma unroll
                for (int n = 0; n < 2; ++n) *(PG8_LAS f32x4*)(T + (ai * HALF + wr * 64 + m * 16 + fr) * 128 + wc * 32 + n * 16 + 4 * fq) = acc[ai][0][m][n];
        __syncthreads();
        const int tid = threadIdx.x;
        if (tid < 128) {
            const int b2 = tid >> 6, p = tid & 63, g = u.e;
            const float lr = fminf(lam_re[g * 64 + p], -1e-4f), li = lam_im[g * 64 + p], dt = __expf(log_dt[g]);
            const float mag = __expf(lr * dt * 16.f), ang = li * dt * 16.f; const float ar = mag * cosf(ang), ai_ = mag * sinf(ang);
            float sr = 0.f, si = 0.f;
            GAS bf16_t* dst = (GAS bf16_t*)SIN + ((size_t)(u.pm * 256 + b2 * 128) * 16 + (p >> 4)) * 4352 + g * 16 + (p & 15);
            const PG8_LAS float* src = T + (b2 * 128) * 128 + p;
#pragma unroll 8
            for (int ch = 0; ch < 128; ++ch) {
                const unsigned w = cvt_pk_bf16(sr, si);
                dst[(size_t)ch * 16 * 4352] = (bf16_t)(w & 0xffffu); dst[(size_t)ch * 16 * 4352 + 4 * 4352] = (bf16_t)(w >> 16);
                const float lr_ = src[ch * 128], li_ = src[ch * 128 + 64];
                const float nr = ar * sr - ai_ * si + lr_, ni = ar * si + ai_ * sr + li_; sr = nr; si = ni;
            }
        }
    }
};
__device__ __forceinline__ float gelu_tanh_(float y) { const float u = 0.7978845608028654f * (y + 0.044715f * y * y * y); const float e = __builtin_amdgcn_exp2f(2.8853900817779268f * u); return y * (1.f - __builtin_amdgcn_rcpf(e + 1.f)); }
struct EpiS5Y {
    static constexpr bool AFTER_DRAIN = false; static constexpr bool PERM = true;
    bf16_t* Y;
    __device__ __forceinline__ void operator()(const f32x4 (&acc)[2][2][4][2], const Unit& u, int wr, int wc, int fr, int fq) const {
        const int row0 = u.pm * BM + wr * 64 + fr;
#pragma unroll
        for (int ai = 0; ai < 2; ++ai)
#pragma unroll
            for (int m = 0; m < 4; ++m) { const size_t r = (size_t)(row0 + ai * HALF + m * 16);
#pragma unroll
                for (int bj = 0; bj < 2; ++bj) { const int col = bj * HALF + wc * 32 + 8 * fq; const int t = col >> 4, c = col & 15;
                    const f32x4 v0 = acc[ai][bj][m][0], v1 = acc[ai][bj][m][1];
                    u32x4 w; w.x = cvt_pk_bf16(gelu_tanh_(v0[0]), gelu_tanh_(v0[1])); w.y = cvt_pk_bf16(gelu_tanh_(v0[2]), gelu_tanh_(v0[3]));
                    w.z = cvt_pk_bf16(gelu_tanh_(v1[0]), gelu_tanh_(v1[1])); w.w = cvt_pk_bf16(gelu_tanh_(v1[2]), gelu_tanh_(v1[3]));
                    *(GAS u32x4*)((GAS bf16_t*)Y + (r * 16 + t) * 1024 + u.e * 16 + c) = w; } }
    }
};

template <class Epi, class Sched>
__device__ __forceinline__ void gemm_phase(PG8_LAS unsigned char* lds, const int K, const Sched& S, const Epi& E) {
    const int tid = threadIdx.x, wid = __builtin_amdgcn_readfirstlane(tid >> 6), lane = tid & 63, wr = wid >> 2, wc = wid & 3, fr = lane & 15, fq = lane >> 4;
    const int nt = K / BK;
    int RR[2], CC[2]; unsigned voffB[2];
#pragma unroll
    for (int i = 0; i < 2; ++i) { stage_rc(tid * 16 + i * 8192, RR[i], CC[i]); const int Rb = Epi::PERM ? ((RR[i] & ~31) + perm32(RR[i] & 31)) : RR[i];
        voffB[i] = (unsigned)(Rb * K + CC[i]) * 2u; }
    const size_t kstep = (size_t)(BK * 2);
    const size_t hstep = (size_t)HALF * K * 2;
    const unsigned ldsw = (unsigned)wid * 1024u;
    const int aoff = lds_byte(wr * 64 + fr, fq * 8), boff = lds_byte(wc * 32 + fr, fq * 8);
#define PG8_SA(b, h) (((b) * 2 + (h)) * HTB)
#define PG8_SB(b, h) ((4 + (b) * 2 + (h)) * HTB)
#define PG8_STAGE(bufoff, gbase, voff) do { _Pragma("unroll") for (int _i = 0; _i < 2; ++_i) \
        __builtin_amdgcn_global_load_lds((const unsigned*)((const char*)(gbase) + (voff)[_i]), (PG8_LAS unsigned*)(lds + (bufoff) + ldsw + _i * 8192), 16, 0, 0); } while (0)
#define PG8_LDA(dst, b, h) do { _Pragma("unroll") for (int m = 0; m < 4; ++m) _Pragma("unroll") for (int k = 0; k < 2; ++k) dst[m][k] = *(const PG8_LAS bf16x8*)(lds + PG8_SA(b, h) + aoff + m * 2048 + k * 1024); } while (0)
#define PG8_LDB(dst, b, h) do { _Pragma("unroll") for (int n = 0; n < 2; ++n) _Pragma("unroll") for (int k = 0; k < 2; ++k) dst[n][k] = *(const PG8_LAS bf16x8*)(lds + PG8_SB(b, h) + boff + n * 2048 + k * 1024); } while (0)
#define PG8_MMA(ai, bj, At, Bt) do { __builtin_amdgcn_s_setprio(1); _Pragma("unroll") for (int m = 0; m < 4; ++m) _Pragma("unroll") for (int n = 0; n < 2; ++n) _Pragma("unroll") for (int k = 0; k < 2; ++k) \
        acc[ai][bj][m][n] = __builtin_amdgcn_mfma_f32_16x16x32_bf16(Bt[n][k], At[m][k], acc[ai][bj][m][n], 0, 0, 0); __builtin_amdgcn_s_setprio(0); } while (0)
#define PG8_WAIT_V(n) asm volatile("s_waitcnt vmcnt(" #n ")" ::: "memory")
#define PG8_WAIT_L(n) asm volatile("s_waitcnt lgkmcnt(" #n ")" ::: "memory")
#define PG8_BAR __builtin_amdgcn_s_barrier()
#define PG8_SCHED __builtin_amdgcn_sched_barrier(0)
    Unit cur, nxt; int ui = 0;
    if (!S.next(0, cur)) return;
    f32x4 acc[2][2][4][2];
#pragma unroll
    for (int a = 0; a < 2; ++a)
#pragma unroll
        for (int b = 0; b < 2; ++b)
#pragma unroll
            for (int m = 0; m < 4; ++m)
#pragma unroll
                for (int n = 0; n < 2; ++n) acc[a][b][m][n] = (f32x4){0.f, 0.f, 0.f, 0.f};
    bf16x8 At[4][2], B0[2][2], B1[2][2];
    constexpr bool GA = Sched::GATHER;
    constexpr int A2 = Sched::A2;
    constexpr int NV = GA ? 2 : 1;
    unsigned vA[NV][2], vN[NV][2];
    const size_t kstepA = S.kstepA(), hstepA = GA ? 0 : S.hstepA();
    const size_t a2off = (A2 > 0) ? S.a2off() : 0;
    S.template a_voff<NV>(cur, vA, RR, CC);
    const char* cA = cur.Ab; const char* cB = cur.Bb;
    PG8_STAGE(PG8_SB(0, 0), cB, voffB); PG8_STAGE(PG8_SB(0, 1), cB + hstep, voffB); PG8_STAGE(PG8_SA(0, 0), cA, vA[0]); PG8_STAGE(PG8_SA(0, 1), cA + hstepA, vA[NV - 1]);
    if (wr == 1) PG8_BAR;
    PG8_WAIT_V(2); PG8_BAR;
    PG8_STAGE(PG8_SB(1, 0), cB + kstep, voffB); PG8_STAGE(PG8_SA(1, 0), cA + kstepA, vA[0]); PG8_STAGE(PG8_SB(1, 1), cB + hstep + kstep, voffB);
    PG8_WAIT_V(6); PG8_BAR;
    for (;;) {
        const bool has_next = S.next(ui + 1, nxt);
        const char* nA = has_next ? nxt.Ab : cA; const char* nB = has_next ? nxt.Bb : cB;
        if constexpr (GA) {
            if (has_next) S.template a_voff<NV>(nxt, vN, RR, CC);
            else {
#pragma unroll
                for (int h = 0; h < NV; ++h)
#pragma unroll
                    for (int i = 0; i < 2; ++i) vN[h][i] = vA[h][i]; }
        }
#pragma clang loop unroll(disable)
        for (int t = 0; t < nt; t += 2) {
            const bool last = (t == nt - 2);
            const bool s1 = (A2 > 0) && (t + 1 >= A2), s2 = (A2 > 0) && !last && (t + 2 >= A2);
            const char* a1 = cA + (size_t)(t + 1) * kstepA + (s1 ? a2off : 0);
            const char* a2 = last ? nA : cA + (size_t)(t + 2) * kstepA + (s2 ? a2off : 0);
            const char* a3 = a2 + kstepA;
            const char* b2 = last ? nB : cB + (size_t)(t + 2) * kstep; const char* b3 = b2 + kstep;
            unsigned v2[NV][2];
#pragma unroll
            for (int h = 0; h < NV; ++h)
#pragma unroll
                for (int i = 0; i < 2; ++i) v2[h][i] = (GA && last) ? vN[h][i] : vA[h][i];
            PG8_LDB(B0, 0, 0); PG8_LDB(B1, 0, 1); PG8_SCHED; PG8_LDA(At, 0, 0); PG8_STAGE(PG8_SA(1, 1), a1 + hstepA, vA[NV - 1]);
            PG8_WAIT_V(8); PG8_WAIT_L(0); PG8_BAR; PG8_MMA(0, 0, At, B0); PG8_MMA(0, 1, At, B1); PG8_BAR; PG8_SCHED;
            PG8_LDA(At, 0, 1); PG8_STAGE(PG8_SB(0, 0), b2, voffB); PG8_STAGE(PG8_SB(0, 1), b2 + hstep, voffB); PG8_STAGE(PG8_SA(0, 0), a2, v2[0]);
            PG8_WAIT_V(8); PG8_WAIT_L(0); PG8_BAR; PG8_MMA(1, 0, At, B0); PG8_MMA(1, 1, At, B1); PG8_BAR; PG8_SCHED;
            PG8_LDB(B0, 1, 0); PG8_LDB(B1, 1, 1); PG8_SCHED; PG8_LDA(At, 1, 0); PG8_STAGE(PG8_SA(0, 1), a2 + hstepA, v2[NV - 1]);
            PG8_WAIT_V(8); PG8_WAIT_L(0); PG8_BAR; PG8_MMA(0, 0, At, B0); PG8_MMA(0, 1, At, B1); PG8_BAR; PG8_SCHED;
            PG8_LDA(At, 1, 1); PG8_STAGE(PG8_SB(1, 0), b3, voffB); PG8_STAGE(PG8_SB(1, 1), b3 + hstep, voffB); PG8_STAGE(PG8_SA(1, 0), a3, v2[0]);
            PG8_WAIT_V(8); PG8_WAIT_L(0); PG8_BAR; PG8_MMA(1, 0, At, B0); PG8_MMA(1, 1, At, B1); PG8_BAR; PG8_SCHED;
        }
        if (wr == 0) PG8_BAR;
        if constexpr (!Epi::AFTER_DRAIN) E(acc, cur, wr, wc, fr, fq);
        if (!has_next) break;
#pragma unroll
        for (int a = 0; a < 2; ++a)
#pragma unroll
            for (int b = 0; b < 2; ++b)
#pragma unroll
                for (int m = 0; m < 4; ++m)
#pragma unroll
                    for (int n = 0; n < 2; ++n) acc[a][b][m][n] = (f32x4){0.f, 0.f, 0.f, 0.f};
        cur = nxt; cA = nA; cB = nB; ++ui;
        if constexpr (GA) {
#pragma unroll
            for (int h = 0; h < NV; ++h)
#pragma unroll
                for (int i = 0; i < 2; ++i) vA[h][i] = vN[h][i]; }
        if (wr == 1) PG8_BAR;
    }
    PG8_WAIT_V(0);
    PG8_BAR;
    if constexpr (Epi::AFTER_DRAIN) E.fused(acc, cur, wr, wc, fr, fq, lds);
#undef PG8_SA
#undef PG8_SB
#undef PG8_STAGE
#undef PG8_LDA
#undef PG8_LDB
#undef PG8_MMA
#undef PG8_WAIT_V
#undef PG8_WAIT_L
#undef PG8_BAR
#undef PG8_SCHED
}
}
using pg8::f32x4; using pg8::f32x2; using pg8::u32x4; using pg8::u32x2; using pg8::cvt_pk_bf16; using pg8::bf_lo; using pg8::bf_hi; using pg8::sigmoidf_;

constexpr int NWAVES = 8, NTHR = 512;
constexpr int DM = 2048, NB = 8, SEQ = 2048, NT = NB * SEQ;
constexpr int DSSM = 1024, NG = 64, GC = 16, NP = 64;
constexpr int DRW = 1024, NH = 16, HD = 64;
constexpr int DIN = 4352, ZW = 3328;
constexpr int NEXP = 64, DEXP = 512, NMOD = 6 * DM;
constexpr float RMS_EPS = 1e-6f, GN_EPS = 64e-5f;
constexpr int CAP_ROWS = 49152;

constexpr size_t MiB = 1u << 20;
constexpr size_t WS_CTL = 0, CTL_ZERO_BYTES = 1 * MiB;
constexpr size_t WS_MOD = 1 * MiB;
constexpr size_t WS_RWT = 1 * MiB + 512 * 1024;
constexpr size_t WS_LORA_T = 2 * MiB + 512 * 1024;
constexpr size_t WS_GLU_T = 4 * MiB;
constexpr size_t WS_WOUT_T = 6 * MiB;
constexpr size_t WS_WIN_T = 14 * MiB;
constexpr size_t WS_TOKINFO = 31 * MiB;
constexpr size_t WS_LIST = 32 * MiB;
constexpr size_t WS_LIN = 36 * MiB;
constexpr size_t WS_H = 44 * MiB;
constexpr size_t WS_PROJ = 108 * MiB;
constexpr size_t WS_MIX = 244 * MiB;
constexpr size_t WS_EW1 = 308 * MiB;
constexpr size_t WS_EW2 = 564 * MiB;
constexpr size_t WS_SIN = 692 * MiB;
constexpr size_t WS_YSG = 44 * MiB;
constexpr size_t WS_S5MT = 860 * MiB;
constexpr size_t WS_S5WT = 872 * MiB;
constexpr size_t WS_VB = 692 * MiB;
constexpr size_t WS_GB = 724 * MiB;
constexpr size_t WS_GHQ = 756 * MiB;
constexpr size_t WS_GT = 948 * MiB;
constexpr size_t WS_BON = 950 * MiB;
constexpr size_t WS_Y = 952 * MiB;
constexpr size_t WS_X1 = 692 * MiB;
constexpr size_t WS_HID = 756 * MiB;
constexpr size_t WS_END = 984 * MiB;
constexpr size_t WS_MIXED = 108 * MiB;
constexpr size_t WS_YSLOT = 108 * MiB;
static_assert(WS_YSLOT + (size_t)CAP_ROWS * 2048 * 2 <= WS_EW1, "yslot overlay");
static_assert(WS_HID + (size_t)CAP_ROWS * 512 * 2 <= WS_END && WS_GHQ + (size_t)8192 * 12288 * 2 <= WS_GT && WS_SIN + (size_t)NT * DIN * 2 <= WS_S5MT, "pool");
constexpr int CW_TMO = 0;
constexpr int CW_BAR = 4096;
constexpr int CW_CNT = 16384;
constexpr int CW_GDONE = 8192, CW_STOP = 8192 + 64, CW_PROG = 8192 + 128;
constexpr int CONV_ITEMS = NEXP * 1536;
constexpr int CONV_POOL = 32768, CONV_MAIN = CONV_ITEMS - CONV_POOL, CONV_CLAIM = 12;
constexpr int CW_POOL = 12288;


constexpr int RING_BYTES = 131072;
constexpr int LDSCTL_OFF = 147456 - 2048;
constexpr int MISC_OFF = LDSCTL_OFF;
constexpr int TP_OFF = LDSCTL_OFF + 256;
constexpr int LDS_BYTES = 147456;

#define LAS __attribute__((address_space(3)))
typedef unsigned short bf16;
typedef GAS unsigned gu32;
#define RLX_AGENT __ATOMIC_RELAXED, __HIP_MEMORY_SCOPE_AGENT

#define XB_TMO      128
#define XB_XCNT(j)  (256  + 64 * (j))
#define XB_XSUB(j)  (1280 + 64 * (j))
#define XB_XGEN(j)  (2304 + 64 * (j))
#define XB_TOP      3328
#define XB_TOPGEN   3392
#define XCD_BAR_WORDS 3456
#define XB_SPIN_CAP (1u << 18)
__device__ __forceinline__ unsigned xb_ld(unsigned* p)              { return __hip_atomic_load(p, __ATOMIC_RELAXED, __HIP_MEMORY_SCOPE_AGENT); }
__device__ __forceinline__ unsigned xb_add(unsigned* p, unsigned v) { return __hip_atomic_fetch_add(p, v, __ATOMIC_RELAXED, __HIP_MEMORY_SCOPE_AGENT); }
__device__ __forceinline__ unsigned xb_xcc_id() { return (unsigned)__builtin_amdgcn_s_getreg((3 << 11) | 20) & 0xFu; }
#define XB_SPIN(cond, bar) do { unsigned _sp = 0; while (cond) { __builtin_amdgcn_s_sleep(1); \
    if ((++_sp & 255u) == 0u) { if (xb_ld(&(bar)[XB_TMO])) break; if (_sp > XB_SPIN_CAP) { atomicAdd(&(bar)[XB_TMO], 1u); break; } } } } while (0)
struct XcdBarrier { unsigned* bar; unsigned x; volatile LAS unsigned* st; };
__device__ __forceinline__ XcdBarrier xcd_barrier_post(unsigned* bar, volatile LAS unsigned* st) {
    XcdBarrier b; b.bar = bar; b.x = xb_xcc_id(); b.st = st;
    if (threadIdx.x == 0) (void)xb_add(&bar[XB_XCNT(b.x)], 1u);
    return b;
}
__device__ __forceinline__ void xcd_barrier_complete(unsigned* bar, unsigned x, unsigned& nloc, unsigned& nx) {
    const unsigned G = gridDim.x * gridDim.y * gridDim.z;
    unsigned sum, cnt, mine, sp = 0u;
    for (;;) {
        sum = 0u; cnt = 0u; mine = 0u;
#pragma unroll
        for (unsigned j = 0; j < 16; ++j) { const unsigned c = xb_ld(&bar[XB_XCNT(j)]); sum += c; cnt += (c > 0u) ? 1u : 0u; mine = (j == x) ? c : mine; }
        if (sum == G) break;
        __builtin_amdgcn_s_sleep(1);
        if ((++sp & 255u) == 0u) { if (xb_ld(&bar[XB_TMO])) break; if (sp > XB_SPIN_CAP) { atomicAdd(&bar[XB_TMO], 1u); break; } }
    }
    nloc = mine > 0u ? mine : 1u; nx = cnt > 0u ? cnt : 1u;
}
__device__ __forceinline__ void xcd_barrier(const XcdBarrier& b) {
    asm volatile("s_waitcnt vmcnt(0)" ::: "memory");
    __syncthreads();
    if (threadIdx.x == 0) {
        unsigned* bar = b.bar;
        __builtin_amdgcn_s_waitcnt(0);
        unsigned nloc = b.st[0], nx = b.st[1];
        if (nloc == 0u) { xcd_barrier_complete(bar, b.x, nloc, nx); b.st[0] = nloc; b.st[1] = nx; }
        const unsigned old = xb_add(&bar[XB_XSUB(b.x)], 1u);
        const unsigned gen = old / nloc;
        if (old + 1u == (gen + 1u) * nloc) {
            __builtin_amdgcn_fence(__ATOMIC_RELEASE, "agent");
            asm volatile("s_waitcnt vmcnt(0)" ::: "memory");
            const unsigned og = xb_add(&bar[XB_TOP], 1u);
            const unsigned tg = og / nx;
            if (og + 1u == (tg + 1u) * nx) xb_add(&bar[XB_TOPGEN], 1u);
            else XB_SPIN(xb_ld(&bar[XB_TOPGEN]) == tg, bar);
            __builtin_amdgcn_fence(__ATOMIC_ACQUIRE, "agent");
            xb_add(&bar[XB_XGEN(b.x)], 1u);
            asm volatile("s_waitcnt vmcnt(0)" ::: "memory");
        } else {
            XB_SPIN(xb_ld(&bar[XB_XGEN(b.x)]) == gen, bar);
            __builtin_amdgcn_fence(__ATOMIC_ACQUIRE, "agent");
            asm volatile("s_waitcnt vmcnt(0)" ::: "memory");
        }
    }
    __syncthreads();
}

struct Args { const float* in[38]; float* out; unsigned char* ws; int ph_lo, ph_hi; };
typedef const float* cfp_t;
typedef __attribute__((address_space(4))) const unsigned char* kargp_t;
struct InTab { kargp_t kp;
    __device__ __forceinline__ const float* operator[](int i) const { return *(const __attribute__((address_space(4))) cfp_t*)(kp + 8 * i); } };
struct Frame {
    LAS unsigned char* lds; volatile LAS unsigned* MISC; unsigned* ctl;
    int tid, lane, wave, vcu, G;
    InTab in; float* out; unsigned char* ws;
};
#define LDS_WAIT() asm volatile("s_waitcnt lgkmcnt(0)" ::: "memory")
#define LAUNDER(p) asm volatile("" : "+s"(p))
#define LDS_BARRIER() do { asm volatile("s_waitcnt lgkmcnt(0)" ::: "memory"); __builtin_amdgcn_s_barrier(); asm volatile("" ::: "memory"); } while (0)
#define PHASE_VIEW() Frame F = F0; LAUNDER(F.ws); LAUNDER(F.in.kp); LAUNDER(F.ctl)
__device__ __forceinline__ float wave_sum(float v) {
#pragma unroll
    for (int o = 1; o < 64; o <<= 1) v += __shfl_xor(v, o);
    return v;
}
__device__ __forceinline__ float wave_max(float v) {
#pragma unroll
    for (int o = 1; o < 64; o <<= 1) v = fmaxf(v, __shfl_xor(v, o));
    return v;
}
__device__ __forceinline__ float row16_sum(float x) {
    x += __builtin_bit_cast(float, __builtin_amdgcn_update_dpp(0, __builtin_bit_cast(int, x), 0xB1, 0xf, 0xf, false));
    x += __builtin_bit_cast(float, __builtin_amdgcn_update_dpp(0, __builtin_bit_cast(int, x), 0x4E, 0xf, 0xf, false));
    x += __builtin_bit_cast(float, __builtin_amdgcn_update_dpp(0, __builtin_bit_cast(int, x), 0x141, 0xf, 0xf, false));
    x += __builtin_bit_cast(float, __builtin_amdgcn_update_dpp(0, __builtin_bit_cast(int, x), 0x140, 0xf, 0xf, false));
    return x;
}
__device__ __forceinline__ unsigned pk2(float lo, float hi) { return cvt_pk_bf16(lo, hi); }
__device__ __forceinline__ float bf2f(bf16 b) { return __uint_as_float(((unsigned)b) << 16); }
__device__ __forceinline__ float gelu_tanh(float y) { const float u = 0.7978845608028654f * (y + 0.044715f * y * y * y); const float e = __expf(2.f * u); const float th = 1.f - 2.f / (e + 1.f); return 0.5f * y * (1.f + th); }

__device__ __forceinline__ void transpose_item(const float* W, int N, bf16* WT, int ldk, int dst_row0, int k0, int n0, int kdst0, LAS float* scr, int lane) {
    float tv[32];
#pragma unroll
    for (int i = 0; i < 32; ++i) tv[i] = __builtin_nontemporal_load((const GAS float*)W + (size_t)(k0 + 2 * i + (lane >> 5)) * N + n0 + (lane & 31));
#pragma unroll
    for (int i = 0; i < 32; ++i) scr[(2 * i + (lane >> 5)) * 33 + (lane & 31)] = tv[i];
    LDS_WAIT(); asm volatile("" ::: "memory");
    const int c = lane & 7;
#pragma unroll
    for (int j = 0; j < 4; ++j) { const int n = (lane >> 3) + 8 * j; const LAS float* s = scr + (8 * c) * 33 + n;
        u32x4 o; o.x = pk2(s[0 * 33], s[1 * 33]); o.y = pk2(s[2 * 33], s[3 * 33]); o.z = pk2(s[4 * 33], s[5 * 33]); o.w = pk2(s[6 * 33], s[7 * 33]);
        *(u32x4*)(WT + (size_t)(dst_row0 + n) * ldk + kdst0 + 8 * c) = o; }
    LDS_WAIT(); asm volatile("" ::: "memory");
}

constexpr int PROJ_PITCH = DIN * 2;
template <int PASS> struct S5Order {
    static constexpr bool GATHER = false; static constexpr int A2 = PASS == 2 ? 4 : 0;
    static constexpr int KB = PASS == 2 ? 384 : 256;
    const char* U; const char* SIN; const char* BT; int G, c;
    __device__ __forceinline__ size_t kstepA() const { return (size_t)4 * PROJ_PITCH; }
    __device__ __forceinline__ size_t hstepA() const { return (size_t)128 * 16 * PROJ_PITCH; }
    __device__ __forceinline__ size_t a2off() const { return (size_t)(SIN - U) - (size_t)A2 * kstepA(); }
    __device__ bool next(int i, pg8::Unit& u) const {
        const int L = i * G + c; if (L >= NG * 4) return false;
        const int g = L >> 2, pm = L & 3; u.e = g; u.pm = pm; u.pn = 0; u.cnt = 256;
        u.Ab = U + (size_t)g * 32 + (size_t)pm * 256 * 16 * PROJ_PITCH; u.Bb = BT + (size_t)g * 256 * KB * 2;
        return true;
    }
    template <int NV> __device__ __forceinline__ void a_voff(const pg8::Unit&, unsigned (&v)[NV][2], const int (&R)[2], const int (&C)[2]) const {
#pragma unroll
        for (int i = 0; i < 2; ++i) v[0][i] = (unsigned)(R[i] * 16 * PROJ_PITCH + (C[i] >> 4) * PROJ_PITCH + (C[i] & 15) * 2);
    }
};
__device__ __forceinline__ void s5_build(const Frame& F, int g) {
    const float* lam_re = F.in[10]; const float* lam_im = F.in[11]; const float* log_dt = F.in[12];
    const float* b_re = F.in[13]; const float* b_im = F.in[14]; const float* c_re = F.in[15]; const float* c_im = F.in[16]; const float* dsk = F.in[17];
    constexpr int PC = 68;
    LAS float* pw2 = (LAS float*)F.lds;
    LAS float* bbr = pw2 + 17 * 64 * 2; LAS float* bbi = bbr + 1024;
    LAS float* cre = bbi + 1024; LAS float* cim = cre + 16 * PC; LAS float* dsl = cim + 16 * PC; LAS float* Kt = dsl + 16;
    bf16* MT = (bf16*)(F.ws + WS_S5MT) + (size_t)g * 256 * 384; bf16* WT = (bf16*)(F.ws + WS_S5WT) + (size_t)g * 256 * 256;
    const float dt = __expf(log_dt[g]);
    __syncthreads();
    for (int i = F.tid; i < 17 * 64; i += NTHR) { const int tau = i >> 6, p = i & 63; const float lr = fminf(lam_re[g * NP + p], -1e-4f), li = lam_im[g * NP + p];
        const float mag = __expf(lr * dt * (float)tau), ang = li * dt * (float)tau; pw2[2 * i] = mag * cosf(ang); pw2[2 * i + 1] = mag * sinf(ang); }
    for (int i = F.tid; i < 1024; i += NTHR) { const int p = i >> 4; const float lr = fminf(lam_re[g * NP + p], -1e-4f), li = lam_im[g * NP + p];
        const float mag = __expf(lr * dt), ang = li * dt; const float ar = mag * cosf(ang), ai = mag * sinf(ang), den = lr * lr + li * li;
        const float qr = ((ar - 1.f) * lr + ai * li) / den, qi = (ai * lr - (ar - 1.f) * li) / den;
        const float br = b_re[(size_t)g * 1024 + i], bi = b_im[(size_t)g * 1024 + i]; bbr[i] = qr * br - qi * bi; bbi[i] = qr * bi + qi * br;
        cre[(i >> 6) * PC + (i & 63)] = c_re[(size_t)g * 1024 + i]; cim[(i >> 6) * PC + (i & 63)] = c_im[(size_t)g * 1024 + i]; }
    if (F.tid < 16) dsl[F.tid] = dsk[g * GC + F.tid];
    __syncthreads();
    { const int half = F.tid >> 8, c = (F.tid >> 4) & 15, c2 = F.tid & 15; float acc[8] = {0.f, 0.f, 0.f, 0.f, 0.f, 0.f, 0.f, 0.f};
      for (int p0 = 0; p0 < 64; p0 += 4) { const f32x4 cr4 = *(const LAS f32x4*)(cre + c * PC + p0), ci4 = *(const LAS f32x4*)(cim + c * PC + p0);
#pragma unroll
          for (int u = 0; u < 4; ++u) { const int p = p0 + u; const float br = bbr[p * 16 + c2], bi = bbi[p * 16 + c2];
              const float cbr = cr4[u] * br - ci4[u] * bi, cbi = cr4[u] * bi + ci4[u] * br;
#pragma unroll
              for (int k = 0; k < 8; ++k) { const f32x2 w = *(const LAS f32x2*)(pw2 + ((half * 8 + k) * 64 + p) * 2); acc[k] += w[0] * cbr - w[1] * cbi; } } }
#pragma unroll
      for (int k = 0; k < 8; ++k) Kt[(half * 8 + k) * 256 + c * 16 + c2] = acc[k]; }
    __syncthreads();
    for (int idx = F.tid; idx < 256 * 32; idx += NTHR) { const int oct = idx & 31, row = idx >> 5, t = row >> 4, c = row & 15, j = oct >> 1, c20 = (oct & 1) * 8;
        f32x4 x0 = (f32x4){0.f, 0.f, 0.f, 0.f}, x1 = x0;
        if (j <= t) { x0 = *(const LAS f32x4*)(Kt + (t - j) * 256 + c * 16 + c20); x1 = *(const LAS f32x4*)(Kt + (t - j) * 256 + c * 16 + c20 + 4); }
        if (j == t && (c >> 3) == (oct & 1)) { const float d = dsl[c];
#pragma unroll
            for (int q = 0; q < 4; ++q) { x0[q] += (q == (c & 7)) ? d : 0.f; x1[q] += (q + 4 == (c & 7)) ? d : 0.f; } }
        u32x4 o; o.x = pk2(x0[0], x0[1]); o.y = pk2(x0[2], x0[3]); o.z = pk2(x1[0], x1[1]); o.w = pk2(x1[2], x1[3]);
        *(u32x4*)(MT + (size_t)row * 384 + oct * 8) = o; }
    for (int idx = F.tid; idx < 256 * 16; idx += NTHR) { const int oct = idx & 15, row = idx >> 4, t = row >> 4, c = row & 15, p0 = (oct & 7) * 8; float v[8];
#pragma unroll
        for (int h = 0; h < 2; ++h) { const f32x4 cr = *(const LAS f32x4*)(cre + c * PC + p0 + 4 * h), ci = *(const LAS f32x4*)(cim + c * PC + p0 + 4 * h);
            const f32x4 wa = *(const LAS f32x4*)(pw2 + ((t + 1) * 64 + p0 + 4 * h) * 2), wb = *(const LAS f32x4*)(pw2 + ((t + 1) * 64 + p0 + 4 * h) * 2 + 4);
            const float pr[4] = {wa[0], wa[2], wb[0], wb[2]}, pi[4] = {wa[1], wa[3], wb[1], wb[3]};
#pragma unroll
            for (int q = 0; q < 4; ++q) v[4 * h + q] = (oct < 8) ? (cr[q] * pr[q] - ci[q] * pi[q]) : -(cr[q] * pi[q] + ci[q] * pr[q]); }
        u32x4 o; o.x = pk2(v[0], v[1]); o.y = pk2(v[2], v[3]); o.z = pk2(v[4], v[5]); o.w = pk2(v[6], v[7]);
        *(u32x4*)(MT + (size_t)row * 384 + 256 + oct * 8) = o; }
    for (int idx = F.tid; idx < 128 * 32; idx += NTHR) { const int oct = idx & 31, row = idx >> 5, part = row >> 6, p = row & 63, j = oct >> 1, c20 = (oct & 1) * 8;
        const f32x2 w = *(const LAS f32x2*)(pw2 + ((15 - j) * 64 + p) * 2); float v[8];
#pragma unroll
        for (int h = 0; h < 2; ++h) { const f32x4 br = *(const LAS f32x4*)(bbr + p * 16 + c20 + 4 * h), bi = *(const LAS f32x4*)(bbi + p * 16 + c20 + 4 * h);
#pragma unroll
            for (int q = 0; q < 4; ++q) v[4 * h + q] = part == 0 ? (w[0] * br[q] - w[1] * bi[q]) : (w[0] * bi[q] + w[1] * br[q]); }
        u32x4 o; o.x = pk2(v[0], v[1]); o.y = pk2(v[2], v[3]); o.z = pk2(v[4], v[5]); o.w = pk2(v[6], v[7]);
        *(u32x4*)(WT + (size_t)row * 256 + oct * 8) = o; }
    __syncthreads();
}

template <int NU> __device__ __forceinline__ void mod_batch(const GAS float* wp, const LAS float* sp0, f32x4 (&acc)[8]) {
    f32x4 w[NU];
#pragma unroll
    for (int u = 0; u < NU; ++u) w[u] = __builtin_nontemporal_load((const GAS f32x4*)(wp + (size_t)(4 * u) * NMOD));
#pragma unroll
    for (int u = 0; u < NU; ++u) { const LAS f32x4* sp = (const LAS f32x4*)(sp0 + 4 * u * 8); const f32x4 s0 = sp[0], s1 = sp[1];
#pragma unroll
        for (int b = 0; b < 4; ++b) { acc[b] += w[u] * s0[b]; acc[4 + b] += w[u] * s1[b]; } }
}
__device__ __forceinline__ void p0_prologue(const Frame& F0) {
    PHASE_VIEW();
    const float* c = F.in[1]; const float* ada_w = F.in[2]; const float* ada_b = F.in[3];
    float* mod = (float*)(F.ws + WS_MOD);
    LAS float* scT = (LAS float*)F.lds;
    LAS float* red = (LAS float*)(F.lds + 65536);
    for (int i = F.tid; i < NB * DM; i += NTHR) { const float v = c[i]; scT[(i & (DM - 1)) * 8 + (i >> 11)] = v / (1.f + __expf(-v)); }
    __syncthreads();
    for (int item = F.vcu; item < NMOD / 64; item += F.G) {
        const int rs = F.lane >> 4, c4 = F.lane & 15, ks = F.wave;
        const GAS float* wp = (const GAS float*)ada_w + (size_t)(ks * 256 + rs) * NMOD + item * 64 + 4 * c4;
        f32x4 acc[8];
#pragma unroll
        for (int b = 0; b < 8; ++b) acc[b] = (f32x4){0.f, 0.f, 0.f, 0.f};
#pragma unroll 1
        for (int q = 0; q < 60; q += 12) mod_batch<12>(wp + (size_t)(4 * q) * NMOD, scT + (ks * 256 + 4 * q + rs) * 8, acc);
        mod_batch<4>(wp + (size_t)240 * NMOD, scT + (ks * 256 + 240 + rs) * 8, acc);
#pragma unroll
        for (int b = 0; b < 8; ++b) *(LAS f32x4*)(red + ((F.wave * 4 + rs) * 8 + b) * 64 + 4 * c4) = acc[b];
        __syncthreads();
        { const int b = F.wave; float s = 0.f;
#pragma unroll
          for (int q = 0; q < 32; ++q) s += red[(q * 8 + b) * 64 + F.lane];
          mod[b * NMOD + item * 64 + F.lane] = s + ada_b[item * 64 + F.lane]; }
        __syncthreads();
    }
    __syncthreads();
    for (int g = F.G - 1 - F.vcu; g < NG; g += F.G) s5_build(F, g);
    LAS float* scr = (LAS float*)(F.lds + F.wave * 16384);
    const int gw = F.vcu * NWAVES + F.wave, NGW = F.G * NWAVES;
    bf16* WinT = (bf16*)(F.ws + WS_WIN_T); bf16* WoutT = (bf16*)(F.ws + WS_WOUT_T); bf16* GluT = (bf16*)(F.ws + WS_GLU_T); bf16* LoraT = (bf16*)(F.ws + WS_LORA_T);
    constexpr int I_IN = (DM / 64) * (DIN / 32), I_OUT = (DM / 64) * (DM / 32), I_GLU = (DSSM / 64) * (DSSM / 32), I_W = 32, I_A = 32, I_G = 64;
    constexpr int NITEMS = I_IN + I_OUT + I_GLU + I_W + I_A + I_G;
    for (int it = gw; it < NITEMS; it += NGW) {
        int r = it;
        if (r < I_IN) { const int nb = DIN / 32, kb = r / nb, n0 = (r % nb) * 32; transpose_item(F.in[8], DIN, WinT, DM, n0, kb * 64, n0, kb * 64, scr, F.lane); continue; } r -= I_IN;
        if (r < I_OUT) { const int nb = DM / 32, kb = r / nb, n0 = (r % nb) * 32; transpose_item(F.in[9], DM, WoutT, DM, n0, kb * 64, n0, kb * 64, scr, F.lane); continue; } r -= I_OUT;
        if (r < I_GLU) { const int nb = DSSM / 32, kb = r / nb, n0 = (r % nb) * 32; transpose_item(F.in[18], DSSM, GluT, DSSM, n0, kb * 64, n0, kb * 64, scr, F.lane); continue; } r -= I_GLU;
        if (r < I_W) { transpose_item(F.in[22], DRW, LoraT, 256, r * 32, 0, r * 32, 0, scr, F.lane); continue; } r -= I_W;
        if (r < I_A) { transpose_item(F.in[24], DRW, LoraT, 256, 1024 + r * 32, 0, r * 32, 64, scr, F.lane); continue; } r -= I_A;
        { const int kb = r / 32, n0 = (r % 32) * 32; transpose_item(F.in[25], DRW, LoraT, 256, 2048 + n0, kb * 64, n0, 128 + kb * 64, scr, F.lane); }
    }
    for (int p = blockIdx.x * NTHR + F.tid; p < 3072 * 32; p += F.G * NTHR) { const int row = p >> 5, c8 = (p & 31) * 8; const int kind = row >> 10;
        const bool data = kind == 0 ? (c8 < 64) : (kind == 1 ? (c8 >= 64 && c8 < 128) : (c8 >= 128));
        if (!data) *(u32x4*)(LoraT + (size_t)row * 256 + c8) = (u32x4){0u, 0u, 0u, 0u}; }
    bf16* rwt = (bf16*)(F.ws + WS_RWT);
    for (int p = blockIdx.x * NTHR + F.tid; p < 64 * 5 * 64 * 8; p += F.G * NTHR) { const int e = p & 7, ln = (p >> 3) & 63, jt = (p >> 9) % 5, ks = (p >> 9) / 5;
        const int j = 16 * jt + (ln & 15), k = 32 * ks + 8 * (ln >> 4) + e;
        const float w = j < 8 ? F.in[31][k * 8 + j] : (j < 72 ? F.in[33][k * 64 + (j - 8)] : 0.f);
        const unsigned hi = pk2(w, 0.f) & 0xffffu; const float wl = w - __uint_as_float(hi << 16);
        const size_t o = ((size_t)((ks * 5 + jt) * 2) * 64 + ln) * 8 + e;
        rwt[o] = (bf16)hi; rwt[o + 512] = (bf16)(pk2(wl, 0.f) & 0xffffu); }
}

__device__ __forceinline__ void p1_h1(const Frame& F0) {
    PHASE_VIEW();
    const GAS float* x = (const GAS float*)F.in[0]; const GAS float* g = (const GAS float*)F.in[4]; const GAS float* mod = (const GAS float*)(F.ws + WS_MOD); GAS bf16* H = (GAS bf16*)(F.ws + WS_H);
    const int gw = F.vcu * NWAVES + F.wave, NGW = F.G * NWAVES;
    f32x4 gv[8];
#pragma unroll
    for (int j = 0; j < 8; ++j) gv[j] = *(const GAS f32x4*)(g + 4 * (F.lane + 64 * j));
    for (int row = gw; row < NT; row += NGW) {
        const int b = row >> 11; const GAS f32x4* xr = (const GAS f32x4*)(x + (size_t)row * DM) + F.lane;
        f32x4 v[8], sh[8], scv[8]; float ss = 0.f;
#pragma unroll
        for (int j = 0; j < 8; ++j) { v[j] = __builtin_nontemporal_load(xr + 64 * j); sh[j] = *(const GAS f32x4*)(mod + b * NMOD + 4 * (F.lane + 64 * j)); scv[j] = *(const GAS f32x4*)(mod + b * NMOD + DM + 4 * (F.lane + 64 * j)); }
#pragma unroll
        for (int j = 0; j < 8; ++j) ss += (v[j].x * v[j].x + v[j].y * v[j].y) + (v[j].z * v[j].z + v[j].w * v[j].w);
        const float rs = rsqrtf(wave_sum(ss) * (1.f / DM) + RMS_EPS);
        u32x2 w[8];
#pragma unroll
        for (int j = 0; j < 8; ++j) { const f32x4 h = v[j] * rs * gv[j] * (scv[j] + 1.0f) + sh[j]; w[j].x = pk2(h.x, h.y); w[j].y = pk2(h.z, h.w); }
        GAS u32x2* o = (GAS u32x2*)(H + (size_t)row * DM) + F.lane;
#pragma unroll
        for (int j = 0; j < 8; ++j) o[64 * j] = w[j];
    }
}

typedef short bf16x8_t __attribute__((ext_vector_type(8)));
#define MFMA16(a, b, c) __builtin_amdgcn_mfma_f32_16x16x32_bf16((a), (b), (c), 0, 0, 0)
__device__ __forceinline__ bf16x8_t lfrag(const LAS bf16* m, int pitch, int row, int k0) { return *(const LAS bf16x8_t*)(m + row * pitch + k0); }
__device__ __forceinline__ void st4(LAS bf16* p, const f32x4& v) { u32x2 w; w.x = pk2(v[0], v[1]); w.y = pk2(v[2], v[3]); *(LAS u32x2*)p = w; }
constexpr int CH_T = 32, CHP_K = 72, CHP_T = 40;
constexpr int CH_GRP_BYTES = 66560;
constexpr size_t GHQ_CHUNK = 12288;
__device__ __forceinline__ float wave_sum_dpp(float x) {
    x = row16_sum(x);
    x += __builtin_bit_cast(float, __builtin_amdgcn_update_dpp(0, __builtin_bit_cast(int, x), 0x142, 0xa, 0xf, false));
    x += __builtin_bit_cast(float, __builtin_amdgcn_update_dpp(0, __builtin_bit_cast(int, x), 0x143, 0xc, 0xf, false));
    return __builtin_bit_cast(float, __builtin_amdgcn_readlane(__builtin_bit_cast(int, x), 63));
}
__device__ __forceinline__ void wave_sum8_dpp(float (&x)[8]) {
#define WS8_STAGE(ctrl, rmask) _Pragma("unroll") for (int i_ = 0; i_ < 8; ++i_) x[i_] += __builtin_bit_cast(float, __builtin_amdgcn_update_dpp(0, __builtin_bit_cast(int, x[i_]), ctrl, rmask, 0xf, false));
    WS8_STAGE(0xB1, 0xf) WS8_STAGE(0x4E, 0xf) WS8_STAGE(0x141, 0xf) WS8_STAGE(0x140, 0xf) WS8_STAGE(0x142, 0xa) WS8_STAGE(0x143, 0xc)
#undef WS8_STAGE
#pragma unroll
    for (int i = 0; i < 8; ++i) x[i] = __builtin_bit_cast(float, __builtin_amdgcn_readlane(__builtin_bit_cast(int, x[i]), 63));
}
__device__ __forceinline__ float tanh_fast(float x) { const float e = __builtin_amdgcn_exp2f(2.8853900817779268f * x); return 1.f - 2.f * __builtin_amdgcn_rcpf(e + 1.f); }
#define INV_P8(acc, A0, L0, M0, A1, L1, M1, A2, L2, M2, A3, L3, M3, A4, L4, M4, A5, L5, M5, A6, L6, M6, A7, L7, M7) do { float tmp_; asm volatile("v_readlane_b32 %1, %2, %10\n\tv_fmac_f32 %0, %1, %18\n\tv_readlane_b32 %1, %3, %11\n\tv_fmac_f32 %0, %1, %19\n\tv_readlane_b32 %1, %4, %12\n\tv_fmac_f32 %0, %1, %20\n\tv_readlane_b32 %1, %5, %13\n\tv_fmac_f32 %0, %1, %21\n\tv_readlane_b32 %1, %6, %14\n\tv_fmac_f32 %0, %1, %22\n\tv_readlane_b32 %1, %7, %15\n\tv_fmac_f32 %0, %1, %23\n\tv_readlane_b32 %1, %8, %16\n\tv_fmac_f32 %0, %1, %24\n\tv_readlane_b32 %1, %9, %17\n\tv_fmac_f32 %0, %1, %25" : "+v"(acc), "=&s"(tmp_) : "v"(A0), "v"(A1), "v"(A2), "v"(A3), "v"(A4), "v"(A5), "v"(A6), "v"(A7), "i"(L0), "i"(L1), "i"(L2), "i"(L3), "i"(L4), "i"(L5), "i"(L6), "i"(L7), "v"(M0), "v"(M1), "v"(M2), "v"(M3), "v"(M4), "v"(M5), "v"(M6), "v"(M7)); } while (0)
#define INV_P4(acc, A0, L0, M0, A1, L1, M1, A2, L2, M2, A3, L3, M3) do { float tmp_; asm volatile("v_readlane_b32 %1, %2, %6\n\tv_fmac_f32 %0, %1, %10\n\tv_readlane_b32 %1, %3, %7\n\tv_fmac_f32 %0, %1, %11\n\tv_readlane_b32 %1, %4, %8\n\tv_fmac_f32 %0, %1, %12\n\tv_readlane_b32 %1, %5, %9\n\tv_fmac_f32 %0, %1, %13" : "+v"(acc), "=&s"(tmp_) : "v"(A0), "v"(A1), "v"(A2), "v"(A3), "i"(L0), "i"(L1), "i"(L2), "i"(L3), "v"(M0), "v"(M1), "v"(M2), "v"(M3)); } while (0)
#define INV_P2(acc, A0, L0, M0, A1, L1, M1) do { float tmp_; asm volatile("v_readlane_b32 %1, %2, %4\n\tv_fmac_f32 %0, %1, %6\n\tv_readlane_b32 %1, %3, %5\n\tv_fmac_f32 %0, %1, %7" : "+v"(acc), "=&s"(tmp_) : "v"(A0), "v"(A1), "i"(L0), "i"(L1), "v"(M0), "v"(M1)); } while (0)
#define INV_P1(acc, A0, L0, M0) do { float tmp_; asm volatile("v_readlane_b32 %1, %2, %3\n\tv_fmac_f32 %0, %1, %4" : "+v"(acc), "=&s"(tmp_) : "v"(A0), "i"(L0), "v"(M0)); } while (0)
__device__ __forceinline__ void p9a_rwkv_chunks(const Frame& F0) {
    PHASE_VIEW();
    const GAS bf16* PROJ = (const GAS bf16*)(F.ws + WS_PROJ); const GAS bf16* LoraT = (const GAS bf16*)(F.ws + WS_LORA_T);
    GAS bf16* VB = (GAS bf16*)(F.ws + WS_VB); GAS bf16* GB = (GAS bf16*)(F.ws + WS_GB); GAS float* BON = (GAS float*)(F.ws + WS_BON);
    const float* mu = F.in[20]; const float* w0 = F.in[21]; const float* a0 = F.in[23]; const float* k_k = F.in[26]; const float* k_a = F.in[27]; const float* r_k = F.in[28];
    GAS bf16* GHQ = (GAS bf16*)(F.ws + WS_GHQ); GAS float* GT = (GAS float*)(F.ws + WS_GT);
    const int grp = F.tid >> 8, gt = F.tid & 255, gw = (F.tid >> 6) & 3, lo = F.lane & 15, hi = F.lane >> 4;
    LAS unsigned char* gb = F.lds + grp * CH_GRP_BYTES;
    LAS bf16* At = (LAS bf16*)gb; LAS bf16* Bt = At + 32 * CHP_K; LAS bf16* Kt = Bt + 32 * CHP_K; LAS bf16* Rt = Kt + 32 * CHP_K;
    LAS bf16* X1T = At; LAS bf16* P1T = X1T + 64 * CHP_T; LAS bf16* Minv = P1T + 64 * CHP_T; LAS bf16* XG = At;
    LAS bf16* AtT = Rt + 32 * CHP_K; LAS bf16* BhT = AtT + 64 * CHP_T; LAS bf16* KhT = BhT + 64 * CHP_T; LAS bf16* VmT = KhT + 64 * CHP_T;
    LAS float* AabF = (LAS float*)(VmT + 64 * CHP_T);
    LAS bf16* Aak = (LAS bf16*)(AabF + 32 * 36); LAS bf16* Arb = Aak + 32 * CHP_T; LAS bf16* Ark = Arb + 32 * CHP_T; LAS bf16* P2T = Ark + 32 * CHP_T;
    LAS float* LWs = AabF; LAS float* AAs = LWs + 32 * 68; LAS bf16* W1 = (LAS bf16*)AabF;
    LAS float* part = (LAS float*)(P2T + 64 * CHP_T);
    LAS bf16* XW = (LAS bf16*)(part + 256); LAS bf16* XA = XW + 32 * CHP_K;
    const f32x4 z4 = (f32x4){0.f, 0.f, 0.f, 0.f};
    LAS unsigned* gbw = (LAS unsigned*)(F.lds + MISC_OFF) + 40 + grp; unsigned gb_target = 0u;
    __syncthreads(); if (gt == 0) *(volatile LAS unsigned*)gbw = 0u; __syncthreads();
#define GROUP_BARRIER() do { gb_target += 4u; asm volatile("s_waitcnt lgkmcnt(0)" ::: "memory"); \
        if (F.lane == 0) (void)__hip_atomic_fetch_add(gbw, 1u, __ATOMIC_RELAXED, __HIP_MEMORY_SCOPE_WORKGROUP); \
        while (*(volatile LAS unsigned*)gbw < gb_target) __builtin_amdgcn_s_sleep(1); \
        asm volatile("" ::: "memory"); } while (0)
    for (int it0 = F.vcu * 2; it0 < NB * (SEQ / CH_T); it0 += F.G * 2) {
        const int item = it0 + grp; const int c = item & 63, b = item >> 6;
        const size_t tok0 = (size_t)b * SEQ + c * CH_T;
        GROUP_BARRIER();
#pragma unroll 4
        for (int i = 0; i < 16; ++i) { const int pidx = gt + 256 * i, t = pidx >> 7, cp = (pidx & 127) * 2;
            const unsigned zw = *(const GAS unsigned*)(PROJ + (tok0 + t) * DIN + 4096 + cp);
            const unsigned pw = (c == 0 && t == 0) ? 0u : *(const GAS unsigned*)(PROJ + (tok0 + t - 1) * DIN + 4096 + cp);
            const f32x2 m = *(const f32x2*)(mu + 3072 + cp);
            const float z0 = bf_lo(zw), z1 = bf_hi(zw); const float v0 = z0 + m.x * (bf_lo(pw) - z0), v1 = z1 + m.y * (bf_hi(pw) - z1);
            if (cp < 64) *(LAS unsigned*)(XW + t * CHP_K + cp) = pk2(tanh_fast(v0), tanh_fast(v1));
            else if (cp < 128) *(LAS unsigned*)(XA + t * CHP_K + cp - 64) = pk2(v0, v1);
            else *(LAS unsigned*)(XG + t * 136 + cp - 128) = pk2(sigmoidf_(v0), sigmoidf_(v1)); }
        GROUP_BARRIER();
        { bf16x8_t xg[2][4];
#pragma unroll
          for (int mt = 0; mt < 2; ++mt)
#pragma unroll
              for (int ks = 0; ks < 4; ++ks) xg[mt][ks] = lfrag(XG, 136, 16 * mt + lo, 32 * ks + 8 * hi);
          bf16x8_t ygc[4], ygn[4];
#pragma unroll
          for (int ks = 0; ks < 4; ++ks) ygc[ks] = *(const GAS bf16x8_t*)(LoraT + (size_t)(2048 + 16 * gw + lo) * 256 + 128 + 32 * ks + 8 * hi);
#pragma unroll 1
          for (int hh = 0; hh < NH; ++hh) { const int n0 = hh * 64 + 16 * gw, n1 = (hh + 1 < NH ? hh + 1 : hh) * 64 + 16 * gw; f32x4 dg[2] = {z4, z4};
#pragma unroll
              for (int ks = 0; ks < 4; ++ks) ygn[ks] = *(const GAS bf16x8_t*)(LoraT + (size_t)(2048 + n1 + lo) * 256 + 128 + 32 * ks + 8 * hi);
#pragma unroll
              for (int ks = 0; ks < 4; ++ks) { dg[0] = MFMA16(ygc[ks], xg[0][ks], dg[0]); dg[1] = MFMA16(ygc[ks], xg[1][ks], dg[1]); }
#pragma unroll
              for (int mt = 0; mt < 2; ++mt) { u32x2 w; w.x = pk2(dg[mt][0], dg[mt][1]); w.y = pk2(dg[mt][2], dg[mt][3]); *(GAS u32x2*)(GB + (tok0 + 16 * mt + lo) * 1024 + n0 + 4 * hi) = w; }
#pragma unroll
              for (int ks = 0; ks < 4; ++ks) ygc[ks] = ygn[ks]; }
        }
        const int k = gt & 63, tq = gw; const bool first = (c == 0 && tq == 0);
        const GAS bf16* pp = PROJ + (tok0 + tq * 8) * DIN + 1024 + k;
        bf16 nr[9], nk[9], nv[9];
#pragma unroll
        for (int i = 0; i < 9; ++i) { const GAS bf16* q = pp + (ptrdiff_t)(i - 1) * DIN; const bool z = first && i == 0;
            nr[i] = z ? (bf16)0 : q[0]; nk[i] = z ? (bf16)0 : q[1024]; nv[i] = z ? (bf16)0 : q[2048]; }
        bf16x8_t lyw[2], lya[2]; f32x4 lw0, la0; float cmur, cmuk, cmuv, ckk, cka, crk;
#define HEAD_LOADS(hn_) do { const int n1_ = (hn_) * 64 + 16 * gw, ch1_ = (hn_) * 64 + k; \
            _Pragma("unroll") for (int ks = 0; ks < 2; ++ks) { lyw[ks] = *(const GAS bf16x8_t*)(LoraT + (size_t)(n1_ + lo) * 256 + 32 * ks + 8 * hi); lya[ks] = *(const GAS bf16x8_t*)(LoraT + (size_t)(1024 + n1_ + lo) * 256 + 64 + 32 * ks + 8 * hi); } \
            lw0 = *(const GAS f32x4*)((const GAS float*)w0 + n1_ + 4 * hi); la0 = *(const GAS f32x4*)((const GAS float*)a0 + n1_ + 4 * hi); \
            cmur = ((const GAS float*)mu)[ch1_]; cmuk = ((const GAS float*)mu)[1024 + ch1_]; cmuv = ((const GAS float*)mu)[2048 + ch1_]; \
            ckk = ((const GAS float*)k_k)[ch1_]; cka = ((const GAS float*)k_a)[ch1_]; crk = ((const GAS float*)r_k)[ch1_]; } while (0)
        HEAD_LOADS(0);
#pragma unroll 1
        for (int h = 0; h < NH; ++h) {
            const int ci = (b * NH + h) * 64 + c; const int ch = h * 64 + k;
            GROUP_BARRIER();
            { const int n0 = h * 64 + 16 * gw; f32x4 dw[2] = {z4, z4}, da[2] = {z4, z4};
#pragma unroll
              for (int ks = 0; ks < 2; ++ks) { const bf16x8_t yw = lyw[ks], ya = lya[ks];
#pragma unroll
                  for (int mt = 0; mt < 2; ++mt) { dw[mt] = MFMA16(yw, lfrag(XW, CHP_K, 16 * mt + lo, 32 * ks + 8 * hi), dw[mt]); da[mt] = MFMA16(ya, lfrag(XA, CHP_K, 16 * mt + lo, 32 * ks + 8 * hi), da[mt]); } }
              const f32x4 w0v = lw0, a0v = la0;
#pragma unroll
              for (int mt = 0; mt < 2; ++mt) { const int t = 16 * mt + lo; f32x4 lwv, aav;
#pragma unroll
                  for (int r = 0; r < 4; ++r) { lwv[r] = (-0.6065306597126334f * 1.4426950408889634f) * sigmoidf_(dw[mt][r] + w0v[r]);     aav[r] = sigmoidf_(da[mt][r] + a0v[r]); }
                  *(LAS f32x4*)(LWs + t * 68 + 16 * gw + 4 * hi) = lwv; *(LAS f32x4*)(AAs + t * 68 + 16 * gw + 4 * hi) = aav; }
            }
            GROUP_BARRIER();
            { const float mur = cmur, muk = cmuk, muv = cmuv, kkc = ckk, kac = cka, rkc = crk;
              float lw[8], ls[8], rv[8], kv[8], vv[8], av[8], bv[8]; float run = 0.f;
              float kraw[8], x8[8];
#pragma unroll
              for (int i = 0; i < 8; ++i) { const int t = tq * 8 + i;
                  const float zr = bf2f(nr[i + 1]), zk = bf2f(nk[i + 1]), zv = bf2f(nv[i + 1]), pr = bf2f(nr[i]), pk_ = bf2f(nk[i]), pv = bf2f(nv[i]);
                  rv[i] = zr + mur * (pr - zr); kraw[i] = zk + muk * (pk_ - zk); vv[i] = zv + muv * (pv - zv);
                  av[i] = AAs[t * 68 + k]; lw[i] = LWs[t * 68 + k];
                  const float kk = kraw[i] * kkc; x8[i] = kk * kk; }
              wave_sum8_dpp(x8);
#pragma unroll
              for (int i = 0; i < 8; ++i) { const float a = av[i]; const float kk = kraw[i] * kkc * __builtin_amdgcn_rsqf(fmaxf(x8[i], 1e-24f));
                  const float km = kraw[i] * (1.f + (a - 1.f) * kac);
                  x8[i] = rv[i] * km * rkc; kv[i] = km; av[i] = -kk; bv[i] = kk * a; run += lw[i]; ls[i] = run; }
              wave_sum8_dpp(x8);
              { float bsel = x8[0];
#pragma unroll
                for (int i = 1; i < 8; ++i) bsel = (F.lane == i) ? x8[i] : bsel;
                if (F.lane < 8) BON[(tok0 + tq * 8 + F.lane) * 16 + h] = bsel; }
              if (h + 1 < NH) {
#pragma unroll
                  for (int i = 0; i < 9; ++i) { const GAS bf16* q = pp + (ptrdiff_t)(i - 1) * DIN + (h + 1) * 64; const bool z = first && i == 0;
                      nr[i] = z ? (bf16)0 : q[0]; nk[i] = z ? (bf16)0 : q[1024]; nv[i] = z ? (bf16)0 : q[2048]; } }
              { u32x4 w; w.x = pk2(vv[0], vv[1]); w.y = pk2(vv[2], vv[3]); w.z = pk2(vv[4], vv[5]); w.w = pk2(vv[6], vv[7]);
                GAS bf16* vb = VB + (tok0 + tq * 8) * 1024 + ch;
                vb[0] = (bf16)(w.x & 0xffffu); vb[1024] = (bf16)(w.x >> 16); vb[2048] = (bf16)(w.y & 0xffffu); vb[3072] = (bf16)(w.y >> 16);
                vb[4096] = (bf16)(w.z & 0xffffu); vb[5120] = (bf16)(w.z >> 16); vb[6144] = (bf16)(w.w & 0xffffu); vb[7168] = (bf16)(w.w >> 16); }
              part[tq * 64 + k] = run;
              GROUP_BARRIER();
              float off = 0.f, tot = 0.f;
#pragma unroll
              for (int q = 0; q < 4; ++q) { const float pq = part[q * 64 + k]; tot += pq; if (q < tq) off += pq; }
              if (tq == 0) GT[(size_t)ci * 64 + k] = __builtin_amdgcn_exp2f(tot);
              float aT[8], bT[8], kT[8];
#pragma unroll
              for (int i = 0; i < 8; ++i) { const int t = tq * 8 + i; const float lg = off + ls[i], lgm = lg - lw[i];
                  const float eneg = __builtin_amdgcn_exp2f(-lg), eh = __builtin_amdgcn_exp2f(tot - lg);
                  const float at = av[i] * __builtin_amdgcn_exp2f(lgm);
                  const unsigned wa = pk2(at, bv[i] * eneg), wk = pk2(kv[i] * eneg, rv[i] * __builtin_amdgcn_exp2f(lg));
                  At[t * CHP_K + k] = (bf16)(wa & 0xffffu); Bt[t * CHP_K + k] = (bf16)(wa >> 16); Kt[t * CHP_K + k] = (bf16)(wk & 0xffffu); Rt[t * CHP_K + k] = (bf16)(wk >> 16);
                  aT[i] = at; bT[i] = bv[i] * eh; kT[i] = kv[i] * eh; }
              u32x4 w;
              w.x = pk2(aT[0], aT[1]); w.y = pk2(aT[2], aT[3]); w.z = pk2(aT[4], aT[5]); w.w = pk2(aT[6], aT[7]); *(LAS u32x4*)(AtT + k * CHP_T + tq * 8) = w;
              w.x = pk2(bT[0], bT[1]); w.y = pk2(bT[2], bT[3]); w.z = pk2(bT[4], bT[5]); w.w = pk2(bT[6], bT[7]); *(LAS u32x4*)(BhT + k * CHP_T + tq * 8) = w;
              w.x = pk2(kT[0], kT[1]); w.y = pk2(kT[2], kT[3]); w.z = pk2(kT[4], kT[5]); w.w = pk2(kT[6], kT[7]); *(LAS u32x4*)(KhT + k * CHP_T + tq * 8) = w;
              w.x = pk2(vv[0], vv[1]); w.y = pk2(vv[2], vv[3]); w.z = pk2(vv[4], vv[5]); w.w = pk2(vv[6], vv[7]); *(LAS u32x4*)(VmT + k * CHP_T + tq * 8) = w;
            }
            GROUP_BARRIER();
            f32x4 dt = z4, a10 = z4;
            const int mi = gw ^ grp;
            { const LAS bf16* X = (mi < 2) ? At : Rt; const LAS bf16* Y = (mi & 1) ? Kt : Bt;
              f32x4 acc[2][2] = {{z4, z4}, {z4, z4}};
#pragma unroll
              for (int ks = 0; ks < 2; ++ks) { bf16x8_t xf[2], yf[2];
#pragma unroll
                  for (int m = 0; m < 2; ++m) { xf[m] = lfrag(X, CHP_K, 16 * m + lo, 32 * ks + 8 * hi); yf[m] = lfrag(Y, CHP_K, 16 * m + lo, 32 * ks + 8 * hi); }
#pragma unroll
                  for (int m = 0; m < 2; ++m)
#pragma unroll
                      for (int n = 0; n < 2; ++n) acc[m][n] = MFMA16(yf[n], xf[m], acc[m][n]);
                  if (mi == 1) dt = MFMA16(lfrag(Bt, CHP_K, 16 + lo, 32 * ks + 8 * hi), xf[1], dt); }
              LAS bf16* dstb = (mi == 1) ? Aak : ((mi == 2) ? Arb : Ark);
#pragma unroll
              for (int m = 0; m < 2; ++m)
#pragma unroll
                  for (int n = 0; n < 2; ++n) { const int t = 16 * m + lo, j0 = 16 * n + 4 * hi; f32x4 v = acc[m][n];
#pragma unroll
                      for (int r = 0; r < 4; ++r) { const int j = j0 + r; const bool keep = (mi < 2) ? (j < t) : (j <= t); v[r] = keep ? v[r] : 0.f; }
                      if (mi != 0) st4(dstb + t * CHP_T + j0, v); else { if (m == 0 && n == 0) dt = v; if (m == 1 && n == 0) a10 = v; } }
              if (mi == 1) {
#pragma unroll
                  for (int r = 0; r < 4; ++r) dt[r] = (4 * hi + r < lo) ? dt[r] : 0.f; }
            }
            GROUP_BARRIER();
            if (mi < 2) {
                int cc = F.lane & 15; asm volatile("" : "+v"(cc));
                float mcol[16];
                { float acc = (0 == cc) ? 1.f : 0.f;
                  mcol[0] = acc; }
                { float acc = (1 == cc) ? 1.f : 0.f;
                  INV_P1(acc, dt[0], 1, mcol[0]);
                  mcol[1] = acc; }
                { float acc = (2 == cc) ? 1.f : 0.f;
                  INV_P2(acc, dt[0], 2, mcol[0], dt[1], 2, mcol[1]);
                  mcol[2] = acc; }
                { float acc = (3 == cc) ? 1.f : 0.f;
                  INV_P2(acc, dt[0], 3, mcol[0], dt[1], 3, mcol[1]);
                  INV_P1(acc, dt[2], 3, mcol[2]);
                  mcol[3] = acc; }
                { float acc = (4 == cc) ? 1.f : 0.f;
                  INV_P4(acc, dt[0], 4, mcol[0], dt[1], 4, mcol[1], dt[2], 4, mcol[2], dt[3], 4, mcol[3]);
                  mcol[4] = acc; }
                { float acc = (5 == cc) ? 1.f : 0.f;
                  INV_P4(acc, dt[0], 5, mcol[0], dt[1], 5, mcol[1], dt[2], 5, mcol[2], dt[3], 5, mcol[3]);
                  INV_P1(acc, dt[0], 21, mcol[4]);
                  mcol[5] = acc; }
                { float acc = (6 == cc) ? 1.f : 0.f;
                  INV_P4(acc, dt[0], 6, mcol[0], dt[1], 6, mcol[1], dt[2], 6, mcol[2], dt[3], 6, mcol[3]);
                  INV_P2(acc, dt[0], 22, mcol[4], dt[1], 22, mcol[5]);
                  mcol[6] = acc; }
                { float acc = (7 == cc) ? 1.f : 0.f;
                  INV_P4(acc, dt[0], 7, mcol[0], dt[1], 7, mcol[1], dt[2], 7, mcol[2], dt[3], 7, mcol[3]);
                  INV_P2(acc, dt[0], 23, mcol[4], dt[1], 23, mcol[5]);
                  INV_P1(acc, dt[2], 23, mcol[6]);
                  mcol[7] = acc; }
                { float acc = (8 == cc) ? 1.f : 0.f;
                  INV_P8(acc, dt[0], 8, mcol[0], dt[1], 8, mcol[1], dt[2], 8, mcol[2], dt[3], 8, mcol[3], dt[0], 24, mcol[4], dt[1], 24, mcol[5], dt[2], 24, mcol[6], dt[3], 24, mcol[7]);
                  mcol[8] = acc; }
                { float acc = (9 == cc) ? 1.f : 0.f;
                  INV_P8(acc, dt[0], 9, mcol[0], dt[1], 9, mcol[1], dt[2], 9, mcol[2], dt[3], 9, mcol[3], dt[0], 25, mcol[4], dt[1], 25, mcol[5], dt[2], 25, mcol[6], dt[3], 25, mcol[7]);
                  INV_P1(acc, dt[0], 41, mcol[8]);
                  mcol[9] = acc; }
                { float acc = (10 == cc) ? 1.f : 0.f;
                  INV_P8(acc, dt[0], 10, mcol[0], dt[1], 10, mcol[1], dt[2], 10, mcol[2], dt[3], 10, mcol[3], dt[0], 26, mcol[4], dt[1], 26, mcol[5], dt[2], 26, mcol[6], dt[3], 26, mcol[7]);
                  INV_P2(acc, dt[0], 42, mcol[8], dt[1], 42, mcol[9]);
                  mcol[10] = acc; }
                { float acc = (11 == cc) ? 1.f : 0.f;
                  INV_P8(acc, dt[0], 11, mcol[0], dt[1], 11, mcol[1], dt[2], 11, mcol[2], dt[3], 11, mcol[3], dt[0], 27, mcol[4], dt[1], 27, mcol[5], dt[2], 27, mcol[6], dt[3], 27, mcol[7]);
                  INV_P2(acc, dt[0], 43, mcol[8], dt[1], 43, mcol[9]);
                  INV_P1(acc, dt[2], 43, mcol[10]);
                  mcol[11] = acc; }
                { float acc = (12 == cc) ? 1.f : 0.f;
                  INV_P8(acc, dt[0], 12, mcol[0], dt[1], 12, mcol[1], dt[2], 12, mcol[2], dt[3], 12, mcol[3], dt[0], 28, mcol[4], dt[1], 28, mcol[5], dt[2], 28, mcol[6], dt[3], 28, mcol[7]);
                  INV_P4(acc, dt[0], 44, mcol[8], dt[1], 44, mcol[9], dt[2], 44, mcol[10], dt[3], 44, mcol[11]);
                  mcol[12] = acc; }
                { float acc = (13 == cc) ? 1.f : 0.f;
                  INV_P8(acc, dt[0], 13, mcol[0], dt[1], 13, mcol[1], dt[2], 13, mcol[2], dt[3], 13, mcol[3], dt[0], 29, mcol[4], dt[1], 29, mcol[5], dt[2], 29, mcol[6], dt[3], 29, mcol[7]);
                  INV_P4(acc, dt[0], 45, mcol[8], dt[1], 45, mcol[9], dt[2], 45, mcol[10], dt[3], 45, mcol[11]);
                  INV_P1(acc, dt[0], 61, mcol[12]);
                  mcol[13] = acc; }
                { float acc = (14 == cc) ? 1.f : 0.f;
                  INV_P8(acc, dt[0], 14, mcol[0], dt[1], 14, mcol[1], dt[2], 14, mcol[2], dt[3], 14, mcol[3], dt[0], 30, mcol[4], dt[1], 30, mcol[5], dt[2], 30, mcol[6], dt[3], 30, mcol[7]);
                  INV_P4(acc, dt[0], 46, mcol[8], dt[1], 46, mcol[9], dt[2], 46, mcol[10], dt[3], 46, mcol[11]);
                  INV_P2(acc, dt[0], 62, mcol[12], dt[1], 62, mcol[13]);
                  mcol[14] = acc; }
                { float acc = (15 == cc) ? 1.f : 0.f;
                  INV_P8(acc, dt[0], 15, mcol[0], dt[1], 15, mcol[1], dt[2], 15, mcol[2], dt[3], 15, mcol[3], dt[0], 31, mcol[4], dt[1], 31, mcol[5], dt[2], 31, mcol[6], dt[3], 31, mcol[7]);
                  INV_P4(acc, dt[0], 47, mcol[8], dt[1], 47, mcol[9], dt[2], 47, mcol[10], dt[3], 47, mcol[11]);
                  INV_P2(acc, dt[0], 63, mcol[12], dt[1], 63, mcol[13]);
                  INV_P1(acc, dt[2], 63, mcol[14]);
                  mcol[15] = acc; }
                if (F.lane < 32) { const int col = F.lane; const bool mine = (mi == 0) ? (col < 16) : (col >= 16);
#pragma unroll
                    for (int t = 0; t < 16; ++t) Minv[(16 * mi + t) * CHP_T + col] = (bf16)(pk2(mine ? mcol[t] : 0.f, 0.f) & 0xffffu); }
                if (mi == 0) { st4(W1 + lo * CHP_T + 4 * hi, a10);
                    f32x4 id;
#pragma unroll
                    for (int r = 0; r < 4; ++r) id[r] = (4 * hi + r == lo) ? 1.f : 0.f;
                    st4(W1 + lo * CHP_T + 16 + 4 * hi, id); }
            } else {
                const int wk = mi - 2;
                for (int tile = wk * 4; tile < wk * 4 + 4; ++tile) { const int mt = tile >> 2, nt = tile & 3;
                    const bf16x8_t xf = lfrag(Aak, CHP_T, 16 * mt + lo, 8 * hi), yf = lfrag(VmT, CHP_T, 16 * nt + lo, 8 * hi);
                    const f32x4 d = MFMA16(xf, yf, z4);
                    st4(X1T + (16 * nt + lo) * CHP_T + 16 * mt + 4 * hi, d); }
            }
            GROUP_BARRIER();
            { const bf16x8_t ya = lfrag(AtT, CHP_T, 16 * gw + lo, 8 * hi), yx = lfrag(X1T, CHP_T, 16 * gw + lo, 8 * hi);
              const bf16x8_t m0 = lfrag(Minv, CHP_T, lo, 8 * hi), m1 = lfrag(Minv, CHP_T, 16 + lo, 8 * hi), w1 = lfrag(W1, CHP_T, lo, 8 * hi);
              LAS bf16* p1r = P1T + (16 * gw + lo) * CHP_T; LAS bf16* p2r = P2T + (16 * gw + lo) * CHP_T;
              const f32x4 a = MFMA16(m0, ya, z4), b = MFMA16(m0, yx, z4);
              st4(p1r + 4 * hi, a); st4(p2r + 4 * hi, b);
              asm volatile("" ::: "memory");
              const bf16x8_t pa = *(const LAS bf16x8_t*)(p1r + 8 * (hi & 1)), pb = *(const LAS bf16x8_t*)(p2r + 8 * (hi & 1));
              const bf16x8_t za = (hi < 2) ? pa : ya, zx = (hi < 2) ? pb : yx;
              const f32x4 ta = MFMA16(w1, za, z4), tb = MFMA16(w1, zx, z4);
              st4(p1r + 16 + 4 * hi, ta); st4(p2r + 16 + 4 * hi, tb);
              asm volatile("" ::: "memory");
              const bf16x8_t qa = *(const LAS bf16x8_t*)(p1r + 8 * hi), qx = *(const LAS bf16x8_t*)(p2r + 8 * hi);
              const f32x4 ca = MFMA16(m1, qa, z4), cb = MFMA16(m1, qx, z4);
              asm volatile("" ::: "memory");
              st4(p1r + 16 + 4 * hi, ca); st4(p2r + 16 + 4 * hi, cb);
            }
            GROUP_BARRIER();
            HEAD_LOADS((h + 1 < NH) ? h + 1 : h);
            { GAS bf16* outp = GHQ + (size_t)ci * GHQ_CHUNK;
              const bf16x8_t p1 = lfrag(P1T, CHP_T, 16 * gw + lo, 8 * hi), p2 = lfrag(P2T, CHP_T, 16 * gw + lo, 8 * hi), vm = lfrag(VmT, CHP_T, 16 * gw + lo, 8 * hi);
#pragma unroll
              for (int mt = 0; mt < 2; ++mt) { const bf16x8_t arb = lfrag(Arb, CHP_T, 16 * mt + lo, 8 * hi), ark = lfrag(Ark, CHP_T, 16 * mt + lo, 8 * hi);
                  f32x4 q1 = MFMA16(p1, arb, z4);
                  { const int t = 16 * mt + lo, k0 = 16 * gw + 4 * hi; const u32x2 rw = *(const LAS u32x2*)(Rt + t * CHP_K + k0);
                    q1[0] += bf_lo(rw.x); q1[1] += bf_hi(rw.x); q1[2] += bf_lo(rw.y); q1[3] += bf_hi(rw.y);
                    u32x2 w; w.x = pk2(q1[0], q1[1]); w.y = pk2(q1[2], q1[3]); *(GAS u32x2*)(outp + 8192 + t * 64 + k0) = w; }
                  f32x4 q2 = MFMA16(arb, p2, z4); q2 = MFMA16(ark, vm, q2);
                  { u32x2 w; w.x = pk2(q2[0], q2[1]); w.y = pk2(q2[2], q2[3]); *(GAS u32x2*)(outp + 10240 + (16 * gw + lo) * 32 + 16 * mt + 4 * hi) = w; } }
#pragma unroll
              for (int mt = 0; mt < 4; ++mt) { const bf16x8_t bh = lfrag(BhT, CHP_T, 16 * mt + lo, 8 * hi), kh = lfrag(KhT, CHP_T, 16 * mt + lo, 8 * hi);
                  const f32x4 g = MFMA16(p1, bh, z4);
                  { u32x2 w; w.x = pk2(g[0], g[1]); w.y = pk2(g[2], g[3]); *(GAS u32x2*)(outp + (16 * mt + lo) * 64 + 16 * gw + 4 * hi) = w; }
                  f32x4 hh = MFMA16(bh, p2, z4); hh = MFMA16(kh, vm, hh);
                  { u32x2 w; w.x = pk2(hh[0], hh[1]); w.y = pk2(hh[2], hh[3]); *(GAS u32x2*)(outp + 4096 + (16 * gw + lo) * 64 + 16 * mt + 4 * hi) = w; } }
            }
        }
    }
    __syncthreads();
#undef GROUP_BARRIER
#undef HEAD_LOADS
}
__device__ __forceinline__ void p9b_rwkv_seq(const Frame& F0) {
    PHASE_VIEW();
    const GAS bf16* GHQ = (const GAS bf16*)(F.ws + WS_GHQ); const GAS float* GT = (const GAS float*)(F.ws + WS_GT); GAS bf16* Yy = (GAS bf16*)(F.ws + WS_Y);
    LAS bf16* Sb = (LAS bf16*)F.lds;
    LAS bf16* Yb = Sb + 2 * 32 * CHP_K;
    const int lo = F.lane & 15, hi = F.lane >> 4, vt = F.wave & 1;
    const bool ywave = F.wave < 4, twave = (F.wave == 4 || F.wave == 5), writer = F.wave >= 6;
    const int kt = ywave ? (F.wave >> 1) : 2, mt = (F.wave >> 1) & 1;
    const f32x4 z4 = (f32x4){0.f, 0.f, 0.f, 0.f};
    for (int item = F.vcu; item < NB * NH * 2; item += F.G) {
        const int b = item >> 5, h = (item >> 1) & 15, vh = item & 1;
        __syncthreads();
        for (int i = F.tid; i < 2 * 32 * CHP_K / 2; i += NTHR) ((LAS unsigned*)Sb)[i] = 0u;
        __syncthreads();
        f32x4 Sf = z4, Sf2 = z4;
        const size_t cbase = (size_t)(b * NH + h) * 64;
        const int vrow = vh * 32 + 16 * vt + lo;
        const int offX = ywave ? 8192 + (16 * mt + lo) * 64 + 8 * hi : (48 + lo) * 64 + 8 * hi;
        const int offX2 = ywave ? 10240 + vrow * 32 + 16 * mt + 4 * hi : 4096 + vrow * 64 + 48 + 4 * hi;
        const int offT2 = ywave ? 16 * kt + 4 * hi : 48 + 4 * hi;
#define SEQ_LOAD(G_, X_, H_, X2_, GT_, GT2_, cc_) do { if (!writer) { const int cn_ = (cc_) < 64 ? (cc_) : 63; const GAS bf16* cp_ = GHQ + (cbase + cn_) * GHQ_CHUNK; \
            G_[0] = *(const GAS bf16x8_t*)(cp_ + (16 * kt + lo) * 64 + 8 * hi); G_[1] = *(const GAS bf16x8_t*)(cp_ + (16 * kt + lo) * 64 + 32 + 8 * hi); \
            H_ = *(const GAS u32x2*)(cp_ + 4096 + vrow * 64 + 16 * kt + 4 * hi); GT_ = *(const GAS f32x4*)(GT + (cbase + cn_) * 64 + 16 * kt + 4 * hi); \
            X_[0] = *(const GAS bf16x8_t*)(cp_ + offX); X_[1] = *(const GAS bf16x8_t*)(cp_ + offX + 32); \
            X2_ = *(const GAS u32x2*)(cp_ + offX2); GT2_ = *(const GAS f32x4*)(GT + (cbase + cn_) * 64 + offT2); } } while (0)
#define SEQ_FLUSH(cc_) do { const int r_ = (F.wave - 6) * 16 + (F.lane >> 2), q_ = F.lane & 3; \
            const u32x4 yv_ = *(const LAS u32x4*)(Yb + ((cc_) & 1) * 1024 + r_ * 32 + 8 * q_); \
            *(GAS u32x4*)(Yy + (size_t)(b * SEQ + (cc_) * CH_T + r_) * 1024 + h * 64 + vh * 32 + 8 * q_) = yv_; } while (0)
#define SEQ_STEP(G_, X_, H_, X2_, GT_, GT2_, cc_) do { \
            const LAS bf16* Sc = Sb + ((cc_) & 1) * 32 * CHP_K; LAS bf16* Sn = Sb + (((cc_) + 1) & 1) * 32 * CHP_K; \
            if (!writer) { \
                const bf16x8_t s0 = lfrag(Sc, CHP_K, 16 * vt + lo, 8 * hi), s1 = lfrag(Sc, CHP_K, 16 * vt + lo, 32 + 8 * hi); \
                f32x4 acc2 = (f32x4){bf_lo(X2_.x), bf_hi(X2_.x), bf_lo(X2_.y), bf_hi(X2_.y)}; \
                if (twave) acc2 = acc2 + GT2_ * Sf2; \
                acc2 = MFMA16(X_[0], s0, acc2); acc2 = MFMA16(X_[1], s1, acc2); \
                f32x4 acc = (f32x4){bf_lo(H_.x), bf_hi(H_.x), bf_lo(H_.y), bf_hi(H_.y)} + GT_ * Sf; \
                acc = MFMA16(G_[0], s0, acc); acc = MFMA16(G_[1], s1, acc); \
                Sf = acc; st4(Sn + (16 * vt + lo) * CHP_K + 16 * kt + 4 * hi, acc); \
                if (twave) { Sf2 = acc2; st4(Sn + (16 * vt + lo) * CHP_K + 48 + 4 * hi, acc2); } \
                else { LAS bf16* yo_ = Yb + ((cc_) & 1) * 1024 + (16 * mt + 4 * hi) * 32 + 16 * vt + lo; const unsigned w01 = pk2(acc2[0], acc2[1]), w23 = pk2(acc2[2], acc2[3]);     \
                    yo_[0] = (bf16)(w01 & 0xffffu); yo_[32] = (bf16)(w01 >> 16); yo_[64] = (bf16)(w23 & 0xffffu); yo_[96] = (bf16)(w23 >> 16); } \
                SEQ_LOAD(G_, X_, H_, X2_, GT_, GT2_, (cc_) + 4); \
            } else if ((cc_) > 0) SEQ_FLUSH((cc_) - 1); \
            asm volatile("s_waitcnt lgkmcnt(0)" ::: "memory"); __builtin_amdgcn_s_barrier(); asm volatile("" ::: "memory"); } while (0)
        bf16x8_t gA[2], xA[2], gB[2], xB[2], gC[2], xC[2], gD[2], xD[2]; u32x2 hA, x2A, hB, x2B, hC, x2C, hD, x2D; f32x4 gtA, gtB, gtC, gtD, gsA, gsB, gsC, gsD;
        SEQ_LOAD(gA, xA, hA, x2A, gtA, gsA, 0); SEQ_LOAD(gB, xB, hB, x2B, gtB, gsB, 1); SEQ_LOAD(gC, xC, hC, x2C, gtC, gsC, 2); SEQ_LOAD(gD, xD, hD, x2D, gtD, gsD, 3);
#pragma unroll
        for (int c = 0; c < 64; c += 4) {
            SEQ_STEP(gA, xA, hA, x2A, gtA, gsA, c); SEQ_STEP(gB, xB, hB, x2B, gtB, gsB, c + 1); SEQ_STEP(gC, xC, hC, x2C, gtC, gsC, c + 2); SEQ_STEP(gD, xD, hD, x2D, gtD, gsD, c + 3);
        }
        if (writer) SEQ_FLUSH(63);
#undef SEQ_LOAD
#undef SEQ_FLUSH
#undef SEQ_STEP
    }
}
__device__ __forceinline__ void p9_rwkv_post(const Frame& F0) {
    PHASE_VIEW();
    const GAS bf16* VB = (const GAS bf16*)(F.ws + WS_VB); const GAS bf16* GB = (const GAS bf16*)(F.ws + WS_GB); const GAS float* BON = (const GAS float*)(F.ws + WS_BON);
    const GAS bf16* Yy = (const GAS bf16*)(F.ws + WS_Y);
    const GAS float* ln_w = (const GAS float*)F.in[29]; const GAS float* ln_b = (const GAS float*)F.in[30]; GAS bf16* MIX = (GAS bf16*)(F.ws + WS_MIX);
    const int gw = F.vcu * NWAVES + F.wave, NGW = F.G * NWAVES;
    u32x2 ywn, vwn, gwn; float bonn;
#define POST_LOAD(it_) do { const int it2 = (it_) < NT * 4 ? (it_) : gw; const int row_ = it2 >> 2, c_ = (it2 & 3) * 256 + F.lane * 4; const size_t idx_ = (size_t)row_ * 1024 + c_; \
        ywn = __builtin_nontemporal_load((const GAS u32x2*)(Yy + idx_)); vwn = __builtin_nontemporal_load((const GAS u32x2*)(VB + idx_)); gwn = __builtin_nontemporal_load((const GAS u32x2*)(GB + idx_)); bonn = BON[row_ * 16 + (c_ >> 6)]; } while (0)
    POST_LOAD(gw);
    for (int it = gw; it < NT * 4; it += NGW) {
        const int row = it >> 2, c = (it & 3) * 256 + F.lane * 4;
        const u32x2 yw = ywn, vw = vwn, gwv = gwn; const float bon = bonn;
        const f32x4 lw = *(const GAS f32x4*)(ln_w + c), lb = *(const GAS f32x4*)(ln_b + c);
        POST_LOAD(it + NGW);
        const f32x4 y = (f32x4){bf_lo(yw.x), bf_hi(yw.x), bf_lo(yw.y), bf_hi(yw.y)};
        const float mean = row16_sum((y.x + y.y) + (y.z + y.w)) * (1.f / 64.f); const f32x4 d = y - mean;
        const float var = row16_sum((d.x * d.x + d.y * d.y) + (d.z * d.z + d.w * d.w)) * (1.f / 64.f); const float rstd = rsqrtf(var + GN_EPS);
        const f32x4 vv = (f32x4){bf_lo(vw.x), bf_hi(vw.x), bf_lo(vw.y), bf_hi(vw.y)}, gg = (f32x4){bf_lo(gwv.x), bf_hi(gwv.x), bf_lo(gwv.y), bf_hi(gwv.y)};
        const f32x4 o = (d * rstd * lw + lb + vv * bon) * gg;
        u32x2 w; w.x = pk2(o.x, o.y); w.y = pk2(o.z, o.w); *(GAS u32x2*)(MIX + (size_t)row * DM + DSSM + c) = w;
    }
#undef POST_LOAD
}

__device__ __forceinline__ void p11_x1_router(const Frame& F0) {
    PHASE_VIEW();
    const GAS float* x = (const GAS float*)F.in[0]; const GAS float* gpost = (const GAS float*)F.in[5]; const GAS float* gpre2 = (const GAS float*)F.in[6]; const GAS float* mod = (const GAS float*)(F.ws + WS_MOD);
    const GAS bf16* MIXED = (const GAS bf16*)(F.ws + WS_MIXED); GAS bf16* X1 = (GAS bf16*)(F.ws + WS_X1); GAS bf16* H = (GAS bf16*)(F.ws + WS_H);
    const GAS bf16x8_t* rwt = (const GAS bf16x8_t*)(F.ws + WS_RWT); const float* b_grp = F.in[32]; const float* b_exp = F.in[34];
    unsigned* tokinfo = (unsigned*)(F.ws + WS_TOKINFO); int* list = (int*)(F.ws + WS_LIST);
    LAS float* slab = (LAS float*)(F.lds + F.wave * 16384) + F.lane * 8;
    LAS float* Lp = (LAS float*)F.lds;
    LAS float* red1 = (LAS float*)(F.lds + 131072); LAS float* red2 = red1 + 128; LAS float* Lf = red2 + 128;
    const int lo = F.lane & 15, hi = F.lane >> 4, k0 = 256 * F.wave + 8 * hi;
    const f32x4 z4 = (f32x4){0.f, 0.f, 0.f, 0.f};
    for (int tile = F.vcu; tile < NT / 16; tile += F.G) {
        const int row = tile * 16 + lo, b = tile >> 7;
        const size_t ro = (size_t)row * DM + k0;
        f32x4 xr[8][2];
#pragma unroll
        for (int s_ = 0; s_ < 8; ++s_) { xr[s_][0] = __builtin_nontemporal_load((const GAS f32x4*)(x + ro + 32 * s_)); xr[s_][1] = __builtin_nontemporal_load((const GAS f32x4*)(x + ro + 32 * s_ + 4)); }
        float ss = 0.f;
#pragma unroll
        for (int s_ = 0; s_ < 8; ++s_) { const u32x4 mw = __builtin_nontemporal_load((const GAS u32x4*)(MIXED + ro + 32 * s_)); const f32x4 a0 = (f32x4){bf_lo(mw.x), bf_hi(mw.x), bf_lo(mw.y), bf_hi(mw.y)}, a1 = (f32x4){bf_lo(mw.z), bf_hi(mw.z), bf_lo(mw.w), bf_hi(mw.w)};
            *(LAS f32x4*)(slab + s_ * 512) = a0; *(LAS f32x4*)(slab + s_ * 512 + 4) = a1;
            ss += (a0.x * a0.x + a0.y * a0.y) + (a0.z * a0.z + a0.w * a0.w) + (a1.x * a1.x + a1.y * a1.y) + (a1.z * a1.z + a1.w * a1.w); }
        ss += __shfl_xor(ss, 16); ss += __shfl_xor(ss, 32);
        if (hi == 0) red1[F.wave * 16 + lo] = ss;
        LDS_BARRIER();
        float tot = 0.f;
#pragma unroll
        for (int w = 0; w < 8; ++w) tot += red1[w * 16 + lo];
        const float rs = rsqrtf(tot * (1.f / DM) + RMS_EPS);
        float ss2 = 0.f;
        const GAS float* modb = mod + b * NMOD + k0;
#pragma unroll
        for (int s_ = 0; s_ < 8; ++s_) { f32x4 xo[2];
#pragma unroll
            for (int q = 0; q < 2; ++q) { const f32x4 xv = xr[s_][q], gv = *(const GAS f32x4*)(gpost + k0 + 32 * s_ + 4 * q), gt = *(const GAS f32x4*)(modb + 2 * DM + 32 * s_ + 4 * q);
                const f32x4 mm = *(const LAS f32x4*)(slab + s_ * 512 + 4 * q);
                const f32x4 v = xv + gt * (mm * rs * gv); *(LAS f32x4*)(slab + s_ * 512 + 4 * q) = v; xo[q] = v;
                ss2 += (v.x * v.x + v.y * v.y) + (v.z * v.z + v.w * v.w); }
            (void)xo; }
        ss2 += __shfl_xor(ss2, 16); ss2 += __shfl_xor(ss2, 32);
        if (hi == 0) red2[F.wave * 16 + lo] = ss2;
        LDS_BARRIER();
        float tot2 = 0.f;
#pragma unroll
        for (int w = 0; w < 8; ++w) tot2 += red2[w * 16 + lo];
        const float rs2 = rsqrtf(tot2 * (1.f / DM) + RMS_EPS);
        f32x4 acc[5] = {z4, z4, z4, z4, z4};
        bf16x8_t wA[10], wB[10]; f32x4 cA[6], cB[6];
#define RT_LOAD(W_, C_, st_) do { const GAS bf16x8_t* wb_ = rwt + (size_t)((F.wave * 8 + (st_)) * 10) * 64; \
            _Pragma("unroll") for (int j_ = 0; j_ < 10; ++j_) W_[j_] = wb_[j_ * 64 + F.lane]; \
            _Pragma("unroll") for (int q_ = 0; q_ < 2; ++q_) { C_[3 * q_] = *(const GAS f32x4*)(gpre2 + k0 + 32 * (st_) + 4 * q_); C_[3 * q_ + 1] = *(const GAS f32x4*)(modb + 3 * DM + 32 * (st_) + 4 * q_); C_[3 * q_ + 2] = *(const GAS f32x4*)(modb + 4 * DM + 32 * (st_) + 4 * q_); } } while (0)
#define RT_STEP(W_, C_, st_) do { f32x4 hv[2]; \
            u32x4 xb_; \
            _Pragma("unroll") for (int q_ = 0; q_ < 2; ++q_) { const f32x4 mm = *(const LAS f32x4*)(slab + (st_) * 512 + 4 * q_); hv[q_] = mm * rs2 * C_[3 * q_] * (C_[3 * q_ + 2] + 1.0f) + C_[3 * q_ + 1]; \
                if (q_ == 0) { xb_.x = pk2(mm.x, mm.y); xb_.y = pk2(mm.z, mm.w); } else { xb_.z = pk2(mm.x, mm.y); xb_.w = pk2(mm.z, mm.w); } } \
            *(LAS u32x4*)(slab + (st_) * 512 + 4) = xb_;     \
            u32x4 hh, hl; \
            hh.x = pk2(hv[0].x, hv[0].y); hh.y = pk2(hv[0].z, hv[0].w); hh.z = pk2(hv[1].x, hv[1].y); hh.w = pk2(hv[1].z, hv[1].w); \
            *(LAS u32x4*)(slab + (st_) * 512) = hh;        \
            hl.x = pk2(hv[0].x - bf_lo(hh.x), hv[0].y - bf_hi(hh.x)); hl.y = pk2(hv[0].z - bf_lo(hh.y), hv[0].w - bf_hi(hh.y)); \
            hl.z = pk2(hv[1].x - bf_lo(hh.z), hv[1].y - bf_hi(hh.z)); hl.w = pk2(hv[1].z - bf_lo(hh.w), hv[1].w - bf_hi(hh.w)); \
            const bf16x8_t fh = __builtin_bit_cast(bf16x8_t, hh), fl = __builtin_bit_cast(bf16x8_t, hl); \
            _Pragma("unroll") for (int jt = 0; jt < 5; ++jt) { acc[jt] = MFMA16(W_[2 * jt], fh, acc[jt]); acc[jt] = MFMA16(W_[2 * jt], fl, acc[jt]); acc[jt] = MFMA16(W_[2 * jt + 1], fh, acc[jt]); } } while (0)
        RT_LOAD(wA, cA, 0);
#pragma unroll 1
        for (int s2 = 0; s2 < 8; s2 += 2) { RT_LOAD(wB, cB, s2 + 1); RT_STEP(wA, cA, s2); RT_LOAD(wA, cA, (s2 + 2 < 8 ? s2 + 2 : 7)); RT_STEP(wB, cB, s2 + 1); }
#undef RT_LOAD
#undef RT_STEP
#pragma unroll
        for (int s_ = 0; s_ < 8; ++s_) { *(GAS u32x4*)(H + ro + 32 * s_) = *(const LAS u32x4*)(slab + s_ * 512); __builtin_nontemporal_store(*(const LAS u32x4*)(slab + s_ * 512 + 4), (GAS u32x4*)(X1 + ro + 32 * s_)); }
        LDS_WAIT(); asm volatile("" ::: "memory");
#pragma unroll
        for (int jt = 0; jt < 5; ++jt) *(LAS f32x4*)(Lp + F.wave * 4096 + lo * 80 + 16 * jt + 4 * hi) = acc[jt];
        LDS_BARRIER();
        for (int i = F.tid; i < 16 * 80; i += NTHR) { float sacc = 0.f;
#pragma unroll
            for (int w = 0; w < 8; ++w) sacc += Lp[w * 4096 + i];
            const int j = i % 80; Lf[i] = sacc + (j < 8 ? b_grp[j] : (j < 72 ? b_exp[j - 8] : 0.f)); }
        LDS_BARRIER();
        if (F.tid < 16) { const LAS float* lg = Lf + F.tid * 80; const int tok = tile * 16 + F.tid;
            int gi = 0; float gmax = lg[0];
#pragma unroll
            for (int j = 1; j < 8; ++j) if (lg[j] > gmax) { gmax = lg[j]; gi = j; }
            float gsum = 0.f;
#pragma unroll
            for (int j = 0; j < 8; ++j) gsum += __expf(lg[j] - gmax);
            const float pg = 1.f / gsum;
            const LAS float* le = lg + 8 + gi * 8; int i1 = 0; float m1 = le[0];
#pragma unroll
            for (int j = 1; j < 8; ++j) if (le[j] > m1) { m1 = le[j]; i1 = j; }
            int i2 = -1; float m2 = -INFINITY;
#pragma unroll
            for (int j = 0; j < 8; ++j) if (j != i1 && le[j] > m2) { m2 = le[j]; i2 = j; }
            const float e2 = __expf(m2 - m1); const float g1 = pg / (1.f + e2), g2 = pg * e2 / (1.f + e2);
            const int x1i = gi * 8 + i1, x2i = gi * 8 + i2;
            const unsigned p1 = atomicAdd(F.ctl + CW_CNT + 64 * x1i, 1u), p2 = atomicAdd(F.ctl + CW_CNT + 64 * x2i, 1u);
            list[x1i * NT + p1] = tok; list[x2i * NT + p2] = tok;
            u32x4 a; a.x = (unsigned)x1i; a.y = p1; a.z = (unsigned)x2i; a.w = p2; *(u32x4*)(tokinfo + (size_t)tok * 8) = a;
            u32x2 g; g.x = __float_as_uint(g1); g.y = __float_as_uint(g2); *(u32x2*)(tokinfo + (size_t)tok * 8 + 4) = g;
        }
    }
    __syncthreads();
}

__device__ __forceinline__ void conv_item_src(const Frame& F, int it, const float*& W, int& N, bf16*& WT, int& ldk, int& drow, int& k0, int& n0) {
    if (it < NEXP * 1024) { const int e = it >> 10, r = it & 1023, which = r >> 9, rr = r & 511; k0 = (rr >> 4) * 64; n0 = (rr & 15) * 32;
        W = F.in[which ? 36 : 35] + (size_t)e * DM * DEXP; N = DEXP; WT = (bf16*)(F.ws + WS_EW1) + (size_t)e * 1024 * DM; ldk = DM; drow = (n0 >> 7) * 256 + which * 128 + (n0 & 127); }
    else { const int j = it - NEXP * 1024, e = j >> 9, r = j & 511; k0 = (r >> 6) * 64; n0 = (r & 63) * 32;
        W = F.in[37] + (size_t)e * DEXP * DM; N = DM; WT = (bf16*)(F.ws + WS_EW2) + (size_t)e * DM * DEXP; ldk = DEXP; drow = n0; }
}
struct ConvItem { const GAS float* src; GAS bf16* dst; int ldk; };
__device__ __forceinline__ void conv_decode(const Frame& F, int it, int lane, ConvItem& ci, int& N) {
    const float* W; int ldk, drow, k0, n0; bf16* WT; conv_item_src(F, it, W, N, WT, ldk, drow, k0, n0);
    ci.src = (const GAS float*)W + (size_t)(k0 + (lane >> 3)) * N + n0 + 4 * (lane & 7); ci.dst = (GAS bf16*)WT + (size_t)(drow + (lane >> 3)) * ldk + k0 + 8 * (lane & 7); ci.ldk = ldk;
}
__device__ __forceinline__ int conv_stream(const Frame& F, int first, int step, int total, const unsigned* stopw) {
    LAS float* scr = (LAS float*)(F.lds + F.wave * 16384);
    const int lane = F.lane;
    f32x4 bA[8], bB[8], bC[8]; ConvItem iA, iB, iC; int done = 0;
#define CV_LOAD(buf, ci, idx) do { int N_; conv_decode(F, (idx) < total ? (idx) : total - 1, lane, ci, N_); _Pragma("unroll") for (int i_ = 0; i_ < 8; ++i_) buf[i_] = __builtin_nontemporal_load((const GAS f32x4*)(ci.src + (size_t)(8 * i_) * N_)); } while (0)
#define CV_PROC(buf, ci) do { _Pragma("unroll") for (int i_ = 0; i_ < 8; ++i_) *(LAS f32x4*)(scr + (8 * i_ + (lane >> 3)) * 36 + 4 * (lane & 7)) = buf[i_]; \
        LDS_WAIT(); asm volatile("" ::: "memory"); \
        { const int c_ = lane & 7; _Pragma("unroll") for (int j_ = 0; j_ < 4; ++j_) { const LAS float* sp = scr + (8 * c_) * 36 + (lane >> 3) + 8 * j_; \
              u32x4 o; o.x = pk2(sp[0 * 36], sp[1 * 36]); o.y = pk2(sp[2 * 36], sp[3 * 36]); o.z = pk2(sp[4 * 36], sp[5 * 36]); o.w = pk2(sp[6 * 36], sp[7 * 36]); \
              __builtin_nontemporal_store(o, (GAS u32x4*)(ci.dst + (size_t)(8 * j_) * ci.ldk)); } } \
        LDS_WAIT(); asm volatile("" ::: "memory"); ++done; } while (0)
#define CV_STOPLD() __hip_atomic_load((const GAS unsigned*)stopw, RLX_AGENT)
#define CV_STOP(v) (__builtin_amdgcn_readfirstlane((int)(v)) != 0)
    int it = first;
    CV_LOAD(bA, iA, it); CV_LOAD(bB, iB, it + step);
    while (it < total) {
        unsigned sv = CV_STOPLD();
        CV_LOAD(bC, iC, it + 2 * step);
        CV_PROC(bA, iA); if (CV_STOP(sv)) break;
        if (it + step >= total) break;
        sv = CV_STOPLD();
        CV_LOAD(bA, iA, it + 3 * step);
        CV_PROC(bB, iB); if (CV_STOP(sv)) break;
        if (it + 2 * step >= total) break;
        sv = CV_STOPLD();
        CV_LOAD(bB, iB, it + 4 * step);
        CV_PROC(bC, iC); if (CV_STOP(sv)) break;
        it += 3 * step;
    }
#undef CV_STOPLD
#undef CV_LOAD
#undef CV_PROC
#undef CV_STOP
    return done;
}
__device__ __forceinline__ void p12_expert_convert(const Frame& F0) {
    PHASE_VIEW();
    volatile LAS int* red = (volatile LAS int*)(F.lds + 131072);
    const int ncw = (F.G >= 256) ? (F.G - CONV_GEMM_BLOCKS) * NWAVES : 0;
    __syncthreads();
    if (F.tid == 0) red[0] = 0x7fffffff;
    __syncthreads();
    for (int i = F.tid; i < ncw; i += NTHR) atomicMin((int*)red, (int)__hip_atomic_load(F.ctl + CW_PROG + i, RLX_AGENT));
    __syncthreads();
    const int start = ncw ? red[0] * ncw : 0;
    __syncthreads();
    const int gw = F.vcu * NWAVES + F.wave, NGW = F.G * NWAVES;
    (void)conv_stream(F, start + gw, NGW, CONV_MAIN, F.ctl + CW_TMO + 2);
}

__device__ __forceinline__ void moe_build_tp(const Frame& F0) {
    PHASE_VIEW();
    volatile LAS int* tp = (volatile LAS int*)(F.lds + TP_OFF);
    __syncthreads();
    if (F.tid < NEXP) { const unsigned c = __hip_atomic_load(F.ctl + CW_CNT + 64 * F.tid, RLX_AGENT); tp[80 + F.tid] = (int)((c + 255u) >> 8); tp[160 + F.tid] = (int)c; }
    __syncthreads();
    if (F.tid == 0) { int s = 0; for (int e = 0; e < NEXP; ++e) { tp[e] = s; s += tp[80 + e]; } tp[NEXP] = s; }
    __syncthreads();
}
template <bool G1> struct MoeOrder {
    static constexpr bool GATHER = G1; static constexpr int A2 = 0;
    static constexpr int NNT = G1 ? 4 : 8, KK = G1 ? DM : DEXP;
    __device__ __forceinline__ size_t kstepA() const { return 128; }
    __device__ __forceinline__ size_t hstepA() const { return (size_t)128 * KK * 2; }
    __device__ __forceinline__ size_t a2off() const { return 0; }
    const LAS int* tp; const unsigned* cntw; const int* list; const char* A; const char* EW; int G, c;
    __device__ bool next(int i, pg8::Unit& u) const {
        const int x = c & 7, r = c >> 3, W = G >> 3;
        const int L = i * W + r, tl = L / NNT; u.pn = L % NNT;
        int cum = 0, e = -1, mt = 0;
#pragma unroll
        for (int j = 0; j < 8; ++j) { const int nj = tp[80 + x + 8 * j]; if (e < 0 && tl < cum + nj) { e = x + 8 * j; mt = tl - cum; } cum += nj; }
        if (e < 0) return false;
        e = __builtin_amdgcn_readfirstlane(e); mt = __builtin_amdgcn_readfirstlane(mt);
        const int tile = tp[e] + mt;
        u.e = e; u.pm = tile; u.cnt = tp[160 + e] - mt * 256;
        u.Bb = EW + ((size_t)e * (G1 ? 1024 : DM) + (size_t)u.pn * 256) * KK * 2;
        u.Ab = G1 ? A : A + (size_t)tile * 256 * KK * 2;
        return true;
    }
    template <int NV> __device__ __forceinline__ void a_voff(const pg8::Unit& u, unsigned (&v)[NV][2], const int (&R)[2], const int (&C)[2]) const {
        if constexpr (G1) {
            const int mt = u.pm - tp[u.e];
#pragma unroll
            for (int h = 0; h < 2; ++h)
#pragma unroll
                for (int i = 0; i < 2; ++i) { const int rr = h * 128 + R[i]; const int tok = list[u.e * NT + mt * 256 + (rr < u.cnt ? rr : 0)]; v[h][i] = (unsigned)(tok * KK + C[i]) * 2u; }
        } else {
#pragma unroll
            for (int i = 0; i < 2; ++i) v[0][i] = (unsigned)(R[i] * KK + C[i]) * 2u;
        }
    }
};

__device__ __forceinline__ void p15_final(const Frame& F0) {
    PHASE_VIEW();
    const GAS bf16* X1 = (const GAS bf16*)(F.ws + WS_X1); const GAS bf16* YS = (const GAS bf16*)(F.ws + WS_YSLOT); const GAS unsigned* tokinfo = (const GAS unsigned*)(F.ws + WS_TOKINFO);
    const GAS float* gpost2 = (const GAS float*)F.in[7]; const GAS float* mod = (const GAS float*)(F.ws + WS_MOD); GAS float* out = (GAS float*)F.out;
    const LAS int* tp = (const LAS int*)(F.lds + TP_OFF);
    const int gw = F.vcu * NWAVES + F.wave, NGW = F.G * NWAVES;
    f32x4 gv[8];
#pragma unroll
    for (int j = 0; j < 8; ++j) gv[j] = *(const GAS f32x4*)(gpost2 + 4 * (F.lane + 64 * j));
    u32x4 tin = *(const GAS u32x4*)(tokinfo + (size_t)gw * 8); u32x2 tgn = *(const GAS u32x2*)(tokinfo + (size_t)gw * 8 + 4);
    for (int row = gw; row < NT; row += NGW) {
        const int b = row >> 11;
        const u32x4 ti = tin; const u32x2 tg = tgn;
        const size_t r1 = (size_t)tp[ti.x] * 256 + ti.y, r2 = (size_t)tp[ti.z] * 256 + ti.w; const float g1 = __uint_as_float(tg.x), g2 = __uint_as_float(tg.y);
        const GAS u32x2* y1 = (const GAS u32x2*)(YS + r1 * DM) + F.lane; const GAS u32x2* y2 = (const GAS u32x2*)(YS + r2 * DM) + F.lane; const GAS u32x2* xp = (const GAS u32x2*)(X1 + (size_t)row * DM) + F.lane;
        u32x2 ya[8], yb[8], xw[8]; f32x4 gt[8];
#pragma unroll
        for (int j = 0; j < 8; ++j) { ya[j] = __builtin_nontemporal_load(y1 + 64 * j); yb[j] = __builtin_nontemporal_load(y2 + 64 * j); xw[j] = __builtin_nontemporal_load(xp + 64 * j); gt[j] = *(const GAS f32x4*)(mod + b * NMOD + 5 * DM + 4 * (F.lane + 64 * j)); }
        { const int rn = (row + NGW < NT) ? row + NGW : row; tin = *(const GAS u32x4*)(tokinfo + (size_t)rn * 8); tgn = *(const GAS u32x2*)(tokinfo + (size_t)rn * 8 + 4); }
        f32x4 v[8]; float ss = 0.f;
#pragma unroll
        for (int j = 0; j < 8; ++j) { const u32x2 a = ya[j], c = yb[j];
            v[j] = (f32x4){bf_lo(a.x), bf_hi(a.x), bf_lo(a.y), bf_hi(a.y)} * g1 + (f32x4){bf_lo(c.x), bf_hi(c.x), bf_lo(c.y), bf_hi(c.y)} * g2;
            ss += (v[j].x * v[j].x + v[j].y * v[j].y) + (v[j].z * v[j].z + v[j].w * v[j].w); }
        const float rs = rsqrtf(wave_sum_dpp(ss) * (1.f / DM) + RMS_EPS);
#pragma unroll
        for (int j = 0; j < 8; ++j) { const f32x4 xv = (f32x4){bf_lo(xw[j].x), bf_hi(xw[j].x), bf_lo(xw[j].y), bf_hi(xw[j].y)}; v[j] = xv + gt[j] * (v[j] * rs * gv[j]); }
#pragma unroll
        for (int j = 0; j < 8; ++j) __builtin_nontemporal_store(v[j], (GAS f32x4*)(out + (size_t)row * DM) + F.lane + 64 * j);
    }
}

constexpr int NPH = 15;
__global__ void __launch_bounds__(NTHR, 2) mk_fwd(Args args) {
    extern __shared__ __attribute__((aligned(16))) unsigned char lds[];
    Frame F0;
    F0.lds = (LAS unsigned char*)lds; F0.MISC = (volatile LAS unsigned*)(F0.lds + MISC_OFF);
    F0.tid = threadIdx.x; F0.lane = F0.tid & 63; F0.wave = __builtin_amdgcn_readfirstlane(F0.tid >> 6);
    F0.G = gridDim.x; { const int bx = blockIdx.x; F0.vcu = (F0.G % 8 == 0) ? (bx % 8) * (F0.G / 8) + bx / 8 : bx; }
    F0.in.kp = (kargp_t)__builtin_amdgcn_kernarg_segment_ptr(); F0.out = args.out; F0.ws = args.ws; F0.ctl = (unsigned*)(args.ws + WS_CTL);
    if (F0.tid < 64) F0.MISC[F0.tid] = 0u;
    __syncthreads();
    const int lo = args.ph_lo, hi = args.ph_hi;
    XcdBarrier bar; bar.bar = F0.ctl + CW_BAR; bar.x = 0; bar.st = nullptr;
    if (hi - lo > 1) bar = xcd_barrier_post(F0.ctl + CW_BAR, F0.MISC + 8);
#ifndef PROBE_MASK
#define PROBE_MASK 0
#endif
#define REPS(k) ((((PROBE_MASK) >> (k)) & 1) + 1)
#define IN(k) (lo <= (k) && (k) < hi)
#define SEAM(k) do { if (IN(k) && IN((k) + 1)) xcd_barrier(bar); } while (0)
    LAS unsigned char* ring = F0.lds;

    if (IN(0)) for (int rep_ = 0; rep_ < REPS(0); ++rep_) { p0_prologue(F0); } SEAM(0);
    if (IN(1)) for (int rep_ = 0; rep_ < REPS(1); ++rep_) { p1_h1(F0); } SEAM(1);
    if (IN(2)) for (int rep_ = 0; rep_ < REPS(2); ++rep_) {
        PHASE_VIEW();
        const int G_GEMM = (F.G >= 256) ? CONV_GEMM_BLOCKS : F.G;
        if ((int)blockIdx.x < G_GEMM) {
            pg8::Gemm g{(const bf16*)(F.ws + WS_H), (const bf16*)(F.ws + WS_WIN_T), NT, DIN, DM}; pg8::StaticOrder S; S.init(g, G_GEMM, (int)blockIdx.x);
            pg8::EpiBf16 E{(bf16*)(F.ws + WS_PROJ), DIN};
            pg8::gemm_phase(ring, DM, S, E);
            __syncthreads();
            if (F.tid == 0 && rep_ == 0) { const unsigned d = atomicAdd(F.ctl + CW_GDONE, 1u); if (d == (unsigned)G_GEMM - 1u) __hip_atomic_store(F.ctl + CW_STOP, 1u, RLX_AGENT); }
        } else if (rep_ == 0) {
            const int jw = ((int)blockIdx.x - G_GEMM) * NWAVES + F.wave, ncw = (F.G - G_GEMM) * NWAVES;
            const int done = conv_stream(F, jw, ncw, CONV_MAIN, F.ctl + CW_STOP);
            if (F.lane == 0) __hip_atomic_store(F.ctl + CW_PROG + jw, (unsigned)done, RLX_AGENT);
        }
    } SEAM(2);
    if (IN(3)) for (int rep_ = 0; rep_ < REPS(3); ++rep_) {
        PHASE_VIEW();
        S5Order<1> S{(const char*)(F.ws + WS_PROJ), (const char*)(F.ws + WS_SIN), (const char*)(F.ws + WS_S5WT), F.G, F.vcu};
        pg8::EpiS5Scan E{(bf16*)(F.ws + WS_SIN), F.in[10], F.in[11], F.in[12]};
        if (F.G >= NG * 4) pg8::gemm_phase(ring, 256, S, E);
    }
    if (IN(3) && IN(4)) { asm volatile("s_waitcnt vmcnt(0)" ::: "memory"); __syncthreads(); __builtin_amdgcn_fence(__ATOMIC_ACQUIRE, "agent"); asm volatile("s_waitcnt vmcnt(0)" ::: "memory"); __syncthreads(); }
    if (IN(4)) for (int rep_ = 0; rep_ < REPS(4); ++rep_) {
        PHASE_VIEW();
        S5Order<2> S{(const char*)(F.ws + WS_PROJ), (const char*)(F.ws + WS_SIN), (const char*)(F.ws + WS_S5MT), F.G, F.vcu};
        pg8::EpiS5Y E{(bf16*)(F.ws + WS_YSG)};
        int kk = 384; LAUNDER(kk);
        pg8::gemm_phase(ring, kk, S, E);
    } SEAM(4);
    if (IN(5)) for (int rep_ = 0; rep_ < REPS(5); ++rep_) {
        PHASE_VIEW();
        pg8::Gemm g{(const bf16*)(F.ws + WS_YSG), (const bf16*)(F.ws + WS_GLU_T), NT, DSSM, DSSM}; pg8::StaticOrder S; S.init(g, F.G, (int)blockIdx.x);
        pg8::EpiGlu E{(const bf16*)(F.ws + WS_YSG), (bf16*)(F.ws + WS_MIX), DM, F.in[19]};
        pg8::gemm_phase(ring, DSSM, S, E);
    }
    if (IN(6)) for (int rep_ = 0; rep_ < REPS(6); ++rep_) { p9a_rwkv_chunks(F0); } SEAM(6);
    if (IN(7)) for (int rep_ = 0; rep_ < REPS(7); ++rep_) { p9b_rwkv_seq(F0); } SEAM(7);
    if (IN(8)) for (int rep_ = 0; rep_ < REPS(8); ++rep_) { p9_rwkv_post(F0); } SEAM(8);
    if (IN(9)) for (int rep_ = 0; rep_ < REPS(9); ++rep_) {
        PHASE_VIEW();
        pg8::Gemm g{(const bf16*)(F.ws + WS_MIX), (const bf16*)(F.ws + WS_WOUT_T), NT, DM, DM}; pg8::StaticOrder S; S.init(g, F.G, (int)blockIdx.x);
        pg8::EpiBf16 E{(bf16*)(F.ws + WS_MIXED), DM};
        pg8::gemm_phase(ring, DM, S, E);
    } SEAM(9);
    if (IN(10)) for (int rep_ = 0; rep_ < REPS(10); ++rep_) { p11_x1_router(F0); }
    if (IN(11)) for (int rep_ = 0; rep_ < REPS(11); ++rep_) { p12_expert_convert(F0); } SEAM(11);
    if (IN(12)) for (int rep_ = 0; rep_ < REPS(12); ++rep_) {
        PHASE_VIEW();
        moe_build_tp(F);
        MoeOrder<true> S{(const LAS int*)(F.lds + TP_OFF), F.ctl + CW_CNT, (const int*)(F.ws + WS_LIST), (const char*)(F.ws + WS_H), (const char*)(F.ws + WS_EW1), F.G, (int)blockIdx.x};
        pg8::EpiSwiglu E{(bf16*)(F.ws + WS_HID)};
        pg8::gemm_phase(ring, DM, S, E);
        __syncthreads();
        for (;;) { int base = 0; if (F.lane == 0) base = (int)atomicAdd(F.ctl + CW_POOL, (unsigned)CONV_CLAIM); base = __builtin_amdgcn_readfirstlane(base);
            if (base >= CONV_POOL) break;
            (void)conv_stream(F, CONV_MAIN + base, 1, CONV_MAIN + (base + CONV_CLAIM < CONV_POOL ? base + CONV_CLAIM : CONV_POOL), F.ctl + CW_TMO + 2); }
    } SEAM(12);
    if (IN(13)) for (int rep_ = 0; rep_ < REPS(13); ++rep_) {
        PHASE_VIEW();
        if (!IN(12)) moe_build_tp(F);
        MoeOrder<false> S{(const LAS int*)(F.lds + TP_OFF), F.ctl + CW_CNT, (const int*)(F.ws + WS_LIST), (const char*)(F.ws + WS_HID), (const char*)(F.ws + WS_EW2), F.G, (int)blockIdx.x};
        pg8::EpiBf16 E{(bf16*)(F.ws + WS_YSLOT), DM};
        pg8::gemm_phase(ring, DEXP, S, E);
    } SEAM(13);
    if (IN(14)) for (int rep_ = 0; rep_ < REPS(14); ++rep_) { if (!IN(13)) moe_build_tp(F0); p15_final(F0); }
#undef IN
#undef SEAM
}

extern "C" void kernel_launch(void* const* d_in, const int* in_sizes, int n_in, void* d_out, int out_size, void* d_ws, size_t ws_size, hipStream_t stream) {
    static int grid = 0;
    if (grid == 0) {
        if (n_in != 38 || out_size != NT * DM || ws_size < WS_END) { fprintf(stderr, "kernel_launch: unexpected problem (n_in %d, out %d, ws %zu < %zu)\n", n_in, out_size, ws_size, (size_t)WS_END); grid = -1; return; }
        int dev = 0, cus = 0, per_cu = 0;
        if (hipGetDevice(&dev) != hipSuccess || hipDeviceGetAttribute(&cus, hipDeviceAttributeMultiprocessorCount, dev) != hipSuccess) { grid = -1; return; }
        if (hipFuncSetAttribute((const void*)mk_fwd, hipFuncAttributeMaxDynamicSharedMemorySize, LDS_BYTES) != hipSuccess) { fprintf(stderr, "kernel_launch: hipFuncSetAttribute failed\n"); grid = -1; return; }
        if (hipOccupancyMaxActiveBlocksPerMultiprocessor(&per_cu, (const void*)mk_fwd, NTHR, LDS_BYTES) != hipSuccess || per_cu < 1) fprintf(stderr, "kernel_launch: occupancy query says %d\n", per_cu);
        (void)hipGetLastError();
        grid = cus;
    }
    if (grid < 0) return;
    if (hipMemsetAsync((char*)d_ws + WS_CTL, 0, CTL_ZERO_BYTES, stream) != hipSuccess) return;
    Args a{};
    for (int i = 0; i < 38; ++i) a.in[i] = (const float*)d_in[i];
    a.out = (float*)d_out; a.ws = (unsigned char*)d_ws;
#if MK_N_LAUNCHES == 1
    a.ph_lo = 0; a.ph_hi = NPH;
    hipLaunchKernelGGL(mk_fwd, dim3(grid), dim3(NTHR), LDS_BYTES, stream, a);
#else
    for (int p = 0; p < NPH; ++p) { a.ph_lo = p; a.ph_hi = p + 1; hipLaunchKernelGGL(mk_fwd, dim3(grid), dim3(NTHR), LDS_BYTES, stream, a); }
#endif
}
```
